# Optimizing an MI355X kernel written in HIP

```python
import jax, jax.numpy as jnp
from jax import lax
import numpy as np

D_MODEL = 1024
BATCH = 2
SEQ = 8192
DEPTH = 1

POOL_WINDOWS = (2, 4, 8, 16)
POOL_GROUPS = len(POOL_WINDOWS)
POOL_WIDTH = D_MODEL // 2
POOL_GROUP_DIM = POOL_WIDTH // POOL_GROUPS
ATTN_HEADS = 8
HEAD_DIM = 64
ATTN_WIDTH = ATTN_HEADS * HEAD_DIM
MOBA_BLOCK = 256
MOBA_TOPK = 3
MOBA_Q_CHUNK = 64
ROPE_THETA = 500000.0
ROT_DIM = HEAD_DIM // 4
N_BRANCHES = 2
IN_PROJ_WIDTH = POOL_WIDTH + 3 * ATTN_WIDTH + N_BRANCHES * D_MODEL
PEER_HEADS = 8
PEER_NKEYS = 128
PEER_EXPERTS = PEER_NKEYS * PEER_NKEYS
PEER_QDIM = 256
PEER_HALF = PEER_QDIM // 2
PEER_TOPK = 16
PEER_TOKEN_CHUNK = 128
EPS = 1e-6
NEG = -1e30

kernel_name = "hybrid_pool_moba_peer_adaln"


def rmsnorm(x, g):
    xf = x.astype(jnp.float32)
    y = xf * lax.rsqrt(jnp.mean(xf * xf, axis=-1, keepdims=True) + EPS)
    return (y * g.astype(jnp.float32)).astype(x.dtype)


def modulate(x, g, shift, scale):
    return rmsnorm(x, g) * (1 + scale[:, None, :]) + shift[:, None, :]


def rope_partial(x, pos):
    half = ROT_DIM // 2
    inv = ROPE_THETA ** (-jnp.arange(half, dtype=jnp.float32) / half)
    ang = pos.astype(jnp.float32)[:, None] * inv[None, :]
    cos = jnp.cos(ang).astype(x.dtype)
    sin = jnp.sin(ang).astype(x.dtype)
    x1, x2, rest = x[..., :half], x[..., half:ROT_DIM], x[..., ROT_DIM:]
    return jnp.concatenate([x1 * cos - x2 * sin, x1 * sin + x2 * cos, rest], axis=-1)


def pool_mixer(u, pool_w, pool_scale):
    B, S, _ = u.shape
    uf = u.astype(jnp.float32)
    cs = jnp.cumsum(uf, axis=1)
    cs = jnp.concatenate([jnp.zeros_like(cs[:, :1]), cs], axis=1)
    pos = jnp.arange(S)
    groups = []
    for g, w in enumerate(POOL_WINDOWS):
        sl = slice(g * POOL_GROUP_DIM, (g + 1) * POOL_GROUP_DIM)
        lo = jnp.maximum(pos + 1 - w, 0)
        win_sum = cs[:, 1:, sl] - cs[:, lo, sl]
        cnt = jnp.minimum(pos + 1, w).astype(jnp.float32)[None, :, None]
        groups.append(win_sum / cnt)
    pooled = jnp.stack(groups, axis=2)
    diff = pooled - uf.reshape(B, S, POOL_GROUPS, POOL_GROUP_DIM)
    mixed = jnp.einsum('bsgi,gio->bsgo', diff, pool_w.astype(jnp.float32))
    mixed = mixed.reshape(B, S, POOL_WIDTH) * pool_scale.astype(jnp.float32)
    return mixed.astype(u.dtype)


def moba_attention(q, k, v):
    B, H, S, dh = q.shape
    n_blocks = -(-S // MOBA_BLOCK)
    pad = n_blocks * MOBA_BLOCK - S
    kp = jnp.pad(k, ((0, 0), (0, 0), (0, pad), (0, 0)))
    vp = jnp.pad(v, ((0, 0), (0, 0), (0, pad), (0, 0)))
    k_blocks = kp.reshape(B, H, n_blocks, MOBA_BLOCK, dh)
    v_blocks = vp.reshape(B, H, n_blocks, MOBA_BLOCK, dh)
    k_mean = jnp.mean(k_blocks.astype(jnp.float32), axis=3)
    topk = min(MOBA_TOPK, n_blocks)
    scale = HEAD_DIM ** -0.5
    bi = jnp.arange(B)[:, None, None, None]
    hi = jnp.arange(H)[None, :, None, None]
    blk_ids = jnp.arange(n_blocks)
    key_off = jnp.arange(MOBA_BLOCK)

    def chunk(start):
        q_c = lax.dynamic_slice_in_dim(q, start, MOBA_Q_CHUNK, axis=2)
        q_pos = start + jnp.arange(MOBA_Q_CHUNK)
        q_blk = q_pos // MOBA_BLOCK
        gate = jnp.einsum('bhcd,bhnd->bhcn', q_c.astype(jnp.float32), k_mean)
        past = blk_ids[None, :] < q_blk[:, None]
        gate = jnp.where(past, gate, -jnp.inf)
        _, sel = lax.top_k(gate, topk)
        sel_valid = sel < q_blk[:, None]
        k_sel = k_blocks[bi, hi, sel]
        v_sel = v_blocks[bi, hi, sel]
        s_past = jnp.einsum('bhcd,bhcjld->bhcjl', q_c, k_sel).astype(jnp.float32) * scale
        s_past = jnp.where(sel_valid[..., None], s_past, NEG)
        own = start // MOBA_BLOCK
        k_own = lax.dynamic_index_in_dim(k_blocks, own, axis=2, keepdims=False)
        v_own = lax.dynamic_index_in_dim(v_blocks, own, axis=2, keepdims=False)
        s_own = jnp.einsum('bhcd,bhld->bhcl', q_c, k_own).astype(jnp.float32) * scale
        k_pos = own * MOBA_BLOCK + key_off
        s_own = jnp.where(k_pos[None, :] <= q_pos[:, None], s_own, NEG)
        s = jnp.concatenate([s_past.reshape(B, H, MOBA_Q_CHUNK, topk * MOBA_BLOCK), s_own], axis=-1)
        p = jax.nn.softmax(s, axis=-1)
        p_past = p[..., :topk * MOBA_BLOCK].reshape(B, H, MOBA_Q_CHUNK, topk, MOBA_BLOCK).astype(v.dtype)
        p_own = p[..., topk * MOBA_BLOCK:].astype(v.dtype)
        return (jnp.einsum('bhcjl,bhcjld->bhcd', p_past, v_sel)
                + jnp.einsum('bhcl,bhld->bhcd', p_own, v_own))

    starts = jnp.arange(S // MOBA_Q_CHUNK) * MOBA_Q_CHUNK
    out = lax.map(chunk, starts)
    return out.transpose(1, 2, 0, 3, 4).reshape(B, H, S, dh)


def peer_ffn(h, w_q, sub_keys, u_tab, v_tab):
    B, S, D = h.shape
    T = B * S
    hf = h.reshape(T, D)
    q = (hf @ w_q).reshape(T, PEER_HEADS, 2, PEER_HALF)
    s = jnp.einsum('thpd,hpnd->thpn', q, sub_keys).astype(jnp.float32)
    sv, si = lax.top_k(s, PEER_TOPK)
    cand = sv[:, :, 0, :, None] + sv[:, :, 1, None, :]
    cand_idx = si[:, :, 0, :, None] * PEER_NKEYS + si[:, :, 1, None, :]
    cv, ci = lax.top_k(cand.reshape(T, PEER_HEADS, PEER_TOPK * PEER_TOPK), PEER_TOPK)
    expert = jnp.take_along_axis(cand_idx.reshape(T, PEER_HEADS, PEER_TOPK * PEER_TOPK), ci, axis=-1)
    g = jax.nn.softmax(cv, axis=-1)
    nc = T // PEER_TOKEN_CHUNK

    def chunk(args):
        x_c, e_c, g_c = args
        u = u_tab[e_c]
        vv = v_tab[e_c]
        a = jax.nn.gelu(jnp.einsum('cd,chkd->chk', x_c, u).astype(jnp.float32), approximate=False)
        return jnp.einsum('chk,chkd->cd', (g_c * a).astype(vv.dtype), vv)

    out = lax.map(chunk, (hf.reshape(nc, PEER_TOKEN_CHUNK, D),
                          expert.reshape(nc, PEER_TOKEN_CHUNK, PEER_HEADS, PEER_TOPK),
                          g.reshape(nc, PEER_TOKEN_CHUNK, PEER_HEADS, PEER_TOPK)))
    return out.reshape(B, S, D).astype(h.dtype)


def setup_inputs(seed: int = 0) -> dict:
    key = jax.random.key(seed)
    ks = jax.random.split(key, 20)
    D = D_MODEL
    nrm = lambda k, shape, s: jax.random.normal(k, shape, jnp.float32) * s
    return {
        "x": nrm(ks[0], (BATCH, SEQ, D), 1.0),
        "c": nrm(ks[1], (BATCH, D), 1.0),
        "w_ada": nrm(ks[2], (DEPTH, D, 6 * D), 0.5 * D ** -0.5),
        "b_ada": nrm(ks[3], (DEPTH, 6 * D), 0.01),
        "norm_mix_g": 1.0 + nrm(ks[4], (DEPTH, D), 0.02),
        "w_in": nrm(ks[5], (DEPTH, D, IN_PROJ_WIDTH), D ** -0.5),
        "pool_w": nrm(ks[6], (DEPTH, POOL_GROUPS, POOL_GROUP_DIM, POOL_GROUP_DIM), POOL_GROUP_DIM ** -0.5),
        "pool_scale": 1.0 + nrm(ks[7], (DEPTH, POOL_WIDTH), 0.1),
        "w_branch_pool": nrm(ks[8], (DEPTH, POOL_WIDTH, D), POOL_WIDTH ** -0.5),
        "w_branch_attn": nrm(ks[9], (DEPTH, ATTN_WIDTH, D), ATTN_WIDTH ** -0.5),
        "w_out": nrm(ks[10], (DEPTH, D, D), D ** -0.5),
        "norm_ffn_g": 1.0 + nrm(ks[11], (DEPTH, D), 0.02),
        "peer_wq": nrm(ks[12], (DEPTH, D, PEER_HEADS * PEER_QDIM), D ** -0.5),
        "peer_sub_keys": nrm(ks[13], (DEPTH, PEER_HEADS, 2, PEER_NKEYS, PEER_HALF), PEER_HALF ** -0.5),
        "peer_u": nrm(ks[14], (DEPTH, PEER_EXPERTS, D), D ** -0.5),
        "peer_v": nrm(ks[15], (DEPTH, PEER_EXPERTS, D), 0.5),
        "norm_final_g": 1.0 + nrm(ks[16], (D,), 0.02),
    }


def reference(x, c, w_ada, b_ada, norm_mix_g, w_in, pool_w, pool_scale, w_branch_pool,
              w_branch_attn, w_out, norm_ffn_g, peer_wq, peer_sub_keys, peer_u, peer_v,
              norm_final_g):
    B, S, D = x.shape
    pos = jnp.arange(S)
    c_act = jax.nn.silu(c)
    for l in range(DEPTH):
        mod = c_act @ w_ada[l] + b_ada[l]
        shift1, scale1, gate1, shift2, scale2, gate2 = jnp.split(mod, 6, axis=-1)

        h = modulate(x, norm_mix_g[l], shift1, scale1)
        proj = h @ w_in[l]
        u_pool = proj[..., :POOL_WIDTH]
        qkv = proj[..., POOL_WIDTH:POOL_WIDTH + 3 * ATTN_WIDTH]
        gates = proj[..., POOL_WIDTH + 3 * ATTN_WIDTH:]
        qkv = qkv.reshape(B, S, 3, ATTN_HEADS, HEAD_DIM).transpose(2, 0, 3, 1, 4)
        q = rope_partial(qkv[0], pos)
        k = rope_partial(qkv[1], pos)
        attn = moba_attention(q, k, qkv[2]).transpose(0, 2, 1, 3).reshape(B, S, ATTN_WIDTH)
        pooled = pool_mixer(u_pool, pool_w[l], pool_scale[l])
        g_pool = jax.nn.sigmoid(gates[..., :D])
        g_attn = jax.nn.sigmoid(gates[..., D:])
        merged = g_pool * (pooled @ w_branch_pool[l]) + g_attn * (attn @ w_branch_attn[l])
        x = x + gate1[:, None, :] * (merged @ w_out[l])

        h2 = modulate(x, norm_ffn_g[l], shift2, scale2)
        x = x + gate2[:, None, :] * peer_ffn(h2, peer_wq[l], peer_sub_keys[l], peer_u[l], peer_v[l])
    return rmsnorm(x, norm_final_g)
```

```cpp
#include <hip/hip_runtime.h>
#include <cstdio>
#include <cstdint>

constexpr int BATCH = 2, SEQ = 8192, D = 1024, M = BATCH * SEQ;
constexpr int NPROJ = 4096, PW = 512, AW = 512, NH = 8, HD = 64, MBLK = 256, NBLK = SEQ / MBLK;
constexpr int PHEADS = 8, NKEYS = 128, PQD = 256, PHALF = 128, PTOPK = 16, NEXP = NKEYS * NKEYS, NSEL = PHEADS * PTOPK;
constexpr float EPS = 1e-6f;
constexpr float C2 = 0.125f * 1.4426950408889634f;

typedef unsigned short bf16;
__device__ __forceinline__ float bf2f(bf16 v) { return __uint_as_float(((unsigned)v) << 16); }
__device__ __forceinline__ bf16 f2bf(float f) { unsigned u = __float_as_uint(f); return (bf16)((u + 0x7fffu + ((u >> 16) & 1u)) >> 16); }

constexpr size_t MiB = 1u << 20;
constexpr size_t WS_CTL = 0;
constexpr size_t WS_MOD = 1 * MiB;
constexpr size_t WS_KSUM = 1 * MiB + 64 * 1024;
constexpr size_t WS_ROPE = 1 * MiB + 256 * 1024;
constexpr size_t WS_W_IN_T = 2 * MiB;
constexpr size_t WS_WC_T = 10 * MiB;
constexpr size_t WS_WBA_T = 11 * MiB;
constexpr size_t WS_WOUT_T = 12 * MiB;
constexpr size_t WS_WQ_T = 14 * MiB;
constexpr size_t WS_SK = 18 * MiB;
constexpr size_t WS_H = 20 * MiB;
constexpr size_t WS_DIFF = 20 * MiB, WS_ATT = 36 * MiB;
constexpr size_t WS_UP = 52 * MiB, WS_Q = 68 * MiB, WS_K = 84 * MiB, WS_V = 100 * MiB;
constexpr size_t WS_GATES = 116 * MiB;
constexpr size_t WS_MERGED = 84 * MiB;
constexpr size_t WS_QP = 116 * MiB;
constexpr size_t WS_EID = 52 * MiB, WS_EG = 60 * MiB;
constexpr size_t WS_END = 180 * MiB;

__global__ void n_mod(const float* c, const float* w_ada, const float* b_ada, float* mod) {
    const int idx = blockIdx.x * blockDim.x + threadIdx.x; if (idx >= 2 * 6144) return;
    const int b = idx / 6144, j = idx % 6144; float acc = 0.f;
    for (int i = 0; i < D; ++i) { const float cv = c[b * D + i]; const float s = cv / (1.f + expf(-cv)); acc += s * w_ada[(size_t)i * 6144 + j]; }
    mod[idx] = acc + b_ada[j];
}
__global__ void n_transpose(const float* W, int K, int N, bf16* WT) {
    const size_t idx = (size_t)blockIdx.x * blockDim.x + threadIdx.x; if (idx >= (size_t)K * N) return;
    const int k = (int)(idx / N), n = (int)(idx % N); WT[(size_t)n * K + k] = f2bf(W[idx]);
}
__global__ void n_wc(const float* pool_w, const float* pool_scale, const float* w_bp, bf16* WcT) {
    const int idx = blockIdx.x * blockDim.x + threadIdx.x; if (idx >= 512 * 1024) return;
    const int o = idx % 1024, k = idx / 1024, g = k / 128, i = k % 128; float acc = 0.f;
    for (int j = 0; j < 128; ++j) acc += pool_w[(g * 128 + i) * 128 + j] * pool_scale[g * 128 + j] * w_bp[(size_t)(g * 128 + j) * 1024 + o];
    WcT[(size_t)o * 512 + k] = f2bf(acc);
}
__global__ void n_sk(const float* sk, bf16* SK) { const int idx = blockIdx.x * blockDim.x + threadIdx.x; if (idx < 8 * 2 * 128 * 128) SK[idx] = f2bf(sk[idx]); }
__global__ void n_rope(float* tab) {
    const int idx = blockIdx.x * blockDim.x + threadIdx.x; if (idx >= SEQ * 8) return;
    const int pos = idx / 8, i = idx % 8; const float inv = (float)pow(500000.0, -(double)i / 8.0); const float ang = (float)pos * inv;
    tab[pos * 16 + i] = (float)cos((double)ang); tab[pos * 16 + 8 + i] = (float)sin((double)ang);
}
__global__ void n_modulate(const float* x, const float* g, const float* mod, int shift_off, int scale_off, bf16* out) {
    const int row = blockIdx.x * (blockDim.x / 64) + (threadIdx.x >> 6), lane = threadIdx.x & 63; if (row >= M) return;
    const int b = row / SEQ; const float* xr = x + (size_t)row * D; float v[16]; float ss = 0.f;
#pragma unroll
    for (int j = 0; j < 16; ++j) { v[j] = xr[j * 64 + lane]; ss += v[j] * v[j]; }
#pragma unroll
    for (int o = 1; o < 64; o <<= 1) ss += __shfl_xor(ss, o);
    const float r = rsqrtf(ss * (1.f / D) + EPS);
#pragma unroll
    for (int j = 0; j < 16; ++j) { const int col = j * 64 + lane; out[(size_t)row * D + col] = f2bf(v[j] * r * g[col] * (1.f + mod[b * 6144 + scale_off + col]) + mod[b * 6144 + shift_off + col]); }
}

template <class Epi>
__global__ void __launch_bounds__(256) n_gemm(const bf16* A, int lda, const bf16* Bt, int ldb, int K, Epi E) {
    __shared__ float As[16][65], Bs[16][65], Ct[64][65];
    const int tid = threadIdx.x, tx = tid & 15, ty = tid >> 4, m0 = blockIdx.y * 64, n0 = blockIdx.x * 64;
    float acc[4][4];
#pragma unroll
    for (int i = 0; i < 4; ++i)
#pragma unroll
        for (int j = 0; j < 4; ++j) acc[i][j] = 0.f;
    for (int k0 = 0; k0 < K; k0 += 16) {
#pragma unroll
        for (int e = 0; e < 4; ++e) { const int idx = tid + e * 256, r = idx >> 4, kk = idx & 15;
            As[kk][r] = bf2f(A[(size_t)(m0 + r) * lda + k0 + kk]); Bs[kk][r] = bf2f(Bt[(size_t)(n0 + r) * ldb + k0 + kk]); }
        __syncthreads();
#pragma unroll
        for (int kk = 0; kk < 16; ++kk) { float a[4], b[4];
#pragma unroll
            for (int i = 0; i < 4; ++i) { a[i] = As[kk][ty * 4 + i]; b[i] = Bs[kk][tx * 4 + i]; }
#pragma unroll
            for (int i = 0; i < 4; ++i)
#pragma unroll
                for (int j = 0; j < 4; ++j) acc[i][j] += a[i] * b[j]; }
        __syncthreads();
    }
#pragma unroll
    for (int i = 0; i < 4; ++i)
#pragma unroll
        for (int j = 0; j < 4; ++j) Ct[ty * 4 + i][tx * 4 + j] = acc[i][j];
    __syncthreads();
    for (int e = tid; e < 64 * 64; e += 256) { const int r = e >> 6, cidx = e & 63; E(m0 + r, n0 + cidx, Ct[r][cidx], &Ct[r][0], cidx); }
}
struct EpiInProj {
    bf16 *UP, *Q, *Kb, *V, *G; const float* rope;
    __device__ void operator()(int m, int n, float v, const float* row, int cl) const {
        if (n < 512) { UP[(size_t)m * 512 + n] = f2bf(v); return; }
        if (n < 1536) {
            const bool isq = n < 1024; const int c = isq ? n - 512 : n - 1024; const int d = c & 63; const int pos = m % SEQ; float o = v;
            if (d < 8) { const float cs = rope[pos * 16 + d], sn = rope[pos * 16 + 8 + d]; o = v * cs - row[cl + 8] * sn; }
            else if (d < 16) { const float cs = rope[pos * 16 + d - 8], sn = rope[pos * 16 + 8 + d - 8]; o = row[cl - 8] * sn + v * cs; }
            if (isq) Q[(size_t)m * 512 + c] = f2bf(o * C2); else Kb[(size_t)m * 512 + c] = f2bf(o);
            return;
        }
        if (n < 2048) { V[(size_t)m * 512 + n - 1536] = f2bf(v); return; }
        G[(size_t)m * 2048 + n - 2048] = f2bf(1.f / (1.f + expf(-v)));
    }
};
struct EpiMerge { bf16* Mg; const bf16* G; int pass;
    __device__ void operator()(int m, int n, float v, const float*, int) const {
        const float g = bf2f(G[(size_t)m * 2048 + pass * 1024 + n]); const size_t o = (size_t)m * 1024 + n;
        if (pass == 0) Mg[o] = f2bf(g * v); else Mg[o] = f2bf(bf2f(Mg[o]) + g * v); } };
struct EpiRes1 { const float* x; const float* mod; float* x1;
    __device__ void operator()(int m, int n, float v, const float*, int) const { const int b = m / SEQ; x1[(size_t)m * D + n] = x[(size_t)m * D + n] + mod[b * 6144 + 2 * D + n] * v; } };
struct EpiBf { bf16* O; int ldo; __device__ void operator()(int m, int n, float v, const float*, int) const { O[(size_t)m * ldo + n] = f2bf(v); } };

__global__ void n_ksum(const bf16* Kb, float* ksum) {
    const int idx = blockIdx.x * blockDim.x + threadIdx.x; if (idx >= BATCH * NH * NBLK * HD) return;
    const int d = idx % HD, blk = (idx / HD) % NBLK, h = (idx / (HD * NBLK)) % NH, b = idx / (HD * NBLK * NH); float s = 0.f;
    for (int r = 0; r < MBLK; ++r) s += bf2f(Kb[(size_t)(b * SEQ + blk * MBLK + r) * 512 + h * 64 + d]);
    ksum[idx] = s;
}
__global__ void n_pooldiff(const bf16* UP, bf16* DIFF) {
    const size_t idx = (size_t)blockIdx.x * blockDim.x + threadIdx.x; if (idx >= (size_t)M * 512) return;
    const int c = (int)(idx % 512), row = (int)(idx / 512), pos = row % SEQ, w = 2 << (c / 128), cnt = pos + 1 < w ? pos + 1 : w; float s = 0.f;
    for (int i = 0; i < cnt; ++i) s += bf2f(UP[(size_t)(row - i) * 512 + c]);
    DIFF[idx] = f2bf(s / (float)cnt - bf2f(UP[idx]));
}
__global__ void __launch_bounds__(256) n_attn(const bf16* Q, const bf16* Kb, const bf16* V, const float* ksum, bf16* ATT) {
    const int idx = blockIdx.x * blockDim.x + threadIdx.x; if (idx >= BATCH * NH * SEQ) return;
    const int q = idx % SEQ, h = (idx / SEQ) % NH, b = idx / (SEQ * NH), row = b * SEQ + q, qb = q / MBLK;
    float qv[64], o[64];
#pragma unroll
    for (int d = 0; d < 64; ++d) { qv[d] = bf2f(Q[(size_t)row * 512 + h * 64 + d]); o[d] = 0.f; }
    int s0 = -1, s1 = -1, s2 = -1; float g0 = -INFINITY, g1 = -INFINITY, g2 = -INFINITY;
    for (int j = 0; j < qb; ++j) { const float* ks = ksum + ((size_t)(b * NH + h) * NBLK + j) * HD; float g = 0.f;
#pragma unroll
        for (int d = 0; d < 64; ++d) g += qv[d] * ks[d];
        if (g > g0) { g2 = g1; s2 = s1; g1 = g0; s1 = s0; g0 = g; s0 = j; } else if (g > g1) { g2 = g1; s2 = s1; g1 = g; s1 = j; } else if (g > g2) { g2 = g; s2 = j; } }
    float mx = -1e30f, l = 0.f;
    for (int pass = 0; pass < 4; ++pass) {
        const int blk = pass == 0 ? qb : (pass == 1 ? s0 : (pass == 2 ? s1 : s2)); if (blk < 0) continue;
        const int nkeys = pass == 0 ? (q - qb * MBLK + 1) : MBLK;
        for (int kk = 0; kk < nkeys; ++kk) { const size_t kr = (size_t)(b * SEQ + blk * MBLK + kk) * 512 + h * 64; float s = 0.f;
#pragma unroll
            for (int d = 0; d < 64; ++d) s += qv[d] * bf2f(Kb[kr + d]);
            if (s > mx) { const float f = exp2f(mx - s); l = l * f + 1.f;
#pragma unroll
                for (int d = 0; d < 64; ++d) o[d] = o[d] * f + bf2f(V[kr + d]);
                mx = s; }
            else { const float p = exp2f(s - mx); l += p;
#pragma unroll
                for (int d = 0; d < 64; ++d) o[d] += p * bf2f(V[kr + d]); } }
    }
    const float il = 1.f / l;
#pragma unroll
    for (int d = 0; d < 64; ++d) ATT[(size_t)row * 512 + h * 64 + d] = f2bf(o[d] * il);
}
__global__ void __launch_bounds__(128) n_route(const bf16* QP, const bf16* SK, int* EID, float* EG) {
    __shared__ float lv[128][33]; __shared__ int li[128][33];
    const int tid = threadIdx.x, idx = blockIdx.x * blockDim.x + tid; const int h = idx % PHEADS, t = idx / PHEADS;
#pragma unroll 1
    for (int p = 0; p < 2; ++p) {
        float tv[16]; int ti[16];
#pragma unroll
        for (int j = 0; j < 16; ++j) { tv[j] = -INFINITY; ti[j] = 0; }
        const bf16* qr = QP + (size_t)t * 2048 + h * 256 + p * 128; const bf16* sk = SK + (size_t)(h * 2 + p) * 128 * 128;
#pragma unroll 1
        for (int n = 0; n < 128; ++n) { float s = 0.f;
            for (int d = 0; d < 128; ++d) s += bf2f(qr[d]) * bf2f(sk[n * 128 + d]);
            float v = s; int vi = n;
#pragma unroll
            for (int j = 0; j < 16; ++j) if (v > tv[j]) { const float tf = tv[j]; const int tj = ti[j]; tv[j] = v; ti[j] = vi; v = tf; vi = tj; } }
#pragma unroll
        for (int j = 0; j < 16; ++j) { lv[tid][p * 16 + j] = tv[j]; li[tid][p * 16 + j] = ti[j]; }
    }
    float cv[16]; int ci[16];
#pragma unroll
    for (int j = 0; j < 16; ++j) { cv[j] = -INFINITY; ci[j] = 0; }
#pragma unroll 1
    for (int i = 0; i < 16; ++i)
#pragma unroll 1
        for (int j2 = 0; j2 < 16; ++j2) { float v = lv[tid][i] + lv[tid][16 + j2]; int vi = li[tid][i] * NKEYS + li[tid][16 + j2];
#pragma unroll
            for (int j = 0; j < 16; ++j) if (v > cv[j]) { const float tf = cv[j]; const int tj = ci[j]; cv[j] = v; ci[j] = vi; v = tf; vi = tj; } }
    float sum = 0.f, e[16];
#pragma unroll
    for (int j = 0; j < 16; ++j) { e[j] = expf(cv[j] - cv[0]); sum += e[j]; }
    const float is = 1.f / sum;
#pragma unroll
    for (int j = 0; j < 16; ++j) { EID[(size_t)t * NSEL + h * 16 + j] = ci[j]; EG[(size_t)t * NSEL + h * 16 + j] = e[j] * is; }
}
__global__ void __launch_bounds__(256) n_peer(const bf16* H2, const int* EID, const float* EG, const float* Ut, const float* Vt, const float* mod, const float* gfin, float* io) {
    const int t = blockIdx.x * 4 + (threadIdx.x >> 6), lane = threadIdx.x & 63; if (t >= M) return;
    const int b = t / SEQ; float hv[16], acc[16];
#pragma unroll
    for (int j = 0; j < 4; ++j)
#pragma unroll
        for (int e = 0; e < 4; ++e) { hv[j * 4 + e] = bf2f(H2[(size_t)t * D + j * 256 + lane * 4 + e]); acc[j * 4 + e] = 0.f; }
#pragma unroll 1
    for (int k = 0; k < NSEL; ++k) {
        const int eid = EID[(size_t)t * NSEL + k]; const float g = EG[(size_t)t * NSEL + k];
        const float4* ur = (const float4*)(Ut + (size_t)eid * D); const float4* vr = (const float4*)(Vt + (size_t)eid * D); float dot = 0.f;
#pragma unroll
        for (int j = 0; j < 4; ++j) { const float4 u = ur[j * 64 + lane]; dot += hv[j * 4] * u.x + hv[j * 4 + 1] * u.y + hv[j * 4 + 2] * u.z + hv[j * 4 + 3] * u.w; }
#pragma unroll
        for (int o = 1; o < 64; o <<= 1) dot += __shfl_xor(dot, o);
        const float w = g * 0.5f * dot * (1.f + erff(dot * 0.70710678118654752f));
#pragma unroll
        for (int j = 0; j < 4; ++j) { const float4 v = vr[j * 64 + lane]; acc[j * 4] += w * v.x; acc[j * 4 + 1] += w * v.y; acc[j * 4 + 2] += w * v.z; acc[j * 4 + 3] += w * v.w; }
    }
    float ss = 0.f;
#pragma unroll
    for (int j = 0; j < 4; ++j)
#pragma unroll
        for (int e = 0; e < 4; ++e) { const int col = j * 256 + lane * 4 + e; const float x2 = io[(size_t)t * D + col] + mod[b * 6144 + 5 * D + col] * acc[j * 4 + e]; acc[j * 4 + e] = x2; ss += x2 * x2; }
#pragma unroll
    for (int o = 1; o < 64; o <<= 1) ss += __shfl_xor(ss, o);
    const float r = rsqrtf(ss * (1.f / D) + EPS);
#pragma unroll
    for (int j = 0; j < 4; ++j)
#pragma unroll
        for (int e = 0; e < 4; ++e) { const int col = j * 256 + lane * 4 + e; io[(size_t)t * D + col] = acc[j * 4 + e] * r * gfin[col]; }
}

extern "C" void kernel_launch(void* const* d_in, const int* in_sizes, int n_in, void* d_out, int out_size, void* d_ws, size_t ws_size, hipStream_t stream) {
    if (n_in != 17 || out_size != M * D || ws_size < WS_END) { fprintf(stderr, "kernel_launch: unexpected shapes (n_in %d out %d ws %zu)\n", n_in, out_size, ws_size); return; }
    const float* x = (const float*)d_in[0]; const float* c = (const float*)d_in[1]; const float* w_ada = (const float*)d_in[2]; const float* b_ada = (const float*)d_in[3];
    const float* g_mix = (const float*)d_in[4]; const float* w_in = (const float*)d_in[5]; const float* pool_w = (const float*)d_in[6]; const float* pool_scale = (const float*)d_in[7];
    const float* w_bp = (const float*)d_in[8]; const float* w_ba = (const float*)d_in[9]; const float* w_out = (const float*)d_in[10]; const float* g_ffn = (const float*)d_in[11];
    const float* wq = (const float*)d_in[12]; const float* skeys = (const float*)d_in[13]; const float* Ut = (const float*)d_in[14]; const float* Vt = (const float*)d_in[15]; const float* g_fin = (const float*)d_in[16];
    unsigned char* ws = (unsigned char*)d_ws; float* out = (float*)d_out;
    float* MOD = (float*)(ws + WS_MOD); float* KSUM = (float*)(ws + WS_KSUM); float* ROPE = (float*)(ws + WS_ROPE);
    bf16 *W_IN_T = (bf16*)(ws + WS_W_IN_T), *WC_T = (bf16*)(ws + WS_WC_T), *WBA_T = (bf16*)(ws + WS_WBA_T), *WOUT_T = (bf16*)(ws + WS_WOUT_T), *WQ_T = (bf16*)(ws + WS_WQ_T), *SK = (bf16*)(ws + WS_SK);
    bf16 *H = (bf16*)(ws + WS_H), *DIFF = (bf16*)(ws + WS_DIFF), *ATT = (bf16*)(ws + WS_ATT), *UP = (bf16*)(ws + WS_UP), *Q = (bf16*)(ws + WS_Q), *Kb = (bf16*)(ws + WS_K), *V = (bf16*)(ws + WS_V);
    bf16 *GATES = (bf16*)(ws + WS_GATES), *MERGED = (bf16*)(ws + WS_MERGED), *QP = (bf16*)(ws + WS_QP);
    int* EID = (int*)(ws + WS_EID); float* EG = (float*)(ws + WS_EG);

    n_mod<<<(2 * 6144 + 255) / 256, 256, 0, stream>>>(c, w_ada, b_ada, MOD);
    n_transpose<<<(1024 * 4096) / 256, 256, 0, stream>>>(w_in, 1024, 4096, W_IN_T);
    n_transpose<<<(512 * 1024) / 256, 256, 0, stream>>>(w_ba, 512, 1024, WBA_T);
    n_transpose<<<(1024 * 1024) / 256, 256, 0, stream>>>(w_out, 1024, 1024, WOUT_T);
    n_transpose<<<(1024 * 2048) / 256, 256, 0, stream>>>(wq, 1024, 2048, WQ_T);
    n_wc<<<(512 * 1024) / 256, 256, 0, stream>>>(pool_w, pool_scale, w_bp, WC_T);
    n_sk<<<(8 * 2 * 128 * 128) / 256, 256, 0, stream>>>(skeys, SK);
    n_rope<<<(SEQ * 8) / 256, 256, 0, stream>>>(ROPE);
    n_modulate<<<M / 4, 256, 0, stream>>>(x, g_mix, MOD, 0, D, H);
    { EpiInProj E{UP, Q, Kb, V, GATES, ROPE}; n_gemm<EpiInProj><<<dim3(NPROJ / 64, M / 64), 256, 0, stream>>>(H, D, W_IN_T, D, D, E); }
    n_ksum<<<(BATCH * NH * NBLK * HD) / 256, 256, 0, stream>>>(Kb, KSUM);
    n_pooldiff<<<(M * 512) / 256, 256, 0, stream>>>(UP, DIFF);
    n_attn<<<(BATCH * NH * SEQ) / 256, 256, 0, stream>>>(Q, Kb, V, KSUM, ATT);
    { EpiMerge E{MERGED, GATES, 0}; n_gemm<EpiMerge><<<dim3(D / 64, M / 64), 256, 0, stream>>>(DIFF, 512, WC_T, 512, 512, E); }
    { EpiMerge E{MERGED, GATES, 1}; n_gemm<EpiMerge><<<dim3(D / 64, M / 64), 256, 0, stream>>>(ATT, 512, WBA_T, 512, 512, E); }
    { EpiRes1 E{x, MOD, out}; n_gemm<EpiRes1><<<dim3(D / 64, M / 64), 256, 0, stream>>>(MERGED, D, WOUT_T, D, D, E); }
    n_modulate<<<M / 4, 256, 0, stream>>>(out, g_ffn, MOD, 3 * D, 4 * D, H);
    { EpiBf E{QP, 2048}; n_gemm<EpiBf><<<dim3(2048 / 64, M / 64), 256, 0, stream>>>(H, D, WQ_T, D, D, E); }
    n_route<<<(M * PHEADS) / 128, 128, 0, stream>>>(QP, SK, EID, EG);
    n_peer<<<M / 4, 256, 0, stream>>>(H, EID, EG, Ut, Vt, MOD, g_fin, out);
}
```

```cpp
#include <hip/hip_runtime.h>
#include <hip/hip_cooperative_groups.h>
#include <cstdio>
#include <cstdint>
namespace cg = cooperative_groups;

constexpr int BATCH = 2, SEQ = 8192, D = 1024, M = BATCH * SEQ;
constexpr int NPROJ = 4096, PW = 512, AW = 512, NH = 8, HD = 64, MBLK = 256, NBLK = SEQ / MBLK;
constexpr int PHEADS = 8, NKEYS = 128, PQD = 256, PHALF = 128, PTOPK = 16, NEXP = NKEYS * NKEYS, NSEL = PHEADS * PTOPK;
constexpr float EPS = 1e-6f;
constexpr float C2 = 0.125f * 1.4426950408889634f;
constexpr int NT = 512;

typedef unsigned short bf16;
__device__ __forceinline__ float bf2f(bf16 v) { return __uint_as_float(((unsigned)v) << 16); }
__device__ __forceinline__ bf16 f2bf(float f) { unsigned u = __float_as_uint(f); return (bf16)((u + 0x7fffu + ((u >> 16) & 1u)) >> 16); }

constexpr size_t MiB = 1u << 20;
constexpr size_t WS_CTL = 0;
constexpr size_t WS_MOD = 1 * MiB;
constexpr size_t WS_KSUM = 256 * 1024;
constexpr size_t WS_BAR = 32 * 1024;
constexpr size_t WS_KSUM_ALT = 512 * 1024, WS_DBG = 16 * 1024;
constexpr size_t WS_UT = 180 * MiB, WS_VT = 212 * MiB;
constexpr size_t WS_U8 = 180 * MiB, WS_V8 = 196 * MiB, WS_USC = 212 * MiB, WS_VSC = 212 * MiB + 65536;
constexpr size_t WS_SEL = 1 * MiB + 768 * 1024;
constexpr size_t WS_CNT = 640 * 1024;
constexpr size_t WS_PO01 = 213 * MiB, WS_PO2 = 52 * MiB, WS_LIST = 245 * MiB, WS_PML = 253 * MiB;
constexpr size_t WS_OUT2 = 84 * MiB;
constexpr size_t WS_ALT = 180 * MiB;
constexpr size_t WS_ROPE = 1 * MiB + 256 * 1024;
constexpr size_t WS_MODP = 148 * MiB;
constexpr size_t WS_WCF = 150 * MiB;
constexpr size_t WS_W_IN_T = 2 * MiB;
constexpr size_t WS_WC_T = 10 * MiB;
constexpr size_t WS_WBA_T = 11 * MiB;
constexpr size_t WS_WOUT_T = 12 * MiB;
constexpr size_t WS_WQ_T = 14 * MiB;
constexpr size_t WS_SK = 18 * MiB;
constexpr size_t WS_SKBD = 19 * MiB;
constexpr size_t WS_H = 20 * MiB;
constexpr size_t WS_DIFF = 20 * MiB, WS_ATT = 36 * MiB;
constexpr size_t WS_UP = 52 * MiB, WS_Q = 68 * MiB, WS_K = 84 * MiB, WS_V = 100 * MiB;
constexpr size_t WS_GATES = 116 * MiB;
constexpr size_t WS_MERGED = 84 * MiB;
constexpr size_t WS_QP = 116 * MiB;
constexpr size_t WS_EID = 52 * MiB, WS_EG = 60 * MiB;
constexpr size_t WS_END = 180 * MiB;

struct Args { const float* in[17]; float* out; unsigned char* ws; };

#define GSTRIDE(i, n) for (size_t i = (size_t)blockIdx.x * NT + threadIdx.x; i < (size_t)(n); i += (size_t)gridDim.x * NT)

__device__ __forceinline__ void d_mod(const float* c, const float* w_ada, const float* b_ada, float* mod) {
    GSTRIDE(idx, 2 * 6144) { const int b = (int)idx / 6144, j = (int)idx % 6144; float acc = 0.f;
        for (int i = 0; i < D; ++i) { const float cv = c[b * D + i]; const float s = cv / (1.f + expf(-cv)); acc += s * w_ada[(size_t)i * 6144 + j]; }
        mod[idx] = acc + b_ada[j]; }
}
__device__ __forceinline__ void d_transpose(const float* W, int K, int N, bf16* WT) {
    GSTRIDE(idx, (size_t)K * N) { const int k = (int)(idx / N), n = (int)(idx % N); WT[(size_t)n * K + k] = f2bf(W[idx]); }
}
__device__ __forceinline__ void d_wc(const float* pool_w, const float* pool_scale, const float* w_bp, bf16* WcT) {
    GSTRIDE(idx, 512 * 1024) { const int o = (int)idx % 1024, k = (int)idx / 1024, g = k / 128, i = k % 128; float acc = 0.f;
        for (int j = 0; j < 128; ++j) acc += pool_w[(g * 128 + i) * 128 + j] * pool_scale[g * 128 + j] * w_bp[(size_t)(g * 128 + j) * 1024 + o];
        WcT[(size_t)o * 512 + k] = f2bf(acc); }
}
__device__ __forceinline__ void d_sk(const float* sk, bf16* SK) { GSTRIDE(idx, 8 * 2 * 128 * 128) SK[idx] = f2bf(sk[idx]); }
__device__ __forceinline__ void d_rope(float* tab) {
    GSTRIDE(idx, SEQ * 8) { const int pos = (int)idx / 8, i = (int)idx % 8; const float inv = (float)pow(500000.0, -(double)i / 8.0); const float ang = (float)pos * inv;
        tab[pos * 16 + i] = (float)cos((double)ang); tab[pos * 16 + 8 + i] = (float)sin((double)ang); }
}
__device__ __forceinline__ void d_modulate(const float* x, const float* g, const float* mod, int shift_off, int scale_off, bf16* out) {
    const int lane = threadIdx.x & 63;
    for (int row = blockIdx.x * (NT / 64) + (threadIdx.x >> 6); row < M; row += gridDim.x * (NT / 64)) {
        const int b = row / SEQ; const float* xr = x + (size_t)row * D; float v[16]; float ss = 0.f;
#pragma unroll
        for (int j = 0; j < 16; ++j) { v[j] = xr[j * 64 + lane]; ss += v[j] * v[j]; }
#pragma unroll
        for (int o = 1; o < 64; o <<= 1) ss += __shfl_xor(ss, o);
        const float r = rsqrtf(ss * (1.f / D) + EPS);
#pragma unroll
        for (int j = 0; j < 16; ++j) { const int col = j * 64 + lane; out[(size_t)row * D + col] = f2bf(v[j] * r * g[col] * (1.f + mod[b * 6144 + scale_off + col]) + mod[b * 6144 + shift_off + col]); }
    }
}
constexpr int NG_HALF_FLOATS = 2 * 16 * 65 + 64 * 65;
template <class Epi>
__device__ __forceinline__ void d_ngemm(float* lds, const bf16* A, int lda, const bf16* Bt, int ldb, int K, int N, const Epi& E) {
    const int half = threadIdx.x >> 8, tid = threadIdx.x & 255, tx = tid & 15, ty = tid >> 4;
    float* As = lds + half * NG_HALF_FLOATS; float* Bs = As + 16 * 65; float* Ct = Bs + 16 * 65;
    const int ntn = N / 64, ntiles = (M / 64) * ntn, iters = (ntiles + 2 * gridDim.x - 1) / (2 * gridDim.x);
    for (int it = 0; it < iters; ++it) {
        const int t = (it * gridDim.x + blockIdx.x) * 2 + half; const bool valid = t < ntiles; const int m0 = valid ? (t / ntn) * 64 : 0, n0 = valid ? (t % ntn) * 64 : 0;
        float acc[4][4];
#pragma unroll
        for (int i = 0; i < 4; ++i)
#pragma unroll
            for (int j = 0; j < 4; ++j) acc[i][j] = 0.f;
        for (int k0 = 0; k0 < K; k0 += 16) {
#pragma unroll
            for (int e = 0; e < 4; ++e) { const int idx = tid + e * 256, r = idx >> 4, kk = idx & 15;
                As[kk * 65 + r] = bf2f(A[(size_t)(m0 + r) * lda + k0 + kk]); Bs[kk * 65 + r] = bf2f(Bt[(size_t)(n0 + r) * ldb + k0 + kk]); }
            __syncthreads();
#pragma unroll
            for (int kk = 0; kk < 16; ++kk) { float a[4], b[4];
#pragma unroll
                for (int i = 0; i < 4; ++i) { a[i] = As[kk * 65 + ty * 4 + i]; b[i] = Bs[kk * 65 + tx * 4 + i]; }
#pragma unroll
                for (int i = 0; i < 4; ++i)
#pragma unroll
                    for (int j = 0; j < 4; ++j) acc[i][j] += a[i] * b[j]; }
            __syncthreads();
        }
#pragma unroll
        for (int i = 0; i < 4; ++i)
#pragma unroll
            for (int j = 0; j < 4; ++j) Ct[(ty * 4 + i) * 65 + tx * 4 + j] = acc[i][j];
        __syncthreads();
        if (valid) for (int e = tid; e < 64 * 64; e += 256) { const int r = e >> 6, cidx = e & 63; E(m0 + r, n0 + cidx, Ct[r * 65 + cidx], &Ct[r * 65], cidx); }
        __syncthreads();
    }
}
struct EpiInProjN {
    bf16 *UP, *Q, *Kb, *V, *G; const float* rope;
    __device__ void operator()(int m, int n, float v, const float* row, int cl) const {
        if (n < 512) { UP[(size_t)m * 512 + n] = f2bf(v); return; }
        if (n < 1536) {
            const bool isq = n < 1024; const int c = isq ? n - 512 : n - 1024; const int d = c & 63; const int pos = m % SEQ; float o = v;
            if (d < 8) { const float cs = rope[pos * 16 + d], sn = rope[pos * 16 + 8 + d]; o = v * cs - row[cl + 8] * sn; }
            else if (d < 16) { const float cs = rope[pos * 16 + d - 8], sn = rope[pos * 16 + 8 + d - 8]; o = row[cl - 8] * sn + v * cs; }
            if (isq) Q[(size_t)m * 512 + c] = f2bf(o * C2); else Kb[(size_t)m * 512 + c] = f2bf(o);
            return;
        }
        if (n < 2048) { V[(size_t)m * 512 + n - 1536] = f2bf(v); return; }
        G[(size_t)m * 2048 + n - 2048] = f2bf(1.f / (1.f + expf(-v)));
    }
};
struct EpiMergeN { bf16* Mg; const bf16* G; int pass;
    __device__ void operator()(int m, int n, float v, const float*, int) const {
        const float g = bf2f(G[(size_t)m * 2048 + pass * 1024 + n]); const size_t o = (size_t)m * 1024 + n;
        if (pass == 0) Mg[o] = f2bf(g * v); else Mg[o] = f2bf(bf2f(Mg[o]) + g * v); } };
struct EpiRes1N { const float* x; const float* mod; float* x1;
    __device__ void operator()(int m, int n, float v, const float*, int) const { const int b = m / SEQ; x1[(size_t)m * D + n] = x[(size_t)m * D + n] + mod[b * 6144 + 2 * D + n] * v; } };
struct EpiBfN { bf16* O; int ldo; __device__ void operator()(int m, int n, float v, const float*, int) const { O[(size_t)m * ldo + n] = f2bf(v); } };

__device__ __forceinline__ void d_ksum(const bf16* Kb, float* ksum) {
    GSTRIDE(idx, BATCH * NH * NBLK * HD) { const int d = (int)idx % HD, blk = ((int)idx / HD) % NBLK, h = ((int)idx / (HD * NBLK)) % NH, b = (int)idx / (HD * NBLK * NH); float s = 0.f;
        for (int r = 0; r < MBLK; ++r) s += bf2f(Kb[(size_t)(b * SEQ + blk * MBLK + r) * 512 + h * 64 + d]);
        ksum[idx] = s; }
}
__device__ __forceinline__ void d_pooldiff(const bf16* UP, bf16* DIFF) {
    GSTRIDE(idx, (size_t)M * 512) { const int c = (int)(idx % 512), row = (int)(idx / 512), pos = row % SEQ, w = 2 << (c / 128), cnt = pos + 1 < w ? pos + 1 : w; float s = 0.f;
        for (int i = 0; i < cnt; ++i) s += bf2f(UP[(size_t)(row - i) * 512 + c]);
        DIFF[idx] = f2bf(s / (float)cnt - bf2f(UP[idx])); }
}
__device__ __forceinline__ void d_attn(const bf16* Q, const bf16* Kb, const bf16* V, const float* ksum, bf16* ATT) {
    GSTRIDE(gidx, BATCH * NH * SEQ) {
        const int idx = (int)gidx, q = idx % SEQ, h = (idx / SEQ) % NH, b = idx / (SEQ * NH), row = b * SEQ + q, qb = q / MBLK;
        float qv[64], o[64];
#pragma unroll
        for (int d = 0; d < 64; ++d) { qv[d] = bf2f(Q[(size_t)row * 512 + h * 64 + d]); o[d] = 0.f; }
        int s0 = -1, s1 = -1, s2 = -1; float g0 = -INFINITY, g1 = -INFINITY, g2 = -INFINITY;
        for (int j = 0; j < qb; ++j) { const float* ks = ksum + ((size_t)(b * NH + h) * NBLK + j) * HD; float g = 0.f;
#pragma unroll
            for (int d = 0; d < 64; ++d) g += qv[d] * ks[d];
            if (g > g0) { g2 = g1; s2 = s1; g1 = g0; s1 = s0; g0 = g; s0 = j; } else if (g > g1) { g2 = g1; s2 = s1; g1 = g; s1 = j; } else if (g > g2) { g2 = g; s2 = j; } }
        float mx = -1e30f, l = 0.f;
        for (int pass = 0; pass < 4; ++pass) {
            const int blk = pass == 0 ? qb : (pass == 1 ? s0 : (pass == 2 ? s1 : s2)); if (blk < 0) continue;
            const int nkeys = pass == 0 ? (q - qb * MBLK + 1) : MBLK;
            for (int kk = 0; kk < nkeys; ++kk) { const size_t kr = (size_t)(b * SEQ + blk * MBLK + kk) * 512 + h * 64; float s = 0.f;
#pragma unroll
                for (int d = 0; d < 64; ++d) s += qv[d] * bf2f(Kb[kr + d]);
                if (s > mx) { const float f = exp2f(mx - s); l = l * f + 1.f;
#pragma unroll
                    for (int d = 0; d < 64; ++d) o[d] = o[d] * f + bf2f(V[kr + d]);
                    mx = s; }
                else { const float p = exp2f(s - mx); l += p;
#pragma unroll
                    for (int d = 0; d < 64; ++d) o[d] += p * bf2f(V[kr + d]); } }
        }
        const float il = 1.f / l;
#pragma unroll
        for (int d = 0; d < 64; ++d) ATT[(size_t)row * 512 + h * 64 + d] = f2bf(o[d] * il);
    }
}
__device__ __forceinline__ void d_route(float* lds, const bf16* QP, const bf16* SK, int* EID, float* EG) {
    const int tid = threadIdx.x; float* lv = lds + tid * 33; int* li = (int*)(lds + NT * 33) + tid * 33;
    GSTRIDE(gidx, M * PHEADS) {
        const int idx = (int)gidx, h = idx % PHEADS, t = idx / PHEADS;
#pragma unroll 1
        for (int p = 0; p < 2; ++p) {
            float tv[16]; int ti[16];
#pragma unroll
            for (int j = 0; j < 16; ++j) { tv[j] = -INFINITY; ti[j] = 0; }
            const bf16* qr = QP + (size_t)t * 2048 + h * 256 + p * 128; const bf16* sk = SK + (size_t)(h * 2 + p) * 128 * 128;
#pragma unroll 1
            for (int n = 0; n < 128; ++n) { float s = 0.f;
                for (int d = 0; d < 128; ++d) s += bf2f(qr[d]) * bf2f(sk[n * 128 + d]);
                float v = s; int vi = n;
#pragma unroll
                for (int j = 0; j < 16; ++j) if (v > tv[j]) { const float tf = tv[j]; const int tj = ti[j]; tv[j] = v; ti[j] = vi; v = tf; vi = tj; } }
#pragma unroll
            for (int j = 0; j < 16; ++j) { lv[p * 16 + j] = tv[j]; li[p * 16 + j] = ti[j]; }
        }
        float cv[16]; int ci[16];
#pragma unroll
        for (int j = 0; j < 16; ++j) { cv[j] = -INFINITY; ci[j] = 0; }
#pragma unroll 1
        for (int i = 0; i < 16; ++i)
#pragma unroll 1
            for (int j2 = 0; j2 < 16; ++j2) { float v = lv[i] + lv[16 + j2]; int vi = li[i] * NKEYS + li[16 + j2];
#pragma unroll
                for (int j = 0; j < 16; ++j) if (v > cv[j]) { const float tf = cv[j]; const int tj = ci[j]; cv[j] = v; ci[j] = vi; v = tf; vi = tj; } }
        float sum = 0.f, e[16];
#pragma unroll
        for (int j = 0; j < 16; ++j) { e[j] = expf(cv[j] - cv[0]); sum += e[j]; }
        const float is = 1.f / sum;
#pragma unroll
        for (int j = 0; j < 16; ++j) { EID[(size_t)t * NSEL + h * 16 + j] = ci[j]; EG[(size_t)t * NSEL + h * 16 + j] = e[j] * is; }
    }
}
__device__ __forceinline__ void d_peer(const bf16* H2, const int* EID, const float* EG, const float* Ut, const float* Vt, const float* mod, const float* gfin, float* io) {
    const int lane = threadIdx.x & 63;
    for (int t = blockIdx.x * (NT / 64) + (threadIdx.x >> 6); t < M; t += gridDim.x * (NT / 64)) {
        const int b = t / SEQ; float hv[16], acc[16];
#pragma unroll
        for (int j = 0; j < 4; ++j)
#pragma unroll
            for (int e = 0; e < 4; ++e) { hv[j * 4 + e] = bf2f(H2[(size_t)t * D + j * 256 + lane * 4 + e]); acc[j * 4 + e] = 0.f; }
#pragma unroll 1
        for (int k = 0; k < NSEL; ++k) {
            const int eid = EID[(size_t)t * NSEL + k]; const float g = EG[(size_t)t * NSEL + k];
            const float4* ur = (const float4*)(Ut + (size_t)eid * D); const float4* vr = (const float4*)(Vt + (size_t)eid * D); float dot = 0.f;
#pragma unroll
            for (int j = 0; j < 4; ++j) { const float4 u = ur[j * 64 + lane]; dot += hv[j * 4] * u.x + hv[j * 4 + 1] * u.y + hv[j * 4 + 2] * u.z + hv[j * 4 + 3] * u.w; }
#pragma unroll
            for (int o = 1; o < 64; o <<= 1) dot += __shfl_xor(dot, o);
            const float w = g * 0.5f * dot * (1.f + erff(dot * 0.70710678118654752f));
#pragma unroll
            for (int j = 0; j < 4; ++j) { const float4 v = vr[j * 64 + lane]; acc[j * 4] += w * v.x; acc[j * 4 + 1] += w * v.y; acc[j * 4 + 2] += w * v.z; acc[j * 4 + 3] += w * v.w; }
        }
        float ss = 0.f;
#pragma unroll
        for (int j = 0; j < 4; ++j)
#pragma unroll
            for (int e = 0; e < 4; ++e) { const int col = j * 256 + lane * 4 + e; const float x2 = io[(size_t)t * D + col] + mod[b * 6144 + 5 * D + col] * acc[j * 4 + e]; acc[j * 4 + e] = x2; ss += x2 * x2; }
#pragma unroll
        for (int o = 1; o < 64; o <<= 1) ss += __shfl_xor(ss, o);
        const float r = rsqrtf(ss * (1.f / D) + EPS);
#pragma unroll
        for (int j = 0; j < 4; ++j)
#pragma unroll
            for (int e = 0; e < 4; ++e) { const int col = j * 256 + lane * 4 + e; io[(size_t)t * D + col] = acc[j * 4 + e] * r * gfin[col]; }
    }
}


#define LAS __attribute__((address_space(3)))
typedef short bf16x8 __attribute__((ext_vector_type(8)));
typedef float f32x4 __attribute__((ext_vector_type(4)));
typedef float f32x2 __attribute__((ext_vector_type(2)));
typedef unsigned u32x4 __attribute__((ext_vector_type(4)));
typedef unsigned u32x2 __attribute__((ext_vector_type(2)));
typedef __bf16 bf16x2_t __attribute__((ext_vector_type(2)));
__device__ __forceinline__ unsigned cvt_pk_bf16(float lo, float hi) { f32x2 v = {lo, hi}; bf16x2_t b = __builtin_convertvector(v, bf16x2_t); return __builtin_bit_cast(unsigned, b); }
__device__ __forceinline__ float bflo(unsigned w) { return __uint_as_float(w << 16); }
__device__ __forceinline__ float bfhi(unsigned w) { return __uint_as_float(w & 0xffff0000u); }

namespace pg8 {
constexpr int BM = 256, BK = 64, HALF = 128, HTB = HALF * BK * 2  , STAGE_BYTES = 8 * HTB, NXCD = 8, WGM = 8;
__device__ __forceinline__ int lds_byte(int r, int c) { const int st = (r >> 4) * 2 + (c >> 5), rr = r & 15, cc = c & 31, ob = rr * 64 + cc * 2; return st * 1024 + (ob ^ (((ob >> 9) & 1) << 5)); }
__device__ __forceinline__ void stage_rc(int b, int& R, int& C) { const int st = b / 1024, sb = b % 1024, swz = sb ^ (((sb >> 9) & 1) << 5); R = (st >> 1) * 16 + swz / 64; C = (st & 1) * 32 + (swz % 64) / 2; }
__device__ __forceinline__ int perm32(int rho) { const int n = rho >> 4, i = rho & 15; return 8 * (i >> 2) + 4 * n + (i & 3); }
struct Unit { int pm, pn; };
struct Gemm { const bf16* A; const bf16* Bt; int M, N, K, lda, a_pn_off; };
struct StaticOrder {
    int nM, nN, nwg, G, c;
    __device__ void init(int M_, int N_, int G_, int c_) { nM = M_ / BM; nN = N_ / BM; nwg = nM * nN; G = G_; c = c_; }
    __device__ bool next(int i, Unit& u) const {
        const long L = (long)i * G + c; if (L >= nwg) return false;
        int wgid = (int)L; { const int q = nwg / NXCD, r = nwg % NXCD, xcd = wgid % NXCD, off = wgid / NXCD; wgid = (xcd < r ? xcd * (q + 1) : r * (q + 1) + (xcd - r) * q) + off; }
        const int nig = WGM * nN, gid = wgid / nig, fm = gid * WGM, gsz = (nM - fm) < WGM ? (nM - fm) : WGM;
        u.pm = fm + ((wgid % nig) % gsz); u.pn = (wgid % nig) / gsz; return true;
    }
};
struct OneUnit { Unit u; __device__ bool next(int i, Unit& o) const { if (i) return false; o = u; return true; } };
template <class Epi, class Sched, bool ALIGN_EPI>
__device__ __forceinline__ void gemm_phase(LAS unsigned char* lds, const Gemm g, const Sched& S, const Epi& E) {
    int tid_ = threadIdx.x; asm volatile("" : "+v"(tid_));
    const int tid = tid_, wid = __builtin_amdgcn_readfirstlane(tid >> 6), lane = tid & 63, wr = wid >> 2, wc = wid & 3, fr = lane & 15, fq = lane >> 4;
    const int K = g.K, nt = K / BK, lda = g.lda;
    unsigned voffA[2], voffB[2];
#pragma unroll
    for (int i = 0; i < 2; ++i) { int R, C; stage_rc(tid * 16 + i * 8192, R, C); const int Rb = Epi::PERM ? ((R & ~31) + perm32(R & 31)) : R;
        voffA[i] = (unsigned)(R * lda + C) * 2u; voffB[i] = (unsigned)(Rb * K + C) * 2u; }
    const size_t kstep = (size_t)(BK * 2);
    const size_t hA = (size_t)HALF * lda * 2, hB = (size_t)HALF * K * 2, tA = 2 * hA, tB = 2 * hB;
    const unsigned ldsw = (unsigned)wid * 1024u;
    const int aoff = lds_byte(wr * 64 + fr, fq * 8), boff = lds_byte(wc * 32 + fr, fq * 8);
#define PG8_SA(b, h) (((b) * 2 + (h)) * HTB)
#define PG8_SB(b, h) ((4 + (b) * 2 + (h)) * HTB)
#define PG8_STAGE(bufoff, gbase, voff) do { _Pragma("unroll") for (int _i = 0; _i < 2; ++_i) \
        __builtin_amdgcn_global_load_lds((const unsigned*)((const char*)(gbase) + (voff)[_i]), (LAS unsigned*)(lds + (bufoff) + ldsw + _i * 8192), 16, 0, 0); } while (0)
#define PG8_LDA(dst, b, h) do { _Pragma("unroll") for (int m = 0; m < 4; ++m) _Pragma("unroll") for (int k = 0; k < 2; ++k) dst[m][k] = *(const LAS bf16x8*)(lds + PG8_SA(b, h) + aoff + m * 2048 + k * 1024); } while (0)
#define PG8_LDB(dst, b, h) do { _Pragma("unroll") for (int n = 0; n < 2; ++n) _Pragma("unroll") for (int k = 0; k < 2; ++k) dst[n][k] = *(const LAS bf16x8*)(lds + PG8_SB(b, h) + boff + n * 2048 + k * 1024); } while (0)
#define PG8_MMA(ai, bj, At, Bt) do { __builtin_amdgcn_s_setprio(1); _Pragma("unroll") for (int m = 0; m < 4; ++m) _Pragma("unroll") for (int n = 0; n < 2; ++n) _Pragma("unroll") for (int k = 0; k < 2; ++k) \
        acc[ai][bj][m][n] = __builtin_amdgcn_mfma_f32_16x16x32_bf16(Bt[n][k], At[m][k], acc[ai][bj][m][n], 0, 0, 0); __builtin_amdgcn_s_setprio(0); } while (0)
#define PG8_WAIT_V(n) asm volatile("s_waitcnt vmcnt(" #n ")" ::: "memory")
#define PG8_WAIT_L(n) asm volatile("s_waitcnt lgkmcnt(" #n ")" ::: "memory")
#define PG8_BAR __builtin_amdgcn_s_barrier()
#define PG8_SCHED __builtin_amdgcn_sched_barrier(0)
    Unit cur, nxt; int ui = 0;
    if (!S.next(0, cur)) return;
    f32x4 acc[2][2][4][2];
#pragma unroll
    for (int a = 0; a < 2; ++a)
#pragma unroll
        for (int b = 0; b < 2; ++b)
#pragma unroll
            for (int m = 0; m < 4; ++m)
#pragma unroll
                for (int n = 0; n < 2; ++n) acc[a][b][m][n] = (f32x4){0.f, 0.f, 0.f, 0.f};
    bf16x8 At[4][2], B0[2][2], B1[2][2];
    const char* cA = (const char*)g.A + (size_t)cur.pm * tA + (size_t)cur.pn * g.a_pn_off * 2; const char* cB = (const char*)g.Bt + (size_t)cur.pn * tB;
    PG8_STAGE(PG8_SB(0, 0), cB, voffB); PG8_STAGE(PG8_SB(0, 1), cB + hB, voffB); PG8_STAGE(PG8_SA(0, 0), cA, voffA); PG8_STAGE(PG8_SA(0, 1), cA + hA, voffA);
    if (wr == 1) PG8_BAR;
    PG8_WAIT_V(2); PG8_BAR;
    PG8_STAGE(PG8_SB(1, 0), cB + kstep, voffB); PG8_STAGE(PG8_SA(1, 0), cA + kstep, voffA); PG8_STAGE(PG8_SB(1, 1), cB + hB + kstep, voffB);
    PG8_WAIT_V(6); PG8_BAR;
    for (;;) {
        const bool has_next = S.next(ui + 1, nxt);
        const char* nA = has_next ? (const char*)g.A + (size_t)nxt.pm * tA + (size_t)nxt.pn * g.a_pn_off * 2 : cA; const char* nB = has_next ? (const char*)g.Bt + (size_t)nxt.pn * tB : cB;
        for (int t = 0; t < nt; t += 2) {
            const bool last = (t == nt - 2);
            const char* a1 = cA + (size_t)(t + 1) * kstep;
            const char* a2 = last ? nA : cA + (size_t)(t + 2) * kstep; const char* b2 = last ? nB : cB + (size_t)(t + 2) * kstep;
            const char* a3 = a2 + kstep; const char* b3 = b2 + kstep;
            PG8_LDB(B0, 0, 0); PG8_LDB(B1, 0, 1); PG8_SCHED; PG8_LDA(At, 0, 0); PG8_STAGE(PG8_SA(1, 1), a1 + hA, voffA);
            PG8_WAIT_V(8); PG8_WAIT_L(0); PG8_BAR; PG8_MMA(0, 0, At, B0); PG8_MMA(0, 1, At, B1); PG8_BAR; PG8_SCHED;
            PG8_LDA(At, 0, 1); PG8_STAGE(PG8_SB(0, 0), b2, voffB); PG8_STAGE(PG8_SB(0, 1), b2 + hB, voffB); PG8_STAGE(PG8_SA(0, 0), a2, voffA);
            PG8_WAIT_V(8); PG8_WAIT_L(0); PG8_BAR; PG8_MMA(1, 0, At, B0); PG8_MMA(1, 1, At, B1); PG8_BAR; PG8_SCHED;
            PG8_LDB(B0, 1, 0); PG8_LDB(B1, 1, 1); PG8_SCHED; PG8_LDA(At, 1, 0); PG8_STAGE(PG8_SA(0, 1), a2 + hA, voffA);
            PG8_WAIT_V(8); PG8_WAIT_L(0); PG8_BAR; PG8_MMA(0, 0, At, B0); PG8_MMA(0, 1, At, B1); PG8_BAR; PG8_SCHED;
            PG8_LDA(At, 1, 1); PG8_STAGE(PG8_SB(1, 0), b3, voffB); PG8_STAGE(PG8_SB(1, 1), b3 + hB, voffB); PG8_STAGE(PG8_SA(1, 0), a3, voffA);
            PG8_WAIT_V(8); PG8_WAIT_L(0); PG8_BAR; PG8_MMA(1, 0, At, B0); PG8_MMA(1, 1, At, B1); PG8_BAR; PG8_SCHED;
        }
        if constexpr (ALIGN_EPI) { if (wr == 0) PG8_BAR; }
        if constexpr (!Epi::AFTER_DRAIN) { E(acc, cur, wr, wc, fr, fq); }
        if (!has_next) break;
#pragma unroll
        for (int a = 0; a < 2; ++a)
#pragma unroll
            for (int b = 0; b < 2; ++b)
#pragma unroll
                for (int m = 0; m < 4; ++m)
#pragma unroll
                    for (int n = 0; n < 2; ++n) acc[a][b][m][n] = (f32x4){0.f, 0.f, 0.f, 0.f};
        cur = nxt; cA = nA; cB = nB; ++ui;
        if constexpr (ALIGN_EPI) { if (wr == 1) PG8_BAR; }
    }
    PG8_WAIT_V(0);
    if constexpr (!ALIGN_EPI) { if (wr == 0) PG8_BAR; }
    PG8_BAR;
    if constexpr (Epi::AFTER_DRAIN) { E.fused(acc, cur, wr, wc, fr, fq, lds, wid, lane); }
#undef PG8_SA
#undef PG8_SB
#undef PG8_STAGE
#undef PG8_LDA
#undef PG8_LDB
#undef PG8_MMA
#undef PG8_WAIT_V
#undef PG8_WAIT_L
#undef PG8_BAR
#undef PG8_SCHED
}
}

__device__ __forceinline__ float fast_sigmoid(float v) { return __builtin_amdgcn_rcpf(1.f + __builtin_amdgcn_exp2f(-1.4426950408889634f * v)); }
struct EpiInProj {
    static constexpr bool PERM = true, AFTER_DRAIN = false;
    bf16 *UP, *Q, *Kb, *V, *G; const float* rope; float* ksum;
    __device__ __forceinline__ void operator()(const f32x4 (&acc)[2][2][4][2], const pg8::Unit& u, int wr, int wc, int fr, int fq) const {
        const int pn = u.pn, row0 = u.pm * 256 + wr * 64 + fr;
        if (pn < 2 || (pn >= 6 && pn < 8)) {
            bf16* O = pn < 2 ? UP : V; const int c0 = (pn & 1) * 256 + wc * 32 + 8 * fq;
#pragma unroll
            for (int ai = 0; ai < 2; ++ai)
#pragma unroll
                for (int m = 0; m < 4; ++m)
#pragma unroll
                    for (int bj = 0; bj < 2; ++bj) { const f32x4 v0 = acc[ai][bj][m][0], v1 = acc[ai][bj][m][1]; u32x4 w;
                        w.x = cvt_pk_bf16(v0[0], v0[1]); w.y = cvt_pk_bf16(v0[2], v0[3]); w.z = cvt_pk_bf16(v1[0], v1[1]); w.w = cvt_pk_bf16(v1[2], v1[3]);
                        *(u32x4*)(O + (size_t)(row0 + ai * 128 + m * 16) * 512 + c0 + bj * 128) = w; }
        } else if (pn < 6) {
            const bool isq = pn < 4; bf16* O = isq ? Q : Kb; const int c0 = (pn & 1) * 256 + wc * 32 + 8 * fq; const bool rot = (wc & 1) == 0;
            float cs[2][8];
#pragma unroll
            for (int bj = 0; bj < 2; ++bj)
#pragma unroll
                for (int i = 0; i < 8; ++i) cs[bj][i] = 0.f;
#pragma unroll
            for (int ai = 0; ai < 2; ++ai)
#pragma unroll
                for (int m = 0; m < 4; ++m) {
                    const int row = row0 + ai * 128 + m * 16, pos = row % SEQ;
                    f32x4 c0v = {1.f, 1.f, 1.f, 1.f}, c1v = c0v, s0v = {0.f, 0.f, 0.f, 0.f}, s1v = s0v;
                    if (rot) { const f32x4* rp = (const f32x4*)(rope + pos * 16); c0v = rp[0]; c1v = rp[1]; s0v = rp[2]; s1v = rp[3]; }
#pragma unroll
                    for (int bj = 0; bj < 2; ++bj) { f32x4 v0 = acc[ai][bj][m][0], v1 = acc[ai][bj][m][1];
                        if (rot) { f32x4 p0, p1;
#pragma unroll
                            for (int i = 0; i < 4; ++i) { p0[i] = __shfl_xor(v0[i], 16); p1[i] = __shfl_xor(v1[i], 16); }
                            if (fq == 0) { v0 = v0 * c0v - p0 * s0v; v1 = v1 * c1v - p1 * s1v; } else if (fq == 1) { v0 = p0 * s0v + v0 * c0v; v1 = p1 * s1v + v1 * c1v; } }
                        if (isq) { v0 = v0 * C2; v1 = v1 * C2; } else {
#pragma unroll
                            for (int i = 0; i < 4; ++i) { cs[bj][i] += v0[i]; cs[bj][4 + i] += v1[i]; } }
                        u32x4 w; w.x = cvt_pk_bf16(v0[0], v0[1]); w.y = cvt_pk_bf16(v0[2], v0[3]); w.z = cvt_pk_bf16(v1[0], v1[1]); w.w = cvt_pk_bf16(v1[2], v1[3]);
                        *(u32x4*)(O + (size_t)row * 512 + c0 + bj * 128) = w; }
                }
            if (!isq) {
                const int b = u.pm / NBLK, blk = u.pm % NBLK;
#pragma unroll
                for (int bj = 0; bj < 2; ++bj)
#pragma unroll
                    for (int i = 0; i < 8; ++i) { float s = cs[bj][i]; s += __shfl_xor(s, 1); s += __shfl_xor(s, 2); s += __shfl_xor(s, 4); s += __shfl_xor(s, 8);
                        if (fr == 0) { const int head = (pn & 1) * 4 + bj * 2 + (wc >> 1), d = (wc & 1) * 32 + 8 * fq + i; atomicAdd(ksum + ((size_t)(b * NH + head) * NBLK + blk) * HD + d, s); } }
            }
        } else {
            const int c0 = (pn - 8) * 256 + wc * 32 + 8 * fq;
#pragma unroll
            for (int ai = 0; ai < 2; ++ai)
#pragma unroll
                for (int m = 0; m < 4; ++m)
#pragma unroll
                    for (int bj = 0; bj < 2; ++bj) { const f32x4 v0 = acc[ai][bj][m][0], v1 = acc[ai][bj][m][1]; u32x4 w;
                        w.x = cvt_pk_bf16(fast_sigmoid(v0[0]), fast_sigmoid(v0[1])); w.y = cvt_pk_bf16(fast_sigmoid(v0[2]), fast_sigmoid(v0[3]));
                        w.z = cvt_pk_bf16(fast_sigmoid(v1[0]), fast_sigmoid(v1[1])); w.w = cvt_pk_bf16(fast_sigmoid(v1[2]), fast_sigmoid(v1[3]));
                        *(u32x4*)(G + (size_t)(row0 + ai * 128 + m * 16) * 2048 + c0 + bj * 128) = w; }
        }
    }
};
template <int PASS> struct EpiMerge {
    static constexpr bool PERM = true, AFTER_DRAIN = false;
    bf16* Mg; const bf16* G;
    __device__ __forceinline__ void operator()(const f32x4 (&acc)[2][2][4][2], const pg8::Unit& u, int wr, int wc, int fr, int fq) const {
        const int row0 = u.pm * 256 + wr * 64 + fr, c0 = u.pn * 256 + wc * 32 + 8 * fq;
#pragma unroll
        for (int ai = 0; ai < 2; ++ai)
#pragma unroll
            for (int m = 0; m < 4; ++m)
#pragma unroll
                for (int bj = 0; bj < 2; ++bj) { const size_t row = (size_t)(row0 + ai * 128 + m * 16); const int col = c0 + bj * 128;
                    const u32x4 gw = *(const u32x4*)(G + row * 2048 + PASS * 1024 + col); const f32x4 v0 = acc[ai][bj][m][0], v1 = acc[ai][bj][m][1];
                    float o[8] = {bflo(gw.x) * v0[0], bfhi(gw.x) * v0[1], bflo(gw.y) * v0[2], bfhi(gw.y) * v0[3], bflo(gw.z) * v1[0], bfhi(gw.z) * v1[1], bflo(gw.w) * v1[2], bfhi(gw.w) * v1[3]};
                    if (PASS == 1) { const u32x4 pw = *(const u32x4*)(Mg + row * 1024 + col);
                        o[0] += bflo(pw.x); o[1] += bfhi(pw.x); o[2] += bflo(pw.y); o[3] += bfhi(pw.y); o[4] += bflo(pw.z); o[5] += bfhi(pw.z); o[6] += bflo(pw.w); o[7] += bfhi(pw.w); }
                    u32x4 w; w.x = cvt_pk_bf16(o[0], o[1]); w.y = cvt_pk_bf16(o[2], o[3]); w.z = cvt_pk_bf16(o[4], o[5]); w.w = cvt_pk_bf16(o[6], o[7]);
                    *(u32x4*)(Mg + row * 1024 + col) = w; }
    }
};
struct EpiRes1 {
    static constexpr bool PERM = false, AFTER_DRAIN = false;
    const float* x; const float* mod; float* x1;
    __device__ __forceinline__ void operator()(const f32x4 (&acc)[2][2][4][2], const pg8::Unit& u, int wr, int wc, int fr, int fq) const {
        const int row0 = u.pm * 256 + wr * 64 + fr, c0 = u.pn * 256 + wc * 32 + 4 * fq, b = u.pm / NBLK;
#pragma unroll
        for (int bj = 0; bj < 2; ++bj)
#pragma unroll
            for (int n = 0; n < 2; ++n) { const int col = c0 + bj * 128 + n * 16; const f32x4 gv = *(const f32x4*)(mod + b * 6144 + 2 * D + col);
#pragma unroll
                for (int ai = 0; ai < 2; ++ai)
#pragma unroll
                    for (int m = 0; m < 4; ++m) { const size_t off = (size_t)(row0 + ai * 128 + m * 16) * D + col; *(f32x4*)(x1 + off) = *(const f32x4*)(x + off) + gv * acc[ai][bj][m][n]; } }
    }
};
struct EpiBf16 {
    static constexpr bool PERM = true, AFTER_DRAIN = false;
    bf16* O; int ldo;
    __device__ __forceinline__ void operator()(const f32x4 (&acc)[2][2][4][2], const pg8::Unit& u, int wr, int wc, int fr, int fq) const {
        const int row0 = u.pm * 256 + wr * 64 + fr, c0 = u.pn * 256 + wc * 32 + 8 * fq;
#pragma unroll
        for (int ai = 0; ai < 2; ++ai)
#pragma unroll
            for (int m = 0; m < 4; ++m)
#pragma unroll
                for (int bj = 0; bj < 2; ++bj) { const f32x4 v0 = acc[ai][bj][m][0], v1 = acc[ai][bj][m][1]; u32x4 w;
                    w.x = cvt_pk_bf16(v0[0], v0[1]); w.y = cvt_pk_bf16(v0[2], v0[3]); w.z = cvt_pk_bf16(v1[0], v1[1]); w.w = cvt_pk_bf16(v1[2], v1[3]);
                    *(u32x4*)(O + (size_t)(row0 + ai * 128 + m * 16) * ldo + c0 + bj * 128) = w; }
    }
};

namespace att {
typedef short v4i16_t __attribute__((ext_vector_type(4)));
typedef float f32x16 __attribute__((ext_vector_type(16)));
constexpr int KB_BYTES = 8192, VROW = 192, VB_BYTES = 64 * VROW, OFF_V = 2 * KB_BYTES, OFF_MISC = OFF_V + 2 * VB_BYTES;
__device__ __forceinline__ int crow(int r, int hi) { return (r & 3) + 8 * (r >> 2) + 4 * hi; }
__device__ __forceinline__ float bfe(bf16x8 v, int j) { return __uint_as_float(((unsigned)(unsigned short)v[j]) << 16); }
__device__ __forceinline__ void attn_phase(LAS unsigned char* lds, const bf16* Q, const bf16* Kb, const bf16* V, const float* ksum, bf16* ATT, int G, int bid) {
    int tid_ = threadIdx.x; asm volatile("" : "+v"(tid_));
    const int tid = tid_, lane = tid & 63, wid = __builtin_amdgcn_readfirstlane(tid >> 6), r32 = lane & 31, hi = lane >> 5;
    const int vcu = (G % 8 == 0) ? (bid % 8) * (G / 8) + bid / 8 : bid;
    LAS unsigned char* Kbuf = lds; LAS unsigned char* Vbuf = lds + OFF_V; LAS int* misc = (LAS int*)(lds + OFF_MISC);
    const int ld_row = tid >> 3, ld_ch = tid & 7;
    const int kst = ld_row * 128 + ((ld_ch ^ ((ld_row >> 1) & 7)) << 4), vst = ld_row * VROW + ld_ch * 16;
    for (int uidx = vcu; uidx < 512; uidx += G) {
        const int bh = (uidx & 255) >> 4, s_ = uidx & 15, qb = uidx < 256 ? s_ : 31 - s_, b = bh >> 3, h = bh & 7;
        const int q_off = wid * 32 + r32; const size_t qrow = (size_t)b * SEQ + qb * 256 + q_off;
        bf16x8 qr[4];
#pragma unroll
        for (int s = 0; s < 4; ++s) qr[s] = *(const bf16x8*)(Q + qrow * 512 + h * 64 + 16 * s + 8 * hi);
        unsigned selmask = 0u;
        { int s0 = -1, s1 = -1, s2 = -1; float g0 = -INFINITY, g1 = -INFINITY, g2 = -INFINITY;
          const float* ksb = ksum + (size_t)(b * NH + h) * NBLK * HD + 8 * hi;
          for (int j = 0; j < qb; ++j) { float part = 0.f;
#pragma unroll
              for (int s = 0; s < 4; ++s) { const f32x4 k0 = *(const f32x4*)(ksb + j * HD + 16 * s), k1 = *(const f32x4*)(ksb + j * HD + 16 * s + 4);
                  part += bfe(qr[s], 0) * k0[0] + bfe(qr[s], 1) * k0[1] + bfe(qr[s], 2) * k0[2] + bfe(qr[s], 3) * k0[3] + bfe(qr[s], 4) * k1[0] + bfe(qr[s], 5) * k1[1] + bfe(qr[s], 6) * k1[2] + bfe(qr[s], 7) * k1[3]; }
              const float g = part + __shfl_xor(part, 32);
              if (g > g0) { g2 = g1; s2 = s1; g1 = g0; s1 = s0; g0 = g; s0 = j; } else if (g > g1) { g2 = g1; s2 = s1; g1 = g; s1 = j; } else if (g > g2) { g2 = g; s2 = j; } }
          if (s0 >= 0) selmask |= 1u << s0; if (s1 >= 0) selmask |= 1u << s1; if (s2 >= 0) selmask |= 1u << s2; }
        { unsigned um = selmask;
#pragma unroll
          for (int o = 1; o < 64; o <<= 1) um |= (unsigned)__shfl_xor((int)um, o);
          if (lane == 0) misc[wid] = (int)um; }
        __syncthreads();
        if (tid == 0) { unsigned uni = 0u; for (int w = 0; w < 8; ++w) uni |= (unsigned)misc[w]; int nb = 1; misc[16] = qb; while (uni) { misc[16 + nb] = __builtin_ctz(uni); uni &= uni - 1u; ++nb; } misc[8] = nb; }
        __syncthreads();
        const int ntiles = misc[8] * 4;
        const bf16* Kg = Kb + ((size_t)b * SEQ) * 512 + h * 64 + ld_ch * 8; const bf16* Vg = V + ((size_t)b * SEQ) * 512 + h * 64 + ld_ch * 8;
        u32x4 kreg, vreg;
        { const int jb0 = misc[16]; const size_t ro = (size_t)(jb0 * 256 + ld_row) * 512; kreg = *(const u32x4*)(Kg + ro); vreg = *(const u32x4*)(Vg + ro); }
        *(LAS u32x4*)(Kbuf + kst) = kreg; *(LAS u32x4*)(Vbuf + vst) = vreg;
        __syncthreads();
        float mrun = -INFINITY, lsum = 0.f; f32x16 o0 = {}, o1 = {};
        for (int n = 0; n < ntiles; ++n) {
            const int jb = misc[16 + (n >> 2)], tt = n & 3; const bool own = n < 4;
            if (n + 1 < ntiles) { const int jn = misc[16 + ((n + 1) >> 2)]; const size_t ro = (size_t)(jn * 256 + ((n + 1) & 3) * 64 + ld_row) * 512; kreg = *(const u32x4*)(Kg + ro); vreg = *(const u32x4*)(Vg + ro); }
            const bool lane_valid = own || ((selmask >> jb) & 1u);
            const bool need = own ? (64 * tt <= 32 * wid + 31) : (__any(lane_valid ? 1 : 0) != 0);
            if (need) {
                const LAS unsigned char* kb_ = Kbuf + (n & 1) * KB_BYTES; const LAS unsigned char* vb_ = Vbuf + (n & 1) * VB_BYTES;
                f32x16 p0 = {}, p1 = {};
#pragma unroll
                for (int s = 0; s < 4; ++s) { const int c = 2 * s + hi; const int sw = ((c ^ ((r32 >> 1) & 7)) << 4);
                    const bf16x8 a0 = *(const LAS bf16x8*)(kb_ + r32 * 128 + sw), a1 = *(const LAS bf16x8*)(kb_ + (32 + r32) * 128 + sw);
                    p0 = __builtin_amdgcn_mfma_f32_32x32x16_bf16(a0, qr[s], p0, 0, 0, 0); p1 = __builtin_amdgcn_mfma_f32_32x32x16_bf16(a1, qr[s], p1, 0, 0, 0); }
                if (own) {
#pragma unroll
                    for (int r = 0; r < 16; ++r) { const int ko = tt * 64 + crow(r, hi); if (ko > q_off) p0[r] = -INFINITY; if (ko + 32 > q_off) p1[r] = -INFINITY; }
                } else if (!lane_valid) {
#pragma unroll
                    for (int r = 0; r < 16; ++r) { p0[r] = -INFINITY; p1[r] = -INFINITY; }
                }
                float mt = fmaxf(p0[0], p1[0]);
#pragma unroll
                for (int r = 1; r < 16; ++r) mt = fmaxf(mt, fmaxf(p0[r], p1[r]));
                mt = fmaxf(mt, __shfl_xor(mt, 32));
                const float mnew = fmaxf(mrun, mt), alpha = __builtin_amdgcn_exp2f(mrun - mnew); mrun = mnew;
                float ps = 0.f;
#pragma unroll
                for (int r = 0; r < 16; ++r) { p0[r] = __builtin_amdgcn_exp2f(p0[r] - mnew); p1[r] = __builtin_amdgcn_exp2f(p1[r] - mnew); ps += p0[r] + p1[r]; }
                lsum = lsum * alpha + ps;
                if (!__all(alpha == 1.f ? 1 : 0)) {
#pragma unroll
                    for (int r = 0; r < 16; ++r) { o0[r] *= alpha; o1[r] *= alpha; } }
                bf16x8 pb[2][2];
#pragma unroll
                for (int s2 = 0; s2 < 2; ++s2) { u32x4 w0, w1;
                    w0.x = cvt_pk_bf16(p0[8 * s2], p0[8 * s2 + 1]); w0.y = cvt_pk_bf16(p0[8 * s2 + 2], p0[8 * s2 + 3]); w0.z = cvt_pk_bf16(p0[8 * s2 + 4], p0[8 * s2 + 5]); w0.w = cvt_pk_bf16(p0[8 * s2 + 6], p0[8 * s2 + 7]);
                    w1.x = cvt_pk_bf16(p1[8 * s2], p1[8 * s2 + 1]); w1.y = cvt_pk_bf16(p1[8 * s2 + 2], p1[8 * s2 + 3]); w1.z = cvt_pk_bf16(p1[8 * s2 + 4], p1[8 * s2 + 5]); w1.w = cvt_pk_bf16(p1[8 * s2 + 6], p1[8 * s2 + 7]);
                    pb[0][s2] = __builtin_bit_cast(bf16x8, w0); pb[1][s2] = __builtin_bit_cast(bf16x8, w1); }
                const LAS unsigned char* vl = vb_ + (4 * hi + ((lane & 15) >> 2)) * VROW + (16 * ((lane >> 4) & 1) + 4 * (lane & 3)) * 2;
#pragma unroll
                for (int dt = 0; dt < 2; ++dt)
#pragma unroll
                    for (int u = 0; u < 2; ++u)
#pragma unroll
                        for (int s2 = 0; s2 < 2; ++s2) { const LAS unsigned char* va = vl + (32 * u + 16 * s2) * VROW + dt * 64;
                            const v4i16_t lo = __builtin_amdgcn_ds_read_tr16_b64_v4i16((LAS v4i16_t*)va), hh = __builtin_amdgcn_ds_read_tr16_b64_v4i16((LAS v4i16_t*)(va + 8 * VROW));
                            const bf16x8 vf = {lo[0], lo[1], lo[2], lo[3], hh[0], hh[1], hh[2], hh[3]};
                            if (dt == 0) o0 = __builtin_amdgcn_mfma_f32_32x32x16_bf16(vf, pb[u][s2], o0, 0, 0, 0); else o1 = __builtin_amdgcn_mfma_f32_32x32x16_bf16(vf, pb[u][s2], o1, 0, 0, 0); }
            }
            if (n + 1 < ntiles) { *(LAS u32x4*)(Kbuf + ((n + 1) & 1) * KB_BYTES + kst) = kreg; *(LAS u32x4*)(Vbuf + ((n + 1) & 1) * VB_BYTES + vst) = vreg; }
            __syncthreads();
        }
        const float inv = 1.f / (lsum + __shfl_xor(lsum, 32));
        bf16* orow = ATT + qrow * 512 + h * 64 + 4 * hi;
#pragma unroll
        for (int g4 = 0; g4 < 4; ++g4) { u32x2 w;
            w.x = cvt_pk_bf16(o0[4 * g4] * inv, o0[4 * g4 + 1] * inv); w.y = cvt_pk_bf16(o0[4 * g4 + 2] * inv, o0[4 * g4 + 3] * inv); *(u32x2*)(orow + 8 * g4) = w;
            w.x = cvt_pk_bf16(o1[4 * g4] * inv, o1[4 * g4 + 1] * inv); w.y = cvt_pk_bf16(o1[4 * g4 + 2] * inv, o1[4 * g4 + 3] * inv); *(u32x2*)(orow + 32 + 8 * g4) = w; }
    }
}
}

__device__ __forceinline__ float dot2bf(unsigned a, unsigned b, float acc) { return __builtin_amdgcn_fdot2_f32_bf16(__builtin_bit_cast(bf16x2_t, a), __builtin_bit_cast(bf16x2_t, b), acc, false); }
__device__ __forceinline__ void d_tab_bf16(const float* T, bf16* O) {
    GSTRIDE(i, (size_t)NEXP * D / 8) { const f32x4 a = ((const f32x4*)T)[2 * i], b = ((const f32x4*)T)[2 * i + 1]; u32x4 w;
        w.x = cvt_pk_bf16(a[0], a[1]); w.y = cvt_pk_bf16(a[2], a[3]); w.z = cvt_pk_bf16(b[0], b[1]); w.w = cvt_pk_bf16(b[2], b[3]); ((u32x4*)O)[i] = w; }
}
__device__ __forceinline__ void peer_phase(const bf16* H2, const int* EID, const float* EG, const bf16* UT, const bf16* VT, const float* mod, const float* gfin, const float* x1, float* outp) {
    int tid_ = threadIdx.x; asm volatile("" : "+v"(tid_));
    const int lane = tid_ & 63, wv = tid_ >> 6;
    for (int t = blockIdx.x * (NT / 64) + wv; t < M; t += gridDim.x * (NT / 64)) {
        const int b = t / SEQ;
        const u32x4 h0 = *(const u32x4*)(H2 + (size_t)t * D + 8 * lane), h1 = *(const u32x4*)(H2 + (size_t)t * D + 512 + 8 * lane);
        const int e0 = EID[(size_t)t * NSEL + lane], e1 = EID[(size_t)t * NSEL + 64 + lane]; const float gg0 = EG[(size_t)t * NSEL + lane], gg1 = EG[(size_t)t * NSEL + 64 + lane];
        float acc[16];
#pragma unroll
        for (int i = 0; i < 16; ++i) acc[i] = 0.f;
#pragma unroll 1
        for (int kb = 0; kb < NSEL; kb += 8) {
            u32x4 ua[8], ub[8], va[8], vb[8];
#pragma unroll
            for (int j = 0; j < 8; ++j) { const int k = kb + j; const int eid = __builtin_amdgcn_readlane(k < 64 ? e0 : e1, k & 63);
                const bf16* ur = UT + (size_t)eid * D + 8 * lane; const bf16* vr = VT + (size_t)eid * D + 8 * lane;
                ua[j] = *(const u32x4*)ur; ub[j] = *(const u32x4*)(ur + 512); va[j] = *(const u32x4*)vr; vb[j] = *(const u32x4*)(vr + 512); }
            float d[8];
#pragma unroll
            for (int j = 0; j < 8; ++j) { float a = 0.f; a = dot2bf(ua[j].x, h0.x, a); a = dot2bf(ua[j].y, h0.y, a); a = dot2bf(ua[j].z, h0.z, a); a = dot2bf(ua[j].w, h0.w, a);
                a = dot2bf(ub[j].x, h1.x, a); a = dot2bf(ub[j].y, h1.y, a); a = dot2bf(ub[j].z, h1.z, a); a = dot2bf(ub[j].w, h1.w, a); d[j] = a; }
            float r4[4], r2[2], r1;
            { const bool up = (lane & 32) != 0;
#pragma unroll
              for (int j = 0; j < 4; ++j) { const float snd = up ? d[j] : d[j + 4], kp = up ? d[j + 4] : d[j]; r4[j] = kp + __shfl_xor(snd, 32); } }
            { const bool up = (lane & 16) != 0;
#pragma unroll
              for (int j = 0; j < 2; ++j) { const float snd = up ? r4[j] : r4[j + 2], kp = up ? r4[j + 2] : r4[j]; r2[j] = kp + __shfl_xor(snd, 16); } }
            { const bool up = (lane & 8) != 0; const float snd = up ? r2[0] : r2[1], kp = up ? r2[1] : r2[0]; r1 = kp + __shfl_xor(snd, 8); }
            r1 += __shfl_xor(r1, 4); r1 += __shfl_xor(r1, 2); r1 += __shfl_xor(r1, 1);
            const float ge = 0.5f * r1 * (1.f + erff(r1 * 0.70710678118654752f));
#pragma unroll
            for (int j = 0; j < 8; ++j) { const int k = kb + j; const float gk = __uint_as_float(__builtin_amdgcn_readlane(__float_as_uint(k < 64 ? gg0 : gg1), k & 63));
                const float w = gk * __uint_as_float(__builtin_amdgcn_readlane(__float_as_uint(ge), ((j & 4) ? 32 : 0) + ((j & 2) ? 16 : 0) + ((j & 1) ? 8 : 0)));
                acc[0] += w * bflo(va[j].x); acc[1] += w * bfhi(va[j].x); acc[2] += w * bflo(va[j].y); acc[3] += w * bfhi(va[j].y); acc[4] += w * bflo(va[j].z); acc[5] += w * bfhi(va[j].z); acc[6] += w * bflo(va[j].w); acc[7] += w * bfhi(va[j].w);
                acc[8] += w * bflo(vb[j].x); acc[9] += w * bfhi(vb[j].x); acc[10] += w * bflo(vb[j].y); acc[11] += w * bfhi(vb[j].y); acc[12] += w * bflo(vb[j].z); acc[13] += w * bfhi(vb[j].z); acc[14] += w * bflo(vb[j].w); acc[15] += w * bfhi(vb[j].w); }
        }
        float ss = 0.f;
#pragma unroll
        for (int c = 0; c < 2; ++c)
#pragma unroll
            for (int q4 = 0; q4 < 2; ++q4) { const int col = c * 512 + 8 * lane + 4 * q4; const f32x4 xv = *(const f32x4*)(x1 + (size_t)t * D + col), gv = *(const f32x4*)(mod + b * 6144 + 5 * D + col);
#pragma unroll
                for (int e = 0; e < 4; ++e) { const float x2 = xv[e] + gv[e] * acc[c * 8 + q4 * 4 + e]; acc[c * 8 + q4 * 4 + e] = x2; ss += x2 * x2; } }
#pragma unroll
        for (int o = 1; o < 64; o <<= 1) ss += __shfl_xor(ss, o);
        const float r = rsqrtf(ss * (1.f / D) + EPS);
#pragma unroll
        for (int c = 0; c < 2; ++c)
#pragma unroll
            for (int q4 = 0; q4 < 2; ++q4) { const int col = c * 512 + 8 * lane + 4 * q4; const f32x4 gf = *(const f32x4*)(gfin + col); f32x4 o;
#pragma unroll
                for (int e = 0; e < 4; ++e) o[e] = acc[c * 8 + q4 * 4 + e] * r * gf[e];
                *(f32x4*)(outp + (size_t)t * D + col) = o; }
    }
}

__device__ __forceinline__ void d_skbd(const float* sk, bf16* SKBD) {
    GSTRIDE(idx, 2048 * 256) { const int n = (int)idx >> 8, kk = (int)idx & 255, p = (n >> 7) & 1; SKBD[idx] = ((kk >> 7) == p) ? f2bf(sk[(size_t)n * 128 + (kk & 127)]) : (bf16)0; }
}
__device__ __forceinline__ unsigned f2sort(float f) { const unsigned b = __float_as_uint(f); return b ^ ((unsigned)((int)b >> 31) | 0x80000000u); }
__device__ __forceinline__ float sort2f(unsigned k) { return __uint_as_float(k ^ (((k >> 31) - 1u) | 0x80000000u)); }
struct EpiRoute {
    static constexpr bool PERM = false, AFTER_DRAIN = true;
    int* EID; float* EG;
    __device__ __forceinline__ void fused(f32x4 (&acc)[2][2][4][2], const pg8::Unit& u, int wr, int wc, int fr_, int fq_, LAS unsigned char* lds, int wid, int lane_) const {
        int lane = lane_; asm volatile("" : "+v"(lane));
        const int fr = lane & 15, fq = lane >> 4;
        constexpr int RS = 257; LAS float* S = (LAS float*)lds; LAS unsigned char* tab = lds + 128 * RS * 4 + ((wid & 3) * 64 + lane) * 32;
#pragma unroll
        for (int ai = 0; ai < 2; ++ai) {
#pragma unroll
            for (int bj = 0; bj < 2; ++bj)
#pragma unroll
                for (int m = 0; m < 4; ++m)
#pragma unroll
                    for (int n = 0; n < 2; ++n) { LAS float* sp = S + (64 * wr + 16 * m + fr) * RS + 128 * bj + 32 * wc + 16 * n + 4 * fq; const f32x4 v = acc[ai][bj][m][n]; sp[0] = v[0]; sp[1] = v[1]; sp[2] = v[2]; sp[3] = v[3]; }
            __syncthreads();
            if (wid < 4) {
                const int rl = 32 * wid + (lane & 31), p = lane >> 5; const LAS float* sp = S + rl * RS + 128 * p;
                unsigned top[16];
#pragma unroll
                for (int j = 0; j < 16; ++j) top[j] = 0u;
#pragma unroll 8
                for (int n = 0; n < 128; ++n) { unsigned key = (f2sort(sp[n]) & ~0x7Fu) | (unsigned)n;
#pragma unroll
                    for (int j = 0; j < 16; ++j) { const unsigned hi_ = max(top[j], key); key = min(top[j], key); top[j] = hi_; } }
                float af[16], bf_[16]; unsigned ia[4] = {0u, 0u, 0u, 0u}, ib[4] = {0u, 0u, 0u, 0u};
#pragma unroll
                for (int j = 0; j < 16; ++j) { const unsigned oth = (unsigned)__shfl_xor((int)top[j], 32); const unsigned ka = p ? oth : top[j], kb = p ? top[j] : oth;
                    af[j] = sort2f(ka & ~0x7Fu); bf_[j] = sort2f(kb & ~0x7Fu); ia[j >> 2] |= (ka & 0x7Fu) << (8 * (j & 3)); ib[j >> 2] |= (kb & 0x7Fu) << (8 * (j & 3)); }
                *(LAS u32x4*)tab = (u32x4){ia[0], ia[1], ia[2], ia[3]}; *(LAS u32x4*)(tab + 16) = (u32x4){ib[0], ib[1], ib[2], ib[3]};
                unsigned ct[16];
#pragma unroll
                for (int j = 0; j < 16; ++j) ct[j] = 0u;
#pragma unroll
                for (int i = 0; i < 16; ++i)
#pragma unroll
                    for (int j2 = 0; j2 < 16; ++j2) if ((i + 1) * (j2 + 1) <= 16) { unsigned key = (f2sort(af[i] + bf_[j2]) & ~0xFFu) | (unsigned)(i * 16 + j2);
#pragma unroll
                        for (int j = 0; j < 16; ++j) { const unsigned hi_ = max(ct[j], key); key = min(ct[j], key); ct[j] = hi_; } }
                asm volatile("s_waitcnt lgkmcnt(0)" ::: "memory");
                int eid[16]; float ev[16]; float sum = 0.f; const float v0 = sort2f(ct[0] & ~0xFFu);
#pragma unroll
                for (int k = 0; k < 16; ++k) { const unsigned code = ct[k] & 0xFFu; const int i_a = tab[code >> 4], i_b = tab[16 + (code & 15u)]; eid[k] = i_a * NKEYS + i_b;
                    ev[k] = __builtin_amdgcn_exp2f((sort2f(ct[k] & ~0xFFu) - v0) * 1.4426950408889634f); sum += ev[k]; }
                const float is = 1.f / sum; const size_t ob = (size_t)(u.pm * 256 + 128 * ai + rl) * NSEL + u.pn * 16 + 8 * p;
                u32x4 e0, e1; f32x4 g0, g1;
                e0.x = p ? eid[8] : eid[0]; e0.y = p ? eid[9] : eid[1]; e0.z = p ? eid[10] : eid[2]; e0.w = p ? eid[11] : eid[3]; e1.x = p ? eid[12] : eid[4]; e1.y = p ? eid[13] : eid[5]; e1.z = p ? eid[14] : eid[6]; e1.w = p ? eid[15] : eid[7];
                g0[0] = (p ? ev[8] : ev[0]) * is; g0[1] = (p ? ev[9] : ev[1]) * is; g0[2] = (p ? ev[10] : ev[2]) * is; g0[3] = (p ? ev[11] : ev[3]) * is; g1[0] = (p ? ev[12] : ev[4]) * is; g1[1] = (p ? ev[13] : ev[5]) * is; g1[2] = (p ? ev[14] : ev[6]) * is; g1[3] = (p ? ev[15] : ev[7]) * is;
                *(u32x4*)(EID + ob) = e0; *(u32x4*)(EID + ob + 4) = e1; *(f32x4*)(EG + ob) = g0; *(f32x4*)(EG + ob + 4) = g1;
            }
            __syncthreads();
        }
    }
};
__device__ __forceinline__ void route_phase(LAS unsigned char* lds, const bf16* QP, const bf16* SKBD, int* EID, float* EG, int G, int bid) {
    pg8::Gemm g{QP, SKBD, M, 2048, 256, 2048, 256}; pg8::StaticOrder S; S.init(M, 2048, G, bid); EpiRoute E{EID, EG}; pg8::OneUnit O;
    for (int i = 0; S.next(i, O.u); ++i) pg8::gemm_phase<EpiRoute, pg8::OneUnit, false>(lds, g, O, E);
}
__device__ __forceinline__ void d_route_summary(const int* EID, const float* EG, float* SUMM) {
    GSTRIDE(idx, M * PHEADS) { float s1 = 0.f, s2 = 0.f; for (int k = 0; k < 16; ++k) { const int e = EID[idx * 16 + k]; const float gk = EG[idx * 16 + k]; s1 += gk * (float)(e % 1021) * (1.f / 1021.f); s2 += gk * (float)e * (1.f / 16384.f); } SUMM[idx * 2] = s1; SUMM[idx * 2 + 1] = s2; }
}

constexpr int MOD_KS = 16;
__device__ __forceinline__ void p0_mod_partials(const float* c, const float* w_ada, float* MODP) {
    const int lane = threadIdx.x & 63, gw = blockIdx.x * (NT / 64) + (threadIdx.x >> 6), ngw = gridDim.x * (NT / 64);
    for (int it = gw; it < 96 * MOD_KS; it += ngw) {
        const int cg_ = it % 96, ks = it / 96, j = cg_ * 64 + lane, k0 = ks * 64;
        const float c0 = c[k0 + lane], c1 = c[D + k0 + lane]; const float a0 = c0 / (1.f + __expf(-c0)), a1 = c1 / (1.f + __expf(-c1));
        float acc0 = 0.f, acc1 = 0.f;
#pragma unroll 16
        for (int k = 0; k < 64; ++k) { const float w = w_ada[(size_t)(k0 + k) * 6144 + j];
            acc0 += __uint_as_float(__builtin_amdgcn_readlane(__float_as_uint(a0), k)) * w; acc1 += __uint_as_float(__builtin_amdgcn_readlane(__float_as_uint(a1), k)) * w; }
        MODP[(size_t)(ks * 2) * 6144 + j] = acc0; MODP[(size_t)(ks * 2 + 1) * 6144 + j] = acc1;
    }
}
__device__ __forceinline__ float mod_reduce(const float* MODP, const float* b_ada, int idx) {
    float s = b_ada[idx % 6144];
#pragma unroll
    for (int ks = 0; ks < MOD_KS; ++ks) s += MODP[(size_t)ks * 2 * 6144 + idx];
    return s;
}
__device__ __forceinline__ void p0_transpose_item(const float* W, int K, int N, bf16* WT, LAS float* scr, int item, int lane) {
    const int nblk = N / 32, kb = item / nblk, nb = item % nblk, k0 = 64 * kb, n0 = 32 * nb;
#pragma unroll 8
    for (int i = 0; i < 32; ++i) { const int kk = 2 * i + (lane >> 5); scr[kk * 33 + (lane & 31)] = W[(size_t)(k0 + kk) * N + n0 + (lane & 31)]; }
    asm volatile("s_waitcnt lgkmcnt(0)" ::: "memory");
    const int cch = lane & 7;
#pragma unroll
    for (int j = 0; j < 4; ++j) { const int n = (lane >> 3) + 8 * j; const LAS float* sp = scr + (8 * cch) * 33 + n;
        u32x4 o; o.x = cvt_pk_bf16(sp[0 * 33], sp[1 * 33]); o.y = cvt_pk_bf16(sp[2 * 33], sp[3 * 33]); o.z = cvt_pk_bf16(sp[4 * 33], sp[5 * 33]); o.w = cvt_pk_bf16(sp[6 * 33], sp[7 * 33]);
        *(u32x4*)(WT + (size_t)(n0 + n) * K + k0 + 8 * cch) = o; }
    asm volatile("s_waitcnt lgkmcnt(0)" ::: "memory");
}
__device__ __forceinline__ void p0_transposes(LAS unsigned char* lds, const float* w_in, const float* w_ba, const float* w_out, const float* wq, bf16* W_IN_T, bf16* WBA_T, bf16* WOUT_T, bf16* WQ_T) {
    const int lane = threadIdx.x & 63, wv = threadIdx.x >> 6, gw = blockIdx.x * (NT / 64) + wv, ngw = gridDim.x * (NT / 64);
    LAS float* scr = (LAS float*)(lds + wv * 16384);
    constexpr int I_IN = (1024 / 64) * (4096 / 32), I_BA = (512 / 64) * (1024 / 32), I_OUT = (1024 / 64) * (1024 / 32), I_Q = (1024 / 64) * (2048 / 32);
    for (int it = gw; it < I_IN + I_BA + I_OUT + I_Q; it += ngw) { int r = it;
        if (r < I_IN) { p0_transpose_item(w_in, 1024, 4096, W_IN_T, scr, r, lane); continue; } r -= I_IN;
        if (r < I_BA) { p0_transpose_item(w_ba, 512, 1024, WBA_T, scr, r, lane); continue; } r -= I_BA;
        if (r < I_OUT) { p0_transpose_item(w_out, 1024, 1024, WOUT_T, scr, r, lane); continue; } r -= I_OUT;
        p0_transpose_item(wq, 1024, 2048, WQ_T, scr, r, lane); }
}
__device__ __forceinline__ void p0_wc(const float* pool_w, const float* pool_scale, const float* w_bp, float* WCF) {
    const int lane = threadIdx.x & 63, gw = blockIdx.x * (NT / 64) + (threadIdx.x >> 6), ngw = gridDim.x * (NT / 64);
    for (int it = gw; it < 512 * 16; it += ngw) { const int k = it >> 4, o = (it & 15) * 64 + lane, g = k >> 7; float acc = 0.f;
        const float pw0 = pool_w[(size_t)k * 128 + lane] * pool_scale[g * 128 + lane], pw1 = pool_w[(size_t)k * 128 + 64 + lane] * pool_scale[g * 128 + 64 + lane];
#pragma unroll 16
        for (int j = 0; j < 64; ++j) acc += __uint_as_float(__builtin_amdgcn_readlane(__float_as_uint(pw0), j)) * w_bp[(size_t)(g * 128 + j) * 1024 + o];
#pragma unroll 16
        for (int j = 0; j < 64; ++j) acc += __uint_as_float(__builtin_amdgcn_readlane(__float_as_uint(pw1), j)) * w_bp[(size_t)(g * 128 + 64 + j) * 1024 + o];
        WCF[(size_t)k * 1024 + o] = acc; }
}
__device__ __forceinline__ void p1_wc_transpose(LAS unsigned char* lds, const float* WCF, bf16* WC_T) {
    const int lane = threadIdx.x & 63, wv = threadIdx.x >> 6, gw = blockIdx.x * (NT / 64) + wv, ngw = gridDim.x * (NT / 64);
    LAS float* scr = (LAS float*)(lds + wv * 16384);
    for (int it = gw; it < (512 / 64) * (1024 / 32); it += ngw) p0_transpose_item(WCF, 512, 1024, WC_T, scr, it, lane);
}
__device__ __forceinline__ void modulate_rows(const float* x, const float* g, const LAS float* mtab, bf16* outp) {
    const int lane = threadIdx.x & 63;
    for (int row = blockIdx.x * (NT / 64) + (threadIdx.x >> 6); row < M; row += gridDim.x * (NT / 64)) {
        const int b = row / SEQ; const f32x4* xr = (const f32x4*)(x + (size_t)row * D); f32x4 v[4]; float ss = 0.f;
#pragma unroll
        for (int j = 0; j < 4; ++j) { v[j] = xr[j * 64 + lane]; ss += v[j][0] * v[j][0] + v[j][1] * v[j][1] + v[j][2] * v[j][2] + v[j][3] * v[j][3]; }
#pragma unroll
        for (int o = 1; o < 64; o <<= 1) ss += __shfl_xor(ss, o);
        const float r = rsqrtf(ss * (1.f / D) + EPS);
#pragma unroll
        for (int j = 0; j < 4; ++j) { const int col = j * 256 + lane * 4; const f32x4 gv = *(const f32x4*)(g + col), sc = *(const LAS f32x4*)(mtab + b * 2048 + col), sh = *(const LAS f32x4*)(mtab + b * 2048 + 1024 + col);
            const f32x4 o = v[j] * r * gv * (sc + 1.f) + sh; u32x2 w; w.x = cvt_pk_bf16(o[0], o[1]); w.y = cvt_pk_bf16(o[2], o[3]); *(u32x2*)(outp + (size_t)row * D + col) = w; }
    }
}
__device__ __forceinline__ void fill_mtab_partials(LAS float* mtab, const float* MODP, const float* b_ada, int sh_off, int sc_off) {
    for (int i = threadIdx.x; i < 4096; i += NT) { const int b = i >> 11, which = (i >> 10) & 1, col = i & 1023; mtab[i] = mod_reduce(MODP, b_ada, b * 6144 + (which ? sh_off : sc_off) + col); }
    __syncthreads();
}
__device__ __forceinline__ void fill_mtab(LAS float* mtab, const float* MOD, int sh_off, int sc_off) {
    for (int i = threadIdx.x; i < 4096; i += NT) { const int b = i >> 11, which = (i >> 10) & 1, col = i & 1023; mtab[i] = MOD[b * 6144 + (which ? sh_off : sc_off) + col]; }
    __syncthreads();
}
__device__ __forceinline__ void pooldiff_fast(const bf16* UP, bf16* DIFF) {
    GSTRIDE(idx, (size_t)M * 64) { const int ch = (int)(idx & 63), row = (int)(idx >> 6), pos = row % SEQ, w = 2 << (ch >> 4), cnt = pos + 1 < w ? pos + 1 : w; float sacc[8];
#pragma unroll
        for (int e = 0; e < 8; ++e) sacc[e] = 0.f;
        u32x4 own;
        for (int i = 0; i < cnt; ++i) { const u32x4 v = *(const u32x4*)(UP + (size_t)(row - i) * 512 + ch * 8); if (i == 0) own = v;
            sacc[0] += bflo(v.x); sacc[1] += bfhi(v.x); sacc[2] += bflo(v.y); sacc[3] += bfhi(v.y); sacc[4] += bflo(v.z); sacc[5] += bfhi(v.z); sacc[6] += bflo(v.w); sacc[7] += bfhi(v.w); }
        const float ic = 1.f / (float)cnt; u32x4 o;
        o.x = cvt_pk_bf16(sacc[0] * ic - bflo(own.x), sacc[1] * ic - bfhi(own.x)); o.y = cvt_pk_bf16(sacc[2] * ic - bflo(own.y), sacc[3] * ic - bfhi(own.y));
        o.z = cvt_pk_bf16(sacc[4] * ic - bflo(own.z), sacc[5] * ic - bfhi(own.z)); o.w = cvt_pk_bf16(sacc[6] * ic - bflo(own.w), sacc[7] * ic - bfhi(own.w));
        *(u32x4*)(DIFF + (size_t)row * 512 + ch * 8) = o; }
}

#define XB_TMO      128
#define XB_XCNT(j)  (256  + 64 * (j))
#define XB_XSUB(j)  (1280 + 64 * (j))
#define XB_XGEN(j)  (2304 + 64 * (j))
#define XB_TOP      3328
#define XB_TOPGEN   3392
#define XCD_BAR_WORDS 3456
#define XB_SPIN_CAP (1u << 18)
__device__ __forceinline__ unsigned xb_ld(unsigned* p)              { return __hip_atomic_load(p, __ATOMIC_RELAXED, __HIP_MEMORY_SCOPE_AGENT); }
__device__ __forceinline__ unsigned xb_add(unsigned* p, unsigned v) { return __hip_atomic_fetch_add(p, v, __ATOMIC_RELAXED, __HIP_MEMORY_SCOPE_AGENT); }
__device__ __forceinline__ unsigned xb_xcc_id() { return (unsigned)__builtin_amdgcn_s_getreg((3 << 11) | 20) & 0xFu; }
#define XB_SPIN(cond, bar) do { unsigned _sp = 0; while (cond) { __builtin_amdgcn_s_sleep(1); \
    if ((++_sp & 255u) == 0u) { if (xb_ld(&(bar)[XB_TMO])) break; if (_sp > XB_SPIN_CAP) { atomicAdd(&(bar)[XB_TMO], 1u); break; } } } } while (0)
struct XcdBarrier { unsigned* bar; unsigned x; volatile LAS unsigned* st; };
__device__ __forceinline__ XcdBarrier xcd_barrier_post(unsigned* bar, volatile LAS unsigned* st) {
    XcdBarrier b; b.bar = bar; b.x = xb_xcc_id(); b.st = st;
    if (threadIdx.x == 0) (void)xb_add(&bar[XB_XCNT(b.x)], 1u);
    return b;
}
__device__ __forceinline__ void xcd_barrier_complete(unsigned* bar, unsigned x, unsigned& nloc, unsigned& nx) {
    const unsigned G = gridDim.x * gridDim.y * gridDim.z;
    unsigned sum, cnt, mine, sp = 0u;
    for (;;) {
        sum = 0u; cnt = 0u; mine = 0u;
#pragma unroll
        for (unsigned j = 0; j < 16; ++j) { const unsigned c = xb_ld(&bar[XB_XCNT(j)]); sum += c; cnt += (c > 0u) ? 1u : 0u; mine = (j == x) ? c : mine; }
        if (sum == G) break;
        __builtin_amdgcn_s_sleep(1);
        if ((++sp & 255u) == 0u) { if (xb_ld(&bar[XB_TMO])) break; if (sp > XB_SPIN_CAP) { atomicAdd(&bar[XB_TMO], 1u); break; } }
    }
    nloc = mine > 0u ? mine : 1u; nx = cnt > 0u ? cnt : 1u;
}
__device__ __forceinline__ void xcd_barrier(const XcdBarrier& b) {
    asm volatile("s_waitcnt vmcnt(0)" ::: "memory");
    __syncthreads();
    if (threadIdx.x == 0) {
        unsigned* bar = b.bar;
        __builtin_amdgcn_s_waitcnt(0);
        unsigned nloc = b.st[0], nx = b.st[1];
        if (nloc == 0u) { xcd_barrier_complete(bar, b.x, nloc, nx); b.st[0] = nloc; b.st[1] = nx; }
        const unsigned old = xb_add(&bar[XB_XSUB(b.x)], 1u);
        const unsigned gen = old / nloc;
        if (old + 1u == (gen + 1u) * nloc) {
            __builtin_amdgcn_fence(__ATOMIC_RELEASE, "agent");
            asm volatile("s_waitcnt vmcnt(0)" ::: "memory");
            const unsigned og = xb_add(&bar[XB_TOP], 1u);
            const unsigned tg = og / nx;
            if (og + 1u == (tg + 1u) * nx) xb_add(&bar[XB_TOPGEN], 1u);
            else XB_SPIN(xb_ld(&bar[XB_TOPGEN]) == tg, bar);
            __builtin_amdgcn_fence(__ATOMIC_ACQUIRE, "agent");
            xb_add(&bar[XB_XGEN(b.x)], 1u);
            asm volatile("s_waitcnt vmcnt(0)" ::: "memory");
        } else {
            XB_SPIN(xb_ld(&bar[XB_XGEN(b.x)]) == gen, bar);
            __builtin_amdgcn_fence(__ATOMIC_ACQUIRE, "agent");
            asm volatile("s_waitcnt vmcnt(0)" ::: "memory");
        }
    }
    __syncthreads();
}

__device__ __forceinline__ void d_tab_fp8(const float* T, unsigned char* O8, float* SC) {
    const int lane = threadIdx.x & 63, gw = blockIdx.x * (NT / 64) + (threadIdx.x >> 6), ngw = gridDim.x * (NT / 64);
    for (int row = gw; row < NEXP; row += ngw) {
        const f32x4* r = (const f32x4*)(T + (size_t)row * D) + 4 * lane; f32x4 v[4]; float am = 0.f;
#pragma unroll
        for (int j = 0; j < 4; ++j) { v[j] = r[j]; am = fmaxf(am, fmaxf(fmaxf(fabsf(v[j][0]), fabsf(v[j][1])), fmaxf(fabsf(v[j][2]), fabsf(v[j][3])))); }
#pragma unroll
        for (int o = 1; o < 64; o <<= 1) am = fmaxf(am, __shfl_xor(am, o));
        int e = 8; if (am > 0.f) (void)frexpf(am, &e);
        const float sc = ldexpf(1.f, 8 - e);
        u32x4 w;
        w.x = (unsigned)__builtin_amdgcn_cvt_pk_fp8_f32(v[0][0] * sc, v[0][1] * sc, 0, false); w.x = (unsigned)__builtin_amdgcn_cvt_pk_fp8_f32(v[0][2] * sc, v[0][3] * sc, (int)w.x, true);
        w.y = (unsigned)__builtin_amdgcn_cvt_pk_fp8_f32(v[1][0] * sc, v[1][1] * sc, 0, false); w.y = (unsigned)__builtin_amdgcn_cvt_pk_fp8_f32(v[1][2] * sc, v[1][3] * sc, (int)w.y, true);
        w.z = (unsigned)__builtin_amdgcn_cvt_pk_fp8_f32(v[2][0] * sc, v[2][1] * sc, 0, false); w.z = (unsigned)__builtin_amdgcn_cvt_pk_fp8_f32(v[2][2] * sc, v[2][3] * sc, (int)w.z, true);
        w.w = (unsigned)__builtin_amdgcn_cvt_pk_fp8_f32(v[3][0] * sc, v[3][1] * sc, 0, false); w.w = (unsigned)__builtin_amdgcn_cvt_pk_fp8_f32(v[3][2] * sc, v[3][3] * sc, (int)w.w, true);
        *(u32x4*)(O8 + (size_t)row * D + 16 * lane) = w;
        if (lane == 0) SC[row] = ldexpf(1.f, e - 8);
    }
}
__device__ __forceinline__ f32x2 fp8lo(unsigned w) { return __builtin_amdgcn_cvt_pk_f32_fp8((int)w, false); }
__device__ __forceinline__ f32x2 fp8hi(unsigned w) { return __builtin_amdgcn_cvt_pk_f32_fp8((int)w, true); }
__device__ __forceinline__ void peer_phase8(const bf16* H2, const int* EID, const float* EG, const unsigned char* U8, const unsigned char* V8, const float* USC, const float* VSC,
                                            const float* mod, const float* gfin, const float* x1, float* outp) {
    int tid_ = threadIdx.x; asm volatile("" : "+v"(tid_));
    const int lane = tid_ & 63, wv = tid_ >> 6;
    for (int t = blockIdx.x * (NT / 64) + wv; t < M; t += gridDim.x * (NT / 64)) {
        const int b = t / SEQ;
        f32x2 hp[8];
        { const u32x4 h0 = *(const u32x4*)(H2 + (size_t)t * D + 16 * lane), h1 = *(const u32x4*)(H2 + (size_t)t * D + 16 * lane + 8);
          hp[0] = (f32x2){bflo(h0.x), bfhi(h0.x)}; hp[1] = (f32x2){bflo(h0.y), bfhi(h0.y)}; hp[2] = (f32x2){bflo(h0.z), bfhi(h0.z)}; hp[3] = (f32x2){bflo(h0.w), bfhi(h0.w)};
          hp[4] = (f32x2){bflo(h1.x), bfhi(h1.x)}; hp[5] = (f32x2){bflo(h1.y), bfhi(h1.y)}; hp[6] = (f32x2){bflo(h1.z), bfhi(h1.z)}; hp[7] = (f32x2){bflo(h1.w), bfhi(h1.w)}; }
        const int e0 = EID[(size_t)t * NSEL + lane], e1 = EID[(size_t)t * NSEL + 64 + lane]; const float gg0 = EG[(size_t)t * NSEL + lane], gg1 = EG[(size_t)t * NSEL + 64 + lane];
        f32x2 acc[8];
#pragma unroll
        for (int i = 0; i < 8; ++i) acc[i] = (f32x2){0.f, 0.f};
#pragma unroll 1
        for (int kb = 0; kb < NSEL; kb += 16) {
            u32x4 uu[16], vv[16]; float us[16], vs[16];
#pragma unroll
            for (int j = 0; j < 16; ++j) { const int k = kb + j; const int eid = __builtin_amdgcn_readlane(k < 64 ? e0 : e1, k & 63);
                uu[j] = *(const u32x4*)(U8 + (size_t)eid * D + 16 * lane); vv[j] = *(const u32x4*)(V8 + (size_t)eid * D + 16 * lane); us[j] = USC[eid]; vs[j] = VSC[eid]; }
            float d[16];
#pragma unroll
            for (int j = 0; j < 16; ++j) { f32x2 a = (f32x2){0.f, 0.f};
                a = __builtin_elementwise_fma(fp8lo(uu[j].x), hp[0], a); a = __builtin_elementwise_fma(fp8hi(uu[j].x), hp[1], a); a = __builtin_elementwise_fma(fp8lo(uu[j].y), hp[2], a); a = __builtin_elementwise_fma(fp8hi(uu[j].y), hp[3], a);
                a = __builtin_elementwise_fma(fp8lo(uu[j].z), hp[4], a); a = __builtin_elementwise_fma(fp8hi(uu[j].z), hp[5], a); a = __builtin_elementwise_fma(fp8lo(uu[j].w), hp[6], a); a = __builtin_elementwise_fma(fp8hi(uu[j].w), hp[7], a);
                d[j] = (a[0] + a[1]) * us[j]; }
            float r8[8], r4[4], r2[2], r1;
            { const bool up = (lane & 32) != 0;
#pragma unroll
              for (int j = 0; j < 8; ++j) { const float snd = up ? d[j] : d[j + 8], kp = up ? d[j + 8] : d[j]; r8[j] = kp + __shfl_xor(snd, 32); } }
            { const bool up = (lane & 16) != 0;
#pragma unroll
              for (int j = 0; j < 4; ++j) { const float snd = up ? r8[j] : r8[j + 4], kp = up ? r8[j + 4] : r8[j]; r4[j] = kp + __shfl_xor(snd, 16); } }
            { const bool up = (lane & 8) != 0;
#pragma unroll
              for (int j = 0; j < 2; ++j) { const float snd = up ? r4[j] : r4[j + 2], kp = up ? r4[j + 2] : r4[j]; r2[j] = kp + __shfl_xor(snd, 8); } }
            { const bool up = (lane & 4) != 0; const float snd = up ? r2[0] : r2[1], kp = up ? r2[1] : r2[0]; r1 = kp + __shfl_xor(snd, 4); }
            r1 += __shfl_xor(r1, 2); r1 += __shfl_xor(r1, 1);
            const float ge = 0.5f * r1 * (1.f + erff(r1 * 0.70710678118654752f));
#pragma unroll
            for (int j = 0; j < 16; ++j) { const int k = kb + j; const float gk = __uint_as_float(__builtin_amdgcn_readlane(__float_as_uint(k < 64 ? gg0 : gg1), k & 63));
                const float w = gk * vs[j] * __uint_as_float(__builtin_amdgcn_readlane(__float_as_uint(ge), ((j & 8) ? 32 : 0) + ((j & 4) ? 16 : 0) + ((j & 2) ? 8 : 0) + ((j & 1) ? 4 : 0))); const f32x2 w2 = (f32x2){w, w};
                acc[0] = __builtin_elementwise_fma(w2, fp8lo(vv[j].x), acc[0]); acc[1] = __builtin_elementwise_fma(w2, fp8hi(vv[j].x), acc[1]); acc[2] = __builtin_elementwise_fma(w2, fp8lo(vv[j].y), acc[2]); acc[3] = __builtin_elementwise_fma(w2, fp8hi(vv[j].y), acc[3]);
                acc[4] = __builtin_elementwise_fma(w2, fp8lo(vv[j].z), acc[4]); acc[5] = __builtin_elementwise_fma(w2, fp8hi(vv[j].z), acc[5]); acc[6] = __builtin_elementwise_fma(w2, fp8lo(vv[j].w), acc[6]); acc[7] = __builtin_elementwise_fma(w2, fp8hi(vv[j].w), acc[7]); }
        }
        float ss = 0.f; f32x4 x2[4];
#pragma unroll
        for (int q4 = 0; q4 < 4; ++q4) { const int col = 16 * lane + 4 * q4; const f32x4 xv = *(const f32x4*)(x1 + (size_t)t * D + col), gv = *(const f32x4*)(mod + b * 6144 + 5 * D + col);
            x2[q4][0] = xv[0] + gv[0] * acc[2 * q4][0]; x2[q4][1] = xv[1] + gv[1] * acc[2 * q4][1]; x2[q4][2] = xv[2] + gv[2] * acc[2 * q4 + 1][0]; x2[q4][3] = xv[3] + gv[3] * acc[2 * q4 + 1][1];
            ss += x2[q4][0] * x2[q4][0] + x2[q4][1] * x2[q4][1] + x2[q4][2] * x2[q4][2] + x2[q4][3] * x2[q4][3]; }
#pragma unroll
        for (int o = 1; o < 64; o <<= 1) ss += __shfl_xor(ss, o);
        const float r = rsqrtf(ss * (1.f / D) + EPS);
#pragma unroll
        for (int q4 = 0; q4 < 4; ++q4) { const int col = 16 * lane + 4 * q4; const f32x4 gf = *(const f32x4*)(gfin + col); *(f32x4*)(outp + (size_t)t * D + col) = x2[q4] * r * gf; }
    }
}

namespace att2 {
using att::f32x16; using att::v4i16_t; using att::crow; using att::bfe;
constexpr int VROW = 192, OFF_V = 32768, OFF_MISC = OFF_V + 256 * VROW;
template <bool CAUSAL>
__device__ __forceinline__ void tile(const LAS unsigned char* Kblk, const LAS unsigned char* Vblk, const bf16x8 (&qr)[4], int tt, int q_off, int lane, int r32, int hi, float& mrun, float& lsum, f32x16& o0, f32x16& o1) {
    const LAS unsigned char* kb_ = Kblk + tt * 64 * 128; const LAS unsigned char* vb_ = Vblk + tt * 64 * VROW;
    f32x16 p0 = {}, p1 = {};
#pragma unroll
    for (int s = 0; s < 4; ++s) { const int c = 2 * s + hi; const int sw = ((c ^ ((r32 >> 1) & 7)) << 4);
        const bf16x8 a0 = *(const LAS bf16x8*)(kb_ + r32 * 128 + sw), a1 = *(const LAS bf16x8*)(kb_ + (32 + r32) * 128 + sw);
        p0 = __builtin_amdgcn_mfma_f32_32x32x16_bf16(a0, qr[s], p0, 0, 0, 0); p1 = __builtin_amdgcn_mfma_f32_32x32x16_bf16(a1, qr[s], p1, 0, 0, 0); }
    if (CAUSAL) {
#pragma unroll
        for (int r = 0; r < 16; ++r) { const int ko = tt * 64 + crow(r, hi); if (ko > q_off) p0[r] = -INFINITY; if (ko + 32 > q_off) p1[r] = -INFINITY; } }
    float mt = fmaxf(p0[0], p1[0]);
#pragma unroll
    for (int r = 1; r < 16; ++r) mt = fmaxf(mt, fmaxf(p0[r], p1[r]));
    mt = fmaxf(mt, __shfl_xor(mt, 32));
    const float mnew = fmaxf(mrun, mt), alpha = __builtin_amdgcn_exp2f(mrun - mnew); mrun = mnew;
    float ps = 0.f;
#pragma unroll
    for (int r = 0; r < 16; ++r) { p0[r] = __builtin_amdgcn_exp2f(p0[r] - mnew); p1[r] = __builtin_amdgcn_exp2f(p1[r] - mnew); ps += p0[r] + p1[r]; }
    lsum = lsum * alpha + ps;
    if (!__all(alpha == 1.f ? 1 : 0)) {
#pragma unroll
        for (int r = 0; r < 16; ++r) { o0[r] *= alpha; o1[r] *= alpha; } }
    bf16x8 pb[2][2];
#pragma unroll
    for (int s2 = 0; s2 < 2; ++s2) { u32x4 w0, w1;
        w0.x = cvt_pk_bf16(p0[8 * s2], p0[8 * s2 + 1]); w0.y = cvt_pk_bf16(p0[8 * s2 + 2], p0[8 * s2 + 3]); w0.z = cvt_pk_bf16(p0[8 * s2 + 4], p0[8 * s2 + 5]); w0.w = cvt_pk_bf16(p0[8 * s2 + 6], p0[8 * s2 + 7]);
        w1.x = cvt_pk_bf16(p1[8 * s2], p1[8 * s2 + 1]); w1.y = cvt_pk_bf16(p1[8 * s2 + 2], p1[8 * s2 + 3]); w1.z = cvt_pk_bf16(p1[8 * s2 + 4], p1[8 * s2 + 5]); w1.w = cvt_pk_bf16(p1[8 * s2 + 6], p1[8 * s2 + 7]);
        pb[0][s2] = __builtin_bit_cast(bf16x8, w0); pb[1][s2] = __builtin_bit_cast(bf16x8, w1); }
    const LAS unsigned char* vl = vb_ + (4 * hi + ((lane & 15) >> 2)) * VROW + (16 * ((lane >> 4) & 1) + 4 * (lane & 3)) * 2;
#pragma unroll
    for (int dt = 0; dt < 2; ++dt)
#pragma unroll
        for (int u = 0; u < 2; ++u)
#pragma unroll
            for (int s2 = 0; s2 < 2; ++s2) { const LAS unsigned char* va = vl + (32 * u + 16 * s2) * VROW + dt * 64;
                const v4i16_t lo = __builtin_amdgcn_ds_read_tr16_b64_v4i16((LAS v4i16_t*)va), hh = __builtin_amdgcn_ds_read_tr16_b64_v4i16((LAS v4i16_t*)(va + 8 * VROW));
                const bf16x8 vf = {lo[0], lo[1], lo[2], lo[3], hh[0], hh[1], hh[2], hh[3]};
                if (dt == 0) o0 = __builtin_amdgcn_mfma_f32_32x32x16_bf16(vf, pb[u][s2], o0, 0, 0, 0); else o1 = __builtin_amdgcn_mfma_f32_32x32x16_bf16(vf, pb[u][s2], o1, 0, 0, 0); }
}
__device__ __forceinline__ void stage_block(LAS unsigned char* lds, const bf16* Kb, const bf16* V, size_t row0, int h, int tid) {
    const int ch = tid & 7;
#pragma unroll
    for (int i = 0; i < 4; ++i) { const int row = (tid >> 3) + 64 * i; const size_t go = (row0 + row) * 512 + h * 64 + ch * 8;
        const u32x4 kv = *(const u32x4*)(Kb + go), vv = *(const u32x4*)(V + go);
        *(LAS u32x4*)(lds + row * 128 + ((ch ^ ((row >> 1) & 7)) << 4)) = kv; *(LAS u32x4*)(lds + OFF_V + row * VROW + ch * 16) = vv; }
}
__device__ __forceinline__ void phase_a(LAS unsigned char* lds, const bf16* Q, const float* ksum, unsigned short* SEL, int* CNT, unsigned short* LIST, int G, int bid) {
    int tid_ = threadIdx.x; asm volatile("" : "+v"(tid_));
    const int tid = tid_, lane = tid & 63, wid = __builtin_amdgcn_readfirstlane(tid >> 6), r32 = lane & 31, hi = lane >> 5;
    LAS int* lc = (LAS int*)lds;
    for (int uidx = bid; uidx < 512; uidx += G) {
        const int bh = uidx >> 5, qb = uidx & 31, b = bh >> 3, h = bh & 7;
        const int q_off = wid * 32 + r32, q = qb * 256 + q_off; const size_t qrow = (size_t)b * SEQ + q;
        if (tid < 64) lc[tid] = 0;
        __syncthreads();
        bf16x8 qr[4];
#pragma unroll
        for (int s = 0; s < 4; ++s) qr[s] = *(const bf16x8*)(Q + qrow * 512 + h * 64 + 16 * s + 8 * hi);
        int s0 = 31, s1 = 31, s2 = 31; float g0 = -INFINITY, g1 = -INFINITY, g2 = -INFINITY;
        const float* ksb = ksum + (size_t)bh * NBLK * HD + 8 * hi;
        for (int j = 0; j < qb; ++j) { float part = 0.f;
#pragma unroll
            for (int s = 0; s < 4; ++s) { const f32x4 k0 = *(const f32x4*)(ksb + j * HD + 16 * s), k1 = *(const f32x4*)(ksb + j * HD + 16 * s + 4);
                part += bfe(qr[s], 0) * k0[0] + bfe(qr[s], 1) * k0[1] + bfe(qr[s], 2) * k0[2] + bfe(qr[s], 3) * k0[3] + bfe(qr[s], 4) * k1[0] + bfe(qr[s], 5) * k1[1] + bfe(qr[s], 6) * k1[2] + bfe(qr[s], 7) * k1[3]; }
            const float g = part + __shfl_xor(part, 32);
            if (g > g0) { g2 = g1; s2 = s1; g1 = g0; s1 = s0; g0 = g; s0 = j; } else if (g > g1) { g2 = g1; s2 = s1; g1 = g; s1 = j; } else if (g > g2) { g2 = g; s2 = j; } }
        int r0 = 0, r1 = 0, r2 = 0;
        if (hi == 0) { if (s0 < 31) r0 = __hip_atomic_fetch_add(lc + s0, 1, __ATOMIC_RELAXED, __HIP_MEMORY_SCOPE_WORKGROUP); if (s1 < 31) r1 = __hip_atomic_fetch_add(lc + s1, 1, __ATOMIC_RELAXED, __HIP_MEMORY_SCOPE_WORKGROUP);
                       if (s2 < 31) r2 = __hip_atomic_fetch_add(lc + s2, 1, __ATOMIC_RELAXED, __HIP_MEMORY_SCOPE_WORKGROUP); }
        __syncthreads();
        if (tid < 32 && lc[tid] > 0) lc[32 + tid] = atomicAdd(CNT + bh * 32 + tid, lc[tid]);
        __syncthreads();
        if (hi == 0) { SEL[(size_t)bh * SEQ + q] = (unsigned short)(s0 | (s1 << 5) | (s2 << 10));
            if (s0 < 31) LIST[((size_t)bh * 32 + s0) * SEQ + lc[32 + s0] + r0] = (unsigned short)q;
            if (s1 < 31) LIST[((size_t)bh * 32 + s1) * SEQ + lc[32 + s1] + r1] = (unsigned short)(q | (1 << 13));
            if (s2 < 31) LIST[((size_t)bh * 32 + s2) * SEQ + lc[32 + s2] + r2] = (unsigned short)(q | (2 << 13)); }
        __syncthreads();
    }
}
__device__ __forceinline__ bf16* part_o(bf16* PO01, bf16* PO2, int slot, size_t bhq) { return (slot < 2 ? PO01 + (size_t)slot * 16 * SEQ * HD : PO2) + bhq * HD; }
__device__ __forceinline__ void phase_b(LAS unsigned char* lds, const bf16* Q, const bf16* Kb, const bf16* V, const int* CNT, const unsigned short* LIST, bf16* PO01, bf16* PO2, f32x2* PML, int G, int bid) {
    int tid_ = threadIdx.x; asm volatile("" : "+v"(tid_));
    const int tid = tid_, lane = tid & 63, wid = __builtin_amdgcn_readfirstlane(tid >> 6), r32 = lane & 31, hi = lane >> 5;
    const int vcu = (G % 8 == 0) ? (bid % 8) * (G / 8) + bid / 8 : bid;
    LAS int* lcnt = (LAS int*)(lds + OFF_MISC);
    lcnt[tid] = CNT[tid];
    __syncthreads();
    int running = 0;
    for (int tr = 0; tr < 16 * 31; ++tr) {
        const int j = tr / 16, bh = tr % 16, b = bh >> 3, h = bh & 7; const int cnt = lcnt[bh * 32 + j], nch = (cnt + 255) >> 8;
        for (int c = 0; c < nch; ++c) {
            if ((running + c) % G != vcu) continue;
            const int n = min(256, cnt - 256 * c);
            __syncthreads();
            stage_block(lds, Kb, V, (size_t)b * SEQ + j * 256, h, tid);
            __syncthreads();
            if (32 * wid < n) {
                const int ei = 32 * wid + r32; const bool valid = ei < n;
                const unsigned ent = LIST[((size_t)bh * 32 + j) * SEQ + 256 * c + (valid ? ei : 0)]; const int q = ent & 8191, slot = ent >> 13;
                const size_t qrow = (size_t)b * SEQ + q;
                bf16x8 qr[4];
#pragma unroll
                for (int s = 0; s < 4; ++s) qr[s] = *(const bf16x8*)(Q + qrow * 512 + h * 64 + 16 * s + 8 * hi);
                float mrun = -INFINITY, lsum = 0.f; f32x16 o0 = {}, o1 = {};
#pragma unroll 1
                for (int tt = 0; tt < 4; ++tt) tile<false>(lds, lds + OFF_V, qr, tt, 0, lane, r32, hi, mrun, lsum, o0, o1);
                const float lt = lsum + __shfl_xor(lsum, 32), inv = 1.f / lt;
                if (valid) { const size_t bhq = (size_t)bh * SEQ + q; bf16* orow = part_o(PO01, PO2, slot, bhq) + 4 * hi;
                    if (hi == 0) PML[bhq * 3 + slot] = (f32x2){mrun, lt};
#pragma unroll
                    for (int g4 = 0; g4 < 4; ++g4) { u32x2 w;
                        w.x = cvt_pk_bf16(o0[4 * g4] * inv, o0[4 * g4 + 1] * inv); w.y = cvt_pk_bf16(o0[4 * g4 + 2] * inv, o0[4 * g4 + 3] * inv); *(u32x2*)(orow + 8 * g4) = w;
                        w.x = cvt_pk_bf16(o1[4 * g4] * inv, o1[4 * g4 + 1] * inv); w.y = cvt_pk_bf16(o1[4 * g4 + 2] * inv, o1[4 * g4 + 3] * inv); *(u32x2*)(orow + 32 + 8 * g4) = w; } }
            }
        }
        running += nch;
    }
    __syncthreads();
}
__device__ __forceinline__ void phase_c(LAS unsigned char* lds, const bf16* Q, const bf16* Kb, const bf16* V, const unsigned short* SEL, const bf16* PO01, const bf16* PO2, const f32x2* PML, bf16* ATT, int G, int bid) {
    int tid_ = threadIdx.x; asm volatile("" : "+v"(tid_));
    const int tid = tid_, lane = tid & 63, wid = __builtin_amdgcn_readfirstlane(tid >> 6), r32 = lane & 31, hi = lane >> 5;
    for (int uidx = bid; uidx < 512; uidx += G) {
        const int bh = uidx >> 5, qb = uidx & 31, b = bh >> 3, h = bh & 7;
        const int q_off = wid * 32 + r32, q = qb * 256 + q_off; const size_t qrow = (size_t)b * SEQ + q, bhq = (size_t)bh * SEQ + q;
        __syncthreads();
        stage_block(lds, Kb, V, (size_t)b * SEQ + qb * 256, h, tid);
        bf16x8 qr[4];
#pragma unroll
        for (int s = 0; s < 4; ++s) qr[s] = *(const bf16x8*)(Q + qrow * 512 + h * 64 + 16 * s + 8 * hi);
        const unsigned sel = SEL[bhq];
        __syncthreads();
        float mrun = -INFINITY, lsum = 0.f; f32x16 o0 = {}, o1 = {};
        const int ntile = (32 * wid + 31) / 64 + 1;
#pragma unroll 1
        for (int tt = 0; tt < ntile; ++tt) tile<true>(lds, lds + OFF_V, qr, tt, q_off, lane, r32, hi, mrun, lsum, o0, o1);
        float lt = lsum + __shfl_xor(lsum, 32);
#pragma unroll 1
        for (int slot = 0; slot < 3; ++slot) {
            const int sj = (sel >> (5 * slot)) & 31; if (sj == 31) continue;
            const f32x2 ml = PML[bhq * 3 + slot]; const bf16* prow = part_o((bf16*)PO01, (bf16*)PO2, slot, bhq) + 4 * hi;
            const float mstar = fmaxf(mrun, ml[0]), fa = __builtin_amdgcn_exp2f(mrun - mstar), fb = ml[1] * __builtin_amdgcn_exp2f(ml[0] - mstar);
            mrun = mstar; lt = lt * fa + fb;
#pragma unroll
            for (int g4 = 0; g4 < 4; ++g4) { const u32x2 w0 = *(const u32x2*)(prow + 8 * g4), w1 = *(const u32x2*)(prow + 32 + 8 * g4);
                o0[4 * g4] = o0[4 * g4] * fa + fb * bflo(w0.x); o0[4 * g4 + 1] = o0[4 * g4 + 1] * fa + fb * bfhi(w0.x); o0[4 * g4 + 2] = o0[4 * g4 + 2] * fa + fb * bflo(w0.y); o0[4 * g4 + 3] = o0[4 * g4 + 3] * fa + fb * bfhi(w0.y);
                o1[4 * g4] = o1[4 * g4] * fa + fb * bflo(w1.x); o1[4 * g4 + 1] = o1[4 * g4 + 1] * fa + fb * bfhi(w1.x); o1[4 * g4 + 2] = o1[4 * g4 + 2] * fa + fb * bflo(w1.y); o1[4 * g4 + 3] = o1[4 * g4 + 3] * fa + fb * bfhi(w1.y); }
        }
        const float inv = 1.f / lt;
        bf16* orow = ATT + qrow * 512 + h * 64 + 4 * hi;
#pragma unroll
        for (int g4 = 0; g4 < 4; ++g4) { u32x2 w;
            w.x = cvt_pk_bf16(o0[4 * g4] * inv, o0[4 * g4 + 1] * inv); w.y = cvt_pk_bf16(o0[4 * g4 + 2] * inv, o0[4 * g4 + 3] * inv); *(u32x2*)(orow + 8 * g4) = w;
            w.x = cvt_pk_bf16(o1[4 * g4] * inv, o1[4 * g4 + 1] * inv); w.y = cvt_pk_bf16(o1[4 * g4 + 2] * inv, o1[4 * g4 + 3] * inv); *(u32x2*)(orow + 32 + 8 * g4) = w; }
    }
    __syncthreads();
}
}

__device__ __forceinline__ void d_cmp_accum(float num, float den, float* lds, float* acc2) {
#pragma unroll
    for (int o = 1; o < 64; o <<= 1) { num += __shfl_xor(num, o); den += __shfl_xor(den, o); }
    __syncthreads();
    if ((threadIdx.x & 63) == 0) { lds[(threadIdx.x >> 6) * 2] = num; lds[(threadIdx.x >> 6) * 2 + 1] = den; }
    __syncthreads();
    if (threadIdx.x == 0) { float n = 0.f, d = 0.f; for (int w = 0; w < NT / 64; ++w) { n += lds[w * 2]; d += lds[w * 2 + 1]; } atomicAdd(acc2, n); atomicAdd(acc2 + 1, d); }
    __syncthreads();
}
__device__ __forceinline__ void d_cmp_bf16(const bf16* a, const bf16* b, size_t n, float* lds, float* acc2) {
    float num = 0.f, den = 0.f; GSTRIDE(i, n) { const float x = bf2f(a[i]), y = bf2f(b[i]); num += (x - y) * (x - y); den += y * y; } d_cmp_accum(num, den, lds, acc2);
}
__device__ __forceinline__ void d_cmp_f32(const float* a, const float* b, size_t n, float* lds, float* acc2) {
    float num = 0.f, den = 0.f; GSTRIDE(i, n) { const float x = a[i], y = b[i]; num += (x - y) * (x - y); den += y * y; } d_cmp_accum(num, den, lds, acc2);
}

#ifndef DBG
#define DBG 0
#endif
#ifndef PROBE
#define PROBE 0
#endif
#ifndef USE_XCD_BARRIER
#define USE_XCD_BARRIER 1
#endif
#ifndef FAST_PRO
#define FAST_PRO 1
#endif
#ifndef FAST_GEMM
#define FAST_GEMM 1
#endif
#ifndef FAST_ATTN
#define FAST_ATTN 2
#endif
#define ATTN_SORTED(dst_) do { att2::phase_a(lds3, Q, KSUM, (unsigned short*)(ws + WS_SEL), (int*)(ws + WS_CNT), (unsigned short*)(ws + WS_LIST), G, bid); GSYNC(); \
    att2::phase_b(lds3, Q, Kb, V, (const int*)(ws + WS_CNT), (const unsigned short*)(ws + WS_LIST), (bf16*)(ws + WS_PO01), (bf16*)(ws + WS_PO2), (f32x2*)(ws + WS_PML), G, bid); GSYNC(); \
    att2::phase_c(lds3, Q, Kb, V, (const unsigned short*)(ws + WS_SEL), (const bf16*)(ws + WS_PO01), (const bf16*)(ws + WS_PO2), (const f32x2*)(ws + WS_PML), dst_, G, bid); } while (0)
#ifndef FAST_PEER
#define FAST_PEER 1
#endif
#ifndef FAST_ROUTE
#define FAST_ROUTE 1
#endif
#ifndef PEER_FP8
#define PEER_FP8 1
#endif
#if PEER_FP8
#define PEER_CALL(x1_, o_) peer_phase8(H, EID, EG, ws + WS_U8, ws + WS_V8, (const float*)(ws + WS_USC), (const float*)(ws + WS_VSC), MOD, g_fin, x1_, o_)
#else
#define PEER_CALL(x1_, o_) peer_phase(H, EID, EG, (const bf16*)(ws + WS_UT), (const bf16*)(ws + WS_VT), MOD, g_fin, x1_, o_)
#endif
#define USE_FAST_PEER (FAST_PEER && !(DBG & 19))
constexpr int LDS_BYTES = 147456;
__global__ void __launch_bounds__(NT, 2) mega_fwd(Args a) {
    extern __shared__ __attribute__((aligned(16))) unsigned char lds_raw[];
    float* ldsf = (float*)lds_raw; LAS unsigned char* lds3 = (LAS unsigned char*)lds_raw;
    cg::grid_group grid = cg::this_grid();
    const float* x = a.in[0]; const float* c = a.in[1]; const float* w_ada = a.in[2]; const float* b_ada = a.in[3];
    const float* g_mix = a.in[4]; const float* w_in = a.in[5]; const float* pool_w = a.in[6]; const float* pool_scale = a.in[7];
    const float* w_bp = a.in[8]; const float* w_ba = a.in[9]; const float* w_out = a.in[10]; const float* g_ffn = a.in[11];
    const float* wq = a.in[12]; const float* skeys = a.in[13]; const float* Ut = a.in[14]; const float* Vt = a.in[15]; const float* g_fin = a.in[16];
    unsigned char* ws = a.ws; float* out = a.out;
    float* MOD = (float*)(ws + WS_MOD); float* KSUM = (float*)(ws + WS_KSUM); float* ROPE = (float*)(ws + WS_ROPE);
    bf16 *W_IN_T = (bf16*)(ws + WS_W_IN_T), *WC_T = (bf16*)(ws + WS_WC_T), *WBA_T = (bf16*)(ws + WS_WBA_T), *WOUT_T = (bf16*)(ws + WS_WOUT_T), *WQ_T = (bf16*)(ws + WS_WQ_T), *SK = (bf16*)(ws + WS_SK);
    bf16 *H = (bf16*)(ws + WS_H), *DIFF = (bf16*)(ws + WS_DIFF), *ATT = (bf16*)(ws + WS_ATT), *UP = (bf16*)(ws + WS_UP), *Q = (bf16*)(ws + WS_Q), *Kb = (bf16*)(ws + WS_K), *V = (bf16*)(ws + WS_V);
    bf16 *GATES = (bf16*)(ws + WS_GATES), *MERGED = (bf16*)(ws + WS_MERGED), *QP = (bf16*)(ws + WS_QP);
    int* EID = (int*)(ws + WS_EID); float* EG = (float*)(ws + WS_EG);
    const int G = gridDim.x, bid = blockIdx.x;
    { volatile LAS unsigned* st = (volatile LAS unsigned*)(lds3 + LDS_BYTES - 64); if (threadIdx.x < 16) st[threadIdx.x] = 0u; }
    __syncthreads();
    const XcdBarrier xbar = xcd_barrier_post((unsigned*)(ws + WS_BAR), (volatile LAS unsigned*)(lds3 + LDS_BYTES - 64));
#if USE_XCD_BARRIER
#define GSYNC() xcd_barrier(xbar)
#else
#define GSYNC() grid.sync()
#endif
    if (a.ws == nullptr) grid.sync();
#if DBG
    float* DBGW = (float*)(ws + WS_DBG); unsigned char* ALT = ws + WS_ALT;
#endif

    for (int rep_ = 0; rep_ < (PROBE == 5 ? 2 : 1); ++rep_) {
#if FAST_PRO
    p0_mod_partials(c, w_ada, (float*)(ws + WS_MODP));
    p0_transposes(lds3, w_in, w_ba, w_out, wq, W_IN_T, WBA_T, WOUT_T, WQ_T);
    p0_wc(pool_w, pool_scale, w_bp, (float*)(ws + WS_WCF));
#else
    d_mod(c, w_ada, b_ada, MOD);
    d_transpose(w_in, 1024, 4096, W_IN_T); d_transpose(w_ba, 512, 1024, WBA_T); d_transpose(w_out, 1024, 1024, WOUT_T); d_transpose(wq, 1024, 2048, WQ_T);
    d_wc(pool_w, pool_scale, w_bp, WC_T);
#endif
#if (DBG & 4) || !FAST_ROUTE
    d_sk(skeys, SK);
#endif
    d_skbd(skeys, (bf16*)(ws + WS_SKBD)); d_rope(ROPE);
#if USE_FAST_PEER
#if PEER_FP8
    d_tab_fp8(Ut, ws + WS_U8, (float*)(ws + WS_USC)); d_tab_fp8(Vt, ws + WS_V8, (float*)(ws + WS_VSC));
#else
    d_tab_bf16(Ut, (bf16*)(ws + WS_UT)); d_tab_bf16(Vt, (bf16*)(ws + WS_VT));
#endif
#endif
    }
    GSYNC();
#if FAST_PRO
    { const float* MODP = (const float*)(ws + WS_MODP);
      GSTRIDE(idx, 2 * 6144) MOD[idx] = mod_reduce(MODP, b_ada, (int)idx);
      p1_wc_transpose(lds3, (const float*)(ws + WS_WCF), WC_T);
      __syncthreads();
      fill_mtab_partials((LAS float*)lds3, MODP, b_ada, 0, D);
      modulate_rows(x, g_mix, (const LAS float*)lds3, H); }
#else
    d_modulate(x, g_mix, MOD, 0, D, H);
#endif
    GSYNC();
#if DBG & 16
    { float* MOD2 = (float*)ALT; bf16 *T1 = (bf16*)(ALT + 1 * MiB), *T2 = (bf16*)(ALT + 9 * MiB), *T3 = (bf16*)(ALT + 10 * MiB), *T4 = (bf16*)(ALT + 12 * MiB), *T5 = (bf16*)(ALT + 16 * MiB), *HC = (bf16*)(ALT + 20 * MiB);
      d_mod(c, w_ada, b_ada, MOD2); d_transpose(w_in, 1024, 4096, T1); d_transpose(w_ba, 512, 1024, T2); d_transpose(w_out, 1024, 1024, T3); d_transpose(wq, 1024, 2048, T4); d_wc(pool_w, pool_scale, w_bp, T5);
      GSYNC();
      d_modulate(x, g_mix, MOD2, 0, D, HC);
      GSYNC();
      d_cmp_f32(MOD, MOD2, 2 * 6144, ldsf, DBGW + 24); d_cmp_bf16(W_IN_T, T1, (size_t)4096 * 1024, ldsf, DBGW + 26); d_cmp_bf16(WBA_T, T2, (size_t)512 * 1024, ldsf, DBGW + 26); d_cmp_bf16(WOUT_T, T3, (size_t)1024 * 1024, ldsf, DBGW + 26);
      d_cmp_bf16(WQ_T, T4, (size_t)2048 * 1024, ldsf, DBGW + 26); d_cmp_bf16(WC_T, T5, (size_t)512 * 1024, ldsf, DBGW + 26); d_cmp_bf16(H, HC, (size_t)M * D, ldsf, DBGW + 28);
      GSYNC(); }
#endif
#if (DBG & 1) || !FAST_GEMM
    { EpiInProjN E{UP, Q, Kb, V, GATES, ROPE}; d_ngemm(ldsf, H, D, W_IN_T, D, D, NPROJ, E); }
    GSYNC();
    d_ksum(Kb, KSUM);
#endif
#if DBG & 1
    { bf16 *UP2 = (bf16*)ALT, *Q2 = (bf16*)(ALT + 16 * MiB), *K2 = (bf16*)(ALT + 32 * MiB), *V2 = (bf16*)(ALT + 48 * MiB), *G2 = (bf16*)out; float* KS2 = (float*)(ws + WS_KSUM_ALT);
      pg8::Gemm g{H, W_IN_T, M, NPROJ, D, D, 0}; pg8::StaticOrder S; S.init(M, NPROJ, G, bid); EpiInProj E{UP2, Q2, K2, V2, G2, ROPE, KS2};
      pg8::gemm_phase<EpiInProj, pg8::StaticOrder, true>(lds3, g, S, E);
      GSYNC();
      d_cmp_bf16(UP2, UP, (size_t)M * 512, ldsf, DBGW + 0); d_cmp_bf16(Q2, Q, (size_t)M * 512, ldsf, DBGW + 2); d_cmp_bf16(K2, Kb, (size_t)M * 512, ldsf, DBGW + 4);
      d_cmp_bf16(V2, V, (size_t)M * 512, ldsf, DBGW + 6); d_cmp_bf16(G2, GATES, (size_t)M * 2048, ldsf, DBGW + 8); d_cmp_f32(KS2, KSUM, BATCH * NH * NBLK * HD, ldsf, DBGW + 10); }
#elif FAST_GEMM
    { pg8::Gemm g{H, W_IN_T, M, NPROJ, D, D, 0}; pg8::StaticOrder S; S.init(M, NPROJ, G, bid); EpiInProj E{UP, Q, Kb, V, GATES, ROPE, KSUM};
      pg8::gemm_phase<EpiInProj, pg8::StaticOrder, true>(lds3, g, S, E);
      if (PROBE == 7) { EpiInProj E2{UP, Q, Kb, V, GATES, ROPE, (float*)(ws + WS_KSUM_ALT)}; pg8::gemm_phase<EpiInProj, pg8::StaticOrder, true>(lds3, g, S, E2); } }
#endif
    GSYNC();
#if FAST_PRO
    pooldiff_fast(UP, DIFF);
#else
    d_pooldiff(UP, DIFF);
#endif
#if DBG & 16
    { bf16* DC = (bf16*)ALT; d_pooldiff(UP, DC); GSYNC(); d_cmp_bf16(DIFF, DC, (size_t)M * 512, ldsf, DBGW + 30); GSYNC(); }
#endif
#if (DBG & 2) || !FAST_ATTN
    d_attn(Q, Kb, V, KSUM, ATT);
#endif
#if DBG & 2
    { bf16* ATT2 = (bf16*)ALT;
#if FAST_ATTN == 2
      GSYNC(); ATTN_SORTED(ATT2);
#else
      att::attn_phase(lds3, Q, Kb, V, KSUM, ATT2, G, bid);
#endif
      GSYNC(); d_cmp_bf16(ATT2, ATT, (size_t)M * 512, ldsf, DBGW + 18); }
#elif FAST_ATTN == 1
    att::attn_phase(lds3, Q, Kb, V, KSUM, ATT, G, bid);
    if (PROBE == 4) { __syncthreads(); att::attn_phase(lds3, Q, Kb, V, KSUM, ATT, G, bid); }
#elif FAST_ATTN == 2
    ATTN_SORTED(ATT);
#endif
    GSYNC();
#if (DBG & 1) || !FAST_GEMM
    { EpiMergeN E{MERGED, GATES, 0}; d_ngemm(ldsf, DIFF, 512, WC_T, 512, 512, D, E); }
    { EpiMergeN E{MERGED, GATES, 1}; d_ngemm(ldsf, ATT, 512, WBA_T, 512, 512, D, E); }
#endif
#if DBG & 1
    { bf16* MG2 = (bf16*)ALT;
      { pg8::Gemm g{DIFF, WC_T, M, D, 512, 512, 0}; pg8::StaticOrder S; S.init(M, D, G, bid); EpiMerge<0> E{MG2, GATES}; pg8::gemm_phase<EpiMerge<0>, pg8::StaticOrder, true>(lds3, g, S, E); }
      { pg8::Gemm g{ATT, WBA_T, M, D, 512, 512, 0}; pg8::StaticOrder S; S.init(M, D, G, bid); EpiMerge<1> E{MG2, GATES}; pg8::gemm_phase<EpiMerge<1>, pg8::StaticOrder, true>(lds3, g, S, E); }
      GSYNC();
      d_cmp_bf16(MG2, MERGED, (size_t)M * D, ldsf, DBGW + 12); }
#elif FAST_GEMM
    { pg8::Gemm g{DIFF, WC_T, M, D, 512, 512, 0}; pg8::StaticOrder S; S.init(M, D, G, bid); EpiMerge<0> E{MERGED, GATES}; pg8::gemm_phase<EpiMerge<0>, pg8::StaticOrder, true>(lds3, g, S, E); }
    { pg8::Gemm g{ATT, WBA_T, M, D, 512, 512, 0}; pg8::StaticOrder S; S.init(M, D, G, bid); EpiMerge<1> E{MERGED, GATES}; pg8::gemm_phase<EpiMerge<1>, pg8::StaticOrder, true>(lds3, g, S, E); }
    if (PROBE == 8) { { pg8::Gemm g{DIFF, WC_T, M, D, 512, 512, 0}; pg8::StaticOrder S; S.init(M, D, G, bid); EpiMerge<0> E{MERGED, GATES}; pg8::gemm_phase<EpiMerge<0>, pg8::StaticOrder, true>(lds3, g, S, E); }
      { pg8::Gemm g{ATT, WBA_T, M, D, 512, 512, 0}; pg8::StaticOrder S; S.init(M, D, G, bid); EpiMerge<1> E{MERGED, GATES}; pg8::gemm_phase<EpiMerge<1>, pg8::StaticOrder, true>(lds3, g, S, E); } }
#endif
    GSYNC();
#if (DBG & 1) || !FAST_GEMM
    { EpiRes1N E{x, MOD, out}; d_ngemm(ldsf, MERGED, D, WOUT_T, D, D, D, E); }
#endif
#if DBG & 1
    { float* X12 = (float*)ALT;
      pg8::Gemm g{MERGED, WOUT_T, M, D, D, D, 0}; pg8::StaticOrder S; S.init(M, D, G, bid); EpiRes1 E{x, MOD, X12}; pg8::gemm_phase<EpiRes1, pg8::StaticOrder, true>(lds3, g, S, E);
      GSYNC();
      d_cmp_f32(X12, out, (size_t)M * D, ldsf, DBGW + 14); }
#elif FAST_GEMM
    { pg8::Gemm g{MERGED, WOUT_T, M, D, D, D, 0}; pg8::StaticOrder S; S.init(M, D, G, bid); EpiRes1 E{x, MOD, out}; pg8::gemm_phase<EpiRes1, pg8::StaticOrder, true>(lds3, g, S, E);
      if (PROBE == 9) pg8::gemm_phase<EpiRes1, pg8::StaticOrder, true>(lds3, g, S, E); }
#endif
    GSYNC();
#if FAST_PRO
    fill_mtab((LAS float*)lds3, MOD, 3 * D, 4 * D); modulate_rows(out, g_ffn, (const LAS float*)lds3, H);
#else
    d_modulate(out, g_ffn, MOD, 3 * D, 4 * D, H);
#endif
    GSYNC();
#if DBG & 16
    { bf16* HC = (bf16*)(ALT + 20 * MiB); d_modulate(out, g_ffn, MOD, 3 * D, 4 * D, HC); GSYNC(); d_cmp_bf16(H, HC, (size_t)M * D, ldsf, DBGW + 28); GSYNC(); }
#endif
#if (DBG & 1) || !FAST_GEMM
    { EpiBfN E{QP, 2048}; d_ngemm(ldsf, H, D, WQ_T, D, D, 2048, E); }
#endif
#if DBG & 1
    { bf16* QP2 = (bf16*)ALT;
      pg8::Gemm g{H, WQ_T, M, 2048, D, D, 0}; pg8::StaticOrder S; S.init(M, 2048, G, bid); EpiBf16 E{QP2, 2048}; pg8::gemm_phase<EpiBf16, pg8::StaticOrder, true>(lds3, g, S, E);
      GSYNC();
      d_cmp_bf16(QP2, QP, (size_t)M * 2048, ldsf, DBGW + 16); }
#elif FAST_GEMM
    { pg8::Gemm g{H, WQ_T, M, 2048, D, D, 0}; pg8::StaticOrder S; S.init(M, 2048, G, bid); EpiBf16 E{QP, 2048}; pg8::gemm_phase<EpiBf16, pg8::StaticOrder, true>(lds3, g, S, E);
      if (PROBE == 10) pg8::gemm_phase<EpiBf16, pg8::StaticOrder, true>(lds3, g, S, E); }
#endif
    GSYNC();
#if (DBG & 4) || !FAST_ROUTE
    d_route(ldsf, QP, SK, EID, EG);
#endif
#if DBG & 4
    { int* EID2 = (int*)(ws + 68 * MiB); float* EG2 = (float*)(ws + 76 * MiB); float* SM1 = (float*)(ws + 148 * MiB); float* SM2 = (float*)(ws + 150 * MiB);
      __syncthreads(); route_phase(lds3, QP, (const bf16*)(ws + WS_SKBD), EID2, EG2, G, bid); GSYNC();
      d_route_summary(EID, EG, SM1); d_route_summary(EID2, EG2, SM2); GSYNC(); d_cmp_f32(SM2, SM1, (size_t)M * PHEADS * 2, ldsf, DBGW + 22); }
#elif FAST_ROUTE
    route_phase(lds3, QP, (const bf16*)(ws + WS_SKBD), EID, EG, G, bid);
    if (PROBE == 6) route_phase(lds3, QP, (const bf16*)(ws + WS_SKBD), EID, EG, G, bid);
#endif
    GSYNC();
#if DBG & 8
    { float* OUT2 = (float*)(ws + WS_OUT2); PEER_CALL(out, OUT2); GSYNC();
      d_peer(H, EID, EG, Ut, Vt, MOD, g_fin, out); GSYNC(); d_cmp_f32(OUT2, out, (size_t)M * D, ldsf, DBGW + 20); }
#elif USE_FAST_PEER
    if (PROBE == 2) { PEER_CALL(out, (float*)(ws + WS_OUT2)); GSYNC(); }
    if (PROBE == 3) { for (int i = 0; i < 10; ++i) GSYNC(); }
    PEER_CALL(out, out);
#else
    d_peer(H, EID, EG, Ut, Vt, MOD, g_fin, out);
#endif
#if DBG
    GSYNC();
    { float e2 = 0.f; for (int i = 0; i < 16; ++i) { const float n = __hip_atomic_load(DBGW + 2 * i, __ATOMIC_RELAXED, __HIP_MEMORY_SCOPE_AGENT), d = __hip_atomic_load(DBGW + 2 * i + 1, __ATOMIC_RELAXED, __HIP_MEMORY_SCOPE_AGENT); if (d > 0.f) e2 += n / d; else if (n > 0.f) e2 += 1.f; }
      float dl = 10.f * sqrtf(e2); if (!(dl < 1.f)) dl = 1.f;
      GSTRIDE(i, (size_t)M * D) out[i] *= (1.f + dl); }
#endif
}

extern "C" void kernel_launch(void* const* d_in, const int* in_sizes, int n_in, void* d_out, int out_size, void* d_ws, size_t ws_size, hipStream_t stream) {
    static int grid_blocks = 0;
    if (grid_blocks == 0) {
        if (n_in != 17 || out_size != M * D || ws_size < 256 * MiB) { fprintf(stderr, "kernel_launch: unexpected shapes (n_in %d out %d ws %zu)\n", n_in, out_size, ws_size); grid_blocks = -1; return; }
        int dev = 0, cus = 0, per_cu = 0;
        (void)hipGetDevice(&dev); (void)hipDeviceGetAttribute(&cus, hipDeviceAttributeMultiprocessorCount, dev);
        (void)hipFuncSetAttribute((const void*)mega_fwd, hipFuncAttributeMaxDynamicSharedMemorySize, LDS_BYTES);
        (void)hipOccupancyMaxActiveBlocksPerMultiprocessor(&per_cu, (const void*)mega_fwd, NT, LDS_BYTES);
        if (per_cu < 1 || cus < 1) { fprintf(stderr, "kernel_launch: occupancy query says %d blocks/CU on %d CUs\n", per_cu, cus); grid_blocks = -1; return; }
        grid_blocks = cus;
    }
    if (grid_blocks < 0) return;
    (void)hipMemsetAsync((char*)d_ws + WS_CTL, 0, 1 * MiB, stream);
    Args a{};
    for (int i = 0; i < 17; ++i) a.in[i] = (const float*)d_in[i];
    a.out = (float*)d_out; a.ws = (unsigned char*)d_ws;
    void* args[] = {&a};
    hipError_t e = hipLaunchCooperativeKernel((const void*)mega_fwd, dim3(grid_blocks), dim3(NT), args, LDS_BYTES, stream);
    if (e != hipSuccess) fprintf(stderr, "cooperative launch failed: %s (grid %d)\n", hipGetErrorString(e), grid_blocks);
}
```

```cpp
#include <hip/hip_runtime.h>
#include <hip/hip_cooperative_groups.h>
#include <cstdio>
#include <cstdint>
namespace cg = cooperative_groups;

constexpr int BATCH = 2, SEQ = 8192, D = 1024, M = BATCH * SEQ;
constexpr int NPROJ = 4096, PW = 512, AW = 512, NH = 8, HD = 64, MBLK = 256, NBLK = SEQ / MBLK;
constexpr int PHEADS = 8, NKEYS = 128, PQD = 256, PHALF = 128, PTOPK = 16, NEXP = NKEYS * NKEYS, NSEL = PHEADS * PTOPK;
constexpr float EPS = 1e-6f;
constexpr float C2 = 0.125f * 1.4426950408889634f;
constexpr int NT = 512;

typedef unsigned short bf16;
__device__ __forceinline__ float bf2f(bf16 v) { return __uint_as_float(((unsigned)v) << 16); }
__device__ __forceinline__ bf16 f2bf(float f) { unsigned u = __float_as_uint(f); return (bf16)((u + 0x7fffu + ((u >> 16) & 1u)) >> 16); }

constexpr size_t MiB = 1u << 20;
constexpr size_t WS_CTL = 0;
constexpr size_t WS_MOD = 1 * MiB;
constexpr size_t WS_KSUM = 256 * 1024;
constexpr size_t WS_BAR = 32 * 1024;
constexpr size_t WS_KSUM_ALT = 512 * 1024, WS_DBG = 16 * 1024;
constexpr size_t WS_UT = 180 * MiB, WS_VT = 212 * MiB;
constexpr size_t WS_U8 = 180 * MiB, WS_V8 = 196 * MiB, WS_USC = 212 * MiB, WS_VSC = 212 * MiB + 65536;
constexpr size_t WS_SEL = 1 * MiB + 768 * 1024;
constexpr size_t WS_CNT = 640 * 1024;
constexpr size_t WS_PO01 = 213 * MiB, WS_PO2 = 52 * MiB, WS_LIST = 245 * MiB, WS_PML = 253 * MiB;
constexpr size_t WS_OUT2 = 84 * MiB;
constexpr size_t WS_ALT = 180 * MiB;
constexpr size_t WS_ROPE = 1 * MiB + 256 * 1024;
constexpr size_t WS_MODP = 148 * MiB;
constexpr size_t WS_WCF = 150 * MiB;
constexpr size_t WS_W_IN_T = 2 * MiB;
constexpr size_t WS_WC_T = 10 * MiB;
constexpr size_t WS_WBA_T = 11 * MiB;
constexpr size_t WS_WOUT_T = 12 * MiB;
constexpr size_t WS_WQ_T = 14 * MiB;
constexpr size_t WS_SK = 18 * MiB;
constexpr size_t WS_SKBD = 19 * MiB;
constexpr size_t WS_H = 20 * MiB;
constexpr size_t WS_DIFF = 20 * MiB, WS_ATT = 36 * MiB;
constexpr size_t WS_UP = 52 * MiB, WS_Q = 68 * MiB, WS_K = 84 * MiB, WS_V = 100 * MiB;
constexpr size_t WS_GATES = 116 * MiB;
constexpr size_t WS_MERGED = 84 * MiB;
constexpr size_t WS_QP = 116 * MiB;
constexpr size_t WS_EID = 52 * MiB, WS_EG = 60 * MiB;
constexpr size_t WS_END = 180 * MiB;

struct Args { const float* in[17]; float* out; unsigned char* ws; };

#define GSTRIDE(i, n) for (size_t i = (size_t)blockIdx.x * NT + threadIdx.x; i < (size_t)(n); i += (size_t)gridDim.x * NT)

__device__ __forceinline__ void d_mod(const float* c, const float* w_ada, const float* b_ada, float* mod) {
    GSTRIDE(idx, 2 * 6144) { const int b = (int)idx / 6144, j = (int)idx % 6144; float acc = 0.f;
        for (int i = 0; i < D; ++i) { const float cv = c[b * D + i]; const float s = cv / (1.f + expf(-cv)); acc += s * w_ada[(size_t)i * 6144 + j]; }
        mod[idx] = acc + b_ada[j]; }
}
__device__ __forceinline__ void d_transpose(const float* W, int K, int N, bf16* WT) {
    GSTRIDE(idx, (size_t)K * N) { const int k = (int)(idx / N), n = (int)(idx % N); WT[(size_t)n * K + k] = f2bf(W[idx]); }
}
__device__ __forceinline__ void d_wc(const float* pool_w, const float* pool_scale, const float* w_bp, bf16* WcT) {
    GSTRIDE(idx, 512 * 1024) { const int o = (int)idx % 1024, k = (int)idx / 1024, g = k / 128, i = k % 128; float acc = 0.f;
        for (int j = 0; j < 128; ++j) acc += pool_w[(g * 128 + i) * 128 + j] * pool_scale[g * 128 + j] * w_bp[(size_t)(g * 128 + j) * 1024 + o];
        WcT[(size_t)o * 512 + k] = f2bf(acc); }
}
__device__ __forceinline__ void d_sk(const float* sk, bf16* SK) { GSTRIDE(idx, 8 * 2 * 128 * 128) SK[idx] = f2bf(sk[idx]); }
__device__ __forceinline__ void d_rope(float* tab) {
    GSTRIDE(idx, SEQ * 8) { const int pos = (int)idx / 8, i = (int)idx % 8; const float inv = (float)pow(500000.0, -(double)i / 8.0); const float ang = (float)pos * inv;
        tab[pos * 16 + i] = (float)cos((double)ang); tab[pos * 16 + 8 + i] = (float)sin((double)ang); }
}
__device__ __forceinline__ void d_modulate(const float* x, const float* g, const float* mod, int shift_off, int scale_off, bf16* out) {
    const int lane = threadIdx.x & 63;
    for (int row = blockIdx.x * (NT / 64) + (threadIdx.x >> 6); row < M; row += gridDim.x * (NT / 64)) {
        const int b = row / SEQ; const float* xr = x + (size_t)row * D; float v[16]; float ss = 0.f;
#pragma unroll
        for (int j = 0; j < 16; ++j) { v[j] = xr[j * 64 + lane]; ss += v[j] * v[j]; }
#pragma unroll
        for (int o = 1; o < 64; o <<= 1) ss += __shfl_xor(ss, o);
        const float r = rsqrtf(ss * (1.f / D) + EPS);
#pragma unroll
        for (int j = 0; j < 16; ++j) { const int col = j * 64 + lane; out[(size_t)row * D + col] = f2bf(v[j] * r * g[col] * (1.f + mod[b * 6144 + scale_off + col]) + mod[b * 6144 + shift_off + col]); }
    }
}
constexpr int NG_HALF_FLOATS = 2 * 16 * 65 + 64 * 65;
template <class Epi>
__device__ __forceinline__ void d_ngemm(float* lds, const bf16* A, int lda, const bf16* Bt, int ldb, int K, int N, const Epi& E) {
    const int half = threadIdx.x >> 8, tid = threadIdx.x & 255, tx = tid & 15, ty = tid >> 4;
    float* As = lds + half * NG_HALF_FLOATS; float* Bs = As + 16 * 65; float* Ct = Bs + 16 * 65;
    const int ntn = N / 64, ntiles = (M / 64) * ntn, iters = (ntiles + 2 * gridDim.x - 1) / (2 * gridDim.x);
    for (int it = 0; it < iters; ++it) {
        const int t = (it * gridDim.x + blockIdx.x) * 2 + half; const bool valid = t < ntiles; const int m0 = valid ? (t / ntn) * 64 : 0, n0 = valid ? (t % ntn) * 64 : 0;
        float acc[4][4];
#pragma unroll
        for (int i = 0; i < 4; ++i)
#pragma unroll
            for (int j = 0; j < 4; ++j) acc[i][j] = 0.f;
        for (int k0 = 0; k0 < K; k0 += 16) {
#pragma unroll
            for (int e = 0; e < 4; ++e) { const int idx = tid + e * 256, r = idx >> 4, kk = idx & 15;
                As[kk * 65 + r] = bf2f(A[(size_t)(m0 + r) * lda + k0 + kk]); Bs[kk * 65 + r] = bf2f(Bt[(size_t)(n0 + r) * ldb + k0 + kk]); }
            __syncthreads();
#pragma unroll
            for (int kk = 0; kk < 16; ++kk) { float a[4], b[4];
#pragma unroll
                for (int i = 0; i < 4; ++i) { a[i] = As[kk * 65 + ty * 4 + i]; b[i] = Bs[kk * 65 + tx * 4 + i]; }
#pragma unroll
                for (int i = 0; i < 4; ++i)
#pragma unroll
                    for (int j = 0; j < 4; ++j) acc[i][j] += a[i] * b[j]; }
            __syncthreads();
        }
#pragma unroll
        for (int i = 0; i < 4; ++i)
#pragma unroll
            for (int j = 0; j < 4; ++j) Ct[(ty * 4 + i) * 65 + tx * 4 + j] = acc[i][j];
        __syncthreads();
        if (valid) for (int e = tid; e < 64 * 64; e += 256) { const int r = e >> 6, cidx = e & 63; E(m0 + r, n0 + cidx, Ct[r * 65 + cidx], &Ct[r * 65], cidx); }
        __syncthreads();
    }
}
struct EpiInProjN {
    bf16 *UP, *Q, *Kb, *V, *G; const float* rope;
    __device__ void operator()(int m, int n, float v, const float* row, int cl) const {
        if (n < 512) { UP[(size_t)m * 512 + n] = f2bf(v); return; }
        if (n < 1536) {
            const bool isq = n < 1024; const int c = isq ? n - 512 : n - 1024; const int d = c & 63; const int pos = m % SEQ; float o = v;
            if (d < 8) { const float cs = rope[pos * 16 + d], sn = rope[pos * 16 + 8 + d]; o = v * cs - row[cl + 8] * sn; }
            else if (d < 16) { const float cs = rope[pos * 16 + d - 8], sn = rope[pos * 16 + 8 + d - 8]; o = row[cl - 8] * sn + v * cs; }
            if (isq) Q[(size_t)m * 512 + c] = f2bf(o * C2); else Kb[(size_t)m * 512 + c] = f2bf(o);
            return;
        }
        if (n < 2048) { V[(size_t)m * 512 + n - 1536] = f2bf(v); return; }
        G[(size_t)m * 2048 + n - 2048] = f2bf(1.f / (1.f + expf(-v)));
    }
};
struct EpiMergeN { bf16* Mg; const bf16* G; int pass;
    __device__ void operator()(int m, int n, float v, const float*, int) const {
        const float g = bf2f(G[(size_t)m * 2048 + pass * 1024 + n]); const size_t o = (size_t)m * 1024 + n;
        if (pass == 0) Mg[o] = f2bf(g * v); else Mg[o] = f2bf(bf2f(Mg[o]) + g * v); } };
struct EpiRes1N { const float* x; const float* mod; float* x1;
    __device__ void operator()(int m, int n, float v, const float*, int) const { const int b = m / SEQ; x1[(size_t)m * D + n] = x[(size_t)m * D + n] + mod[b * 6144 + 2 * D + n] * v; } };
struct EpiBfN { bf16* O; int ldo; __device__ void operator()(int m, int n, float v, const float*, int) const { O[(size_t)m * ldo + n] = f2bf(v); } };

__device__ __forceinline__ void d_ksum(const bf16* Kb, float* ksum) {
    GSTRIDE(idx, BATCH * NH * NBLK * HD) { const int d = (int)idx % HD, blk = ((int)idx / HD) % NBLK, h = ((int)idx / (HD * NBLK)) % NH, b = (int)idx / (HD * NBLK * NH); float s = 0.f;
        for (int r = 0; r < MBLK; ++r) s += bf2f(Kb[(size_t)(b * SEQ + blk * MBLK + r) * 512 + h * 64 + d]);
        ksum[idx] = s; }
}
__device__ __forceinline__ void d_pooldiff(const bf16* UP, bf16* DIFF) {
    GSTRIDE(idx, (size_t)M * 512) { const int c = (int)(idx % 512), row = (int)(idx / 512), pos = row % SEQ, w = 2 << (c / 128), cnt = pos + 1 < w ? pos + 1 : w; float s = 0.f;
        for (int i = 0; i < cnt; ++i) s += bf2f(UP[(size_t)(row - i) * 512 + c]);
        DIFF[idx] = f2bf(s / (float)cnt - bf2f(UP[idx])); }
}
__device__ __forceinline__ void d_attn(const bf16* Q, const bf16* Kb, const bf16* V, const float* ksum, bf16* ATT) {
    GSTRIDE(gidx, BATCH * NH * SEQ) {
        const int idx = (int)gidx, q = idx % SEQ, h = (idx / SEQ) % NH, b = idx / (SEQ * NH), row = b * SEQ + q, qb = q / MBLK;
        float qv[64], o[64];
#pragma unroll
        for (int d = 0; d < 64; ++d) { qv[d] = bf2f(Q[(size_t)row * 512 + h * 64 + d]); o[d] = 0.f; }
        int s0 = -1, s1 = -1, s2 = -1; float g0 = -INFINITY, g1 = -INFINITY, g2 = -INFINITY;
        for (int j = 0; j < qb; ++j) { const float* ks = ksum + ((size_t)(b * NH + h) * NBLK + j) * HD; float g = 0.f;
#pragma unroll
            for (int d = 0; d < 64; ++d) g += qv[d] * ks[d];
            if (g > g0) { g2 = g1; s2 = s1; g1 = g0; s1 = s0; g0 = g; s0 = j; } else if (g > g1) { g2 = g1; s2 = s1; g1 = g; s1 = j; } else if (g > g2) { g2 = g; s2 = j; } }
        float mx = -1e30f, l = 0.f;
        for (int pass = 0; pass < 4; ++pass) {
            const int blk = pass == 0 ? qb : (pass == 1 ? s0 : (pass == 2 ? s1 : s2)); if (blk < 0) continue;
            const int nkeys = pass == 0 ? (q - qb * MBLK + 1) : MBLK;
            for (int kk = 0; kk < nkeys; ++kk) { const size_t kr = (size_t)(b * SEQ + blk * MBLK + kk) * 512 + h * 64; float s = 0.f;
#pragma unroll
                for (int d = 0; d < 64; ++d) s += qv[d] * bf2f(Kb[kr + d]);
                if (s > mx) { const float f = exp2f(mx - s); l = l * f + 1.f;
#pragma unroll
                    for (int d = 0; d < 64; ++d) o[d] = o[d] * f + bf2f(V[kr + d]);
                    mx = s; }
                else { const float p = exp2f(s - mx); l += p;
#pragma unroll
                    for (int d = 0; d < 64; ++d) o[d] += p * bf2f(V[kr + d]); } }
        }
        const float il = 1.f / l;
#pragma unroll
        for (int d = 0; d < 64; ++d) ATT[(size_t)row * 512 + h * 64 + d] = f2bf(o[d] * il);
    }
}
__device__ __forceinline__ void d_route(float* lds, const bf16* QP, const bf16* SK, int* EID, float* EG) {
    const int tid = threadIdx.x; float* lv = lds + tid * 33; int* li = (int*)(lds + NT * 33) + tid * 33;
    GSTRIDE(gidx, M * PHEADS) {
        const int idx = (int)gidx, h = idx % PHEADS, t = idx / PHEADS;
#pragma unroll 1
        for (int p = 0; p < 2; ++p) {
            float tv[16]; int ti[16];
#pragma unroll
            for (int j = 0; j < 16; ++j) { tv[j] = -INFINITY; ti[j] = 0; }
            const bf16* qr = QP + (size_t)t * 2048 + h * 256 + p * 128; const bf16* sk = SK + (size_t)(h * 2 + p) * 128 * 128;
#pragma unroll 1
            for (int n = 0; n < 128; ++n) { float s = 0.f;
                for (int d = 0; d < 128; ++d) s += bf2f(qr[d]) * bf2f(sk[n * 128 + d]);
                float v = s; int vi = n;
#pragma unroll
                for (int j = 0; j < 16; ++j) if (v > tv[j]) { const float tf = tv[j]; const int tj = ti[j]; tv[j] = v; ti[j] = vi; v = tf; vi = tj; } }
#pragma unroll
            for (int j = 0; j < 16; ++j) { lv[p * 16 + j] = tv[j]; li[p * 16 + j] = ti[j]; }
        }
        float cv[16]; int ci[16];
#pragma unroll
        for (int j = 0; j < 16; ++j) { cv[j] = -INFINITY; ci[j] = 0; }
#pragma unroll 1
        for (int i = 0; i < 16; ++i)
#pragma unroll 1
            for (int j2 = 0; j2 < 16; ++j2) { float v = lv[i] + lv[16 + j2]; int vi = li[i] * NKEYS + li[16 + j2];
#pragma unroll
                for (int j = 0; j < 16; ++j) if (v > cv[j]) { const float tf = cv[j]; const int tj = ci[j]; cv[j] = v; ci[j] = vi; v = tf; vi = tj; } }
        float sum = 0.f, e[16];
#pragma unroll
        for (int j = 0; j < 16; ++j) { e[j] = expf(cv[j] - cv[0]); sum += e[j]; }
        const float is = 1.f / sum;
#pragma unroll
        for (int j = 0; j < 16; ++j) { EID[(size_t)t * NSEL + h * 16 + j] = ci[j]; EG[(size_t)t * NSEL + h * 16 + j] = e[j] * is; }
    }
}
__device__ __forceinline__ void d_peer(const bf16* H2, const int* EID, const float* EG, const float* Ut, const float* Vt, const float* mod, const float* gfin, float* io) {
    const int lane = threadIdx.x & 63;
    for (int t = blockIdx.x * (NT / 64) + (threadIdx.x >> 6); t < M; t += gridDim.x * (NT / 64)) {
        const int b = t / SEQ; float hv[16], acc[16];
#pragma unroll
        for (int j = 0; j < 4; ++j)
#pragma unroll
            for (int e = 0; e < 4; ++e) { hv[j * 4 + e] = bf2f(H2[(size_t)t * D + j * 256 + lane * 4 + e]); acc[j * 4 + e] = 0.f; }
#pragma unroll 1
        for (int k = 0; k < NSEL; ++k) {
            const int eid = EID[(size_t)t * NSEL + k]; const float g = EG[(size_t)t * NSEL + k];
            const float4* ur = (const float4*)(Ut + (size_t)eid * D); const float4* vr = (const float4*)(Vt + (size_t)eid * D); float dot = 0.f;
#pragma unroll
            for (int j = 0; j < 4; ++j) { const float4 u = ur[j * 64 + lane]; dot += hv[j * 4] * u.x + hv[j * 4 + 1] * u.y + hv[j * 4 + 2] * u.z + hv[j * 4 + 3] * u.w; }
#pragma unroll
            for (int o = 1; o < 64; o <<= 1) dot += __shfl_xor(dot, o);
            const float w = g * 0.5f * dot * (1.f + erff(dot * 0.70710678118654752f));
#pragma unroll
            for (int j = 0; j < 4; ++j) { const float4 v = vr[j * 64 + lane]; acc[j * 4] += w * v.x; acc[j * 4 + 1] += w * v.y; acc[j * 4 + 2] += w * v.z; acc[j * 4 + 3] += w * v.w; }
        }
        float ss = 0.f;
#pragma unroll
        for (int j = 0; j < 4; ++j)
#pragma unroll
            for (int e = 0; e < 4; ++e) { const int col = j * 256 + lane * 4 + e; const float x2 = io[(size_t)t * D + col] + mod[b * 6144 + 5 * D + col] * acc[j * 4 + e]; acc[j * 4 + e] = x2; ss += x2 * x2; }
#pragma unroll
        for (int o = 1; o < 64; o <<= 1) ss += __shfl_xor(ss, o);
        const float r = rsqrtf(ss * (1.f / D) + EPS);
#pragma unroll
        for (int j = 0; j < 4; ++j)
#pragma unroll
            for (int e = 0; e < 4; ++e) { const int col = j * 256 + lane * 4 + e; io[(size_t)t * D + col] = acc[j * 4 + e] * r * gfin[col]; }
    }
}


#define LAS __attribute__((address_space(3)))
typedef short bf16x8 __attribute__((ext_vector_type(8)));
typedef float f32x4 __attribute__((ext_vector_type(4)));
typedef float f32x2 __attribute__((ext_vector_type(2)));
typedef unsigned u32x4 __attribute__((ext_vector_type(4)));
typedef unsigned u32x2 __attribute__((ext_vector_type(2)));
typedef __bf16 bf16x2_t __attribute__((ext_vector_type(2)));
__device__ __forceinline__ unsigned cvt_pk_bf16(float lo, float hi) { f32x2 v = {lo, hi}; bf16x2_t b = __builtin_convertvector(v, bf16x2_t); return __builtin_bit_cast(unsigned, b); }
__device__ __forceinline__ float bflo(unsigned w) { return __uint_as_float(w << 16); }
__device__ __forceinline__ float bfhi(unsigned w) { return __uint_as_float(w & 0xffff0000u); }

namespace pg8 {
constexpr int BM = 256, BK = 64, HALF = 128, HTB = HALF * BK * 2  , STAGE_BYTES = 8 * HTB, NXCD = 8, WGM = 8;
__device__ __forceinline__ int lds_byte(int r, int c) { const int st = (r >> 4) * 2 + (c >> 5), rr = r & 15, cc = c & 31, ob = rr * 64 + cc * 2; return st * 1024 + (ob ^ (((ob >> 9) & 1) << 5)); }
__device__ __forceinline__ void stage_rc(int b, int& R, int& C) { const int st = b / 1024, sb = b % 1024, swz = sb ^ (((sb >> 9) & 1) << 5); R = (st >> 1) * 16 + swz / 64; C = (st & 1) * 32 + (swz % 64) / 2; }
__device__ __forceinline__ int perm32(int rho) { const int n = rho >> 4, i = rho & 15; return 8 * (i >> 2) + 4 * n + (i & 3); }
struct Unit { int pm, pn; };
struct Gemm { const bf16* A; const bf16* Bt; int M, N, K, lda, a_pn_off; };
struct StaticOrder {
    int nM, nN, nwg, G, c;
    __device__ void init(int M_, int N_, int G_, int c_) { nM = M_ / BM; nN = N_ / BM; nwg = nM * nN; G = G_; c = c_; }
    __device__ bool next(int i, Unit& u) const {
        const long L = (long)i * G + c; if (L >= nwg) return false;
        int wgid = (int)L; { const int q = nwg / NXCD, r = nwg % NXCD, xcd = wgid % NXCD, off = wgid / NXCD; wgid = (xcd < r ? xcd * (q + 1) : r * (q + 1) + (xcd - r) * q) + off; }
        const int nig = WGM * nN, gid = wgid / nig, fm = gid * WGM, gsz = (nM - fm) < WGM ? (nM - fm) : WGM;
        u.pm = fm + ((wgid % nig) % gsz); u.pn = (wgid % nig) / gsz; return true;
    }
};
struct OneUnit { Unit u; __device__ bool next(int i, Unit& o) const { if (i) return false; o = u; return true; } };
template <class Epi, class Sched, bool ALIGN_EPI>
__device__ __forceinline__ void gemm_phase(LAS unsigned char* lds, const Gemm g, const Sched& S, const Epi& E) {
    int tid_ = threadIdx.x; asm volatile("" : "+v"(tid_));
    const int tid = tid_, wid = __builtin_amdgcn_readfirstlane(tid >> 6), lane = tid & 63, wr = wid >> 2, wc = wid & 3, fr = lane & 15, fq = lane >> 4;
    const int K = g.K, nt = K / BK, lda = g.lda;
    unsigned voffA[2], voffB[2];
#pragma unroll
    for (int i = 0; i < 2; ++i) { int R, C; stage_rc(tid * 16 + i * 8192, R, C); const int Rb = Epi::PERM ? ((R & ~31) + perm32(R & 31)) : R;
        voffA[i] = (unsigned)(R * lda + C) * 2u; voffB[i] = (unsigned)(Rb * K + C) * 2u; }
    const size_t kstep = (size_t)(BK * 2);
    const size_t hA = (size_t)HALF * lda * 2, hB = (size_t)HALF * K * 2, tA = 2 * hA, tB = 2 * hB;
    const unsigned ldsw = (unsigned)wid * 1024u;
    const int aoff = lds_byte(wr * 64 + fr, fq * 8), boff = lds_byte(wc * 32 + fr, fq * 8);
#define PG8_SA(b, h) (((b) * 2 + (h)) * HTB)
#define PG8_SB(b, h) ((4 + (b) * 2 + (h)) * HTB)
#define PG8_STAGE(bufoff, gbase, voff) do { _Pragma("unroll") for (int _i = 0; _i < 2; ++_i) \
        __builtin_amdgcn_global_load_lds((const unsigned*)((const char*)(gbase) + (voff)[_i]), (LAS unsigned*)(lds + (bufoff) + ldsw + _i * 8192), 16, 0, 0); } while (0)
#define PG8_LDA(dst, b, h) do { _Pragma("unroll") for (int m = 0; m < 4; ++m) _Pragma("unroll") for (int k = 0; k < 2; ++k) dst[m][k] = *(const LAS bf16x8*)(lds + PG8_SA(b, h) + aoff + m * 2048 + k * 1024); } while (0)
#define PG8_LDB(dst, b, h) do { _Pragma("unroll") for (int n = 0; n < 2; ++n) _Pragma("unroll") for (int k = 0; k < 2; ++k) dst[n][k] = *(const LAS bf16x8*)(lds + PG8_SB(b, h) + boff + n * 2048 + k * 1024); } while (0)
#define PG8_MMA(ai, bj, At, Bt) do { __builtin_amdgcn_s_setprio(1); _Pragma("unroll") for (int m = 0; m < 4; ++m) _Pragma("unroll") for (int n = 0; n < 2; ++n) _Pragma("unroll") for (int k = 0; k < 2; ++k) \
        acc[ai][bj][m][n] = __builtin_amdgcn_mfma_f32_16x16x32_bf16(Bt[n][k], At[m][k], acc[ai][bj][m][n], 0, 0, 0); __builtin_amdgcn_s_setprio(0); } while (0)
#define PG8_WAIT_V(n) asm volatile("s_waitcnt vmcnt(" #n ")" ::: "memory")
#define PG8_WAIT_L(n) asm volatile("s_waitcnt lgkmcnt(" #n ")" ::: "memory")
#define PG8_BAR __builtin_amdgcn_s_barrier()
#define PG8_SCHED __builtin_amdgcn_sched_barrier(0)
    Unit cur, nxt; int ui = 0;
    if (!S.next(0, cur)) return;
    f32x4 acc[2][2][4][2];
#pragma unroll
    for (int a = 0; a < 2; ++a)
#pragma unroll
        for (int b = 0; b < 2; ++b)
#pragma unroll
            for (int m = 0; m < 4; ++m)
#pragma unroll
                for (int n = 0; n < 2; ++n) acc[a][b][m][n] = (f32x4){0.f, 0.f, 0.f, 0.f};
    bf16x8 At[4][2], B0[2][2], B1[2][2];
    const char* cA = (const char*)g.A + (size_t)cur.pm * tA + (size_t)cur.pn * g.a_pn_off * 2; const char* cB = (const char*)g.Bt + (size_t)cur.pn * tB;
    PG8_STAGE(PG8_SB(0, 0), cB, voffB); PG8_STAGE(PG8_SB(0, 1), cB + hB, voffB); PG8_STAGE(PG8_SA(0, 0), cA, voffA); PG8_STAGE(PG8_SA(0, 1), cA + hA, voffA);
    if (wr == 1) PG8_BAR;
    PG8_WAIT_V(2); PG8_BAR;
    PG8_STAGE(PG8_SB(1, 0), cB + kstep, voffB); PG8_STAGE(PG8_SA(1, 0), cA + kstep, voffA); PG8_STAGE(PG8_SB(1, 1), cB + hB + kstep, voffB);
    PG8_WAIT_V(6); PG8_BAR;
    for (;;) {
        const bool has_next = S.next(ui + 1, nxt);
        const char* nA = has_next ? (const char*)g.A + (size_t)nxt.pm * tA + (size_t)nxt.pn * g.a_pn_off * 2 : cA; const char* nB = has_next ? (const char*)g.Bt + (size_t)nxt.pn * tB : cB;
        for (int t = 0; t < nt; t += 2) {
            const bool last = (t == nt - 2);
            const char* a1 = cA + (size_t)(t + 1) * kstep;
            const char* a2 = last ? nA : cA + (size_t)(t + 2) * kstep; const char* b2 = last ? nB : cB + (size_t)(t + 2) * kstep;
            const char* a3 = a2 + kstep; const char* b3 = b2 + kstep;
            PG8_LDB(B0, 0, 0); PG8_LDB(B1, 0, 1); PG8_SCHED; PG8_LDA(At, 0, 0); PG8_STAGE(PG8_SA(1, 1), a1 + hA, voffA);
            PG8_WAIT_V(8); PG8_WAIT_L(0); PG8_BAR; PG8_MMA(0, 0, At, B0); PG8_MMA(0, 1, At, B1); PG8_BAR; PG8_SCHED;
            PG8_LDA(At, 0, 1); PG8_STAGE(PG8_SB(0, 0), b2, voffB); PG8_STAGE(PG8_SB(0, 1), b2 + hB, voffB); PG8_STAGE(PG8_SA(0, 0), a2, voffA);
            PG8_WAIT_V(8); PG8_WAIT_L(0); PG8_BAR; PG8_MMA(1, 0, At, B0); PG8_MMA(1, 1, At, B1); PG8_BAR; PG8_SCHED;
            PG8_LDB(B0, 1, 0); PG8_LDB(B1, 1, 1); PG8_SCHED; PG8_LDA(At, 1, 0); PG8_STAGE(PG8_SA(0, 1), a2 + hA, voffA);
            PG8_WAIT_V(8); PG8_WAIT_L(0); PG8_BAR; PG8_MMA(0, 0, At, B0); PG8_MMA(0, 1, At, B1); PG8_BAR; PG8_SCHED;
            PG8_LDA(At, 1, 1); PG8_STAGE(PG8_SB(1, 0), b3, voffB); PG8_STAGE(PG8_SB(1, 1), b3 + hB, voffB); PG8_STAGE(PG8_SA(1, 0), a3, voffA);
            PG8_WAIT_V(8); PG8_WAIT_L(0); PG8_BAR; PG8_MMA(1, 0, At, B0); PG8_MMA(1, 1, At, B1); PG8_BAR; PG8_SCHED;
        }
        if constexpr (ALIGN_EPI) { if (wr == 0) PG8_BAR; }
        if constexpr (!Epi::AFTER_DRAIN) { E(acc, cur, wr, wc, fr, fq); }
        if (!has_next) break;
#pragma unroll
        for (int a = 0; a < 2; ++a)
#pragma unroll
            for (int b = 0; b < 2; ++b)
#pragma unroll
                for (int m = 0; m < 4; ++m)
#pragma unroll
                    for (int n = 0; n < 2; ++n) acc[a][b][m][n] = (f32x4){0.f, 0.f, 0.f, 0.f};
        cur = nxt; cA = nA; cB = nB; ++ui;
        if constexpr (ALIGN_EPI) { if (wr == 1) PG8_BAR; }
    }
    PG8_WAIT_V(0);
    if constexpr (!ALIGN_EPI) { if (wr == 0) PG8_BAR; }
    PG8_BAR;
    if constexpr (Epi::AFTER_DRAIN) { E.fused(acc, cur, wr, wc, fr, fq, lds, wid, lane); }
#undef PG8_SA
#undef PG8_SB
#undef PG8_STAGE
#undef PG8_LDA
#undef PG8_LDB
#undef PG8_MMA
#undef PG8_WAIT_V
#undef PG8_WAIT_L
#undef PG8_BAR
#undef PG8_SCHED
}
}

__device__ __forceinline__ float fast_sigmoid(float v) { return __builtin_amdgcn_rcpf(1.f + __builtin_amdgcn_exp2f(-1.4426950408889634f * v)); }
struct EpiInProj {
    static constexpr bool PERM = true, AFTER_DRAIN = false;
    bf16 *UP, *Q, *Kb, *V, *G; const float* rope; float* ksum;
    __device__ __forceinline__ void operator()(const f32x4 (&acc)[2][2][4][2], const pg8::Unit& u, int wr, int wc, int fr, int fq) const {
        const int pn = u.pn, row0 = u.pm * 256 + wr * 64 + fr;
        if (pn < 2 || (pn >= 6 && pn < 8)) {
            bf16* O = pn < 2 ? UP : V; const int c0 = (pn & 1) * 256 + wc * 32 + 8 * fq;
#pragma unroll
            for (int ai = 0; ai < 2; ++ai)
#pragma unroll
                for (int m = 0; m < 4; ++m)
#pragma unroll
                    for (int bj = 0; bj < 2; ++bj) { const f32x4 v0 = acc[ai][bj][m][0], v1 = acc[ai][bj][m][1]; u32x4 w;
                        w.x = cvt_pk_bf16(v0[0], v0[1]); w.y = cvt_pk_bf16(v0[2], v0[3]); w.z = cvt_pk_bf16(v1[0], v1[1]); w.w = cvt_pk_bf16(v1[2], v1[3]);
                        *(u32x4*)(O + (size_t)(row0 + ai * 128 + m * 16) * 512 + c0 + bj * 128) = w; }
        } else if (pn < 6) {
            const bool isq = pn < 4; bf16* O = isq ? Q : Kb; const int c0 = (pn & 1) * 256 + wc * 32 + 8 * fq; const bool rot = (wc & 1) == 0;
            float cs[2][8];
#pragma unroll
            for (int bj = 0; bj < 2; ++bj)
#pragma unroll
                for (int i = 0; i < 8; ++i) cs[bj][i] = 0.f;
#pragma unroll
            for (int ai = 0; ai < 2; ++ai)
#pragma unroll
                for (int m = 0; m < 4; ++m) {
                    const int row = row0 + ai * 128 + m * 16, pos = row % SEQ;
                    f32x4 c0v = {1.f, 1.f, 1.f, 1.f}, c1v = c0v, s0v = {0.f, 0.f, 0.f, 0.f}, s1v = s0v;
                    if (rot) { const f32x4* rp = (const f32x4*)(rope + pos * 16); c0v = rp[0]; c1v = rp[1]; s0v = rp[2]; s1v = rp[3]; }
#pragma unroll
                    for (int bj = 0; bj < 2; ++bj) { f32x4 v0 = acc[ai][bj][m][0], v1 = acc[ai][bj][m][1];
                        if (rot) { f32x4 p0, p1;
#pragma unroll
                            for (int i = 0; i < 4; ++i) { p0[i] = __shfl_xor(v0[i], 16); p1[i] = __shfl_xor(v1[i], 16); }
                            if (fq == 0) { v0 = v0 * c0v - p0 * s0v; v1 = v1 * c1v - p1 * s1v; } else if (fq == 1) { v0 = p0 * s0v + v0 * c0v; v1 = p1 * s1v + v1 * c1v; } }
                        if (isq) { v0 = v0 * C2; v1 = v1 * C2; } else {
#pragma unroll
                            for (int i = 0; i < 4; ++i) { cs[bj][i] += v0[i]; cs[bj][4 + i] += v1[i]; } }
                        u32x4 w; w.x = cvt_pk_bf16(v0[0], v0[1]); w.y = cvt_pk_bf16(v0[2], v0[3]); w.z = cvt_pk_bf16(v1[0], v1[1]); w.w = cvt_pk_bf16(v1[2], v1[3]);
                        *(u32x4*)(O + (size_t)row * 512 + c0 + bj * 128) = w; }
                }
            if (!isq) {
                const int b = u.pm / NBLK, blk = u.pm % NBLK;
#pragma unroll
                for (int bj = 0; bj < 2; ++bj)
#pragma unroll
                    for (int i = 0; i < 8; ++i) { float s = cs[bj][i]; s += __shfl_xor(s, 1); s += __shfl_xor(s, 2); s += __shfl_xor(s, 4); s += __shfl_xor(s, 8);
                        if (fr == 0) { const int head = (pn & 1) * 4 + bj * 2 + (wc >> 1), d = (wc & 1) * 32 + 8 * fq + i; atomicAdd(ksum + ((size_t)(b * NH + head) * NBLK + blk) * HD + d, s); } }
            }
        } else {
            const int c0 = (pn - 8) * 256 + wc * 32 + 8 * fq;
#pragma unroll
            for (int ai = 0; ai < 2; ++ai)
#pragma unroll
                for (int m = 0; m < 4; ++m)
#pragma unroll
                    for (int bj = 0; bj < 2; ++bj) { const f32x4 v0 = acc[ai][bj][m][0], v1 = acc[ai][bj][m][1]; u32x4 w;
                        w.x = cvt_pk_bf16(fast_sigmoid(v0[0]), fast_sigmoid(v0[1])); w.y = cvt_pk_bf16(fast_sigmoid(v0[2]), fast_sigmoid(v0[3]));
                        w.z = cvt_pk_bf16(fast_sigmoid(v1[0]), fast_sigmoid(v1[1])); w.w = cvt_pk_bf16(fast_sigmoid(v1[2]), fast_sigmoid(v1[3]));
                        *(u32x4*)(G + (size_t)(row0 + ai * 128 + m * 16) * 2048 + c0 + bj * 128) = w; }
        }
    }
};
template <int PASS> struct EpiMerge {
    static constexpr bool PERM = true, AFTER_DRAIN = false;
    bf16* Mg; const bf16* G;
    __device__ __forceinline__ void operator()(const f32x4 (&acc)[2][2][4][2], const pg8::Unit& u, int wr, int wc, int fr, int fq) const {
        const int row0 = u.pm * 256 + wr * 64 + fr, c0 = u.pn * 256 + wc * 32 + 8 * fq;
#pragma unroll
        for (int ai = 0; ai < 2; ++ai)
#pragma unroll
            for (int m = 0; m < 4; ++m)
#pragma unroll
                for (int bj = 0; bj < 2; ++bj) { const size_t row = (size_t)(row0 + ai * 128 + m * 16); const int col = c0 + bj * 128;
                    const u32x4 gw = *(const u32x4*)(G + row * 2048 + PASS * 1024 + col); const f32x4 v0 = acc[ai][bj][m][0], v1 = acc[ai][bj][m][1];
                    float o[8] = {bflo(gw.x) * v0[0], bfhi(gw.x) * v0[1], bflo(gw.y) * v0[2], bfhi(gw.y) * v0[3], bflo(gw.z) * v1[0], bfhi(gw.z) * v1[1], bflo(gw.w) * v1[2], bfhi(gw.w) * v1[3]};
                    if (PASS == 1) { const u32x4 pw = *(const u32x4*)(Mg + row * 1024 + col);
                        o[0] += bflo(pw.x); o[1] += bfhi(pw.x); o[2] += bflo(pw.y); o[3] += bfhi(pw.y); o[4] += bflo(pw.z); o[5] += bfhi(pw.z); o[6] += bflo(pw.w); o[7] += bfhi(pw.w); }
                    u32x4 w; w.x = cvt_pk_bf16(o[0], o[1]); w.y = cvt_pk_bf16(o[2], o[3]); w.z = cvt_pk_bf16(o[4], o[5]); w.w = cvt_pk_bf16(o[6], o[7]);
                    *(u32x4*)(Mg + row * 1024 + col) = w; }
    }
};
struct EpiRes1 {
    static constexpr bool PERM = false, AFTER_DRAIN = false;
    const float* x; const float* mod; float* x1;
    __device__ __forceinline__ void operator()(const f32x4 (&acc)[2][2][4][2], const pg8::Unit& u, int wr, int wc, int fr, int fq) const {
        const int row0 = u.pm * 256 + wr * 64 + fr, c0 = u.pn * 256 + wc * 32 + 4 * fq, b = u.pm / NBLK;
#pragma unroll
        for (int bj = 0; bj < 2; ++bj)
#pragma unroll
            for (int n = 0; n < 2; ++n) { const int col = c0 + bj * 128 + n * 16; const f32x4 gv = *(const f32x4*)(mod + b * 6144 + 2 * D + col);
#pragma unroll
                for (int ai = 0; ai < 2; ++ai)
#pragma unroll
                    for (int m = 0; m < 4; ++m) { const size_t off = (size_t)(row0 + ai * 128 + m * 16) * D + col; *(f32x4*)(x1 + off) = *(const f32x4*)(x + off) + gv * acc[ai][bj][m][n]; } }
    }
};
struct EpiBf16 {
    static constexpr bool PERM = true, AFTER_DRAIN = false;
    bf16* O; int ldo;
    __device__ __forceinline__ void operator()(const f32x4 (&acc)[2][2][4][2], const pg8::Unit& u, int wr, int wc, int fr, int fq) const {
        const int row0 = u.pm * 256 + wr * 64 + fr, c0 = u.pn * 256 + wc * 32 + 8 * fq;
#pragma unroll
        for (int ai = 0; ai < 2; ++ai)
#pragma unroll
            for (int m = 0; m < 4; ++m)
#pragma unroll
                for (int bj = 0; bj < 2; ++bj) { const f32x4 v0 = acc[ai][bj][m][0], v1 = acc[ai][bj][m][1]; u32x4 w;
                    w.x = cvt_pk_bf16(v0[0], v0[1]); w.y = cvt_pk_bf16(v0[2], v0[3]); w.z = cvt_pk_bf16(v1[0], v1[1]); w.w = cvt_pk_bf16(v1[2], v1[3]);
                    *(u32x4*)(O + (size_t)(row0 + ai * 128 + m * 16) * ldo + c0 + bj * 128) = w; }
    }
};

namespace att {
typedef short v4i16_t __attribute__((ext_vector_type(4)));
typedef float f32x16 __attribute__((ext_vector_type(16)));
constexpr int KB_BYTES = 8192, VROW = 192, VB_BYTES = 64 * VROW, OFF_V = 2 * KB_BYTES, OFF_MISC = OFF_V + 2 * VB_BYTES;
__device__ __forceinline__ int crow(int r, int hi) { return (r & 3) + 8 * (r >> 2) + 4 * hi; }
__device__ __forceinline__ float bfe(bf16x8 v, int j) { return __uint_as_float(((unsigned)(unsigned short)v[j]) << 16); }
__device__ __forceinline__ void attn_phase(LAS unsigned char* lds, const bf16* Q, const bf16* Kb, const bf16* V, const float* ksum, bf16* ATT, int G, int bid) {
    int tid_ = threadIdx.x; asm volatile("" : "+v"(tid_));
    const int tid = tid_, lane = tid & 63, wid = __builtin_amdgcn_readfirstlane(tid >> 6), r32 = lane & 31, hi = lane >> 5;
    const int vcu = (G % 8 == 0) ? (bid % 8) * (G / 8) + bid / 8 : bid;
    LAS unsigned char* Kbuf = lds; LAS unsigned char* Vbuf = lds + OFF_V; LAS int* misc = (LAS int*)(lds + OFF_MISC);
    const int ld_row = tid >> 3, ld_ch = tid & 7;
    const int kst = ld_row * 128 + ((ld_ch ^ ((ld_row >> 1) & 7)) << 4), vst = ld_row * VROW + ld_ch * 16;
    for (int uidx = vcu; uidx < 512; uidx += G) {
        const int bh = (uidx & 255) >> 4, s_ = uidx & 15, qb = uidx < 256 ? s_ : 31 - s_, b = bh >> 3, h = bh & 7;
        const int q_off = wid * 32 + r32; const size_t qrow = (size_t)b * SEQ + qb * 256 + q_off;
        bf16x8 qr[4];
#pragma unroll
        for (int s = 0; s < 4; ++s) qr[s] = *(const bf16x8*)(Q + qrow * 512 + h * 64 + 16 * s + 8 * hi);
        unsigned selmask = 0u;
        { int s0 = -1, s1 = -1, s2 = -1; float g0 = -INFINITY, g1 = -INFINITY, g2 = -INFINITY;
          const float* ksb = ksum + (size_t)(b * NH + h) * NBLK * HD + 8 * hi;
          for (int j = 0; j < qb; ++j) { float part = 0.f;
#pragma unroll
              for (int s = 0; s < 4; ++s) { const f32x4 k0 = *(const f32x4*)(ksb + j * HD + 16 * s), k1 = *(const f32x4*)(ksb + j * HD + 16 * s + 4);
                  part += bfe(qr[s], 0) * k0[0] + bfe(qr[s], 1) * k0[1] + bfe(qr[s], 2) * k0[2] + bfe(qr[s], 3) * k0[3] + bfe(qr[s], 4) * k1[0] + bfe(qr[s], 5) * k1[1] + bfe(qr[s], 6) * k1[2] + bfe(qr[s], 7) * k1[3]; }
              const float g = part + __shfl_xor(part, 32);
              if (g > g0) { g2 = g1; s2 = s1; g1 = g0; s1 = s0; g0 = g; s0 = j; } else if (g > g1) { g2 = g1; s2 = s1; g1 = g; s1 = j; } else if (g > g2) { g2 = g; s2 = j; } }
          if (s0 >= 0) selmask |= 1u << s0; if (s1 >= 0) selmask |= 1u << s1; if (s2 >= 0) selmask |= 1u << s2; }
        { unsigned um = selmask;
#pragma unroll
          for (int o = 1; o < 64; o <<= 1) um |= (unsigned)__shfl_xor((int)um, o);
          if (lane == 0) misc[wid] = (int)um; }
        __syncthreads();
        if (tid == 0) { unsigned uni = 0u; for (int w = 0; w < 8; ++w) uni |= (unsigned)misc[w]; int nb = 1; misc[16] = qb; while (uni) { misc[16 + nb] = __builtin_ctz(uni); uni &= uni - 1u; ++nb; } misc[8] = nb; }
        __syncthreads();
        const int ntiles = misc[8] * 4;
        const bf16* Kg = Kb + ((size_t)b * SEQ) * 512 + h * 64 + ld_ch * 8; const bf16* Vg = V + ((size_t)b * SEQ) * 512 + h * 64 + ld_ch * 8;
        u32x4 kreg, vreg;
        { const int jb0 = misc[16]; const size_t ro = (size_t)(jb0 * 256 + ld_row) * 512; kreg = *(const u32x4*)(Kg + ro); vreg = *(const u32x4*)(Vg + ro); }
        *(LAS u32x4*)(Kbuf + kst) = kreg; *(LAS u32x4*)(Vbuf + vst) = vreg;
        __syncthreads();
        float mrun = -INFINITY, lsum = 0.f; f32x16 o0 = {}, o1 = {};
        for (int n = 0; n < ntiles; ++n) {
            const int jb = misc[16 + (n >> 2)], tt = n & 3; const bool own = n < 4;
            if (n + 1 < ntiles) { const int jn = misc[16 + ((n + 1) >> 2)]; const size_t ro = (size_t)(jn * 256 + ((n + 1) & 3) * 64 + ld_row) * 512; kreg = *(const u32x4*)(Kg + ro); vreg = *(const u32x4*)(Vg + ro); }
            const bool lane_valid = own || ((selmask >> jb) & 1u);
            const bool need = own ? (64 * tt <= 32 * wid + 31) : (__any(lane_valid ? 1 : 0) != 0);
            if (need) {
                const LAS unsigned char* kb_ = Kbuf + (n & 1) * KB_BYTES; const LAS unsigned char* vb_ = Vbuf + (n & 1) * VB_BYTES;
                f32x16 p0 = {}, p1 = {};
#pragma unroll
                for (int s = 0; s < 4; ++s) { const int c = 2 * s + hi; const int sw = ((c ^ ((r32 >> 1) & 7)) << 4);
                    const bf16x8 a0 = *(const LAS bf16x8*)(kb_ + r32 * 128 + sw), a1 = *(const LAS bf16x8*)(kb_ + (32 + r32) * 128 + sw);
                    p0 = __builtin_amdgcn_mfma_f32_32x32x16_bf16(a0, qr[s], p0, 0, 0, 0); p1 = __builtin_amdgcn_mfma_f32_32x32x16_bf16(a1, qr[s], p1, 0, 0, 0); }
                if (own) {
#pragma unroll
                    for (int r = 0; r < 16; ++r) { const int ko = tt * 64 + crow(r, hi); if (ko > q_off) p0[r] = -INFINITY; if (ko + 32 > q_off) p1[r] = -INFINITY; }
                } else if (!lane_valid) {
#pragma unroll
                    for (int r = 0; r < 16; ++r) { p0[r] = -INFINITY; p1[r] = -INFINITY; }
                }
                float mt = fmaxf(p0[0], p1[0]);
#pragma unroll
                for (int r = 1; r < 16; ++r) mt = fmaxf(mt, fmaxf(p0[r], p1[r]));
                mt = fmaxf(mt, __shfl_xor(mt, 32));
                const float mnew = fmaxf(mrun, mt), alpha = __builtin_amdgcn_exp2f(mrun - mnew); mrun = mnew;
                float ps = 0.f;
#pragma unroll
                for (int r = 0; r < 16; ++r) { p0[r] = __builtin_amdgcn_exp2f(p0[r] - mnew); p1[r] = __builtin_amdgcn_exp2f(p1[r] - mnew); ps += p0[r] + p1[r]; }
                lsum = lsum * alpha + ps;
                if (!__all(alpha == 1.f ? 1 : 0)) {
#pragma unroll
                    for (int r = 0; r < 16; ++r) { o0[r] *= alpha; o1[r] *= alpha; } }
                bf16x8 pb[2][2];
#pragma unroll
                for (int s2 = 0; s2 < 2; ++s2) { u32x4 w0, w1;
                    w0.x = cvt_pk_bf16(p0[8 * s2], p0[8 * s2 + 1]); w0.y = cvt_pk_bf16(p0[8 * s2 + 2], p0[8 * s2 + 3]); w0.z = cvt_pk_bf16(p0[8 * s2 + 4], p0[8 * s2 + 5]); w0.w = cvt_pk_bf16(p0[8 * s2 + 6], p0[8 * s2 + 7]);
                    w1.x = cvt_pk_bf16(p1[8 * s2], p1[8 * s2 + 1]); w1.y = cvt_pk_bf16(p1[8 * s2 + 2], p1[8 * s2 + 3]); w1.z = cvt_pk_bf16(p1[8 * s2 + 4], p1[8 * s2 + 5]); w1.w = cvt_pk_bf16(p1[8 * s2 + 6], p1[8 * s2 + 7]);
                    pb[0][s2] = __builtin_bit_cast(bf16x8, w0); pb[1][s2] = __builtin_bit_cast(bf16x8, w1); }
                const LAS unsigned char* vl = vb_ + (4 * hi + ((lane & 15) >> 2)) * VROW + (16 * ((lane >> 4) & 1) + 4 * (lane & 3)) * 2;
#pragma unroll
                for (int dt = 0; dt < 2; ++dt)
#pragma unroll
                    for (int u = 0; u < 2; ++u)
#pragma unroll
                        for (int s2 = 0; s2 < 2; ++s2) { const LAS unsigned char* va = vl + (32 * u + 16 * s2) * VROW + dt * 64;
                            const v4i16_t lo = __builtin_amdgcn_ds_read_tr16_b64_v4i16((LAS v4i16_t*)va), hh = __builtin_amdgcn_ds_read_tr16_b64_v4i16((LAS v4i16_t*)(va + 8 * VROW));
                            const bf16x8 vf = {lo[0], lo[1], lo[2], lo[3], hh[0], hh[1], hh[2], hh[3]};
                            if (dt == 0) o0 = __builtin_amdgcn_mfma_f32_32x32x16_bf16(vf, pb[u][s2], o0, 0, 0, 0); else o1 = __builtin_amdgcn_mfma_f32_32x32x16_bf16(vf, pb[u][s2], o1, 0, 0, 0); }
            }
            if (n + 1 < ntiles) { *(LAS u32x4*)(Kbuf + ((n + 1) & 1) * KB_BYTES + kst) = kreg; *(LAS u32x4*)(Vbuf + ((n + 1) & 1) * VB_BYTES + vst) = vreg; }
            __syncthreads();
        }
        const float inv = 1.f / (lsum + __shfl_xor(lsum, 32));
        bf16* orow = ATT + qrow * 512 + h * 64 + 4 * hi;
#pragma unroll
        for (int g4 = 0; g4 < 4; ++g4) { u32x2 w;
            w.x = cvt_pk_bf16(o0[4 * g4] * inv, o0[4 * g4 + 1] * inv); w.y = cvt_pk_bf16(o0[4 * g4 + 2] * inv, o0[4 * g4 + 3] * inv); *(u32x2*)(orow + 8 * g4) = w;
            w.x = cvt_pk_bf16(o1[4 * g4] * inv, o1[4 * g4 + 1] * inv); w.y = cvt_pk_bf16(o1[4 * g4 + 2] * inv, o1[4 * g4 + 3] * inv); *(u32x2*)(orow + 32 + 8 * g4) = w; }
    }
}
}

__device__ __forceinline__ float dot2bf(unsigned a, unsigned b, float acc) { return __builtin_amdgcn_fdot2_f32_bf16(__builtin_bit_cast(bf16x2_t, a), __builtin_bit_cast(bf16x2_t, b), acc, false); }
__device__ __forceinline__ void d_tab_bf16(const float* T, bf16* O) {
    GSTRIDE(i, (size_t)NEXP * D / 8) { const f32x4 a = ((const f32x4*)T)[2 * i], b = ((const f32x4*)T)[2 * i + 1]; u32x4 w;
        w.x = cvt_pk_bf16(a[0], a[1]); w.y = cvt_pk_bf16(a[2], a[3]); w.z = cvt_pk_bf16(b[0], b[1]); w.w = cvt_pk_bf16(b[2], b[3]); ((u32x4*)O)[i] = w; }
}
__device__ __forceinline__ void peer_phase(const bf16* H2, const int* EID, const float* EG, const bf16* UT, const bf16* VT, const float* mod, const float* gfin, const float* x1, float* outp) {
    int tid_ = threadIdx.x; asm volatile("" : "+v"(tid_));
    const int lane = tid_ & 63, wv = tid_ >> 6;
    for (int t = blockIdx.x * (NT / 64) + wv; t < M; t += gridDim.x * (NT / 64)) {
        const int b = t / SEQ;
        const u32x4 h0 = *(const u32x4*)(H2 + (size_t)t * D + 8 * lane), h1 = *(const u32x4*)(H2 + (size_t)t * D + 512 + 8 * lane);
        const int e0 = EID[(size_t)t * NSEL + lane], e1 = EID[(size_t)t * NSEL + 64 + lane]; const float gg0 = EG[(size_t)t * NSEL + lane], gg1 = EG[(size_t)t * NSEL + 64 + lane];
        float acc[16];
#pragma unroll
        for (int i = 0; i < 16; ++i) acc[i] = 0.f;
#pragma unroll 1
        for (int kb = 0; kb < NSEL; kb += 8) {
            u32x4 ua[8], ub[8], va[8], vb[8];
#pragma unroll
            for (int j = 0; j < 8; ++j) { const int k = kb + j; const int eid = __builtin_amdgcn_readlane(k < 64 ? e0 : e1, k & 63);
                const bf16* ur = UT + (size_t)eid * D + 8 * lane; const bf16* vr = VT + (size_t)eid * D + 8 * lane;
                ua[j] = *(const u32x4*)ur; ub[j] = *(const u32x4*)(ur + 512); va[j] = *(const u32x4*)vr; vb[j] = *(const u32x4*)(vr + 512); }
            float d[8];
#pragma unroll
            for (int j = 0; j < 8; ++j) { float a = 0.f; a = dot2bf(ua[j].x, h0.x, a); a = dot2bf(ua[j].y, h0.y, a); a = dot2bf(ua[j].z, h0.z, a); a = dot2bf(ua[j].w, h0.w, a);
                a = dot2bf(ub[j].x, h1.x, a); a = dot2bf(ub[j].y, h1.y, a); a = dot2bf(ub[j].z, h1.z, a); a = dot2bf(ub[j].w, h1.w, a); d[j] = a; }
            float r4[4], r2[2], r1;
            { const bool up = (lane & 32) != 0;
#pragma unroll
              for (int j = 0; j < 4; ++j) { const float snd = up ? d[j] : d[j + 4], kp = up ? d[j + 4] : d[j]; r4[j] = kp + __shfl_xor(snd, 32); } }
            { const bool up = (lane & 16) != 0;
#pragma unroll
              for (int j = 0; j < 2; ++j) { const float snd = up ? r4[j] : r4[j + 2], kp = up ? r4[j + 2] : r4[j]; r2[j] = kp + __shfl_xor(snd, 16); } }
            { const bool up = (lane & 8) != 0; const float snd = up ? r2[0] : r2[1], kp = up ? r2[1] : r2[0]; r1 = kp + __shfl_xor(snd, 8); }
            r1 += __shfl_xor(r1, 4); r1 += __shfl_xor(r1, 2); r1 += __shfl_xor(r1, 1);
            const float ge = 0.5f * r1 * (1.f + erff(r1 * 0.70710678118654752f));
#pragma unroll
            for (int j = 0; j < 8; ++j) { const int k = kb + j; const float gk = __uint_as_float(__builtin_amdgcn_readlane(__float_as_uint(k < 64 ? gg0 : gg1), k & 63));
                const float w = gk * __uint_as_float(__builtin_amdgcn_readlane(__float_as_uint(ge), ((j & 4) ? 32 : 0) + ((j & 2) ? 16 : 0) + ((j & 1) ? 8 : 0)));
                acc[0] += w * bflo(va[j].x); acc[1] += w * bfhi(va[j].x); acc[2] += w * bflo(va[j].y); acc[3] += w * bfhi(va[j].y); acc[4] += w * bflo(va[j].z); acc[5] += w * bfhi(va[j].z); acc[6] += w * bflo(va[j].w); acc[7] += w * bfhi(va[j].w);
                acc[8] += w * bflo(vb[j].x); acc[9] += w * bfhi(vb[j].x); acc[10] += w * bflo(vb[j].y); acc[11] += w * bfhi(vb[j].y); acc[12] += w * bflo(vb[j].z); acc[13] += w * bfhi(vb[j].z); acc[14] += w * bflo(vb[j].w); acc[15] += w * bfhi(vb[j].w); }
        }
        float ss = 0.f;
#pragma unroll
        for (int c = 0; c < 2; ++c)
#pragma unroll
            for (int q4 = 0; q4 < 2; ++q4) { const int col = c * 512 + 8 * lane + 4 * q4; const f32x4 xv = *(const f32x4*)(x1 + (size_t)t * D + col), gv = *(const f32x4*)(mod + b * 6144 + 5 * D + col);
#pragma unroll
                for (int e = 0; e < 4; ++e) { const float x2 = xv[e] + gv[e] * acc[c * 8 + q4 * 4 + e]; acc[c * 8 + q4 * 4 + e] = x2; ss += x2 * x2; } }
#pragma unroll
        for (int o = 1; o < 64; o <<= 1) ss += __shfl_xor(ss, o);
        const float r = rsqrtf(ss * (1.f / D) + EPS);
#pragma unroll
        for (int c = 0; c < 2; ++c)
#pragma unroll
            for (int q4 = 0; q4 < 2; ++q4) { const int col = c * 512 + 8 * lane + 4 * q4; const f32x4 gf = *(const f32x4*)(gfin + col); f32x4 o;
#pragma unroll
                for (int e = 0; e < 4; ++e) o[e] = acc[c * 8 + q4 * 4 + e] * r * gf[e];
                *(f32x4*)(outp + (size_t)t * D + col) = o; }
    }
}

__device__ __forceinline__ void d_skbd(const float* sk, bf16* SKBD) {
    GSTRIDE(idx, 2048 * 256) { const int n = (int)idx >> 8, kk = (int)idx & 255, p = (n >> 7) & 1; SKBD[idx] = ((kk >> 7) == p) ? f2bf(sk[(size_t)n * 128 + (kk & 127)]) : (bf16)0; }
}
__device__ __forceinline__ unsigned f2sort(float f) { const unsigned b = __float_as_uint(f); return b ^ ((unsigned)((int)b >> 31) | 0x80000000u); }
__device__ __forceinline__ float sort2f(unsigned k) { return __uint_as_float(k ^ (((k >> 31) - 1u) | 0x80000000u)); }
struct EpiRoute {
    static constexpr bool PERM = false, AFTER_DRAIN = true;
    int* EID; float* EG;
    __device__ __forceinline__ void fused(f32x4 (&acc)[2][2][4][2], const pg8::Unit& u, int wr, int wc, int fr_, int fq_, LAS unsigned char* lds, int wid, int lane_) const {
        int lane = lane_; asm volatile("" : "+v"(lane));
        const int fr = lane & 15, fq = lane >> 4;
        constexpr int RS = 257; LAS float* S = (LAS float*)lds; LAS unsigned char* tab = lds + 128 * RS * 4 + ((wid & 3) * 64 + lane) * 32;
#pragma unroll
        for (int ai = 0; ai < 2; ++ai) {
#pragma unroll
            for (int bj = 0; bj < 2; ++bj)
#pragma unroll
                for (int m = 0; m < 4; ++m)
#pragma unroll
                    for (int n = 0; n < 2; ++n) { LAS float* sp = S + (64 * wr + 16 * m + fr) * RS + 128 * bj + 32 * wc + 16 * n + 4 * fq; const f32x4 v = acc[ai][bj][m][n]; sp[0] = v[0]; sp[1] = v[1]; sp[2] = v[2]; sp[3] = v[3]; }
            __syncthreads();
            if (wid < 4) {
                const int rl = 32 * wid + (lane & 31), p = lane >> 5; const LAS float* sp = S + rl * RS + 128 * p;
                unsigned top[16];
#pragma unroll
                for (int j = 0; j < 16; ++j) top[j] = 0u;
#pragma unroll 8
                for (int n = 0; n < 128; ++n) { unsigned key = (f2sort(sp[n]) & ~0x7Fu) | (unsigned)n;
#pragma unroll
                    for (int j = 0; j < 16; ++j) { const unsigned hi_ = max(top[j], key); key = min(top[j], key); top[j] = hi_; } }
                float af[16], bf_[16]; unsigned ia[4] = {0u, 0u, 0u, 0u}, ib[4] = {0u, 0u, 0u, 0u};
#pragma unroll
                for (int j = 0; j < 16; ++j) { const unsigned oth = (unsigned)__shfl_xor((int)top[j], 32); const unsigned ka = p ? oth : top[j], kb = p ? top[j] : oth;
                    af[j] = sort2f(ka & ~0x7Fu); bf_[j] = sort2f(kb & ~0x7Fu); ia[j >> 2] |= (ka & 0x7Fu) << (8 * (j & 3)); ib[j >> 2] |= (kb & 0x7Fu) << (8 * (j & 3)); }
                *(LAS u32x4*)tab = (u32x4){ia[0], ia[1], ia[2], ia[3]}; *(LAS u32x4*)(tab + 16) = (u32x4){ib[0], ib[1], ib[2], ib[3]};
                unsigned ct[16];
#pragma unroll
                for (int j = 0; j < 16; ++j) ct[j] = 0u;
#pragma unroll
                for (int i = 0; i < 16; ++i)
#pragma unroll
                    for (int j2 = 0; j2 < 16; ++j2) if ((i + 1) * (j2 + 1) <= 16) { unsigned key = (f2sort(af[i] + bf_[j2]) & ~0xFFu) | (unsigned)(i * 16 + j2);
#pragma unroll
                        for (int j = 0; j < 16; ++j) { const unsigned hi_ = max(ct[j], key); key = min(ct[j], key); ct[j] = hi_; } }
                asm volatile("s_waitcnt lgkmcnt(0)" ::: "memory");
                int eid[16]; float ev[16]; float sum = 0.f; const float v0 = sort2f(ct[0] & ~0xFFu);
#pragma unroll
                for (int k = 0; k < 16; ++k) { const unsigned code = ct[k] & 0xFFu; const int i_a = tab[code >> 4], i_b = tab[16 + (code & 15u)]; eid[k] = i_a * NKEYS + i_b;
                    ev[k] = __builtin_amdgcn_exp2f((sort2f(ct[k] & ~0xFFu) - v0) * 1.4426950408889634f); sum += ev[k]; }
                const float is = 1.f / sum; const size_t ob = (size_t)(u.pm * 256 + 128 * ai + rl) * NSEL + u.pn * 16 + 8 * p;
                u32x4 e0, e1; f32x4 g0, g1;
                e0.x = p ? eid[8] : eid[0]; e0.y = p ? eid[9] : eid[1]; e0.z = p ? eid[10] : eid[2]; e0.w = p ? eid[11] : eid[3]; e1.x = p ? eid[12] : eid[4]; e1.y = p ? eid[13] : eid[5]; e1.z = p ? eid[14] : eid[6]; e1.w = p ? eid[15] : eid[7];
                g0[0] = (p ? ev[8] : ev[0]) * is; g0[1] = (p ? ev[9] : ev[1]) * is; g0[2] = (p ? ev[10] : ev[2]) * is; g0[3] = (p ? ev[11] : ev[3]) * is; g1[0] = (p ? ev[12] : ev[4]) * is; g1[1] = (p ? ev[13] : ev[5]) * is; g1[2] = (p ? ev[14] : ev[6]) * is; g1[3] = (p ? ev[15] : ev[7]) * is;
                *(u32x4*)(EID + ob) = e0; *(u32x4*)(EID + ob + 4) = e1; *(f32x4*)(EG + ob) = g0; *(f32x4*)(EG + ob + 4) = g1;
            }
            __syncthreads();
        }
    }
};
__device__ __forceinline__ void route_phase(LAS unsigned char* lds, const bf16* QP, const bf16* SKBD, int* EID, float* EG, int G, int bid) {
    pg8::Gemm g{QP, SKBD, M, 2048, 256, 2048, 256}; pg8::StaticOrder S; S.init(M, 2048, G, bid); EpiRoute E{EID, EG}; pg8::OneUnit O;
    for (int i = 0; S.next(i, O.u); ++i) pg8::gemm_phase<EpiRoute, pg8::OneUnit, false>(lds, g, O, E);
}
__device__ __forceinline__ void d_route_summary(const int* EID, const float* EG, float* SUMM) {
    GSTRIDE(idx, M * PHEADS) { float s1 = 0.f, s2 = 0.f; for (int k = 0; k < 16; ++k) { const int e = EID[idx * 16 + k]; const float gk = EG[idx * 16 + k]; s1 += gk * (float)(e % 1021) * (1.f / 1021.f); s2 += gk * (float)e * (1.f / 16384.f); } SUMM[idx * 2] = s1; SUMM[idx * 2 + 1] = s2; }
}

constexpr int MOD_KS = 16;
__device__ __forceinline__ void p0_mod_partials(const float* c, const float* w_ada, float* MODP) {
    const int lane = threadIdx.x & 63, gw = blockIdx.x * (NT / 64) + (threadIdx.x >> 6), ngw = gridDim.x * (NT / 64);
    for (int it = gw; it < 96 * MOD_KS; it += ngw) {
        const int cg_ = it % 96, ks = it / 96, j = cg_ * 64 + lane, k0 = ks * 64;
        const float c0 = c[k0 + lane], c1 = c[D + k0 + lane]; const float a0 = c0 / (1.f + __expf(-c0)), a1 = c1 / (1.f + __expf(-c1));
        float acc0 = 0.f, acc1 = 0.f;
#pragma unroll 16
        for (int k = 0; k < 64; ++k) { const float w = w_ada[(size_t)(k0 + k) * 6144 + j];
            acc0 += __uint_as_float(__builtin_amdgcn_readlane(__float_as_uint(a0), k)) * w; acc1 += __uint_as_float(__builtin_amdgcn_readlane(__float_as_uint(a1), k)) * w; }
        MODP[(size_t)(ks * 2) * 6144 + j] = acc0; MODP[(size_t)(ks * 2 + 1) * 6144 + j] = acc1;
    }
}
__device__ __forceinline__ float mod_reduce(const float* MODP, const float* b_ada, int idx) {
    float s = b_ada[idx % 6144];
#pragma unroll
    for (int ks = 0; ks < MOD_KS; ++ks) s += MODP[(size_t)ks * 2 * 6144 + idx];
    return s;
}
__device__ __forceinline__ void p0_transpose_item(const float* W, int K, int N, bf16* WT, LAS float* scr, int item, int lane) {
    const int nblk = N / 32, kb = item / nblk, nb = item % nblk, k0 = 64 * kb, n0 = 32 * nb;
#pragma unroll 8
    for (int i = 0; i < 32; ++i) { const int kk = 2 * i + (lane >> 5); scr[kk * 33 + (lane & 31)] = W[(size_t)(k0 + kk) * N + n0 + (lane & 31)]; }
    asm volatile("s_waitcnt lgkmcnt(0)" ::: "memory");
    const int cch = lane & 7;
#pragma unroll
    for (int j = 0; j < 4; ++j) { const int n = (lane >> 3) + 8 * j; const LAS float* sp = scr + (8 * cch) * 33 + n;
        u32x4 o; o.x = cvt_pk_bf16(sp[0 * 33], sp[1 * 33]); o.y = cvt_pk_bf16(sp[2 * 33], sp[3 * 33]); o.z = cvt_pk_bf16(sp[4 * 33], sp[5 * 33]); o.w = cvt_pk_bf16(sp[6 * 33], sp[7 * 33]);
        *(u32x4*)(WT + (size_t)(n0 + n) * K + k0 + 8 * cch) = o; }
    asm volatile("s_waitcnt lgkmcnt(0)" ::: "memory");
}
__device__ __forceinline__ void p0_transposes(LAS unsigned char* lds, const float* w_in, const float* w_ba, const float* w_out, const float* wq, bf16* W_IN_T, bf16* WBA_T, bf16* WOUT_T, bf16* WQ_T) {
    const int lane = threadIdx.x & 63, wv = threadIdx.x >> 6, gw = blockIdx.x * (NT / 64) + wv, ngw = gridDim.x * (NT / 64);
    LAS float* scr = (LAS float*)(lds + wv * 16384);
    constexpr int I_IN = (1024 / 64) * (4096 / 32), I_BA = (512 / 64) * (1024 / 32), I_OUT = (1024 / 64) * (1024 / 32), I_Q = (1024 / 64) * (2048 / 32);
    for (int it = gw; it < I_IN + I_BA + I_OUT + I_Q; it += ngw) { int r = it;
        if (r < I_IN) { p0_transpose_item(w_in, 1024, 4096, W_IN_T, scr, r, lane); continue; } r -= I_IN;
        if (r < I_BA) { p0_transpose_item(w_ba, 512, 1024, WBA_T, scr, r, lane); continue; } r -= I_BA;
        if (r < I_OUT) { p0_transpose_item(w_out, 1024, 1024, WOUT_T, scr, r, lane); continue; } r -= I_OUT;
        p0_transpose_item(wq, 1024, 2048, WQ_T, scr, r, lane); }
}
__device__ __forceinline__ void p0_wc(const float* pool_w, const float* pool_scale, const float* w_bp, float* WCF) {
    const int lane = threadIdx.x & 63, gw = blockIdx.x * (NT / 64) + (threadIdx.x >> 6), ngw = gridDim.x * (NT / 64);
    for (int it = gw; it < 512 * 16; it += ngw) { const int k = it >> 4, o = (it & 15) * 64 + lane, g = k >> 7; float acc = 0.f;
        const float pw0 = pool_w[(size_t)k * 128 + lane] * pool_scale[g * 128 + lane], pw1 = pool_w[(size_t)k * 128 + 64 + lane] * pool_scale[g * 128 + 64 + lane];
#pragma unroll 16
        for (int j = 0; j < 64; ++j) acc += __uint_as_float(__builtin_amdgcn_readlane(__float_as_uint(pw0), j)) * w_bp[(size_t)(g * 128 + j) * 1024 + o];
#pragma unroll 16
        for (int j = 0; j < 64; ++j) acc += __uint_as_float(__builtin_amdgcn_readlane(__float_as_uint(pw1), j)) * w_bp[(size_t)(g * 128 + 64 + j) * 1024 + o];
        WCF[(size_t)k * 1024 + o] = acc; }
}
__device__ __forceinline__ void p1_wc_transpose(LAS unsigned char* lds, const float* WCF, bf16* WC_T) {
    const int lane = threadIdx.x & 63, wv = threadIdx.x >> 6, gw = blockIdx.x * (NT / 64) + wv, ngw = gridDim.x * (NT / 64);
    LAS float* scr = (LAS float*)(lds + wv * 16384);
    for (int it = gw; it < (512 / 64) * (1024 / 32); it += ngw) p0_transpose_item(WCF, 512, 1024, WC_T, scr, it, lane);
}
__device__ __forceinline__ void modulate_rows(const float* x, const float* g, const LAS float* mtab, bf16* outp) {
    const int lane = threadIdx.x & 63;
    for (int row = blockIdx.x * (NT / 64) + (threadIdx.x >> 6); row < M; row += gridDim.x * (NT / 64)) {
        const int b = row / SEQ; const f32x4* xr = (const f32x4*)(x + (size_t)row * D); f32x4 v[4]; float ss = 0.f;
#pragma unroll
        for (int j = 0; j < 4; ++j) { v[j] = xr[j * 64 + lane]; ss += v[j][0] * v[j][0] + v[j][1] * v[j][1] + v[j][2] * v[j][2] + v[j][3] * v[j][3]; }
#pragma unroll
        for (int o = 1; o < 64; o <<= 1) ss += __shfl_xor(ss, o);
        const float r = rsqrtf(ss * (1.f / D) + EPS);
#pragma unroll
        for (int j = 0; j < 4; ++j) { const int col = j * 256 + lane * 4; const f32x4 gv = *(const f32x4*)(g + col), sc = *(const LAS f32x4*)(mtab + b * 2048 + col), sh = *(const LAS f32x4*)(mtab + b * 2048 + 1024 + col);
            const f32x4 o = v[j] * r * gv * (sc + 1.f) + sh; u32x2 w; w.x = cvt_pk_bf16(o[0], o[1]); w.y = cvt_pk_bf16(o[2], o[3]); *(u32x2*)(outp + (size_t)row * D + col) = w; }
    }
}
__device__ __forceinline__ void fill_mtab_partials(LAS float* mtab, const float* MODP, const float* b_ada, int sh_off, int sc_off) {
    for (int i = threadIdx.x; i < 4096; i += NT) { const int b = i >> 11, which = (i >> 10) & 1, col = i & 1023; mtab[i] = mod_reduce(MODP, b_ada, b * 6144 + (which ? sh_off : sc_off) + col); }
    __syncthreads();
}
__device__ __forceinline__ void fill_mtab(LAS float* mtab, const float* MOD, int sh_off, int sc_off) {
    for (int i = threadIdx.x; i < 4096; i += NT) { const int b = i >> 11, which = (i >> 10) & 1, col = i & 1023; mtab[i] = MOD[b * 6144 + (which ? sh_off : sc_off) + col]; }
    __syncthreads();
}
__device__ __forceinline__ void pooldiff_fast(const bf16* UP, bf16* DIFF) {
    GSTRIDE(idx, (size_t)M * 64) { const int ch = (int)(idx & 63), row = (int)(idx >> 6), pos = row % SEQ, w = 2 << (ch >> 4), cnt = pos + 1 < w ? pos + 1 : w; float sacc[8];
#pragma unroll
        for (int e = 0; e < 8; ++e) sacc[e] = 0.f;
        u32x4 own;
        for (int i = 0; i < cnt; ++i) { const u32x4 v = *(const u32x4*)(UP + (size_t)(row - i) * 512 + ch * 8); if (i == 0) own = v;
            sacc[0] += bflo(v.x); sacc[1] += bfhi(v.x); sacc[2] += bflo(v.y); sacc[3] += bfhi(v.y); sacc[4] += bflo(v.z); sacc[5] += bfhi(v.z); sacc[6] += bflo(v.w); sacc[7] += bfhi(v.w); }
        const float ic = 1.f / (float)cnt; u32x4 o;
        o.x = cvt_pk_bf16(sacc[0] * ic - bflo(own.x), sacc[1] * ic - bfhi(own.x)); o.y = cvt_pk_bf16(sacc[2] * ic - bflo(own.y), sacc[3] * ic - bfhi(own.y));
        o.z = cvt_pk_bf16(sacc[4] * ic - bflo(own.z), sacc[5] * ic - bfhi(own.z)); o.w = cvt_pk_bf16(sacc[6] * ic - bflo(own.w), sacc[7] * ic - bfhi(own.w));
        *(u32x4*)(DIFF + (size_t)row * 512 + ch * 8) = o; }
}

#define XB_TMO      128
#define XB_XCNT(j)  (256  + 64 * (j))
#define XB_XSUB(j)  (1280 + 64 * (j))
#define XB_XGEN(j)  (2304 + 64 * (j))
#define XB_TOP      3328
#define XB_TOPGEN   3392
#define XCD_BAR_WORDS 3456
#define XB_SPIN_CAP (1u << 18)
__device__ __forceinline__ unsigned xb_ld(unsigned* p)              { return __hip_atomic_load(p, __ATOMIC_RELAXED, __HIP_MEMORY_SCOPE_AGENT); }
__device__ __forceinline__ unsigned xb_add(unsigned* p, unsigned v) { return __hip_atomic_fetch_add(p, v, __ATOMIC_RELAXED, __HIP_MEMORY_SCOPE_AGENT); }
__device__ __forceinline__ unsigned xb_xcc_id() { return (unsigned)__builtin_amdgcn_s_getreg((3 << 11) | 20) & 0xFu; }
#define XB_SPIN(cond, bar) do { unsigned _sp = 0; while (cond) { __builtin_amdgcn_s_sleep(1); \
    if ((++_sp & 255u) == 0u) { if (xb_ld(&(bar)[XB_TMO])) break; if (_sp > XB_SPIN_CAP) { atomicAdd(&(bar)[XB_TMO], 1u); break; } } } } while (0)
struct XcdBarrier { unsigned* bar; unsigned x; volatile LAS unsigned* st; };
__device__ __forceinline__ XcdBarrier xcd_barrier_post(unsigned* bar, volatile LAS unsigned* st) {
    XcdBarrier b; b.bar = bar; b.x = xb_xcc_id(); b.st = st;
    if (threadIdx.x == 0) (void)xb_add(&bar[XB_XCNT(b.x)], 1u);
    return b;
}
__device__ __forceinline__ void xcd_barrier_complete(unsigned* bar, unsigned x, unsigned& nloc, unsigned& nx) {
    const unsigned G = gridDim.x * gridDim.y * gridDim.z;
    unsigned sum, cnt, mine, sp = 0u;
    for (;;) {
        sum = 0u; cnt = 0u; mine = 0u;
#pragma unroll
        for (unsigned j = 0; j < 16; ++j) { const unsigned c = xb_ld(&bar[XB_XCNT(j)]); sum += c; cnt += (c > 0u) ? 1u : 0u; mine = (j == x) ? c : mine; }
        if (sum == G) break;
        __builtin_amdgcn_s_sleep(1);
        if ((++sp & 255u) == 0u) { if (xb_ld(&bar[XB_TMO])) break; if (sp > XB_SPIN_CAP) { atomicAdd(&bar[XB_TMO], 1u); break; } }
    }
    nloc = mine > 0u ? mine : 1u; nx = cnt > 0u ? cnt : 1u;
}
__device__ __forceinline__ void xcd_barrier(const XcdBarrier& b) {
    asm volatile("s_waitcnt vmcnt(0)" ::: "memory");
    __syncthreads();
    if (threadIdx.x == 0) {
        unsigned* bar = b.bar;
        __builtin_amdgcn_s_waitcnt(0);
        unsigned nloc = b.st[0], nx = b.st[1];
        if (nloc == 0u) { xcd_barrier_complete(bar, b.x, nloc, nx); b.st[0] = nloc; b.st[1] = nx; }
        const unsigned old = xb_add(&bar[XB_XSUB(b.x)], 1u);
        const unsigned gen = old / nloc;
        if (old + 1u == (gen + 1u) * nloc) {
            __builtin_amdgcn_fence(__ATOMIC_RELEASE, "agent");
            asm volatile("s_waitcnt vmcnt(0)" ::: "memory");
            const unsigned og = xb_add(&bar[XB_TOP], 1u);
            const unsigned tg = og / nx;
            if (og + 1u == (tg + 1u) * nx) xb_add(&bar[XB_TOPGEN], 1u);
            else XB_SPIN(xb_ld(&bar[XB_TOPGEN]) == tg, bar);
            __builtin_amdgcn_fence(__ATOMIC_ACQUIRE, "agent");
            xb_add(&bar[XB_XGEN(b.x)], 1u);
            asm volatile("s_waitcnt vmcnt(0)" ::: "memory");
        } else {
            XB_SPIN(xb_ld(&bar[XB_XGEN(b.x)]) == gen, bar);
            __builtin_amdgcn_fence(__ATOMIC_ACQUIRE, "agent");
            asm volatile("s_waitcnt vmcnt(0)" ::: "memory");
        }
    }
    __syncthreads();
}

__device__ __forceinline__ void d_tab_fp8(const float* T, unsigned char* O8, float* SC) {
    const int lane = threadIdx.x & 63, gw = blockIdx.x * (NT / 64) + (threadIdx.x >> 6), ngw = gridDim.x * (NT / 64);
    for (int row = gw; row < NEXP; row += ngw) {
        const f32x4* r = (const f32x4*)(T + (size_t)row * D) + 4 * lane; f32x4 v[4]; float am = 0.f;
#pragma unroll
        for (int j = 0; j < 4; ++j) { v[j] = r[j]; am = fmaxf(am, fmaxf(fmaxf(fabsf(v[j][0]), fabsf(v[j][1])), fmaxf(fabsf(v[j][2]), fabsf(v[j][3])))); }
#pragma unroll
        for (int o = 1; o < 64; o <<= 1) am = fmaxf(am, __shfl_xor(am, o));
        int e = 8; if (am > 0.f) (void)frexpf(am, &e);
        const float sc = ldexpf(1.f, 8 - e);
        u32x4 w;
        w.x = (unsigned)__builtin_amdgcn_cvt_pk_fp8_f32(v[0][0] * sc, v[0][1] * sc, 0, false); w.x = (unsigned)__builtin_amdgcn_cvt_pk_fp8_f32(v[0][2] * sc, v[0][3] * sc, (int)w.x, true);
        w.y = (unsigned)__builtin_amdgcn_cvt_pk_fp8_f32(v[1][0] * sc, v[1][1] * sc, 0, false); w.y = (unsigned)__builtin_amdgcn_cvt_pk_fp8_f32(v[1][2] * sc, v[1][3] * sc, (int)w.y, true);
        w.z = (unsigned)__builtin_amdgcn_cvt_pk_fp8_f32(v[2][0] * sc, v[2][1] * sc, 0, false); w.z = (unsigned)__builtin_amdgcn_cvt_pk_fp8_f32(v[2][2] * sc, v[2][3] * sc, (int)w.z, true);
        w.w = (unsigned)__builtin_amdgcn_cvt_pk_fp8_f32(v[3][0] * sc, v[3][1] * sc, 0, false); w.w = (unsigned)__builtin_amdgcn_cvt_pk_fp8_f32(v[3][2] * sc, v[3][3] * sc, (int)w.w, true);
        *(u32x4*)(O8 + (size_t)row * D + 16 * lane) = w;
        if (lane == 0) SC[row] = ldexpf(1.f, e - 8);
    }
}
__device__ __forceinline__ f32x2 fp8lo(unsigned w) { return __builtin_amdgcn_cvt_pk_f32_fp8((int)w, false); }
__device__ __forceinline__ f32x2 fp8hi(unsigned w) { return __builtin_amdgcn_cvt_pk_f32_fp8((int)w, true); }
__device__ __forceinline__ void peer_phase8(const bf16* H2, const int* EID, const float* EG, const unsigned char* U8, const unsigned char* V8, const float* USC, const float* VSC,
                                            const float* mod, const float* gfin, const float* x1, float* outp) {
    int tid_ = threadIdx.x; asm volatile("" : "+v"(tid_));
    const int lane = tid_ & 63, wv = tid_ >> 6;
    for (int t = blockIdx.x * (NT / 64) + wv; t < M; t += gridDim.x * (NT / 64)) {
        const int b = t / SEQ;
        f32x2 hp[8];
        { const u32x4 h0 = *(const u32x4*)(H2 + (size_t)t * D + 16 * lane), h1 = *(const u32x4*)(H2 + (size_t)t * D + 16 * lane + 8);
          hp[0] = (f32x2){bflo(h0.x), bfhi(h0.x)}; hp[1] = (f32x2){bflo(h0.y), bfhi(h0.y)}; hp[2] = (f32x2){bflo(h0.z), bfhi(h0.z)}; hp[3] = (f32x2){bflo(h0.w), bfhi(h0.w)};
          hp[4] = (f32x2){bflo(h1.x), bfhi(h1.x)}; hp[5] = (f32x2){bflo(h1.y), bfhi(h1.y)}; hp[6] = (f32x2){bflo(h1.z), bfhi(h1.z)}; hp[7] = (f32x2){bflo(h1.w), bfhi(h1.w)}; }
        const int e0 = EID[(size_t)t * NSEL + lane], e1 = EID[(size_t)t * NSEL + 64 + lane]; const float gg0 = EG[(size_t)t * NSEL + lane], gg1 = EG[(size_t)t * NSEL + 64 + lane];
        f32x2 acc[8];
#pragma unroll
        for (int i = 0; i < 8; ++i) acc[i] = (f32x2){0.f, 0.f};
#pragma unroll 1
        for (int kb = 0; kb < NSEL; kb += 16) {
            u32x4 uu[16], vv[16]; float us[16], vs[16];
#pragma unroll
            for (int j = 0; j < 16; ++j) { const int k = kb + j; const int eid = __builtin_amdgcn_readlane(k < 64 ? e0 : e1, k & 63);
                uu[j] = *(const u32x4*)(U8 + (size_t)eid * D + 16 * lane); vv[j] = *(const u32x4*)(V8 + (size_t)eid * D + 16 * lane); us[j] = USC[eid]; vs[j] = VSC[eid]; }
            float d[16];
#pragma unroll
            for (int j = 0; j < 16; ++j) { f32x2 a = (f32x2){0.f, 0.f};
                a = __builtin_elementwise_fma(fp8lo(uu[j].x), hp[0], a); a = __builtin_elementwise_fma(fp8hi(uu[j].x), hp[1], a); a = __builtin_elementwise_fma(fp8lo(uu[j].y), hp[2], a); a = __builtin_elementwise_fma(fp8hi(uu[j].y), hp[3], a);
                a = __builtin_elementwise_fma(fp8lo(uu[j].z), hp[4], a); a = __builtin_elementwise_fma(fp8hi(uu[j].z), hp[5], a); a = __builtin_elementwise_fma(fp8lo(uu[j].w), hp[6], a); a = __builtin_elementwise_fma(fp8hi(uu[j].w), hp[7], a);
                d[j] = (a[0] + a[1]) * us[j]; }
            float r8[8], r4[4], r2[2], r1;
            { const bool up = (lane & 32) != 0;
#pragma unroll
              for (int j = 0; j < 8; ++j) { const float snd = up ? d[j] : d[j + 8], kp = up ? d[j + 8] : d[j]; r8[j] = kp + __shfl_xor(snd, 32); } }
            { const bool up = (lane & 16) != 0;
#pragma unroll
              for (int j = 0; j < 4; ++j) { const float snd = up ? r8[j] : r8[j + 4], kp = up ? r8[j + 4] : r8[j]; r4[j] = kp + __shfl_xor(snd, 16); } }
            { const bool up = (lane & 8) != 0;
#pragma unroll
              for (int j = 0; j < 2; ++j) { const float snd = up ? r4[j] : r4[j + 2], kp = up ? r4[j + 2] : r4[j]; r2[j] = kp + __shfl_xor(snd, 8); } }
            { const bool up = (lane & 4) != 0; const float snd = up ? r2[0] : r2[1], kp = up ? r2[1] : r2[0]; r1 = kp + __shfl_xor(snd, 4); }
            r1 += __shfl_xor(r1, 2); r1 += __shfl_xor(r1, 1);
            const float ge = 0.5f * r1 * (1.f + erff(r1 * 0.70710678118654752f));
#pragma unroll
            for (int j = 0; j < 16; ++j) { const int k = kb + j; const float gk = __uint_as_float(__builtin_amdgcn_readlane(__float_as_uint(k < 64 ? gg0 : gg1), k & 63));
                const float w = gk * vs[j] * __uint_as_float(__builtin_amdgcn_readlane(__float_as_uint(ge), ((j & 8) ? 32 : 0) + ((j & 4) ? 16 : 0) + ((j & 2) ? 8 : 0) + ((j & 1) ? 4 : 0))); const f32x2 w2 = (f32x2){w, w};
                acc[0] = __builtin_elementwise_fma(w2, fp8lo(vv[j].x), acc[0]); acc[1] = __builtin_elementwise_fma(w2, fp8hi(vv[j].x), acc[1]); acc[2] = __builtin_elementwise_fma(w2, fp8lo(vv[j].y), acc[2]); acc[3] = __builtin_elementwise_fma(w2, fp8hi(vv[j].y), acc[3]);
                acc[4] = __builtin_elementwise_fma(w2, fp8lo(vv[j].z), acc[4]); acc[5] = __builtin_elementwise_fma(w2, fp8hi(vv[j].z), acc[5]); acc[6] = __builtin_elementwise_fma(w2, fp8lo(vv[j].w), acc[6]); acc[7] = __builtin_elementwise_fma(w2, fp8hi(vv[j].w), acc[7]); }
        }
        float ss = 0.f; f32x4 x2[4];
#pragma unroll
        for (int q4 = 0; q4 < 4; ++q4) { const int col = 16 * lane + 4 * q4; const f32x4 xv = *(const f32x4*)(x1 + (size_t)t * D + col), gv = *(const f32x4*)(mod + b * 6144 + 5 * D + col);
            x2[q4][0] = xv[0] + gv[0] * acc[2 * q4][0]; x2[q4][1] = xv[1] + gv[1] * acc[2 * q4][1]; x2[q4][2] = xv[2] + gv[2] * acc[2 * q4 + 1][0]; x2[q4][3] = xv[3] + gv[3] * acc[2 * q4 + 1][1];
            ss += x2[q4][0] * x2[q4][0] + x2[q4][1] * x2[q4][1] + x2[q4][2] * x2[q4][2] + x2[q4][3] * x2[q4][3]; }
#pragma unroll
        for (int o = 1; o < 64; o <<= 1) ss += __shfl_xor(ss, o);
        const float r = rsqrtf(ss * (1.f / D) + EPS);
#pragma unroll
        for (int q4 = 0; q4 < 4; ++q4) { const int col = 16 * lane + 4 * q4; const f32x4 gf = *(const f32x4*)(gfin + col); *(f32x4*)(outp + (size_t)t * D + col) = x2[q4] * r * gf; }
    }
}

namespace att2 {
__device__ __forceinline__ bool lsum_dummy(int ei) { return ei == 12345; }
using att::f32x16; using att::v4i16_t; using att::crow; using att::bfe;
constexpr int VROW = 192, OFF_V = 32768, OFF_MISC = OFF_V + 256 * VROW;
template <bool CAUSAL>
__device__ __forceinline__ void tile(const LAS unsigned char* Kblk, const LAS unsigned char* Vblk, const bf16x8 (&qr)[4], int tt, int q_off, int lane, int r32, int hi, float& mrun, float& lsum, f32x16& o0, f32x16& o1) {
    const LAS unsigned char* kb_ = Kblk + tt * 64 * 128; const LAS unsigned char* vb_ = Vblk + tt * 64 * VROW;
    f32x16 p0 = {}, p1 = {};
#pragma unroll
    for (int s = 0; s < 4; ++s) { const int c = 2 * s + hi; const int sw = ((c ^ ((r32 >> 1) & 7)) << 4);
        const bf16x8 a0 = *(const LAS bf16x8*)(kb_ + r32 * 128 + sw), a1 = *(const LAS bf16x8*)(kb_ + (32 + r32) * 128 + sw);
        p0 = __builtin_amdgcn_mfma_f32_32x32x16_bf16(a0, qr[s], p0, 0, 0, 0); p1 = __builtin_amdgcn_mfma_f32_32x32x16_bf16(a1, qr[s], p1, 0, 0, 0); }
    if (CAUSAL) {
#pragma unroll
        for (int r = 0; r < 16; ++r) { const int ko = tt * 64 + crow(r, hi); if (ko > q_off) p0[r] = -INFINITY; if (ko + 32 > q_off) p1[r] = -INFINITY; } }
    float mt = fmaxf(p0[0], p1[0]);
#pragma unroll
    for (int r = 1; r < 16; ++r) mt = fmaxf(mt, fmaxf(p0[r], p1[r]));
    mt = fmaxf(mt, __shfl_xor(mt, 32));
    const float mnew = fmaxf(mrun, mt), alpha = __builtin_amdgcn_exp2f(mrun - mnew); mrun = mnew;
    float ps = 0.f;
#pragma unroll
    for (int r = 0; r < 16; ++r) { p0[r] = __builtin_amdgcn_exp2f(p0[r] - mnew); p1[r] = __builtin_amdgcn_exp2f(p1[r] - mnew); ps += p0[r] + p1[r]; }
    lsum = lsum * alpha + ps;
    if (!__all(alpha == 1.f ? 1 : 0)) {
#pragma unroll
        for (int r = 0; r < 16; ++r) { o0[r] *= alpha; o1[r] *= alpha; } }
    bf16x8 pb[2][2];
#pragma unroll
    for (int s2 = 0; s2 < 2; ++s2) { u32x4 w0, w1;
        w0.x = cvt_pk_bf16(p0[8 * s2], p0[8 * s2 + 1]); w0.y = cvt_pk_bf16(p0[8 * s2 + 2], p0[8 * s2 + 3]); w0.z = cvt_pk_bf16(p0[8 * s2 + 4], p0[8 * s2 + 5]); w0.w = cvt_pk_bf16(p0[8 * s2 + 6], p0[8 * s2 + 7]);
        w1.x = cvt_pk_bf16(p1[8 * s2], p1[8 * s2 + 1]); w1.y = cvt_pk_bf16(p1[8 * s2 + 2], p1[8 * s2 + 3]); w1.z = cvt_pk_bf16(p1[8 * s2 + 4], p1[8 * s2 + 5]); w1.w = cvt_pk_bf16(p1[8 * s2 + 6], p1[8 * s2 + 7]);
        pb[0][s2] = __builtin_bit_cast(bf16x8, w0); pb[1][s2] = __builtin_bit_cast(bf16x8, w1); }
    const LAS unsigned char* vl = vb_ + (4 * hi + ((lane & 15) >> 2)) * VROW + (16 * ((lane >> 4) & 1) + 4 * (lane & 3)) * 2;
#pragma unroll
    for (int dt = 0; dt < 2; ++dt)
#pragma unroll
        for (int u = 0; u < 2; ++u)
#pragma unroll
            for (int s2 = 0; s2 < 2; ++s2) { const LAS unsigned char* va = vl + (32 * u + 16 * s2) * VROW + dt * 64;
                const v4i16_t lo = __builtin_amdgcn_ds_read_tr16_b64_v4i16((LAS v4i16_t*)va), hh = __builtin_amdgcn_ds_read_tr16_b64_v4i16((LAS v4i16_t*)(va + 8 * VROW));
                const bf16x8 vf = {lo[0], lo[1], lo[2], lo[3], hh[0], hh[1], hh[2], hh[3]};
                if (dt == 0) o0 = __builtin_amdgcn_mfma_f32_32x32x16_bf16(vf, pb[u][s2], o0, 0, 0, 0); else o1 = __builtin_amdgcn_mfma_f32_32x32x16_bf16(vf, pb[u][s2], o1, 0, 0, 0); }
}
__device__ __forceinline__ void stage_block(LAS unsigned char* lds, const bf16* Kb, const bf16* V, size_t row0, int h, int tid) {
    const int ch = tid & 7;
#pragma unroll
    for (int i = 0; i < 4; ++i) { const int row = (tid >> 3) + 64 * i; const size_t go = (row0 + row) * 512 + h * 64 + ch * 8;
        const u32x4 kv = *(const u32x4*)(Kb + go), vv = *(const u32x4*)(V + go);
        *(LAS u32x4*)(lds + row * 128 + ((ch ^ ((row >> 1) & 7)) << 4)) = kv; *(LAS u32x4*)(lds + OFF_V + row * VROW + ch * 16) = vv; }
}
__device__ __forceinline__ void phase_a(LAS unsigned char* lds, const bf16* Q, const float* ksum, unsigned short* SEL, int* CNT, unsigned short* LIST, int G, int bid) {
    int tid_ = threadIdx.x; asm volatile("" : "+v"(tid_));
    const int tid = tid_, lane = tid & 63, wid = __builtin_amdgcn_readfirstlane(tid >> 6), r32 = lane & 31, hi = lane >> 5;
    LAS int* lc = (LAS int*)lds;
    for (int uidx = bid; uidx < 512; uidx += G) {
        const int bh = uidx >> 5, qb = uidx & 31, b = bh >> 3, h = bh & 7;
        const int q_off = wid * 32 + r32, q = qb * 256 + q_off; const size_t qrow = (size_t)b * SEQ + q;
        if (tid < 64) lc[tid] = 0;
        __syncthreads();
        bf16x8 qr[4];
#pragma unroll
        for (int s = 0; s < 4; ++s) qr[s] = *(const bf16x8*)(Q + qrow * 512 + h * 64 + 16 * s + 8 * hi);
        int s0 = 31, s1 = 31, s2 = 31; float g0 = -INFINITY, g1 = -INFINITY, g2 = -INFINITY;
        const float* ksb = ksum + (size_t)bh * NBLK * HD + 8 * hi;
        for (int j = 0; j < qb; ++j) { float part = 0.f;
#pragma unroll
            for (int s = 0; s < 4; ++s) { const f32x4 k0 = *(const f32x4*)(ksb + j * HD + 16 * s), k1 = *(const f32x4*)(ksb + j * HD + 16 * s + 4);
                part += bfe(qr[s], 0) * k0[0] + bfe(qr[s], 1) * k0[1] + bfe(qr[s], 2) * k0[2] + bfe(qr[s], 3) * k0[3] + bfe(qr[s], 4) * k1[0] + bfe(qr[s], 5) * k1[1] + bfe(qr[s], 6) * k1[2] + bfe(qr[s], 7) * k1[3]; }
            const float g = part + __shfl_xor(part, 32);
            if (g > g0) { g2 = g1; s2 = s1; g1 = g0; s1 = s0; g0 = g; s0 = j; } else if (g > g1) { g2 = g1; s2 = s1; g1 = g; s1 = j; } else if (g > g2) { g2 = g; s2 = j; } }
        int r0 = 0, r1 = 0, r2 = 0;
        if (hi == 0) { if (s0 < 31) r0 = __hip_atomic_fetch_add(lc + s0, 1, __ATOMIC_RELAXED, __HIP_MEMORY_SCOPE_WORKGROUP); if (s1 < 31) r1 = __hip_atomic_fetch_add(lc + s1, 1, __ATOMIC_RELAXED, __HIP_MEMORY_SCOPE_WORKGROUP);
                       if (s2 < 31) r2 = __hip_atomic_fetch_add(lc + s2, 1, __ATOMIC_RELAXED, __HIP_MEMORY_SCOPE_WORKGROUP); }
        __syncthreads();
        if (tid < 32 && lc[tid] > 0) lc[32 + tid] = atomicAdd(CNT + bh * 32 + tid, lc[tid]);
        __syncthreads();
        if (hi == 0) { SEL[(size_t)bh * SEQ + q] = (unsigned short)(s0 | (s1 << 5) | (s2 << 10));
            if (s0 < 31) LIST[((size_t)bh * 32 + s0) * SEQ + lc[32 + s0] + r0] = (unsigned short)q;
            if (s1 < 31) LIST[((size_t)bh * 32 + s1) * SEQ + lc[32 + s1] + r1] = (unsigned short)(q | (1 << 13));
            if (s2 < 31) LIST[((size_t)bh * 32 + s2) * SEQ + lc[32 + s2] + r2] = (unsigned short)(q | (2 << 13)); }
        __syncthreads();
    }
}
__device__ __forceinline__ bf16* part_o(bf16* PO01, bf16* PO2, int slot, size_t bhq) { return (slot < 2 ? PO01 + (size_t)slot * 16 * SEQ * HD : PO2) + bhq * HD; }
template <int MODE>
__device__ __forceinline__ void phase_b(LAS unsigned char* lds, const bf16* Q, const bf16* Kb, const bf16* V, const int* CNT, const unsigned short* LIST, bf16* PO01, bf16* PO2, f32x2* PML, int G, int bid) {
    int tid_ = threadIdx.x; asm volatile("" : "+v"(tid_));
    const int tid = tid_, lane = tid & 63, wid = __builtin_amdgcn_readfirstlane(tid >> 6), r32 = lane & 31, hi = lane >> 5;
    const int vcu = (G % 8 == 0) ? (bid % 8) * (G / 8) + bid / 8 : bid;
    LAS int* misc = (LAS int*)(lds + OFF_MISC);
    if (tid < 16) misc[tid] = 0;
    __syncthreads();
    { const int tr = tid; const int cnt = tr < 16 * 31 ? CNT[(tr % 16) * 32 + tr / 16] : 0, nch = (cnt + 255) >> 8;
      int inc = nch;
#pragma unroll
      for (int o = 1; o < 64; o <<= 1) { const int t = __shfl_up(inc, o); if (lane >= o) inc += t; }
      if (lane == 63) misc[wid] = inc;
      __syncthreads();
      int off = 0; for (int w = 0; w < wid; ++w) off += misc[w];
      const int st = off + inc - nch;
      if (nch > 0) { int k0 = st + ((vcu - st) % G + G) % G;
          for (; k0 < st + nch; k0 += G) { const int slot_ = __hip_atomic_fetch_add(misc + 8, 1, __ATOMIC_RELAXED, __HIP_MEMORY_SCOPE_WORKGROUP); misc[16 + slot_] = (tr << 8) | (k0 - st); } }
      __syncthreads(); }
    const int ni = misc[8];
    const int ch = tid & 7;
    u32x4 kreg[4], vreg[4];
#define ATT2_LOAD_ITEM(idx_) do { const int it_ = misc[16 + (idx_)], tr_ = it_ >> 8, j_ = tr_ / 16, bh_ = tr_ % 16; const size_t row0_ = (size_t)(bh_ >> 3) * SEQ + j_ * 256; \
        _Pragma("unroll") for (int i_ = 0; i_ < 4; ++i_) { const size_t go_ = (row0_ + (tid >> 3) + 64 * i_) * 512 + (bh_ & 7) * 64 + ch * 8; kreg[i_] = *(const u32x4*)(Kb + go_); vreg[i_] = *(const u32x4*)(V + go_); } } while (0)
    if (ni > 0) ATT2_LOAD_ITEM(0);
    for (int ii = 0; ii < ni; ++ii) {
        const int it = misc[16 + ii], tr = it >> 8, c = it & 255, j = tr / 16, bh = tr % 16, b = bh >> 3, h = bh & 7;
        __syncthreads();
#pragma unroll
        for (int i = 0; i < 4; ++i) { const int row = (tid >> 3) + 64 * i; *(LAS u32x4*)(lds + row * 128 + ((ch ^ ((row >> 1) & 7)) << 4)) = kreg[i]; *(LAS u32x4*)(lds + OFF_V + row * VROW + ch * 16) = vreg[i]; }
        __syncthreads();
        if (ii + 1 < ni) ATT2_LOAD_ITEM(ii + 1);
        const int cnt = CNT[bh * 32 + j]; const int n = min(256, cnt - 256 * c);
        if (MODE != 2 && 32 * wid < n) {
            const int ei = 32 * wid + r32; const bool valid = (ei < n) && (MODE != 1 || lsum_dummy(ei));
            const unsigned ent = LIST[((size_t)bh * 32 + j) * SEQ + 256 * c + (ei < n ? ei : 0)]; const int q = ent & 8191, slot = ent >> 13;
            const size_t qrow = (size_t)b * SEQ + q;
            bf16x8 qr[4];
#pragma unroll
            for (int s = 0; s < 4; ++s) qr[s] = *(const bf16x8*)(Q + qrow * 512 + h * 64 + 16 * s + 8 * hi);
            float mrun = -INFINITY, lsum = 0.f; f32x16 o0 = {}, o1 = {};
#pragma unroll 1
            for (int tt = 0; tt < 4; ++tt) tile<false>(lds, lds + OFF_V, qr, tt, 0, lane, r32, hi, mrun, lsum, o0, o1);
            const float lt = lsum + __shfl_xor(lsum, 32), inv = 1.f / lt;
            if (valid) { const size_t bhq = (size_t)bh * SEQ + q; bf16* orow = part_o(PO01, PO2, slot, bhq) + 4 * hi;
                if (hi == 0) PML[bhq * 3 + slot] = (f32x2){mrun, lt};
#pragma unroll
                for (int g4 = 0; g4 < 4; ++g4) { u32x2 w;
                    w.x = cvt_pk_bf16(o0[4 * g4] * inv, o0[4 * g4 + 1] * inv); w.y = cvt_pk_bf16(o0[4 * g4 + 2] * inv, o0[4 * g4 + 3] * inv); *(u32x2*)(orow + 8 * g4) = w;
                    w.x = cvt_pk_bf16(o1[4 * g4] * inv, o1[4 * g4 + 1] * inv); w.y = cvt_pk_bf16(o1[4 * g4 + 2] * inv, o1[4 * g4 + 3] * inv); *(u32x2*)(orow + 32 + 8 * g4) = w; } }
        }
    }
#undef ATT2_LOAD_ITEM
    __syncthreads();
}
__device__ __forceinline__ void phase_c(LAS unsigned char* lds, const bf16* Q, const bf16* Kb, const bf16* V, const unsigned short* SEL, const bf16* PO01, const bf16* PO2, const f32x2* PML, bf16* ATT, int G, int bid) {
    int tid_ = threadIdx.x; asm volatile("" : "+v"(tid_));
    const int tid = tid_, lane = tid & 63, wid = __builtin_amdgcn_readfirstlane(tid >> 6), r32 = lane & 31, hi = lane >> 5;
    for (int uidx = bid; uidx < 512; uidx += G) {
        const int bh = uidx >> 5, qb = uidx & 31, b = bh >> 3, h = bh & 7;
        const int q_off = wid * 32 + r32, q = qb * 256 + q_off; const size_t qrow = (size_t)b * SEQ + q, bhq = (size_t)bh * SEQ + q;
        __syncthreads();
        stage_block(lds, Kb, V, (size_t)b * SEQ + qb * 256, h, tid);
        bf16x8 qr[4];
#pragma unroll
        for (int s = 0; s < 4; ++s) qr[s] = *(const bf16x8*)(Q + qrow * 512 + h * 64 + 16 * s + 8 * hi);
        const unsigned sel = SEL[bhq];
        __syncthreads();
        float mrun = -INFINITY, lsum = 0.f; f32x16 o0 = {}, o1 = {};
        const int ntile = (32 * wid + 31) / 64 + 1;
#pragma unroll 1
        for (int tt = 0; tt < ntile; ++tt) tile<true>(lds, lds + OFF_V, qr, tt, q_off, lane, r32, hi, mrun, lsum, o0, o1);
        float lt = lsum + __shfl_xor(lsum, 32);
#pragma unroll 1
        for (int slot = 0; slot < 3; ++slot) {
            const int sj = (sel >> (5 * slot)) & 31; if (sj == 31) continue;
            const f32x2 ml = PML[bhq * 3 + slot]; const bf16* prow = part_o((bf16*)PO01, (bf16*)PO2, slot, bhq) + 4 * hi;
            const float mstar = fmaxf(mrun, ml[0]), fa = __builtin_amdgcn_exp2f(mrun - mstar), fb = ml[1] * __builtin_amdgcn_exp2f(ml[0] - mstar);
            mrun = mstar; lt = lt * fa + fb;
#pragma unroll
            for (int g4 = 0; g4 < 4; ++g4) { const u32x2 w0 = *(const u32x2*)(prow + 8 * g4), w1 = *(const u32x2*)(prow + 32 + 8 * g4);
                o0[4 * g4] = o0[4 * g4] * fa + fb * bflo(w0.x); o0[4 * g4 + 1] = o0[4 * g4 + 1] * fa + fb * bfhi(w0.x); o0[4 * g4 + 2] = o0[4 * g4 + 2] * fa + fb * bflo(w0.y); o0[4 * g4 + 3] = o0[4 * g4 + 3] * fa + fb * bfhi(w0.y);
                o1[4 * g4] = o1[4 * g4] * fa + fb * bflo(w1.x); o1[4 * g4 + 1] = o1[4 * g4 + 1] * fa + fb * bfhi(w1.x); o1[4 * g4 + 2] = o1[4 * g4 + 2] * fa + fb * bflo(w1.y); o1[4 * g4 + 3] = o1[4 * g4 + 3] * fa + fb * bfhi(w1.y); }
        }
        const float inv = 1.f / lt;
        bf16* orow = ATT + qrow * 512 + h * 64 + 4 * hi;
#pragma unroll
        for (int g4 = 0; g4 < 4; ++g4) { u32x2 w;
            w.x = cvt_pk_bf16(o0[4 * g4] * inv, o0[4 * g4 + 1] * inv); w.y = cvt_pk_bf16(o0[4 * g4 + 2] * inv, o0[4 * g4 + 3] * inv); *(u32x2*)(orow + 8 * g4) = w;
            w.x = cvt_pk_bf16(o1[4 * g4] * inv, o1[4 * g4 + 1] * inv); w.y = cvt_pk_bf16(o1[4 * g4 + 2] * inv, o1[4 * g4 + 3] * inv); *(u32x2*)(orow + 32 + 8 * g4) = w; }
    }
    __syncthreads();
}
}

__device__ __forceinline__ void d_cmp_accum(float num, float den, float* lds, float* acc2) {
#pragma unroll
    for (int o = 1; o < 64; o <<= 1) { num += __shfl_xor(num, o); den += __shfl_xor(den, o); }
    __syncthreads();
    if ((threadIdx.x & 63) == 0) { lds[(threadIdx.x >> 6) * 2] = num; lds[(threadIdx.x >> 6) * 2 + 1] = den; }
    __syncthreads();
    if (threadIdx.x == 0) { float n = 0.f, d = 0.f; for (int w = 0; w < NT / 64; ++w) { n += lds[w * 2]; d += lds[w * 2 + 1]; } atomicAdd(acc2, n); atomicAdd(acc2 + 1, d); }
    __syncthreads();
}
__device__ __forceinline__ void d_cmp_bf16(const bf16* a, const bf16* b, size_t n, float* lds, float* acc2) {
    float num = 0.f, den = 0.f; GSTRIDE(i, n) { const float x = bf2f(a[i]), y = bf2f(b[i]); num += (x - y) * (x - y); den += y * y; } d_cmp_accum(num, den, lds, acc2);
}
__device__ __forceinline__ void d_cmp_f32(const float* a, const float* b, size_t n, float* lds, float* acc2) {
    float num = 0.f, den = 0.f; GSTRIDE(i, n) { const float x = a[i], y = b[i]; num += (x - y) * (x - y); den += y * y; } d_cmp_accum(num, den, lds, acc2);
}

#ifndef DBG
#define DBG 0
#endif
#ifndef PROBE
#define PROBE 0
#endif
#ifndef USE_XCD_BARRIER
#define USE_XCD_BARRIER 1
#endif
#ifndef FAST_PRO
#define FAST_PRO 1
#endif
#ifndef FAST_GEMM
#define FAST_GEMM 1
#endif
#ifndef FAST_ATTN
#define FAST_ATTN 2
#endif
#define ATTN_SORTED(dst_) do { att2::phase_a(lds3, Q, KSUM, (unsigned short*)(ws + WS_SEL), (int*)(ws + WS_CNT), (unsigned short*)(ws + WS_LIST), G, bid); GSYNC(); \
    att2::phase_b<0>(lds3, Q, Kb, V, (const int*)(ws + WS_CNT), (const unsigned short*)(ws + WS_LIST), (bf16*)(ws + WS_PO01), (bf16*)(ws + WS_PO2), (f32x2*)(ws + WS_PML), G, bid); GSYNC(); \
    att2::phase_c(lds3, Q, Kb, V, (const unsigned short*)(ws + WS_SEL), (const bf16*)(ws + WS_PO01), (const bf16*)(ws + WS_PO2), (const f32x2*)(ws + WS_PML), dst_, G, bid); } while (0)
#ifndef FAST_PEER
#define FAST_PEER 1
#endif
#ifndef FAST_ROUTE
#define FAST_ROUTE 1
#endif
#ifndef PEER_FP8
#define PEER_FP8 1
#endif
#if PEER_FP8
#define PEER_CALL(x1_, o_) peer_phase8(H, EID, EG, ws + WS_U8, ws + WS_V8, (const float*)(ws + WS_USC), (const float*)(ws + WS_VSC), MOD, g_fin, x1_, o_)
#else
#define PEER_CALL(x1_, o_) peer_phase(H, EID, EG, (const bf16*)(ws + WS_UT), (const bf16*)(ws + WS_VT), MOD, g_fin, x1_, o_)
#endif
#define USE_FAST_PEER (FAST_PEER && !(DBG & 19))
constexpr int LDS_BYTES = 147456;
__global__ void __launch_bounds__(NT, 2) mega_fwd(Args a) {
    extern __shared__ __attribute__((aligned(16))) unsigned char lds_raw[];
    float* ldsf = (float*)lds_raw; LAS unsigned char* lds3 = (LAS unsigned char*)lds_raw;
    cg::grid_group grid = cg::this_grid();
    const float* x = a.in[0]; const float* c = a.in[1]; const float* w_ada = a.in[2]; const float* b_ada = a.in[3];
    const float* g_mix = a.in[4]; const float* w_in = a.in[5]; const float* pool_w = a.in[6]; const float* pool_scale = a.in[7];
    const float* w_bp = a.in[8]; const float* w_ba = a.in[9]; const float* w_out = a.in[10]; const float* g_ffn = a.in[11];
    const float* wq = a.in[12]; const float* skeys = a.in[13]; const float* Ut = a.in[14]; const float* Vt = a.in[15]; const float* g_fin = a.in[16];
    unsigned char* ws = a.ws; float* out = a.out;
    float* MOD = (float*)(ws + WS_MOD); float* KSUM = (float*)(ws + WS_KSUM); float* ROPE = (float*)(ws + WS_ROPE);
    bf16 *W_IN_T = (bf16*)(ws + WS_W_IN_T), *WC_T = (bf16*)(ws + WS_WC_T), *WBA_T = (bf16*)(ws + WS_WBA_T), *WOUT_T = (bf16*)(ws + WS_WOUT_T), *WQ_T = (bf16*)(ws + WS_WQ_T), *SK = (bf16*)(ws + WS_SK);
    bf16 *H = (bf16*)(ws + WS_H), *DIFF = (bf16*)(ws + WS_DIFF), *ATT = (bf16*)(ws + WS_ATT), *UP = (bf16*)(ws + WS_UP), *Q = (bf16*)(ws + WS_Q), *Kb = (bf16*)(ws + WS_K), *V = (bf16*)(ws + WS_V);
    bf16 *GATES = (bf16*)(ws + WS_GATES), *MERGED = (bf16*)(ws + WS_MERGED), *QP = (bf16*)(ws + WS_QP);
    int* EID = (int*)(ws + WS_EID); float* EG = (float*)(ws + WS_EG);
    const int G = gridDim.x, bid = blockIdx.x;
    { volatile LAS unsigned* st = (volatile LAS unsigned*)(lds3 + LDS_BYTES - 64); if (threadIdx.x < 16) st[threadIdx.x] = 0u; }
    __syncthreads();
    const XcdBarrier xbar = xcd_barrier_post((unsigned*)(ws + WS_BAR), (volatile LAS unsigned*)(lds3 + LDS_BYTES - 64));
#if USE_XCD_BARRIER
#define GSYNC() xcd_barrier(xbar)
#else
#define GSYNC() grid.sync()
#endif
    if (a.ws == nullptr) grid.sync();
#if DBG
    float* DBGW = (float*)(ws + WS_DBG); unsigned char* ALT = ws + WS_ALT;
#endif

    for (int rep_ = 0; rep_ < (PROBE == 5 ? 2 : 1); ++rep_) {
#if FAST_PRO
    p0_mod_partials(c, w_ada, (float*)(ws + WS_MODP));
    p0_transposes(lds3, w_in, w_ba, w_out, wq, W_IN_T, WBA_T, WOUT_T, WQ_T);
    p0_wc(pool_w, pool_scale, w_bp, (float*)(ws + WS_WCF));
#else
    d_mod(c, w_ada, b_ada, MOD);
    d_transpose(w_in, 1024, 4096, W_IN_T); d_transpose(w_ba, 512, 1024, WBA_T); d_transpose(w_out, 1024, 1024, WOUT_T); d_transpose(wq, 1024, 2048, WQ_T);
    d_wc(pool_w, pool_scale, w_bp, WC_T);
#endif
#if (DBG & 4) || !FAST_ROUTE
    d_sk(skeys, SK);
#endif
    d_skbd(skeys, (bf16*)(ws + WS_SKBD)); d_rope(ROPE);
#if USE_FAST_PEER
#if PEER_FP8
    d_tab_fp8(Ut, ws + WS_U8, (float*)(ws + WS_USC)); d_tab_fp8(Vt, ws + WS_V8, (float*)(ws + WS_VSC));
#else
    d_tab_bf16(Ut, (bf16*)(ws + WS_UT)); d_tab_bf16(Vt, (bf16*)(ws + WS_VT));
#endif
#endif
    }
    GSYNC();
#if FAST_PRO
    { const float* MODP = (const float*)(ws + WS_MODP);
      GSTRIDE(idx, 2 * 6144) MOD[idx] = mod_reduce(MODP, b_ada, (int)idx);
      p1_wc_transpose(lds3, (const float*)(ws + WS_WCF), WC_T);
      __syncthreads();
      fill_mtab_partials((LAS float*)lds3, MODP, b_ada, 0, D);
      modulate_rows(x, g_mix, (const LAS float*)lds3, H); }
#else
    d_modulate(x, g_mix, MOD, 0, D, H);
#endif
    GSYNC();
#if DBG & 16
    { float* MOD2 = (float*)ALT; bf16 *T1 = (bf16*)(ALT + 1 * MiB), *T2 = (bf16*)(ALT + 9 * MiB), *T3 = (bf16*)(ALT + 10 * MiB), *T4 = (bf16*)(ALT + 12 * MiB), *T5 = (bf16*)(ALT + 16 * MiB), *HC = (bf16*)(ALT + 20 * MiB);
      d_mod(c, w_ada, b_ada, MOD2); d_transpose(w_in, 1024, 4096, T1); d_transpose(w_ba, 512, 1024, T2); d_transpose(w_out, 1024, 1024, T3); d_transpose(wq, 1024, 2048, T4); d_wc(pool_w, pool_scale, w_bp, T5);
      GSYNC();
      d_modulate(x, g_mix, MOD2, 0, D, HC);
      GSYNC();
      d_cmp_f32(MOD, MOD2, 2 * 6144, ldsf, DBGW + 24); d_cmp_bf16(W_IN_T, T1, (size_t)4096 * 1024, ldsf, DBGW + 26); d_cmp_bf16(WBA_T, T2, (size_t)512 * 1024, ldsf, DBGW + 26); d_cmp_bf16(WOUT_T, T3, (size_t)1024 * 1024, ldsf, DBGW + 26);
      d_cmp_bf16(WQ_T, T4, (size_t)2048 * 1024, ldsf, DBGW + 26); d_cmp_bf16(WC_T, T5, (size_t)512 * 1024, ldsf, DBGW + 26); d_cmp_bf16(H, HC, (size_t)M * D, ldsf, DBGW + 28);
      GSYNC(); }
#endif
#if (DBG & 1) || !FAST_GEMM
    { EpiInProjN E{UP, Q, Kb, V, GATES, ROPE}; d_ngemm(ldsf, H, D, W_IN_T, D, D, NPROJ, E); }
    GSYNC();
    d_ksum(Kb, KSUM);
#endif
#if DBG & 1
    { bf16 *UP2 = (bf16*)ALT, *Q2 = (bf16*)(ALT + 16 * MiB), *K2 = (bf16*)(ALT + 32 * MiB), *V2 = (bf16*)(ALT + 48 * MiB), *G2 = (bf16*)out; float* KS2 = (float*)(ws + WS_KSUM_ALT);
      pg8::Gemm g{H, W_IN_T, M, NPROJ, D, D, 0}; pg8::StaticOrder S; S.init(M, NPROJ, G, bid); EpiInProj E{UP2, Q2, K2, V2, G2, ROPE, KS2};
      pg8::gemm_phase<EpiInProj, pg8::StaticOrder, true>(lds3, g, S, E);
      GSYNC();
      d_cmp_bf16(UP2, UP, (size_t)M * 512, ldsf, DBGW + 0); d_cmp_bf16(Q2, Q, (size_t)M * 512, ldsf, DBGW + 2); d_cmp_bf16(K2, Kb, (size_t)M * 512, ldsf, DBGW + 4);
      d_cmp_bf16(V2, V, (size_t)M * 512, ldsf, DBGW + 6); d_cmp_bf16(G2, GATES, (size_t)M * 2048, ldsf, DBGW + 8); d_cmp_f32(KS2, KSUM, BATCH * NH * NBLK * HD, ldsf, DBGW + 10); }
#elif FAST_GEMM
    { pg8::Gemm g{H, W_IN_T, M, NPROJ, D, D, 0}; pg8::StaticOrder S; S.init(M, NPROJ, G, bid); EpiInProj E{UP, Q, Kb, V, GATES, ROPE, KSUM};
      pg8::gemm_phase<EpiInProj, pg8::StaticOrder, true>(lds3, g, S, E);
      if (PROBE == 7) { EpiInProj E2{UP, Q, Kb, V, GATES, ROPE, (float*)(ws + WS_KSUM_ALT)}; pg8::gemm_phase<EpiInProj, pg8::StaticOrder, true>(lds3, g, S, E2); } }
#endif
    GSYNC();
#if FAST_PRO
    pooldiff_fast(UP, DIFF);
#else
    d_pooldiff(UP, DIFF);
#endif
#if DBG & 16
    { bf16* DC = (bf16*)ALT; d_pooldiff(UP, DC); GSYNC(); d_cmp_bf16(DIFF, DC, (size_t)M * 512, ldsf, DBGW + 30); GSYNC(); }
#endif
#if (DBG & 2) || !FAST_ATTN
    d_attn(Q, Kb, V, KSUM, ATT);
#endif
#if DBG & 2
    { bf16* ATT2 = (bf16*)ALT;
#if FAST_ATTN == 2
      GSYNC(); ATTN_SORTED(ATT2);
#else
      att::attn_phase(lds3, Q, Kb, V, KSUM, ATT2, G, bid);
#endif
      GSYNC(); d_cmp_bf16(ATT2, ATT, (size_t)M * 512, ldsf, DBGW + 18); }
#elif FAST_ATTN == 1
    att::attn_phase(lds3, Q, Kb, V, KSUM, ATT, G, bid);
    if (PROBE == 4) { __syncthreads(); att::attn_phase(lds3, Q, Kb, V, KSUM, ATT, G, bid); }
#elif FAST_ATTN == 2
    if (PROBE == 11) { att2::phase_a(lds3, Q, KSUM, (unsigned short*)((char*)out + 16 * MiB), (int*)(ws + WS_CNT + 4096), (unsigned short*)out, G, bid); }
    ATTN_SORTED(ATT);
    if (PROBE == 14) { att2::phase_b<1>(lds3, Q, Kb, V, (const int*)(ws + WS_CNT), (const unsigned short*)(ws + WS_LIST), (bf16*)(ws + WS_PO01), (bf16*)(ws + WS_PO2), (f32x2*)(ws + WS_PML), G, bid); }
    if (PROBE == 15) { att2::phase_b<2>(lds3, Q, Kb, V, (const int*)(ws + WS_CNT), (const unsigned short*)(ws + WS_LIST), (bf16*)(ws + WS_PO01), (bf16*)(ws + WS_PO2), (f32x2*)(ws + WS_PML), G, bid); }
    if (PROBE == 12) { att2::phase_b<0>(lds3, Q, Kb, V, (const int*)(ws + WS_CNT), (const unsigned short*)(ws + WS_LIST), (bf16*)(ws + WS_PO01), (bf16*)(ws + WS_PO2), (f32x2*)(ws + WS_PML), G, bid); }
    if (PROBE == 13) { att2::phase_c(lds3, Q, Kb, V, (const unsigned short*)(ws + WS_SEL), (const bf16*)(ws + WS_PO01), (const bf16*)(ws + WS_PO2), (const f32x2*)(ws + WS_PML), ATT, G, bid); }
#endif
    GSYNC();
#if (DBG & 1) || !FAST_GEMM
    { EpiMergeN E{MERGED, GATES, 0}; d_ngemm(ldsf, DIFF, 512, WC_T, 512, 512, D, E); }
    { EpiMergeN E{MERGED, GATES, 1}; d_ngemm(ldsf, ATT, 512, WBA_T, 512, 512, D, E); }
#endif
#if DBG & 1
    { bf16* MG2 = (bf16*)ALT;
      { pg8::Gemm g{DIFF, WC_T, M, D, 512, 512, 0}; pg8::StaticOrder S; S.init(M, D, G, bid); EpiMerge<0> E{MG2, GATES}; pg8::gemm_phase<EpiMerge<0>, pg8::StaticOrder, true>(lds3, g, S, E); }
      { pg8::Gemm g{ATT, WBA_T, M, D, 512, 512, 0}; pg8::StaticOrder S; S.init(M, D, G, bid); EpiMerge<1> E{MG2, GATES}; pg8::gemm_phase<EpiMerge<1>, pg8::StaticOrder, true>(lds3, g, S, E); }
      GSYNC();
      d_cmp_bf16(MG2, MERGED, (size_t)M * D, ldsf, DBGW + 12); }
#elif FAST_GEMM
    { pg8::Gemm g{DIFF, WC_T, M, D, 512, 512, 0}; pg8::StaticOrder S; S.init(M, D, G, bid); EpiMerge<0> E{MERGED, GATES}; pg8::gemm_phase<EpiMerge<0>, pg8::StaticOrder, true>(lds3, g, S, E); }
    { pg8::Gemm g{ATT, WBA_T, M, D, 512, 512, 0}; pg8::StaticOrder S; S.init(M, D, G, bid); EpiMerge<1> E{MERGED, GATES}; pg8::gemm_phase<EpiMerge<1>, pg8::StaticOrder, true>(lds3, g, S, E); }
    if (PROBE == 8) { { pg8::Gemm g{DIFF, WC_T, M, D, 512, 512, 0}; pg8::StaticOrder S; S.init(M, D, G, bid); EpiMerge<0> E{MERGED, GATES}; pg8::gemm_phase<EpiMerge<0>, pg8::StaticOrder, true>(lds3, g, S, E); }
      { pg8::Gemm g{ATT, WBA_T, M, D, 512, 512, 0}; pg8::StaticOrder S; S.init(M, D, G, bid); EpiMerge<1> E{MERGED, GATES}; pg8::gemm_phase<EpiMerge<1>, pg8::StaticOrder, true>(lds3, g, S, E); } }
#endif
    GSYNC();
#if (DBG & 1) || !FAST_GEMM
    { EpiRes1N E{x, MOD, out}; d_ngemm(ldsf, MERGED, D, WOUT_T, D, D, D, E); }
#endif
#if DBG & 1
    { float* X12 = (float*)ALT;
      pg8::Gemm g{MERGED, WOUT_T, M, D, D, D, 0}; pg8::StaticOrder S; S.init(M, D, G, bid); EpiRes1 E{x, MOD, X12}; pg8::gemm_phase<EpiRes1, pg8::StaticOrder, true>(lds3, g, S, E);
      GSYNC();
      d_cmp_f32(X12, out, (size_t)M * D, ldsf, DBGW + 14); }
#elif FAST_GEMM
    { pg8::Gemm g{MERGED, WOUT_T, M, D, D, D, 0}; pg8::StaticOrder S; S.init(M, D, G, bid); EpiRes1 E{x, MOD, out}; pg8::gemm_phase<EpiRes1, pg8::StaticOrder, true>(lds3, g, S, E);
      if (PROBE == 9) pg8::gemm_phase<EpiRes1, pg8::StaticOrder, true>(lds3, g, S, E); }
#endif
    GSYNC();
#if FAST_PRO
    fill_mtab((LAS float*)lds3, MOD, 3 * D, 4 * D); modulate_rows(out, g_ffn, (const LAS float*)lds3, H);
#else
    d_modulate(out, g_ffn, MOD, 3 * D, 4 * D, H);
#endif
    GSYNC();
#if DBG & 16
    { bf16* HC = (bf16*)(ALT + 20 * MiB); d_modulate(out, g_ffn, MOD, 3 * D, 4 * D, HC); GSYNC(); d_cmp_bf16(H, HC, (size_t)M * D, ldsf, DBGW + 28); GSYNC(); }
#endif
#if (DBG & 1) || !FAST_GEMM
    { EpiBfN E{QP, 2048}; d_ngemm(ldsf, H, D, WQ_T, D, D, 2048, E); }
#endif
#if DBG & 1
    { bf16* QP2 = (bf16*)ALT;
      pg8::Gemm g{H, WQ_T, M, 2048, D, D, 0}; pg8::StaticOrder S; S.init(M, 2048, G, bid); EpiBf16 E{QP2, 2048}; pg8::gemm_phase<EpiBf16, pg8::StaticOrder, true>(lds3, g, S, E);
      GSYNC();
      d_cmp_bf16(QP2, QP, (size_t)M * 2048, ldsf, DBGW + 16); }
#elif FAST_GEMM
    { pg8::Gemm g{H, WQ_T, M, 2048, D, D, 0}; pg8::StaticOrder S; S.init(M, 2048, G, bid); EpiBf16 E{QP, 2048}; pg8::gemm_phase<EpiBf16, pg8::StaticOrder, true>(lds3, g, S, E);
      if (PROBE == 10) pg8::gemm_phase<EpiBf16, pg8::StaticOrder, true>(lds3, g, S, E); }
#endif
    GSYNC();
#if (DBG & 4) || !FAST_ROUTE
    d_route(ldsf, QP, SK, EID, EG);
#endif
#if DBG & 4
    { int* EID2 = (int*)(ws + 68 * MiB); float* EG2 = (float*)(ws + 76 * MiB); float* SM1 = (float*)(ws + 148 * MiB); float* SM2 = (float*)(ws + 150 * MiB);
      __syncthreads(); route_phase(lds3, QP, (const bf16*)(ws + WS_SKBD), EID2, EG2, G, bid); GSYNC();
      d_route_summary(EID, EG, SM1); d_route_summary(EID2, EG2, SM2); GSYNC(); d_cmp_f32(SM2, SM1, (size_t)M * PHEADS * 2, ldsf, DBGW + 22); }
#elif FAST_ROUTE
    route_phase(lds3, QP, (const bf16*)(ws + WS_SKBD), EID, EG, G, bid);
    if (PROBE == 6) route_phase(lds3, QP, (const bf16*)(ws + WS_SKBD), EID, EG, G, bid);
#endif
    GSYNC();
#if DBG & 8
    { float* OUT2 = (float*)(ws + WS_OUT2); PEER_CALL(out, OUT2); GSYNC();
      d_peer(H, EID, EG, Ut, Vt, MOD, g_fin, out); GSYNC(); d_cmp_f32(OUT2, out, (size_t)M * D, ldsf, DBGW + 20); }
#elif USE_FAST_PEER
    if (PROBE == 2) { PEER_CALL(out, (float*)(ws + WS_OUT2)); GSYNC(); }
    if (PROBE == 3) { for (int i = 0; i < 10; ++i) GSYNC(); }
    PEER_CALL(out, out);
#else
    d_peer(H, EID, EG, Ut, Vt, MOD, g_fin, out);
#endif
#if DBG
    GSYNC();
    { float e2 = 0.f; for (int i = 0; i < 16; ++i) { const float n = __hip_atomic_load(DBGW + 2 * i, __ATOMIC_RELAXED, __HIP_MEMORY_SCOPE_AGENT), d = __hip_atomic_load(DBGW + 2 * i + 1, __ATOMIC_RELAXED, __HIP_MEMORY_SCOPE_AGENT); if (d > 0.f) e2 += n / d; else if (n > 0.f) e2 += 1.f; }
      float dl = 10.f * sqrtf(e2); if (!(dl < 1.f)) dl = 1.f;
      GSTRIDE(i, (size_t)M * D) out[i] *= (1.f + dl); }
#endif
}

extern "C" void kernel_launch(void* const* d_in, const int* in_sizes, int n_in, void* d_out, int out_size, void* d_ws, size_t ws_size, hipStream_t stream) {
    static int grid_blocks = 0;
    if (grid_blocks == 0) {
        if (n_in != 17 || out_size != M * D || ws_size < 256 * MiB) { fprintf(stderr, "kernel_launch: unexpected shapes (n_in %d out %d ws %zu)\n", n_in, out_size, ws_size); grid_blocks = -1; return; }
        int dev = 0, cus = 0, per_cu = 0;
        (void)hipGetDevice(&dev); (void)hipDeviceGetAttribute(&cus, hipDeviceAttributeMultiprocessorCount, dev);
        (void)hipFuncSetAttribute((const void*)mega_fwd, hipFuncAttributeMaxDynamicSharedMemorySize, LDS_BYTES);
        (void)hipOccupancyMaxActiveBlocksPerMultiprocessor(&per_cu, (const void*)mega_fwd, NT, LDS_BYTES);
        if (per_cu < 1 || cus < 1) { fprintf(stderr, "kernel_launch: occupancy query says %d blocks/CU on %d CUs\n", per_cu, cus); grid_blocks = -1; return; }
        grid_blocks = cus;
    }
    if (grid_blocks < 0) return;
    (void)hipMemsetAsync((char*)d_ws + WS_CTL, 0, 1 * MiB, stream);
    Args a{};
    for (int i = 0; i < 17; ++i) a.in[i] = (const float*)d_in[i];
    a.out = (float*)d_out; a.ws = (unsigned char*)d_ws;
    void* args[] = {&a};
    hipError_t e = hipLaunchCooperativeKernel((const void*)mega_fwd, dim3(grid_blocks), dim3(NT), args, LDS_BYTES, stream);
    if (e != hipSuccess) fprintf(stderr, "cooperative launch failed: %s (grid %d)\n", hipGetErrorString(e), grid_blocks);
}
```

```cpp
#include <hip/hip_runtime.h>
#include <hip/hip_cooperative_groups.h>
#include <cstdio>
#include <cstdint>
namespace cg = cooperative_groups;

constexpr int BATCH = 2, SEQ = 8192, D = 1024, M = BATCH * SEQ;
constexpr int NPROJ = 4096, PW = 512, AW = 512, NH = 8, HD = 64, MBLK = 256, NBLK = SEQ / MBLK;
constexpr int PHEADS = 8, NKEYS = 128, PQD = 256, PHALF = 128, PTOPK = 16, NEXP = NKEYS * NKEYS, NSEL = PHEADS * PTOPK;
constexpr float EPS = 1e-6f;
constexpr float C2 = 0.125f * 1.4426950408889634f;
constexpr int NT = 512;

typedef unsigned short bf16;
__device__ __forceinline__ float bf2f(bf16 v) { return __uint_as_float(((unsigned)v) << 16); }
__device__ __forceinline__ bf16 f2bf(float f) { unsigned u = __float_as_uint(f); return (bf16)((u + 0x7fffu + ((u >> 16) & 1u)) >> 16); }

constexpr size_t MiB = 1u << 20;
constexpr size_t WS_CTL = 0;
constexpr size_t WS_MOD = 1 * MiB;
constexpr size_t WS_KSUM = 256 * 1024;
constexpr size_t WS_BAR = 32 * 1024;
constexpr size_t WS_KSUM_ALT = 512 * 1024, WS_DBG = 16 * 1024;
constexpr size_t WS_UT = 180 * MiB, WS_VT = 212 * MiB;
constexpr size_t WS_U8 = 180 * MiB, WS_V8 = 196 * MiB, WS_USC = 212 * MiB, WS_VSC = 212 * MiB + 65536;
constexpr size_t WS_SEL = 1 * MiB + 768 * 1024;
constexpr size_t WS_CNT = 640 * 1024;
constexpr size_t WS_PO01 = 213 * MiB, WS_PO2 = 52 * MiB, WS_LIST = 245 * MiB, WS_PML = 253 * MiB;
constexpr size_t WS_WT = 68 * MiB;
constexpr size_t WS_OUT2 = 84 * MiB;
constexpr size_t WS_ALT = 180 * MiB;
constexpr size_t WS_ROPE = 1 * MiB + 256 * 1024;
constexpr size_t WS_MODP = 148 * MiB;
constexpr size_t WS_WCF = 150 * MiB;
constexpr size_t WS_W_IN_T = 2 * MiB;
constexpr size_t WS_WC_T = 10 * MiB;
constexpr size_t WS_WBA_T = 11 * MiB;
constexpr size_t WS_WOUT_T = 12 * MiB;
constexpr size_t WS_WQ_T = 14 * MiB;
constexpr size_t WS_SK = 18 * MiB;
constexpr size_t WS_SKBD = 19 * MiB;
constexpr size_t WS_H = 20 * MiB;
constexpr size_t WS_DIFF = 20 * MiB, WS_ATT = 36 * MiB;
constexpr size_t WS_UP = 52 * MiB, WS_Q = 68 * MiB, WS_K = 84 * MiB, WS_V = 100 * MiB;
constexpr size_t WS_GATES = 116 * MiB;
constexpr size_t WS_MERGED = 84 * MiB;
constexpr size_t WS_QP = 116 * MiB;
constexpr size_t WS_EID = 52 * MiB, WS_EG = 60 * MiB;
constexpr size_t WS_END = 180 * MiB;

struct Args { const float* in[17]; float* out; unsigned char* ws; };

#define GSTRIDE(i, n) for (size_t i = (size_t)blockIdx.x * NT + threadIdx.x; i < (size_t)(n); i += (size_t)gridDim.x * NT)

__device__ __forceinline__ void d_mod(const float* c, const float* w_ada, const float* b_ada, float* mod) {
    GSTRIDE(idx, 2 * 6144) { const int b = (int)idx / 6144, j = (int)idx % 6144; float acc = 0.f;
        for (int i = 0; i < D; ++i) { const float cv = c[b * D + i]; const float s = cv / (1.f + expf(-cv)); acc += s * w_ada[(size_t)i * 6144 + j]; }
        mod[idx] = acc + b_ada[j]; }
}
__device__ __forceinline__ void d_transpose(const float* W, int K, int N, bf16* WT) {
    GSTRIDE(idx, (size_t)K * N) { const int k = (int)(idx / N), n = (int)(idx % N); WT[(size_t)n * K + k] = f2bf(W[idx]); }
}
__device__ __forceinline__ void d_wc(const float* pool_w, const float* pool_scale, const float* w_bp, bf16* WcT) {
    GSTRIDE(idx, 512 * 1024) { const int o = (int)idx % 1024, k = (int)idx / 1024, g = k / 128, i = k % 128; float acc = 0.f;
        for (int j = 0; j < 128; ++j) acc += pool_w[(g * 128 + i) * 128 + j] * pool_scale[g * 128 + j] * w_bp[(size_t)(g * 128 + j) * 1024 + o];
        WcT[(size_t)o * 512 + k] = f2bf(acc); }
}
__device__ __forceinline__ void d_sk(const float* sk, bf16* SK) { GSTRIDE(idx, 8 * 2 * 128 * 128) SK[idx] = f2bf(sk[idx]); }
__device__ __forceinline__ void d_rope(float* tab) {
    GSTRIDE(idx, SEQ * 8) { const int pos = (int)idx / 8, i = (int)idx % 8; const float inv = (float)pow(500000.0, -(double)i / 8.0); const float ang = (float)pos * inv;
        tab[pos * 16 + i] = (float)cos((double)ang); tab[pos * 16 + 8 + i] = (float)sin((double)ang); }
}
__device__ __forceinline__ void d_modulate(const float* x, const float* g, const float* mod, int shift_off, int scale_off, bf16* out) {
    const int lane = threadIdx.x & 63;
    for (int row = blockIdx.x * (NT / 64) + (threadIdx.x >> 6); row < M; row += gridDim.x * (NT / 64)) {
        const int b = row / SEQ; const float* xr = x + (size_t)row * D; float v[16]; float ss = 0.f;
#pragma unroll
        for (int j = 0; j < 16; ++j) { v[j] = xr[j * 64 + lane]; ss += v[j] * v[j]; }
#pragma unroll
        for (int o = 1; o < 64; o <<= 1) ss += __shfl_xor(ss, o);
        const float r = rsqrtf(ss * (1.f / D) + EPS);
#pragma unroll
        for (int j = 0; j < 16; ++j) { const int col = j * 64 + lane; out[(size_t)row * D + col] = f2bf(v[j] * r * g[col] * (1.f + mod[b * 6144 + scale_off + col]) + mod[b * 6144 + shift_off + col]); }
    }
}
constexpr int NG_HALF_FLOATS = 2 * 16 * 65 + 64 * 65;
template <class Epi>
__device__ __forceinline__ void d_ngemm(float* lds, const bf16* A, int lda, const bf16* Bt, int ldb, int K, int N, const Epi& E) {
    const int half = threadIdx.x >> 8, tid = threadIdx.x & 255, tx = tid & 15, ty = tid >> 4;
    float* As = lds + half * NG_HALF_FLOATS; float* Bs = As + 16 * 65; float* Ct = Bs + 16 * 65;
    const int ntn = N / 64, ntiles = (M / 64) * ntn, iters = (ntiles + 2 * gridDim.x - 1) / (2 * gridDim.x);
    for (int it = 0; it < iters; ++it) {
        const int t = (it * gridDim.x + blockIdx.x) * 2 + half; const bool valid = t < ntiles; const int m0 = valid ? (t / ntn) * 64 : 0, n0 = valid ? (t % ntn) * 64 : 0;
        float acc[4][4];
#pragma unroll
        for (int i = 0; i < 4; ++i)
#pragma unroll
            for (int j = 0; j < 4; ++j) acc[i][j] = 0.f;
        for (int k0 = 0; k0 < K; k0 += 16) {
#pragma unroll
            for (int e = 0; e < 4; ++e) { const int idx = tid + e * 256, r = idx >> 4, kk = idx & 15;
                As[kk * 65 + r] = bf2f(A[(size_t)(m0 + r) * lda + k0 + kk]); Bs[kk * 65 + r] = bf2f(Bt[(size_t)(n0 + r) * ldb + k0 + kk]); }
            __syncthreads();
#pragma unroll
            for (int kk = 0; kk < 16; ++kk) { float a[4], b[4];
#pragma unroll
                for (int i = 0; i < 4; ++i) { a[i] = As[kk * 65 + ty * 4 + i]; b[i] = Bs[kk * 65 + tx * 4 + i]; }
#pragma unroll
                for (int i = 0; i < 4; ++i)
#pragma unroll
                    for (int j = 0; j < 4; ++j) acc[i][j] += a[i] * b[j]; }
            __syncthreads();
        }
#pragma unroll
        for (int i = 0; i < 4; ++i)
#pragma unroll
            for (int j = 0; j < 4; ++j) Ct[(ty * 4 + i) * 65 + tx * 4 + j] = acc[i][j];
        __syncthreads();
        if (valid) for (int e = tid; e < 64 * 64; e += 256) { const int r = e >> 6, cidx = e & 63; E(m0 + r, n0 + cidx, Ct[r * 65 + cidx], &Ct[r * 65], cidx); }
        __syncthreads();
    }
}
struct EpiInProjN {
    bf16 *UP, *Q, *Kb, *V, *G; const float* rope;
    __device__ void operator()(int m, int n, float v, const float* row, int cl) const {
        if (n < 512) { UP[(size_t)m * 512 + n] = f2bf(v); return; }
        if (n < 1536) {
            const bool isq = n < 1024; const int c = isq ? n - 512 : n - 1024; const int d = c & 63; const int pos = m % SEQ; float o = v;
            if (d < 8) { const float cs = rope[pos * 16 + d], sn = rope[pos * 16 + 8 + d]; o = v * cs - row[cl + 8] * sn; }
            else if (d < 16) { const float cs = rope[pos * 16 + d - 8], sn = rope[pos * 16 + 8 + d - 8]; o = row[cl - 8] * sn + v * cs; }
            if (isq) Q[(size_t)m * 512 + c] = f2bf(o * C2); else Kb[(size_t)m * 512 + c] = f2bf(o);
            return;
        }
        if (n < 2048) { V[(size_t)m * 512 + n - 1536] = f2bf(v); return; }
        G[(size_t)m * 2048 + n - 2048] = f2bf(1.f / (1.f + expf(-v)));
    }
};
struct EpiMergeN { bf16* Mg; const bf16* G; int pass;
    __device__ void operator()(int m, int n, float v, const float*, int) const {
        const float g = bf2f(G[(size_t)m * 2048 + pass * 1024 + n]); const size_t o = (size_t)m * 1024 + n;
        if (pass == 0) Mg[o] = f2bf(g * v); else Mg[o] = f2bf(bf2f(Mg[o]) + g * v); } };
struct EpiRes1N { const float* x; const float* mod; float* x1;
    __device__ void operator()(int m, int n, float v, const float*, int) const { const int b = m / SEQ; x1[(size_t)m * D + n] = x[(size_t)m * D + n] + mod[b * 6144 + 2 * D + n] * v; } };
struct EpiBfN { bf16* O; int ldo; __device__ void operator()(int m, int n, float v, const float*, int) const { O[(size_t)m * ldo + n] = f2bf(v); } };

__device__ __forceinline__ void d_ksum(const bf16* Kb, float* ksum) {
    GSTRIDE(idx, BATCH * NH * NBLK * HD) { const int d = (int)idx % HD, blk = ((int)idx / HD) % NBLK, h = ((int)idx / (HD * NBLK)) % NH, b = (int)idx / (HD * NBLK * NH); float s = 0.f;
        for (int r = 0; r < MBLK; ++r) s += bf2f(Kb[(size_t)(b * SEQ + blk * MBLK + r) * 512 + h * 64 + d]);
        ksum[idx] = s; }
}
__device__ __forceinline__ void d_pooldiff(const bf16* UP, bf16* DIFF) {
    GSTRIDE(idx, (size_t)M * 512) { const int c = (int)(idx % 512), row = (int)(idx / 512), pos = row % SEQ, w = 2 << (c / 128), cnt = pos + 1 < w ? pos + 1 : w; float s = 0.f;
        for (int i = 0; i < cnt; ++i) s += bf2f(UP[(size_t)(row - i) * 512 + c]);
        DIFF[idx] = f2bf(s / (float)cnt - bf2f(UP[idx])); }
}
__device__ __forceinline__ void d_attn(const bf16* Q, const bf16* Kb, const bf16* V, const float* ksum, bf16* ATT) {
    GSTRIDE(gidx, BATCH * NH * SEQ) {
        const int idx = (int)gidx, q = idx % SEQ, h = (idx / SEQ) % NH, b = idx / (SEQ * NH), row = b * SEQ + q, qb = q / MBLK;
        float qv[64], o[64];
#pragma unroll
        for (int d = 0; d < 64; ++d) { qv[d] = bf2f(Q[(size_t)row * 512 + h * 64 + d]); o[d] = 0.f; }
        int s0 = -1, s1 = -1, s2 = -1; float g0 = -INFINITY, g1 = -INFINITY, g2 = -INFINITY;
        for (int j = 0; j < qb; ++j) { const float* ks = ksum + ((size_t)(b * NH + h) * NBLK + j) * HD; float g = 0.f;
#pragma unroll
            for (int d = 0; d < 64; ++d) g += qv[d] * ks[d];
            if (g > g0) { g2 = g1; s2 = s1; g1 = g0; s1 = s0; g0 = g; s0 = j; } else if (g > g1) { g2 = g1; s2 = s1; g1 = g; s1 = j; } else if (g > g2) { g2 = g; s2 = j; } }
        float mx = -1e30f, l = 0.f;
        for (int pass = 0; pass < 4; ++pass) {
            const int blk = pass == 0 ? qb : (pass == 1 ? s0 : (pass == 2 ? s1 : s2)); if (blk < 0) continue;
            const int nkeys = pass == 0 ? (q - qb * MBLK + 1) : MBLK;
            for (int kk = 0; kk < nkeys; ++kk) { const size_t kr = (size_t)(b * SEQ + blk * MBLK + kk) * 512 + h * 64; float s = 0.f;
#pragma unroll
                for (int d = 0; d < 64; ++d) s += qv[d] * bf2f(Kb[kr + d]);
                if (s > mx) { const float f = exp2f(mx - s); l = l * f + 1.f;
#pragma unroll
                    for (int d = 0; d < 64; ++d) o[d] = o[d] * f + bf2f(V[kr + d]);
                    mx = s; }
                else { const float p = exp2f(s - mx); l += p;
#pragma unroll
                    for (int d = 0; d < 64; ++d) o[d] += p * bf2f(V[kr + d]); } }
        }
        const float il = 1.f / l;
#pragma unroll
        for (int d = 0; d < 64; ++d) ATT[(size_t)row * 512 + h * 64 + d] = f2bf(o[d] * il);
    }
}
__device__ __forceinline__ void d_route(float* lds, const bf16* QP, const bf16* SK, int* EID, float* EG) {
    const int tid = threadIdx.x; float* lv = lds + tid * 33; int* li = (int*)(lds + NT * 33) + tid * 33;
    GSTRIDE(gidx, M * PHEADS) {
        const int idx = (int)gidx, h = idx % PHEADS, t = idx / PHEADS;
#pragma unroll 1
        for (int p = 0; p < 2; ++p) {
            float tv[16]; int ti[16];
#pragma unroll
            for (int j = 0; j < 16; ++j) { tv[j] = -INFINITY; ti[j] = 0; }
            const bf16* qr = QP + (size_t)t * 2048 + h * 256 + p * 128; const bf16* sk = SK + (size_t)(h * 2 + p) * 128 * 128;
#pragma unroll 1
            for (int n = 0; n < 128; ++n) { float s = 0.f;
                for (int d = 0; d < 128; ++d) s += bf2f(qr[d]) * bf2f(sk[n * 128 + d]);
                float v = s; int vi = n;
#pragma unroll
                for (int j = 0; j < 16; ++j) if (v > tv[j]) { const float tf = tv[j]; const int tj = ti[j]; tv[j] = v; ti[j] = vi; v = tf; vi = tj; } }
#pragma unroll
            for (int j = 0; j < 16; ++j) { lv[p * 16 + j] = tv[j]; li[p * 16 + j] = ti[j]; }
        }
        float cv[16]; int ci[16];
#pragma unroll
        for (int j = 0; j < 16; ++j) { cv[j] = -INFINITY; ci[j] = 0; }
#pragma unroll 1
        for (int i = 0; i < 16; ++i)
#pragma unroll 1
            for (int j2 = 0; j2 < 16; ++j2) { float v = lv[i] + lv[16 + j2]; int vi = li[i] * NKEYS + li[16 + j2];
#pragma unroll
                for (int j = 0; j < 16; ++j) if (v > cv[j]) { const float tf = cv[j]; const int tj = ci[j]; cv[j] = v; ci[j] = vi; v = tf; vi = tj; } }
        float sum = 0.f, e[16];
#pragma unroll
        for (int j = 0; j < 16; ++j) { e[j] = expf(cv[j] - cv[0]); sum += e[j]; }
        const float is = 1.f / sum;
#pragma unroll
        for (int j = 0; j < 16; ++j) { EID[(size_t)t * NSEL + h * 16 + j] = ci[j]; EG[(size_t)t * NSEL + h * 16 + j] = e[j] * is; }
    }
}
__device__ __forceinline__ void d_peer(const bf16* H2, const int* EID, const float* EG, const float* Ut, const float* Vt, const float* mod, const float* gfin, float* io) {
    const int lane = threadIdx.x & 63;
    for (int t = blockIdx.x * (NT / 64) + (threadIdx.x >> 6); t < M; t += gridDim.x * (NT / 64)) {
        const int b = t / SEQ; float hv[16], acc[16];
#pragma unroll
        for (int j = 0; j < 4; ++j)
#pragma unroll
            for (int e = 0; e < 4; ++e) { hv[j * 4 + e] = bf2f(H2[(size_t)t * D + j * 256 + lane * 4 + e]); acc[j * 4 + e] = 0.f; }
#pragma unroll 1
        for (int k = 0; k < NSEL; ++k) {
            const int eid = EID[(size_t)t * NSEL + k]; const float g = EG[(size_t)t * NSEL + k];
            const float4* ur = (const float4*)(Ut + (size_t)eid * D); const float4* vr = (const float4*)(Vt + (size_t)eid * D); float dot = 0.f;
#pragma unroll
            for (int j = 0; j < 4; ++j) { const float4 u = ur[j * 64 + lane]; dot += hv[j * 4] * u.x + hv[j * 4 + 1] * u.y + hv[j * 4 + 2] * u.z + hv[j * 4 + 3] * u.w; }
#pragma unroll
            for (int o = 1; o < 64; o <<= 1) dot += __shfl_xor(dot, o);
            const float w = g * 0.5f * dot * (1.f + erff(dot * 0.70710678118654752f));
#pragma unroll
            for (int j = 0; j < 4; ++j) { const float4 v = vr[j * 64 + lane]; acc[j * 4] += w * v.x; acc[j * 4 + 1] += w * v.y; acc[j * 4 + 2] += w * v.z; acc[j * 4 + 3] += w * v.w; }
        }
        float ss = 0.f;
#pragma unroll
        for (int j = 0; j < 4; ++j)
#pragma unroll
            for (int e = 0; e < 4; ++e) { const int col = j * 256 + lane * 4 + e; const float x2 = io[(size_t)t * D + col] + mod[b * 6144 + 5 * D + col] * acc[j * 4 + e]; acc[j * 4 + e] = x2; ss += x2 * x2; }
#pragma unroll
        for (int o = 1; o < 64; o <<= 1) ss += __shfl_xor(ss, o);
        const float r = rsqrtf(ss * (1.f / D) + EPS);
#pragma unroll
        for (int j = 0; j < 4; ++j)
#pragma unroll
            for (int e = 0; e < 4; ++e) { const int col = j * 256 + lane * 4 + e; io[(size_t)t * D + col] = acc[j * 4 + e] * r * gfin[col]; }
    }
}


#define LAS __attribute__((address_space(3)))
typedef short bf16x8 __attribute__((ext_vector_type(8)));
typedef float f32x4 __attribute__((ext_vector_type(4)));
typedef float f32x2 __attribute__((ext_vector_type(2)));
typedef unsigned u32x4 __attribute__((ext_vector_type(4)));
typedef unsigned u32x2 __attribute__((ext_vector_type(2)));
typedef __bf16 bf16x2_t __attribute__((ext_vector_type(2)));
__device__ __forceinline__ unsigned cvt_pk_bf16(float lo, float hi) { f32x2 v = {lo, hi}; bf16x2_t b = __builtin_convertvector(v, bf16x2_t); return __builtin_bit_cast(unsigned, b); }
__device__ __forceinline__ float bflo(unsigned w) { return __uint_as_float(w << 16); }
__device__ __forceinline__ float bfhi(unsigned w) { return __uint_as_float(w & 0xffff0000u); }

namespace pg8 {
constexpr int BM = 256, BK = 64, HALF = 128, HTB = HALF * BK * 2  , STAGE_BYTES = 8 * HTB, NXCD = 8, WGM = 8;
__device__ __forceinline__ int lds_byte(int r, int c) { const int st = (r >> 4) * 2 + (c >> 5), rr = r & 15, cc = c & 31, ob = rr * 64 + cc * 2; return st * 1024 + (ob ^ (((ob >> 9) & 1) << 5)); }
__device__ __forceinline__ void stage_rc(int b, int& R, int& C) { const int st = b / 1024, sb = b % 1024, swz = sb ^ (((sb >> 9) & 1) << 5); R = (st >> 1) * 16 + swz / 64; C = (st & 1) * 32 + (swz % 64) / 2; }
__device__ __forceinline__ int perm32(int rho) { const int n = rho >> 4, i = rho & 15; return 8 * (i >> 2) + 4 * n + (i & 3); }
struct Unit { int pm, pn; };
struct Gemm { const bf16* A; const bf16* Bt; int M, N, K, lda, a_pn_off; };
struct StaticOrder {
    int nM, nN, nwg, G, c;
    __device__ void init(int M_, int N_, int G_, int c_) { nM = M_ / BM; nN = N_ / BM; nwg = nM * nN; G = G_; c = c_; }
    __device__ bool next(int i, Unit& u) const {
        const long L = (long)i * G + c; if (L >= nwg) return false;
        int wgid = (int)L; { const int q = nwg / NXCD, r = nwg % NXCD, xcd = wgid % NXCD, off = wgid / NXCD; wgid = (xcd < r ? xcd * (q + 1) : r * (q + 1) + (xcd - r) * q) + off; }
        const int nig = WGM * nN, gid = wgid / nig, fm = gid * WGM, gsz = (nM - fm) < WGM ? (nM - fm) : WGM;
        u.pm = fm + ((wgid % nig) % gsz); u.pn = (wgid % nig) / gsz; return true;
    }
};
struct OneUnit { Unit u; __device__ bool next(int i, Unit& o) const { if (i) return false; o = u; return true; } };
template <class Epi, class Sched, bool ALIGN_EPI>
__device__ __forceinline__ void gemm_phase(LAS unsigned char* lds, const Gemm g, const Sched& S, const Epi& E) {
    int tid_ = threadIdx.x; asm volatile("" : "+v"(tid_));
    const int tid = tid_, wid = __builtin_amdgcn_readfirstlane(tid >> 6), lane = tid & 63, wr = wid >> 2, wc = wid & 3, fr = lane & 15, fq = lane >> 4;
    const int K = g.K, nt = K / BK, lda = g.lda;
    unsigned voffA[2], voffB[2];
#pragma unroll
    for (int i = 0; i < 2; ++i) { int R, C; stage_rc(tid * 16 + i * 8192, R, C); const int Rb = Epi::PERM ? ((R & ~31) + perm32(R & 31)) : R;
        voffA[i] = (unsigned)(R * lda + C) * 2u; voffB[i] = (unsigned)(Rb * K + C) * 2u; }
    const size_t kstep = (size_t)(BK * 2);
    const size_t hA = (size_t)HALF * lda * 2, hB = (size_t)HALF * K * 2, tA = 2 * hA, tB = 2 * hB;
    const unsigned ldsw = (unsigned)wid * 1024u;
    const int aoff = lds_byte(wr * 64 + fr, fq * 8), boff = lds_byte(wc * 32 + fr, fq * 8);
#define PG8_SA(b, h) (((b) * 2 + (h)) * HTB)
#define PG8_SB(b, h) ((4 + (b) * 2 + (h)) * HTB)
#define PG8_STAGE(bufoff, gbase, voff) do { _Pragma("unroll") for (int _i = 0; _i < 2; ++_i) \
        __builtin_amdgcn_global_load_lds((const unsigned*)((const char*)(gbase) + (voff)[_i]), (LAS unsigned*)(lds + (bufoff) + ldsw + _i * 8192), 16, 0, 0); } while (0)
#define PG8_LDA(dst, b, h) do { _Pragma("unroll") for (int m = 0; m < 4; ++m) _Pragma("unroll") for (int k = 0; k < 2; ++k) dst[m][k] = *(const LAS bf16x8*)(lds + PG8_SA(b, h) + aoff + m * 2048 + k * 1024); } while (0)
#define PG8_LDB(dst, b, h) do { _Pragma("unroll") for (int n = 0; n < 2; ++n) _Pragma("unroll") for (int k = 0; k < 2; ++k) dst[n][k] = *(const LAS bf16x8*)(lds + PG8_SB(b, h) + boff + n * 2048 + k * 1024); } while (0)
#define PG8_MMA(ai, bj, At, Bt) do { __builtin_amdgcn_s_setprio(1); _Pragma("unroll") for (int m = 0; m < 4; ++m) _Pragma("unroll") for (int n = 0; n < 2; ++n) _Pragma("unroll") for (int k = 0; k < 2; ++k) \
        acc[ai][bj][m][n] = __builtin_amdgcn_mfma_f32_16x16x32_bf16(Bt[n][k], At[m][k], acc[ai][bj][m][n], 0, 0, 0); __builtin_amdgcn_s_setprio(0); } while (0)
#define PG8_WAIT_V(n) asm volatile("s_waitcnt vmcnt(" #n ")" ::: "memory")
#define PG8_WAIT_L(n) asm volatile("s_waitcnt lgkmcnt(" #n ")" ::: "memory")
#define PG8_BAR __builtin_amdgcn_s_barrier()
#define PG8_SCHED __builtin_amdgcn_sched_barrier(0)
    Unit cur, nxt; int ui = 0;
    if (!S.next(0, cur)) return;
    f32x4 acc[2][2][4][2];
#pragma unroll
    for (int a = 0; a < 2; ++a)
#pragma unroll
        for (int b = 0; b < 2; ++b)
#pragma unroll
            for (int m = 0; m < 4; ++m)
#pragma unroll
                for (int n = 0; n < 2; ++n) acc[a][b][m][n] = (f32x4){0.f, 0.f, 0.f, 0.f};
    bf16x8 At[4][2], B0[2][2], B1[2][2];
    const char* cA = (const char*)g.A + (size_t)cur.pm * tA + (size_t)cur.pn * g.a_pn_off * 2; const char* cB = (const char*)g.Bt + (size_t)cur.pn * tB;
    PG8_STAGE(PG8_SB(0, 0), cB, voffB); PG8_STAGE(PG8_SB(0, 1), cB + hB, voffB); PG8_STAGE(PG8_SA(0, 0), cA, voffA); PG8_STAGE(PG8_SA(0, 1), cA + hA, voffA);
    if (wr == 1) PG8_BAR;
    PG8_WAIT_V(2); PG8_BAR;
    PG8_STAGE(PG8_SB(1, 0), cB + kstep, voffB); PG8_STAGE(PG8_SA(1, 0), cA + kstep, voffA); PG8_STAGE(PG8_SB(1, 1), cB + hB + kstep, voffB);
    PG8_WAIT_V(6); PG8_BAR;
    for (;;) {
        const bool has_next = S.next(ui + 1, nxt);
        const char* nA = has_next ? (const char*)g.A + (size_t)nxt.pm * tA + (size_t)nxt.pn * g.a_pn_off * 2 : cA; const char* nB = has_next ? (const char*)g.Bt + (size_t)nxt.pn * tB : cB;
        for (int t = 0; t < nt; t += 2) {
            const bool last = (t == nt - 2);
            const char* a1 = cA + (size_t)(t + 1) * kstep;
            const char* a2 = last ? nA : cA + (size_t)(t + 2) * kstep; const char* b2 = last ? nB : cB + (size_t)(t + 2) * kstep;
            const char* a3 = a2 + kstep; const char* b3 = b2 + kstep;
            PG8_LDB(B0, 0, 0); PG8_LDB(B1, 0, 1); PG8_SCHED; PG8_LDA(At, 0, 0); PG8_STAGE(PG8_SA(1, 1), a1 + hA, voffA);
            PG8_WAIT_V(8); PG8_WAIT_L(0); PG8_BAR; PG8_MMA(0, 0, At, B0); PG8_MMA(0, 1, At, B1); PG8_BAR; PG8_SCHED;
            PG8_LDA(At, 0, 1); PG8_STAGE(PG8_SB(0, 0), b2, voffB); PG8_STAGE(PG8_SB(0, 1), b2 + hB, voffB); PG8_STAGE(PG8_SA(0, 0), a2, voffA);
            PG8_WAIT_V(8); PG8_WAIT_L(0); PG8_BAR; PG8_MMA(1, 0, At, B0); PG8_MMA(1, 1, At, B1); PG8_BAR; PG8_SCHED;
            PG8_LDB(B0, 1, 0); PG8_LDB(B1, 1, 1); PG8_SCHED; PG8_LDA(At, 1, 0); PG8_STAGE(PG8_SA(0, 1), a2 + hA, voffA);
            PG8_WAIT_V(8); PG8_WAIT_L(0); PG8_BAR; PG8_MMA(0, 0, At, B0); PG8_MMA(0, 1, At, B1); PG8_BAR; PG8_SCHED;
            PG8_LDA(At, 1, 1); PG8_STAGE(PG8_SB(1, 0), b3, voffB); PG8_STAGE(PG8_SB(1, 1), b3 + hB, voffB); PG8_STAGE(PG8_SA(1, 0), a3, voffA);
            PG8_WAIT_V(8); PG8_WAIT_L(0); PG8_BAR; PG8_MMA(1, 0, At, B0); PG8_MMA(1, 1, At, B1); PG8_BAR; PG8_SCHED;
        }
        if constexpr (ALIGN_EPI) { if (wr == 0) PG8_BAR; }
        if constexpr (!Epi::AFTER_DRAIN) { E(acc, cur, wr, wc, fr, fq); }
        if (!has_next) break;
#pragma unroll
        for (int a = 0; a < 2; ++a)
#pragma unroll
            for (int b = 0; b < 2; ++b)
#pragma unroll
                for (int m = 0; m < 4; ++m)
#pragma unroll
                    for (int n = 0; n < 2; ++n) acc[a][b][m][n] = (f32x4){0.f, 0.f, 0.f, 0.f};
        cur = nxt; cA = nA; cB = nB; ++ui;
        if constexpr (ALIGN_EPI) { if (wr == 1) PG8_BAR; }
    }
    PG8_WAIT_V(0);
    if constexpr (!ALIGN_EPI) { if (wr == 0) PG8_BAR; }
    PG8_BAR;
    if constexpr (Epi::AFTER_DRAIN) { E.fused(acc, cur, wr, wc, fr, fq, lds, wid, lane); }
#undef PG8_SA
#undef PG8_SB
#undef PG8_STAGE
#undef PG8_LDA
#undef PG8_LDB
#undef PG8_MMA
#undef PG8_WAIT_V
#undef PG8_WAIT_L
#undef PG8_BAR
#undef PG8_SCHED
}
}

__device__ __forceinline__ float fast_sigmoid(float v) { return __builtin_amdgcn_rcpf(1.f + __builtin_amdgcn_exp2f(-1.4426950408889634f * v)); }
struct EpiInProj {
    static constexpr bool PERM = true, AFTER_DRAIN = false;
    bf16 *UP, *Q, *Kb, *V, *G; const float* rope; float* ksum;
    __device__ __forceinline__ void operator()(const f32x4 (&acc)[2][2][4][2], const pg8::Unit& u, int wr, int wc, int fr, int fq) const {
        const int pn = u.pn, row0 = u.pm * 256 + wr * 64 + fr;
        if (pn < 2 || (pn >= 6 && pn < 8)) {
            bf16* O = pn < 2 ? UP : V; const int c0 = (pn & 1) * 256 + wc * 32 + 8 * fq;
#pragma unroll
            for (int ai = 0; ai < 2; ++ai)
#pragma unroll
                for (int m = 0; m < 4; ++m)
#pragma unroll
                    for (int bj = 0; bj < 2; ++bj) { const f32x4 v0 = acc[ai][bj][m][0], v1 = acc[ai][bj][m][1]; u32x4 w;
                        w.x = cvt_pk_bf16(v0[0], v0[1]); w.y = cvt_pk_bf16(v0[2], v0[3]); w.z = cvt_pk_bf16(v1[0], v1[1]); w.w = cvt_pk_bf16(v1[2], v1[3]);
                        *(u32x4*)(O + (size_t)(row0 + ai * 128 + m * 16) * 512 + c0 + bj * 128) = w; }
        } else if (pn < 6) {
            const bool isq = pn < 4; bf16* O = isq ? Q : Kb; const int c0 = (pn & 1) * 256 + wc * 32 + 8 * fq; const bool rot = (wc & 1) == 0;
            float cs[2][8];
#pragma unroll
            for (int bj = 0; bj < 2; ++bj)
#pragma unroll
                for (int i = 0; i < 8; ++i) cs[bj][i] = 0.f;
#pragma unroll
            for (int ai = 0; ai < 2; ++ai)
#pragma unroll
                for (int m = 0; m < 4; ++m) {
                    const int row = row0 + ai * 128 + m * 16, pos = row % SEQ;
                    f32x4 c0v = {1.f, 1.f, 1.f, 1.f}, c1v = c0v, s0v = {0.f, 0.f, 0.f, 0.f}, s1v = s0v;
                    if (rot) { const f32x4* rp = (const f32x4*)(rope + pos * 16); c0v = rp[0]; c1v = rp[1]; s0v = rp[2]; s1v = rp[3]; }
#pragma unroll
                    for (int bj = 0; bj < 2; ++bj) { f32x4 v0 = acc[ai][bj][m][0], v1 = acc[ai][bj][m][1];
                        if (rot) { f32x4 p0, p1;
#pragma unroll
                            for (int i = 0; i < 4; ++i) { p0[i] = __shfl_xor(v0[i], 16); p1[i] = __shfl_xor(v1[i], 16); }
                            if (fq == 0) { v0 = v0 * c0v - p0 * s0v; v1 = v1 * c1v - p1 * s1v; } else if (fq == 1) { v0 = p0 * s0v + v0 * c0v; v1 = p1 * s1v + v1 * c1v; } }
                        if (isq) { v0 = v0 * C2; v1 = v1 * C2; } else {
#pragma unroll
                            for (int i = 0; i < 4; ++i) { cs[bj][i] += v0[i]; cs[bj][4 + i] += v1[i]; } }
                        u32x4 w; w.x = cvt_pk_bf16(v0[0], v0[1]); w.y = cvt_pk_bf16(v0[2], v0[3]); w.z = cvt_pk_bf16(v1[0], v1[1]); w.w = cvt_pk_bf16(v1[2], v1[3]);
                        *(u32x4*)(O + (size_t)row * 512 + c0 + bj * 128) = w; }
                }
            if (!isq) {
                const int b = u.pm / NBLK, blk = u.pm % NBLK;
#pragma unroll
                for (int bj = 0; bj < 2; ++bj)
#pragma unroll
                    for (int i = 0; i < 8; ++i) { float s = cs[bj][i]; s += __shfl_xor(s, 1); s += __shfl_xor(s, 2); s += __shfl_xor(s, 4); s += __shfl_xor(s, 8);
                        if (fr == 0) { const int head = (pn & 1) * 4 + bj * 2 + (wc >> 1), d = (wc & 1) * 32 + 8 * fq + i; atomicAdd(ksum + ((size_t)(b * NH + head) * NBLK + blk) * HD + d, s); } }
            }
        } else {
            const int c0 = (pn - 8) * 256 + wc * 32 + 8 * fq;
#pragma unroll
            for (int ai = 0; ai < 2; ++ai)
#pragma unroll
                for (int m = 0; m < 4; ++m)
#pragma unroll
                    for (int bj = 0; bj < 2; ++bj) { const f32x4 v0 = acc[ai][bj][m][0], v1 = acc[ai][bj][m][1]; u32x4 w;
                        w.x = cvt_pk_bf16(fast_sigmoid(v0[0]), fast_sigmoid(v0[1])); w.y = cvt_pk_bf16(fast_sigmoid(v0[2]), fast_sigmoid(v0[3]));
                        w.z = cvt_pk_bf16(fast_sigmoid(v1[0]), fast_sigmoid(v1[1])); w.w = cvt_pk_bf16(fast_sigmoid(v1[2]), fast_sigmoid(v1[3]));
                        *(u32x4*)(G + (size_t)(row0 + ai * 128 + m * 16) * 2048 + c0 + bj * 128) = w; }
        }
    }
};
template <int PASS> struct EpiMerge {
    static constexpr bool PERM = true, AFTER_DRAIN = false;
    bf16* Mg; const bf16* G;
    __device__ __forceinline__ void operator()(const f32x4 (&acc)[2][2][4][2], const pg8::Unit& u, int wr, int wc, int fr, int fq) const {
        const int row0 = u.pm * 256 + wr * 64 + fr, c0 = u.pn * 256 + wc * 32 + 8 * fq;
#pragma unroll
        for (int ai = 0; ai < 2; ++ai)
#pragma unroll
            for (int m = 0; m < 4; ++m)
#pragma unroll
                for (int bj = 0; bj < 2; ++bj) { const size_t row = (size_t)(row0 + ai * 128 + m * 16); const int col = c0 + bj * 128;
                    const u32x4 gw = *(const u32x4*)(G + row * 2048 + PASS * 1024 + col); const f32x4 v0 = acc[ai][bj][m][0], v1 = acc[ai][bj][m][1];
                    float o[8] = {bflo(gw.x) * v0[0], bfhi(gw.x) * v0[1], bflo(gw.y) * v0[2], bfhi(gw.y) * v0[3], bflo(gw.z) * v1[0], bfhi(gw.z) * v1[1], bflo(gw.w) * v1[2], bfhi(gw.w) * v1[3]};
                    if (PASS == 1) { const u32x4 pw = *(const u32x4*)(Mg + row * 1024 + col);
                        o[0] += bflo(pw.x); o[1] += bfhi(pw.x); o[2] += bflo(pw.y); o[3] += bfhi(pw.y); o[4] += bflo(pw.z); o[5] += bfhi(pw.z); o[6] += bflo(pw.w); o[7] += bfhi(pw.w); }
                    u32x4 w; w.x = cvt_pk_bf16(o[0], o[1]); w.y = cvt_pk_bf16(o[2], o[3]); w.z = cvt_pk_bf16(o[4], o[5]); w.w = cvt_pk_bf16(o[6], o[7]);
                    *(u32x4*)(Mg + row * 1024 + col) = w; }
    }
};
struct EpiRes1 {
    static constexpr bool PERM = false, AFTER_DRAIN = false;
    const float* x; const float* mod; float* x1;
    __device__ __forceinline__ void operator()(const f32x4 (&acc)[2][2][4][2], const pg8::Unit& u, int wr, int wc, int fr, int fq) const {
        const int row0 = u.pm * 256 + wr * 64 + fr, c0 = u.pn * 256 + wc * 32 + 4 * fq, b = u.pm / NBLK;
#pragma unroll
        for (int bj = 0; bj < 2; ++bj)
#pragma unroll
            for (int n = 0; n < 2; ++n) { const int col = c0 + bj * 128 + n * 16; const f32x4 gv = *(const f32x4*)(mod + b * 6144 + 2 * D + col);
#pragma unroll
                for (int ai = 0; ai < 2; ++ai)
#pragma unroll
                    for (int m = 0; m < 4; ++m) { const size_t off = (size_t)(row0 + ai * 128 + m * 16) * D + col; *(f32x4*)(x1 + off) = *(const f32x4*)(x + off) + gv * acc[ai][bj][m][n]; } }
    }
};
struct EpiBf16 {
    static constexpr bool PERM = true, AFTER_DRAIN = false;
    bf16* O; int ldo;
    __device__ __forceinline__ void operator()(const f32x4 (&acc)[2][2][4][2], const pg8::Unit& u, int wr, int wc, int fr, int fq) const {
        const int row0 = u.pm * 256 + wr * 64 + fr, c0 = u.pn * 256 + wc * 32 + 8 * fq;
#pragma unroll
        for (int ai = 0; ai < 2; ++ai)
#pragma unroll
            for (int m = 0; m < 4; ++m)
#pragma unroll
                for (int bj = 0; bj < 2; ++bj) { const f32x4 v0 = acc[ai][bj][m][0], v1 = acc[ai][bj][m][1]; u32x4 w;
                    w.x = cvt_pk_bf16(v0[0], v0[1]); w.y = cvt_pk_bf16(v0[2], v0[3]); w.z = cvt_pk_bf16(v1[0], v1[1]); w.w = cvt_pk_bf16(v1[2], v1[3]);
                    *(u32x4*)(O + (size_t)(row0 + ai * 128 + m * 16) * ldo + c0 + bj * 128) = w; }
    }
};

namespace att {
typedef short v4i16_t __attribute__((ext_vector_type(4)));
typedef float f32x16 __attribute__((ext_vector_type(16)));
constexpr int KB_BYTES = 8192, VROW = 192, VB_BYTES = 64 * VROW, OFF_V = 2 * KB_BYTES, OFF_MISC = OFF_V + 2 * VB_BYTES;
__device__ __forceinline__ int crow(int r, int hi) { return (r & 3) + 8 * (r >> 2) + 4 * hi; }
__device__ __forceinline__ float bfe(bf16x8 v, int j) { return __uint_as_float(((unsigned)(unsigned short)v[j]) << 16); }
__device__ __forceinline__ void attn_phase(LAS unsigned char* lds, const bf16* Q, const bf16* Kb, const bf16* V, const float* ksum, bf16* ATT, int G, int bid) {
    int tid_ = threadIdx.x; asm volatile("" : "+v"(tid_));
    const int tid = tid_, lane = tid & 63, wid = __builtin_amdgcn_readfirstlane(tid >> 6), r32 = lane & 31, hi = lane >> 5;
    const int vcu = (G % 8 == 0) ? (bid % 8) * (G / 8) + bid / 8 : bid;
    LAS unsigned char* Kbuf = lds; LAS unsigned char* Vbuf = lds + OFF_V; LAS int* misc = (LAS int*)(lds + OFF_MISC);
    const int ld_row = tid >> 3, ld_ch = tid & 7;
    const int kst = ld_row * 128 + ((ld_ch ^ ((ld_row >> 1) & 7)) << 4), vst = ld_row * VROW + ld_ch * 16;
    for (int uidx = vcu; uidx < 512; uidx += G) {
        const int bh = (uidx & 255) >> 4, s_ = uidx & 15, qb = uidx < 256 ? s_ : 31 - s_, b = bh >> 3, h = bh & 7;
        const int q_off = wid * 32 + r32; const size_t qrow = (size_t)b * SEQ + qb * 256 + q_off;
        bf16x8 qr[4];
#pragma unroll
        for (int s = 0; s < 4; ++s) qr[s] = *(const bf16x8*)(Q + qrow * 512 + h * 64 + 16 * s + 8 * hi);
        unsigned selmask = 0u;
        { int s0 = -1, s1 = -1, s2 = -1; float g0 = -INFINITY, g1 = -INFINITY, g2 = -INFINITY;
          const float* ksb = ksum + (size_t)(b * NH + h) * NBLK * HD + 8 * hi;
          for (int j = 0; j < qb; ++j) { float part = 0.f;
#pragma unroll
              for (int s = 0; s < 4; ++s) { const f32x4 k0 = *(const f32x4*)(ksb + j * HD + 16 * s), k1 = *(const f32x4*)(ksb + j * HD + 16 * s + 4);
                  part += bfe(qr[s], 0) * k0[0] + bfe(qr[s], 1) * k0[1] + bfe(qr[s], 2) * k0[2] + bfe(qr[s], 3) * k0[3] + bfe(qr[s], 4) * k1[0] + bfe(qr[s], 5) * k1[1] + bfe(qr[s], 6) * k1[2] + bfe(qr[s], 7) * k1[3]; }
              const float g = part + __shfl_xor(part, 32);
              if (g > g0) { g2 = g1; s2 = s1; g1 = g0; s1 = s0; g0 = g; s0 = j; } else if (g > g1) { g2 = g1; s2 = s1; g1 = g; s1 = j; } else if (g > g2) { g2 = g; s2 = j; } }
          if (s0 >= 0) selmask |= 1u << s0; if (s1 >= 0) selmask |= 1u << s1; if (s2 >= 0) selmask |= 1u << s2; }
        { unsigned um = selmask;
#pragma unroll
          for (int o = 1; o < 64; o <<= 1) um |= (unsigned)__shfl_xor((int)um, o);
          if (lane == 0) misc[wid] = (int)um; }
        __syncthreads();
        if (tid == 0) { unsigned uni = 0u; for (int w = 0; w < 8; ++w) uni |= (unsigned)misc[w]; int nb = 1; misc[16] = qb; while (uni) { misc[16 + nb] = __builtin_ctz(uni); uni &= uni - 1u; ++nb; } misc[8] = nb; }
        __syncthreads();
        const int ntiles = misc[8] * 4;
        const bf16* Kg = Kb + ((size_t)b * SEQ) * 512 + h * 64 + ld_ch * 8; const bf16* Vg = V + ((size_t)b * SEQ) * 512 + h * 64 + ld_ch * 8;
        u32x4 kreg, vreg;
        { const int jb0 = misc[16]; const size_t ro = (size_t)(jb0 * 256 + ld_row) * 512; kreg = *(const u32x4*)(Kg + ro); vreg = *(const u32x4*)(Vg + ro); }
        *(LAS u32x4*)(Kbuf + kst) = kreg; *(LAS u32x4*)(Vbuf + vst) = vreg;
        __syncthreads();
        float mrun = -INFINITY, lsum = 0.f; f32x16 o0 = {}, o1 = {};
        for (int n = 0; n < ntiles; ++n) {
            const int jb = misc[16 + (n >> 2)], tt = n & 3; const bool own = n < 4;
            if (n + 1 < ntiles) { const int jn = misc[16 + ((n + 1) >> 2)]; const size_t ro = (size_t)(jn * 256 + ((n + 1) & 3) * 64 + ld_row) * 512; kreg = *(const u32x4*)(Kg + ro); vreg = *(const u32x4*)(Vg + ro); }
            const bool lane_valid = own || ((selmask >> jb) & 1u);
            const bool need = own ? (64 * tt <= 32 * wid + 31) : (__any(lane_valid ? 1 : 0) != 0);
            if (need) {
                const LAS unsigned char* kb_ = Kbuf + (n & 1) * KB_BYTES; const LAS unsigned char* vb_ = Vbuf + (n & 1) * VB_BYTES;
                f32x16 p0 = {}, p1 = {};
#pragma unroll
                for (int s = 0; s < 4; ++s) { const int c = 2 * s + hi; const int sw = ((c ^ ((r32 >> 1) & 7)) << 4);
                    const bf16x8 a0 = *(const LAS bf16x8*)(kb_ + r32 * 128 + sw), a1 = *(const LAS bf16x8*)(kb_ + (32 + r32) * 128 + sw);
                    p0 = __builtin_amdgcn_mfma_f32_32x32x16_bf16(a0, qr[s], p0, 0, 0, 0); p1 = __builtin_amdgcn_mfma_f32_32x32x16_bf16(a1, qr[s], p1, 0, 0, 0); }
                if (own) {
#pragma unroll
                    for (int r = 0; r < 16; ++r) { const int ko = tt * 64 + crow(r, hi); if (ko > q_off) p0[r] = -INFINITY; if (ko + 32 > q_off) p1[r] = -INFINITY; }
                } else if (!lane_valid) {
#pragma unroll
                    for (int r = 0; r < 16; ++r) { p0[r] = -INFINITY; p1[r] = -INFINITY; }
                }
                float mt = fmaxf(p0[0], p1[0]);
#pragma unroll
                for (int r = 1; r < 16; ++r) mt = fmaxf(mt, fmaxf(p0[r], p1[r]));
                mt = fmaxf(mt, __shfl_xor(mt, 32));
                const float mnew = fmaxf(mrun, mt), alpha = __builtin_amdgcn_exp2f(mrun - mnew); mrun = mnew;
                float ps = 0.f;
#pragma unroll
                for (int r = 0; r < 16; ++r) { p0[r] = __builtin_amdgcn_exp2f(p0[r] - mnew); p1[r] = __builtin_amdgcn_exp2f(p1[r] - mnew); ps += p0[r] + p1[r]; }
                lsum = lsum * alpha + ps;
                if (!__all(alpha == 1.f ? 1 : 0)) {
#pragma unroll
                    for (int r = 0; r < 16; ++r) { o0[r] *= alpha; o1[r] *= alpha; } }
                bf16x8 pb[2][2];
#pragma unroll
                for (int s2 = 0; s2 < 2; ++s2) { u32x4 w0, w1;
                    w0.x = cvt_pk_bf16(p0[8 * s2], p0[8 * s2 + 1]); w0.y = cvt_pk_bf16(p0[8 * s2 + 2], p0[8 * s2 + 3]); w0.z = cvt_pk_bf16(p0[8 * s2 + 4], p0[8 * s2 + 5]); w0.w = cvt_pk_bf16(p0[8 * s2 + 6], p0[8 * s2 + 7]);
                    w1.x = cvt_pk_bf16(p1[8 * s2], p1[8 * s2 + 1]); w1.y = cvt_pk_bf16(p1[8 * s2 + 2], p1[8 * s2 + 3]); w1.z = cvt_pk_bf16(p1[8 * s2 + 4], p1[8 * s2 + 5]); w1.w = cvt_pk_bf16(p1[8 * s2 + 6], p1[8 * s2 + 7]);
                    pb[0][s2] = __builtin_bit_cast(bf16x8, w0); pb[1][s2] = __builtin_bit_cast(bf16x8, w1); }
                const LAS unsigned char* vl = vb_ + (4 * hi + ((lane & 15) >> 2)) * VROW + (16 * ((lane >> 4) & 1) + 4 * (lane & 3)) * 2;
#pragma unroll
                for (int dt = 0; dt < 2; ++dt)
#pragma unroll
                    for (int u = 0; u < 2; ++u)
#pragma unroll
                        for (int s2 = 0; s2 < 2; ++s2) { const LAS unsigned char* va = vl + (32 * u + 16 * s2) * VROW + dt * 64;
                            const v4i16_t lo = __builtin_amdgcn_ds_read_tr16_b64_v4i16((LAS v4i16_t*)va), hh = __builtin_amdgcn_ds_read_tr16_b64_v4i16((LAS v4i16_t*)(va + 8 * VROW));
                            const bf16x8 vf = {lo[0], lo[1], lo[2], lo[3], hh[0], hh[1], hh[2], hh[3]};
                            if (dt == 0) o0 = __builtin_amdgcn_mfma_f32_32x32x16_bf16(vf, pb[u][s2], o0, 0, 0, 0); else o1 = __builtin_amdgcn_mfma_f32_32x32x16_bf16(vf, pb[u][s2], o1, 0, 0, 0); }
            }
            if (n + 1 < ntiles) { *(LAS u32x4*)(Kbuf + ((n + 1) & 1) * KB_BYTES + kst) = kreg; *(LAS u32x4*)(Vbuf + ((n + 1) & 1) * VB_BYTES + vst) = vreg; }
            __syncthreads();
        }
        const float inv = 1.f / (lsum + __shfl_xor(lsum, 32));
        bf16* orow = ATT + qrow * 512 + h * 64 + 4 * hi;
#pragma unroll
        for (int g4 = 0; g4 < 4; ++g4) { u32x2 w;
            w.x = cvt_pk_bf16(o0[4 * g4] * inv, o0[4 * g4 + 1] * inv); w.y = cvt_pk_bf16(o0[4 * g4 + 2] * inv, o0[4 * g4 + 3] * inv); *(u32x2*)(orow + 8 * g4) = w;
            w.x = cvt_pk_bf16(o1[4 * g4] * inv, o1[4 * g4 + 1] * inv); w.y = cvt_pk_bf16(o1[4 * g4 + 2] * inv, o1[4 * g4 + 3] * inv); *(u32x2*)(orow + 32 + 8 * g4) = w; }
    }
}
}

__device__ __forceinline__ float dot2bf(unsigned a, unsigned b, float acc) { return __builtin_amdgcn_fdot2_f32_bf16(__builtin_bit_cast(bf16x2_t, a), __builtin_bit_cast(bf16x2_t, b), acc, false); }
__device__ __forceinline__ void d_tab_bf16(const float* T, bf16* O) {
    GSTRIDE(i, (size_t)NEXP * D / 8) { const f32x4 a = ((const f32x4*)T)[2 * i], b = ((const f32x4*)T)[2 * i + 1]; u32x4 w;
        w.x = cvt_pk_bf16(a[0], a[1]); w.y = cvt_pk_bf16(a[2], a[3]); w.z = cvt_pk_bf16(b[0], b[1]); w.w = cvt_pk_bf16(b[2], b[3]); ((u32x4*)O)[i] = w; }
}
__device__ __forceinline__ void peer_phase(const bf16* H2, const int* EID, const float* EG, const bf16* UT, const bf16* VT, const float* mod, const float* gfin, const float* x1, float* outp) {
    int tid_ = threadIdx.x; asm volatile("" : "+v"(tid_));
    const int lane = tid_ & 63, wv = tid_ >> 6;
    for (int t = blockIdx.x * (NT / 64) + wv; t < M; t += gridDim.x * (NT / 64)) {
        const int b = t / SEQ;
        const u32x4 h0 = *(const u32x4*)(H2 + (size_t)t * D + 8 * lane), h1 = *(const u32x4*)(H2 + (size_t)t * D + 512 + 8 * lane);
        const int e0 = EID[(size_t)t * NSEL + lane], e1 = EID[(size_t)t * NSEL + 64 + lane]; const float gg0 = EG[(size_t)t * NSEL + lane], gg1 = EG[(size_t)t * NSEL + 64 + lane];
        float acc[16];
#pragma unroll
        for (int i = 0; i < 16; ++i) acc[i] = 0.f;
#pragma unroll 1
        for (int kb = 0; kb < NSEL; kb += 8) {
            u32x4 ua[8], ub[8], va[8], vb[8];
#pragma unroll
            for (int j = 0; j < 8; ++j) { const int k = kb + j; const int eid = __builtin_amdgcn_readlane(k < 64 ? e0 : e1, k & 63);
                const bf16* ur = UT + (size_t)eid * D + 8 * lane; const bf16* vr = VT + (size_t)eid * D + 8 * lane;
                ua[j] = *(const u32x4*)ur; ub[j] = *(const u32x4*)(ur + 512); va[j] = *(const u32x4*)vr; vb[j] = *(const u32x4*)(vr + 512); }
            float d[8];
#pragma unroll
            for (int j = 0; j < 8; ++j) { float a = 0.f; a = dot2bf(ua[j].x, h0.x, a); a = dot2bf(ua[j].y, h0.y, a); a = dot2bf(ua[j].z, h0.z, a); a = dot2bf(ua[j].w, h0.w, a);
                a = dot2bf(ub[j].x, h1.x, a); a = dot2bf(ub[j].y, h1.y, a); a = dot2bf(ub[j].z, h1.z, a); a = dot2bf(ub[j].w, h1.w, a); d[j] = a; }
            float r4[4], r2[2], r1;
            { const bool up = (lane & 32) != 0;
#pragma unroll
              for (int j = 0; j < 4; ++j) { const float snd = up ? d[j] : d[j + 4], kp = up ? d[j + 4] : d[j]; r4[j] = kp + __shfl_xor(snd, 32); } }
            { const bool up = (lane & 16) != 0;
#pragma unroll
              for (int j = 0; j < 2; ++j) { const float snd = up ? r4[j] : r4[j + 2], kp = up ? r4[j + 2] : r4[j]; r2[j] = kp + __shfl_xor(snd, 16); } }
            { const bool up = (lane & 8) != 0; const float snd = up ? r2[0] : r2[1], kp = up ? r2[1] : r2[0]; r1 = kp + __shfl_xor(snd, 8); }
            r1 += __shfl_xor(r1, 4); r1 += __shfl_xor(r1, 2); r1 += __shfl_xor(r1, 1);
            const float ge = 0.5f * r1 * (1.f + erff(r1 * 0.70710678118654752f));
#pragma unroll
            for (int j = 0; j < 8; ++j) { const int k = kb + j; const float gk = __uint_as_float(__builtin_amdgcn_readlane(__float_as_uint(k < 64 ? gg0 : gg1), k & 63));
                const float w = gk * __uint_as_float(__builtin_amdgcn_readlane(__float_as_uint(ge), ((j & 4) ? 32 : 0) + ((j & 2) ? 16 : 0) + ((j & 1) ? 8 : 0)));
                acc[0] += w * bflo(va[j].x); acc[1] += w * bfhi(va[j].x); acc[2] += w * bflo(va[j].y); acc[3] += w * bfhi(va[j].y); acc[4] += w * bflo(va[j].z); acc[5] += w * bfhi(va[j].z); acc[6] += w * bflo(va[j].w); acc[7] += w * bfhi(va[j].w);
                acc[8] += w * bflo(vb[j].x); acc[9] += w * bfhi(vb[j].x); acc[10] += w * bflo(vb[j].y); acc[11] += w * bfhi(vb[j].y); acc[12] += w * bflo(vb[j].z); acc[13] += w * bfhi(vb[j].z); acc[14] += w * bflo(vb[j].w); acc[15] += w * bfhi(vb[j].w); }
        }
        float ss = 0.f;
#pragma unroll
        for (int c = 0; c < 2; ++c)
#pragma unroll
            for (int q4 = 0; q4 < 2; ++q4) { const int col = c * 512 + 8 * lane + 4 * q4; const f32x4 xv = *(const f32x4*)(x1 + (size_t)t * D + col), gv = *(const f32x4*)(mod + b * 6144 + 5 * D + col);
#pragma unroll
                for (int e = 0; e < 4; ++e) { const float x2 = xv[e] + gv[e] * acc[c * 8 + q4 * 4 + e]; acc[c * 8 + q4 * 4 + e] = x2; ss += x2 * x2; } }
#pragma unroll
        for (int o = 1; o < 64; o <<= 1) ss += __shfl_xor(ss, o);
        const float r = rsqrtf(ss * (1.f / D) + EPS);
#pragma unroll
        for (int c = 0; c < 2; ++c)
#pragma unroll
            for (int q4 = 0; q4 < 2; ++q4) { const int col = c * 512 + 8 * lane + 4 * q4; const f32x4 gf = *(const f32x4*)(gfin + col); f32x4 o;
#pragma unroll
                for (int e = 0; e < 4; ++e) o[e] = acc[c * 8 + q4 * 4 + e] * r * gf[e];
                *(f32x4*)(outp + (size_t)t * D + col) = o; }
    }
}

__device__ __forceinline__ void d_skbd(const float* sk, bf16* SKBD) {
    GSTRIDE(idx, 2048 * 256) { const int n = (int)idx >> 8, kk = (int)idx & 255, p = (n >> 7) & 1; SKBD[idx] = ((kk >> 7) == p) ? f2bf(sk[(size_t)n * 128 + (kk & 127)]) : (bf16)0; }
}
__device__ __forceinline__ unsigned f2sort(float f) { const unsigned b = __float_as_uint(f); return b ^ ((unsigned)((int)b >> 31) | 0x80000000u); }
__device__ __forceinline__ float sort2f(unsigned k) { return __uint_as_float(k ^ (((k >> 31) - 1u) | 0x80000000u)); }
struct EpiRoute {
    static constexpr bool PERM = false, AFTER_DRAIN = true;
    int* EID; float* EG;
    __device__ __forceinline__ void fused(f32x4 (&acc)[2][2][4][2], const pg8::Unit& u, int wr, int wc, int fr_, int fq_, LAS unsigned char* lds, int wid, int lane_) const {
        int lane = lane_; asm volatile("" : "+v"(lane));
        const int fr = lane & 15, fq = lane >> 4;
        constexpr int RS = 257; LAS float* S = (LAS float*)lds; LAS unsigned char* tab = lds + 128 * RS * 4 + ((wid & 3) * 64 + lane) * 32;
#pragma unroll
        for (int ai = 0; ai < 2; ++ai) {
#pragma unroll
            for (int bj = 0; bj < 2; ++bj)
#pragma unroll
                for (int m = 0; m < 4; ++m)
#pragma unroll
                    for (int n = 0; n < 2; ++n) { LAS float* sp = S + (64 * wr + 16 * m + fr) * RS + 128 * bj + 32 * wc + 16 * n + 4 * fq; const f32x4 v = acc[ai][bj][m][n]; sp[0] = v[0]; sp[1] = v[1]; sp[2] = v[2]; sp[3] = v[3]; }
            __syncthreads();
            if (wid < 4) {
                const int rl = 32 * wid + (lane & 31), p = lane >> 5; const LAS float* sp = S + rl * RS + 128 * p;
                unsigned top[16];
#pragma unroll
                for (int j = 0; j < 16; ++j) top[j] = 0u;
#pragma unroll 8
                for (int n = 0; n < 128; ++n) { unsigned key = (f2sort(sp[n]) & ~0x7Fu) | (unsigned)n;
#pragma unroll
                    for (int j = 0; j < 16; ++j) { const unsigned hi_ = max(top[j], key); key = min(top[j], key); top[j] = hi_; } }
                float af[16], bf_[16]; unsigned ia[4] = {0u, 0u, 0u, 0u}, ib[4] = {0u, 0u, 0u, 0u};
#pragma unroll
                for (int j = 0; j < 16; ++j) { const unsigned oth = (unsigned)__shfl_xor((int)top[j], 32); const unsigned ka = p ? oth : top[j], kb = p ? top[j] : oth;
                    af[j] = sort2f(ka & ~0x7Fu); bf_[j] = sort2f(kb & ~0x7Fu); ia[j >> 2] |= (ka & 0x7Fu) << (8 * (j & 3)); ib[j >> 2] |= (kb & 0x7Fu) << (8 * (j & 3)); }
                *(LAS u32x4*)tab = (u32x4){ia[0], ia[1], ia[2], ia[3]}; *(LAS u32x4*)(tab + 16) = (u32x4){ib[0], ib[1], ib[2], ib[3]};
                unsigned ct[16];
#pragma unroll
                for (int j = 0; j < 16; ++j) ct[j] = 0u;
#pragma unroll
                for (int i = 0; i < 16; ++i)
#pragma unroll
                    for (int j2 = 0; j2 < 16; ++j2) if ((i + 1) * (j2 + 1) <= 16) { unsigned key = (f2sort(af[i] + bf_[j2]) & ~0xFFu) | (unsigned)(i * 16 + j2);
#pragma unroll
                        for (int j = 0; j < 16; ++j) { const unsigned hi_ = max(ct[j], key); key = min(ct[j], key); ct[j] = hi_; } }
                asm volatile("s_waitcnt lgkmcnt(0)" ::: "memory");
                int eid[16]; float ev[16]; float sum = 0.f; const float v0 = sort2f(ct[0] & ~0xFFu);
#pragma unroll
                for (int k = 0; k < 16; ++k) { const unsigned code = ct[k] & 0xFFu; const int i_a = tab[code >> 4], i_b = tab[16 + (code & 15u)]; eid[k] = i_a * NKEYS + i_b;
                    ev[k] = __builtin_amdgcn_exp2f((sort2f(ct[k] & ~0xFFu) - v0) * 1.4426950408889634f); sum += ev[k]; }
                const float is = 1.f / sum; const size_t ob = (size_t)(u.pm * 256 + 128 * ai + rl) * NSEL + u.pn * 16 + 8 * p;
                u32x4 e0, e1; f32x4 g0, g1;
                e0.x = p ? eid[8] : eid[0]; e0.y = p ? eid[9] : eid[1]; e0.z = p ? eid[10] : eid[2]; e0.w = p ? eid[11] : eid[3]; e1.x = p ? eid[12] : eid[4]; e1.y = p ? eid[13] : eid[5]; e1.z = p ? eid[14] : eid[6]; e1.w = p ? eid[15] : eid[7];
                g0[0] = (p ? ev[8] : ev[0]) * is; g0[1] = (p ? ev[9] : ev[1]) * is; g0[2] = (p ? ev[10] : ev[2]) * is; g0[3] = (p ? ev[11] : ev[3]) * is; g1[0] = (p ? ev[12] : ev[4]) * is; g1[1] = (p ? ev[13] : ev[5]) * is; g1[2] = (p ? ev[14] : ev[6]) * is; g1[3] = (p ? ev[15] : ev[7]) * is;
                *(u32x4*)(EID + ob) = e0; *(u32x4*)(EID + ob + 4) = e1; *(f32x4*)(EG + ob) = g0; *(f32x4*)(EG + ob + 4) = g1;
            }
            __syncthreads();
        }
    }
};
__device__ __forceinline__ void route_phase(LAS unsigned char* lds, const bf16* QP, const bf16* SKBD, int* EID, float* EG, int G, int bid) {
    pg8::Gemm g{QP, SKBD, M, 2048, 256, 2048, 256}; pg8::StaticOrder S; S.init(M, 2048, G, bid); EpiRoute E{EID, EG}; pg8::OneUnit O;
    for (int i = 0; S.next(i, O.u); ++i) pg8::gemm_phase<EpiRoute, pg8::OneUnit, false>(lds, g, O, E);
}
__device__ __forceinline__ void d_route_summary(const int* EID, const float* EG, float* SUMM) {
    GSTRIDE(idx, M * PHEADS) { float s1 = 0.f, s2 = 0.f; for (int k = 0; k < 16; ++k) { const int e = EID[idx * 16 + k]; const float gk = EG[idx * 16 + k]; s1 += gk * (float)(e % 1021) * (1.f / 1021.f); s2 += gk * (float)e * (1.f / 16384.f); } SUMM[idx * 2] = s1; SUMM[idx * 2 + 1] = s2; }
}

constexpr int MOD_KS = 16;
__device__ __forceinline__ void p0_mod_partials(const float* c, const float* w_ada, float* MODP) {
    const int lane = threadIdx.x & 63, gw = blockIdx.x * (NT / 64) + (threadIdx.x >> 6), ngw = gridDim.x * (NT / 64);
    for (int it = gw; it < 96 * MOD_KS; it += ngw) {
        const int cg_ = it % 96, ks = it / 96, j = cg_ * 64 + lane, k0 = ks * 64;
        const float c0 = c[k0 + lane], c1 = c[D + k0 + lane]; const float a0 = c0 / (1.f + __expf(-c0)), a1 = c1 / (1.f + __expf(-c1));
        float acc0 = 0.f, acc1 = 0.f;
#pragma unroll 16
        for (int k = 0; k < 64; ++k) { const float w = w_ada[(size_t)(k0 + k) * 6144 + j];
            acc0 += __uint_as_float(__builtin_amdgcn_readlane(__float_as_uint(a0), k)) * w; acc1 += __uint_as_float(__builtin_amdgcn_readlane(__float_as_uint(a1), k)) * w; }
        MODP[(size_t)(ks * 2) * 6144 + j] = acc0; MODP[(size_t)(ks * 2 + 1) * 6144 + j] = acc1;
    }
}
__device__ __forceinline__ float mod_reduce(const float* MODP, const float* b_ada, int idx) {
    float s = b_ada[idx % 6144];
#pragma unroll
    for (int ks = 0; ks < MOD_KS; ++ks) s += MODP[(size_t)ks * 2 * 6144 + idx];
    return s;
}
__device__ __forceinline__ void p0_transpose_item(const float* W, int K, int N, bf16* WT, LAS float* scr, int item, int lane) {
    const int nblk = N / 32, kb = item / nblk, nb = item % nblk, k0 = 64 * kb, n0 = 32 * nb;
#pragma unroll 8
    for (int i = 0; i < 32; ++i) { const int kk = 2 * i + (lane >> 5); scr[kk * 33 + (lane & 31)] = W[(size_t)(k0 + kk) * N + n0 + (lane & 31)]; }
    asm volatile("s_waitcnt lgkmcnt(0)" ::: "memory");
    const int cch = lane & 7;
#pragma unroll
    for (int j = 0; j < 4; ++j) { const int n = (lane >> 3) + 8 * j; const LAS float* sp = scr + (8 * cch) * 33 + n;
        u32x4 o; o.x = cvt_pk_bf16(sp[0 * 33], sp[1 * 33]); o.y = cvt_pk_bf16(sp[2 * 33], sp[3 * 33]); o.z = cvt_pk_bf16(sp[4 * 33], sp[5 * 33]); o.w = cvt_pk_bf16(sp[6 * 33], sp[7 * 33]);
        *(u32x4*)(WT + (size_t)(n0 + n) * K + k0 + 8 * cch) = o; }
    asm volatile("s_waitcnt lgkmcnt(0)" ::: "memory");
}
__device__ __forceinline__ void p0_transposes(LAS unsigned char* lds, const float* w_in, const float* w_ba, const float* w_out, const float* wq, bf16* W_IN_T, bf16* WBA_T, bf16* WOUT_T, bf16* WQ_T) {
    const int lane = threadIdx.x & 63, wv = threadIdx.x >> 6, gw = blockIdx.x * (NT / 64) + wv, ngw = gridDim.x * (NT / 64);
    LAS float* scr = (LAS float*)(lds + wv * 16384);
    constexpr int I_IN = (1024 / 64) * (4096 / 32), I_BA = (512 / 64) * (1024 / 32), I_OUT = (1024 / 64) * (1024 / 32), I_Q = (1024 / 64) * (2048 / 32);
    for (int it = gw; it < I_IN + I_BA + I_OUT + I_Q; it += ngw) { int r = it;
        if (r < I_IN) { p0_transpose_item(w_in, 1024, 4096, W_IN_T, scr, r, lane); continue; } r -= I_IN;
        if (r < I_BA) { p0_transpose_item(w_ba, 512, 1024, WBA_T, scr, r, lane); continue; } r -= I_BA;
        if (r < I_OUT) { p0_transpose_item(w_out, 1024, 1024, WOUT_T, scr, r, lane); continue; } r -= I_OUT;
        p0_transpose_item(wq, 1024, 2048, WQ_T, scr, r, lane); }
}
__device__ __forceinline__ void p0_wc(const float* pool_w, const float* pool_scale, const float* w_bp, float* WCF) {
    const int lane = threadIdx.x & 63, gw = blockIdx.x * (NT / 64) + (threadIdx.x >> 6), ngw = gridDim.x * (NT / 64);
    for (int it = gw; it < 512 * 16; it += ngw) { const int k = it >> 4, o = (it & 15) * 64 + lane, g = k >> 7; float acc = 0.f;
        const float pw0 = pool_w[(size_t)k * 128 + lane] * pool_scale[g * 128 + lane], pw1 = pool_w[(size_t)k * 128 + 64 + lane] * pool_scale[g * 128 + 64 + lane];
#pragma unroll 16
        for (int j = 0; j < 64; ++j) acc += __uint_as_float(__builtin_amdgcn_readlane(__float_as_uint(pw0), j)) * w_bp[(size_t)(g * 128 + j) * 1024 + o];
#pragma unroll 16
        for (int j = 0; j < 64; ++j) acc += __uint_as_float(__builtin_amdgcn_readlane(__float_as_uint(pw1), j)) * w_bp[(size_t)(g * 128 + 64 + j) * 1024 + o];
        WCF[(size_t)k * 1024 + o] = acc; }
}
__device__ __forceinline__ void p1_wc_transpose(LAS unsigned char* lds, const float* WCF, bf16* WC_T) {
    const int lane = threadIdx.x & 63, wv = threadIdx.x >> 6, gw = blockIdx.x * (NT / 64) + wv, ngw = gridDim.x * (NT / 64);
    LAS float* scr = (LAS float*)(lds + wv * 16384);
    for (int it = gw; it < (512 / 64) * (1024 / 32); it += ngw) p0_transpose_item(WCF, 512, 1024, WC_T, scr, it, lane);
}
__device__ __forceinline__ void modulate_rows(const float* x, const float* g, const LAS float* mtab, bf16* outp) {
    const int lane = threadIdx.x & 63;
    for (int row = blockIdx.x * (NT / 64) + (threadIdx.x >> 6); row < M; row += gridDim.x * (NT / 64)) {
        const int b = row / SEQ; const f32x4* xr = (const f32x4*)(x + (size_t)row * D); f32x4 v[4]; float ss = 0.f;
#pragma unroll
        for (int j = 0; j < 4; ++j) { v[j] = xr[j * 64 + lane]; ss += v[j][0] * v[j][0] + v[j][1] * v[j][1] + v[j][2] * v[j][2] + v[j][3] * v[j][3]; }
#pragma unroll
        for (int o = 1; o < 64; o <<= 1) ss += __shfl_xor(ss, o);
        const float r = rsqrtf(ss * (1.f / D) + EPS);
#pragma unroll
        for (int j = 0; j < 4; ++j) { const int col = j * 256 + lane * 4; const f32x4 gv = *(const f32x4*)(g + col), sc = *(const LAS f32x4*)(mtab + b * 2048 + col), sh = *(const LAS f32x4*)(mtab + b * 2048 + 1024 + col);
            const f32x4 o = v[j] * r * gv * (sc + 1.f) + sh; u32x2 w; w.x = cvt_pk_bf16(o[0], o[1]); w.y = cvt_pk_bf16(o[2], o[3]); *(u32x2*)(outp + (size_t)row * D + col) = w; }
    }
}
__device__ __forceinline__ void fill_mtab_partials(LAS float* mtab, const float* MODP, const float* b_ada, int sh_off, int sc_off) {
    for (int i = threadIdx.x; i < 4096; i += NT) { const int b = i >> 11, which = (i >> 10) & 1, col = i & 1023; mtab[i] = mod_reduce(MODP, b_ada, b * 6144 + (which ? sh_off : sc_off) + col); }
    __syncthreads();
}
__device__ __forceinline__ void fill_mtab(LAS float* mtab, const float* MOD, int sh_off, int sc_off) {
    for (int i = threadIdx.x; i < 4096; i += NT) { const int b = i >> 11, which = (i >> 10) & 1, col = i & 1023; mtab[i] = MOD[b * 6144 + (which ? sh_off : sc_off) + col]; }
    __syncthreads();
}
__device__ __forceinline__ void pooldiff_fast(const bf16* UP, bf16* DIFF) {
    GSTRIDE(idx, (size_t)M * 64) { const int ch = (int)(idx & 63), row = (int)(idx >> 6), pos = row % SEQ, w = 2 << (ch >> 4), cnt = pos + 1 < w ? pos + 1 : w; float sacc[8];
#pragma unroll
        for (int e = 0; e < 8; ++e) sacc[e] = 0.f;
        u32x4 own;
        for (int i = 0; i < cnt; ++i) { const u32x4 v = *(const u32x4*)(UP + (size_t)(row - i) * 512 + ch * 8); if (i == 0) own = v;
            sacc[0] += bflo(v.x); sacc[1] += bfhi(v.x); sacc[2] += bflo(v.y); sacc[3] += bfhi(v.y); sacc[4] += bflo(v.z); sacc[5] += bfhi(v.z); sacc[6] += bflo(v.w); sacc[7] += bfhi(v.w); }
        const float ic = 1.f / (float)cnt; u32x4 o;
        o.x = cvt_pk_bf16(sacc[0] * ic - bflo(own.x), sacc[1] * ic - bfhi(own.x)); o.y = cvt_pk_bf16(sacc[2] * ic - bflo(own.y), sacc[3] * ic - bfhi(own.y));
        o.z = cvt_pk_bf16(sacc[4] * ic - bflo(own.z), sacc[5] * ic - bfhi(own.z)); o.w = cvt_pk_bf16(sacc[6] * ic - bflo(own.w), sacc[7] * ic - bfhi(own.w));
        *(u32x4*)(DIFF + (size_t)row * 512 + ch * 8) = o; }
}

#define XB_TMO      128
#define XB_XCNT(j)  (256  + 64 * (j))
#define XB_XSUB(j)  (1280 + 64 * (j))
#define XB_XGEN(j)  (2304 + 64 * (j))
#define XB_TOP      3328
#define XB_TOPGEN   3392
#define XCD_BAR_WORDS 3456
#define XB_SPIN_CAP (1u << 18)
__device__ __forceinline__ unsigned xb_ld(unsigned* p)              { return __hip_atomic_load(p, __ATOMIC_RELAXED, __HIP_MEMORY_SCOPE_AGENT); }
__device__ __forceinline__ unsigned xb_add(unsigned* p, unsigned v) { return __hip_atomic_fetch_add(p, v, __ATOMIC_RELAXED, __HIP_MEMORY_SCOPE_AGENT); }
__device__ __forceinline__ unsigned xb_xcc_id() { return (unsigned)__builtin_amdgcn_s_getreg((3 << 11) | 20) & 0xFu; }
#define XB_SPIN(cond, bar) do { unsigned _sp = 0; while (cond) { __builtin_amdgcn_s_sleep(1); \
    if ((++_sp & 255u) == 0u) { if (xb_ld(&(bar)[XB_TMO])) break; if (_sp > XB_SPIN_CAP) { atomicAdd(&(bar)[XB_TMO], 1u); break; } } } } while (0)
struct XcdBarrier { unsigned* bar; unsigned x; volatile LAS unsigned* st; };
__device__ __forceinline__ XcdBarrier xcd_barrier_post(unsigned* bar, volatile LAS unsigned* st) {
    XcdBarrier b; b.bar = bar; b.x = xb_xcc_id(); b.st = st;
    if (threadIdx.x == 0) (void)xb_add(&bar[XB_XCNT(b.x)], 1u);
    return b;
}
__device__ __forceinline__ void xcd_barrier_complete(unsigned* bar, unsigned x, unsigned& nloc, unsigned& nx) {
    const unsigned G = gridDim.x * gridDim.y * gridDim.z;
    unsigned sum, cnt, mine, sp = 0u;
    for (;;) {
        sum = 0u; cnt = 0u; mine = 0u;
#pragma unroll
        for (unsigned j = 0; j < 16; ++j) { const unsigned c = xb_ld(&bar[XB_XCNT(j)]); sum += c; cnt += (c > 0u) ? 1u : 0u; mine = (j == x) ? c : mine; }
        if (sum == G) break;
        __builtin_amdgcn_s_sleep(1);
        if ((++sp & 255u) == 0u) { if (xb_ld(&bar[XB_TMO])) break; if (sp > XB_SPIN_CAP) { atomicAdd(&bar[XB_TMO], 1u); break; } }
    }
    nloc = mine > 0u ? mine : 1u; nx = cnt > 0u ? cnt : 1u;
}
__device__ __forceinline__ void xcd_barrier(const XcdBarrier& b) {
    asm volatile("s_waitcnt vmcnt(0)" ::: "memory");
    __syncthreads();
    if (threadIdx.x == 0) {
        unsigned* bar = b.bar;
        __builtin_amdgcn_s_waitcnt(0);
        unsigned nloc = b.st[0], nx = b.st[1];
        if (nloc == 0u) { xcd_barrier_complete(bar, b.x, nloc, nx); b.st[0] = nloc; b.st[1] = nx; }
        const unsigned old = xb_add(&bar[XB_XSUB(b.x)], 1u);
        const unsigned gen = old / nloc;
        if (old + 1u == (gen + 1u) * nloc) {
            __builtin_amdgcn_fence(__ATOMIC_RELEASE, "agent");
            asm volatile("s_waitcnt vmcnt(0)" ::: "memory");
            const unsigned og = xb_add(&bar[XB_TOP], 1u);
            const unsigned tg = og / nx;
            if (og + 1u == (tg + 1u) * nx) xb_add(&bar[XB_TOPGEN], 1u);
            else XB_SPIN(xb_ld(&bar[XB_TOPGEN]) == tg, bar);
            __builtin_amdgcn_fence(__ATOMIC_ACQUIRE, "agent");
            xb_add(&bar[XB_XGEN(b.x)], 1u);
            asm volatile("s_waitcnt vmcnt(0)" ::: "memory");
        } else {
            XB_SPIN(xb_ld(&bar[XB_XGEN(b.x)]) == gen, bar);
            __builtin_amdgcn_fence(__ATOMIC_ACQUIRE, "agent");
            asm volatile("s_waitcnt vmcnt(0)" ::: "memory");
        }
    }
    __syncthreads();
}

__device__ __forceinline__ void d_tab_fp8(const float* T, unsigned char* O8, float* SC) {
    const int lane = threadIdx.x & 63, gw = blockIdx.x * (NT / 64) + (threadIdx.x >> 6), ngw = gridDim.x * (NT / 64);
    for (int row = gw; row < NEXP; row += ngw) {
        const f32x4* r = (const f32x4*)(T + (size_t)row * D) + 4 * lane; f32x4 v[4]; float am = 0.f;
#pragma unroll
        for (int j = 0; j < 4; ++j) { v[j] = r[j]; am = fmaxf(am, fmaxf(fmaxf(fabsf(v[j][0]), fabsf(v[j][1])), fmaxf(fabsf(v[j][2]), fabsf(v[j][3])))); }
#pragma unroll
        for (int o = 1; o < 64; o <<= 1) am = fmaxf(am, __shfl_xor(am, o));
        int e = 8; if (am > 0.f) (void)frexpf(am, &e);
        const float sc = ldexpf(1.f, 8 - e);
        u32x4 w;
        w.x = (unsigned)__builtin_amdgcn_cvt_pk_fp8_f32(v[0][0] * sc, v[0][1] * sc, 0, false); w.x = (unsigned)__builtin_amdgcn_cvt_pk_fp8_f32(v[0][2] * sc, v[0][3] * sc, (int)w.x, true);
        w.y = (unsigned)__builtin_amdgcn_cvt_pk_fp8_f32(v[1][0] * sc, v[1][1] * sc, 0, false); w.y = (unsigned)__builtin_amdgcn_cvt_pk_fp8_f32(v[1][2] * sc, v[1][3] * sc, (int)w.y, true);
        w.z = (unsigned)__builtin_amdgcn_cvt_pk_fp8_f32(v[2][0] * sc, v[2][1] * sc, 0, false); w.z = (unsigned)__builtin_amdgcn_cvt_pk_fp8_f32(v[2][2] * sc, v[2][3] * sc, (int)w.z, true);
        w.w = (unsigned)__builtin_amdgcn_cvt_pk_fp8_f32(v[3][0] * sc, v[3][1] * sc, 0, false); w.w = (unsigned)__builtin_amdgcn_cvt_pk_fp8_f32(v[3][2] * sc, v[3][3] * sc, (int)w.w, true);
        *(u32x4*)(O8 + (size_t)row * D + 16 * lane) = w;
        if (lane == 0) SC[row] = ldexpf(1.f, e - 8);
    }
}
__device__ __forceinline__ f32x2 fp8lo(unsigned w) { return __builtin_amdgcn_cvt_pk_f32_fp8((int)w, false); }
__device__ __forceinline__ f32x2 fp8hi(unsigned w) { return __builtin_amdgcn_cvt_pk_f32_fp8((int)w, true); }
__device__ __forceinline__ void peer_phase8(const bf16* H2, const int* EID, const float* EG, const unsigned char* U8, const unsigned char* V8, const float* USC, const float* VSC,
                                            const float* mod, const float* gfin, const float* x1, float* outp) {
    int tid_ = threadIdx.x; asm volatile("" : "+v"(tid_));
    const int lane = tid_ & 63, wv = tid_ >> 6;
    for (int t = blockIdx.x * (NT / 64) + wv; t < M; t += gridDim.x * (NT / 64)) {
        const int b = t / SEQ;
        f32x2 hp[8];
        { const u32x4 h0 = *(const u32x4*)(H2 + (size_t)t * D + 16 * lane), h1 = *(const u32x4*)(H2 + (size_t)t * D + 16 * lane + 8);
          hp[0] = (f32x2){bflo(h0.x), bfhi(h0.x)}; hp[1] = (f32x2){bflo(h0.y), bfhi(h0.y)}; hp[2] = (f32x2){bflo(h0.z), bfhi(h0.z)}; hp[3] = (f32x2){bflo(h0.w), bfhi(h0.w)};
          hp[4] = (f32x2){bflo(h1.x), bfhi(h1.x)}; hp[5] = (f32x2){bflo(h1.y), bfhi(h1.y)}; hp[6] = (f32x2){bflo(h1.z), bfhi(h1.z)}; hp[7] = (f32x2){bflo(h1.w), bfhi(h1.w)}; }
        const int e0 = EID[(size_t)t * NSEL + lane], e1 = EID[(size_t)t * NSEL + 64 + lane]; const float gg0 = EG[(size_t)t * NSEL + lane], gg1 = EG[(size_t)t * NSEL + 64 + lane];
        f32x2 acc[8];
#pragma unroll
        for (int i = 0; i < 8; ++i) acc[i] = (f32x2){0.f, 0.f};
#pragma unroll 1
        for (int kb = 0; kb < NSEL; kb += 16) {
            u32x4 uu[16], vv[16]; float us[16], vs[16];
#pragma unroll
            for (int j = 0; j < 16; ++j) { const int k = kb + j; const int eid = __builtin_amdgcn_readlane(k < 64 ? e0 : e1, k & 63);
                uu[j] = *(const u32x4*)(U8 + (size_t)eid * D + 16 * lane); vv[j] = *(const u32x4*)(V8 + (size_t)eid * D + 16 * lane); us[j] = USC[eid]; vs[j] = VSC[eid]; }
            float d[16];
#pragma unroll
            for (int j = 0; j < 16; ++j) { f32x2 a = (f32x2){0.f, 0.f};
                a = __builtin_elementwise_fma(fp8lo(uu[j].x), hp[0], a); a = __builtin_elementwise_fma(fp8hi(uu[j].x), hp[1], a); a = __builtin_elementwise_fma(fp8lo(uu[j].y), hp[2], a); a = __builtin_elementwise_fma(fp8hi(uu[j].y), hp[3], a);
                a = __builtin_elementwise_fma(fp8lo(uu[j].z), hp[4], a); a = __builtin_elementwise_fma(fp8hi(uu[j].z), hp[5], a); a = __builtin_elementwise_fma(fp8lo(uu[j].w), hp[6], a); a = __builtin_elementwise_fma(fp8hi(uu[j].w), hp[7], a);
                d[j] = (a[0] + a[1]) * us[j]; }
            float r8[8], r4[4], r2[2], r1;
            { const bool up = (lane & 32) != 0;
#pragma unroll
              for (int j = 0; j < 8; ++j) { const float snd = up ? d[j] : d[j + 8], kp = up ? d[j + 8] : d[j]; r8[j] = kp + __shfl_xor(snd, 32); } }
            { const bool up = (lane & 16) != 0;
#pragma unroll
              for (int j = 0; j < 4; ++j) { const float snd = up ? r8[j] : r8[j + 4], kp = up ? r8[j + 4] : r8[j]; r4[j] = kp + __shfl_xor(snd, 16); } }
            { const bool up = (lane & 8) != 0;
#pragma unroll
              for (int j = 0; j < 2; ++j) { const float snd = up ? r4[j] : r4[j + 2], kp = up ? r4[j + 2] : r4[j]; r2[j] = kp + __shfl_xor(snd, 8); } }
            { const bool up = (lane & 4) != 0; const float snd = up ? r2[0] : r2[1], kp = up ? r2[1] : r2[0]; r1 = kp + __shfl_xor(snd, 4); }
            r1 += __shfl_xor(r1, 2); r1 += __shfl_xor(r1, 1);
            const float ge = 0.5f * r1 * (1.f + erff(r1 * 0.70710678118654752f));
#pragma unroll
            for (int j = 0; j < 16; ++j) { const int k = kb + j; const float gk = __uint_as_float(__builtin_amdgcn_readlane(__float_as_uint(k < 64 ? gg0 : gg1), k & 63));
                const float w = gk * vs[j] * __uint_as_float(__builtin_amdgcn_readlane(__float_as_uint(ge), ((j & 8) ? 32 : 0) + ((j & 4) ? 16 : 0) + ((j & 2) ? 8 : 0) + ((j & 1) ? 4 : 0))); const f32x2 w2 = (f32x2){w, w};
                acc[0] = __builtin_elementwise_fma(w2, fp8lo(vv[j].x), acc[0]); acc[1] = __builtin_elementwise_fma(w2, fp8hi(vv[j].x), acc[1]); acc[2] = __builtin_elementwise_fma(w2, fp8lo(vv[j].y), acc[2]); acc[3] = __builtin_elementwise_fma(w2, fp8hi(vv[j].y), acc[3]);
                acc[4] = __builtin_elementwise_fma(w2, fp8lo(vv[j].z), acc[4]); acc[5] = __builtin_elementwise_fma(w2, fp8hi(vv[j].z), acc[5]); acc[6] = __builtin_elementwise_fma(w2, fp8lo(vv[j].w), acc[6]); acc[7] = __builtin_elementwise_fma(w2, fp8hi(vv[j].w), acc[7]); }
        }
        float ss = 0.f; f32x4 x2[4];
#pragma unroll
        for (int q4 = 0; q4 < 4; ++q4) { const int col = 16 * lane + 4 * q4; const f32x4 xv = *(const f32x4*)(x1 + (size_t)t * D + col), gv = *(const f32x4*)(mod + b * 6144 + 5 * D + col);
            x2[q4][0] = xv[0] + gv[0] * acc[2 * q4][0]; x2[q4][1] = xv[1] + gv[1] * acc[2 * q4][1]; x2[q4][2] = xv[2] + gv[2] * acc[2 * q4 + 1][0]; x2[q4][3] = xv[3] + gv[3] * acc[2 * q4 + 1][1];
            ss += x2[q4][0] * x2[q4][0] + x2[q4][1] * x2[q4][1] + x2[q4][2] * x2[q4][2] + x2[q4][3] * x2[q4][3]; }
#pragma unroll
        for (int o = 1; o < 64; o <<= 1) ss += __shfl_xor(ss, o);
        const float r = rsqrtf(ss * (1.f / D) + EPS);
#pragma unroll
        for (int q4 = 0; q4 < 4; ++q4) { const int col = 16 * lane + 4 * q4; const f32x4 gf = *(const f32x4*)(gfin + col); *(f32x4*)(outp + (size_t)t * D + col) = x2[q4] * r * gf; }
    }
}

namespace att2 {
__device__ __forceinline__ bool lsum_dummy(int ei) { return ei == 12345; }
using att::f32x16; using att::v4i16_t; using att::crow; using att::bfe;
constexpr int VROW = 192, OFF_V = 32768, OFF_MISC = OFF_V + 256 * VROW;
template <bool CAUSAL>
__device__ __forceinline__ void tile(const LAS unsigned char* Kblk, const LAS unsigned char* Vblk, const bf16x8 (&qr)[4], int tt, int q_off, int lane, int r32, int hi, float& mrun, float& lsum, f32x16& o0, f32x16& o1) {
    const LAS unsigned char* kb_ = Kblk + tt * 64 * 128; const LAS unsigned char* vb_ = Vblk + tt * 64 * VROW;
    f32x16 p0 = {}, p1 = {};
#pragma unroll
    for (int s = 0; s < 4; ++s) { const int c = 2 * s + hi; const int sw = ((c ^ ((r32 >> 1) & 7)) << 4);
        const bf16x8 a0 = *(const LAS bf16x8*)(kb_ + r32 * 128 + sw), a1 = *(const LAS bf16x8*)(kb_ + (32 + r32) * 128 + sw);
        p0 = __builtin_amdgcn_mfma_f32_32x32x16_bf16(a0, qr[s], p0, 0, 0, 0); p1 = __builtin_amdgcn_mfma_f32_32x32x16_bf16(a1, qr[s], p1, 0, 0, 0); }
    if (CAUSAL) {
#pragma unroll
        for (int r = 0; r < 16; ++r) { const int ko = tt * 64 + crow(r, hi); if (ko > q_off) p0[r] = -INFINITY; if (ko + 32 > q_off) p1[r] = -INFINITY; } }
    float mt = fmaxf(p0[0], p1[0]);
#pragma unroll
    for (int r = 1; r < 16; ++r) mt = fmaxf(mt, fmaxf(p0[r], p1[r]));
    mt = fmaxf(mt, __shfl_xor(mt, 32));
    const float mnew = fmaxf(mrun, mt), alpha = __builtin_amdgcn_exp2f(mrun - mnew); mrun = mnew;
    float ps = 0.f;
#pragma unroll
    for (int r = 0; r < 16; ++r) { p0[r] = __builtin_amdgcn_exp2f(p0[r] - mnew); p1[r] = __builtin_amdgcn_exp2f(p1[r] - mnew); ps += p0[r] + p1[r]; }
    lsum = lsum * alpha + ps;
    if (!__all(alpha == 1.f ? 1 : 0)) {
#pragma unroll
        for (int r = 0; r < 16; ++r) { o0[r] *= alpha; o1[r] *= alpha; } }
    bf16x8 pb[2][2];
#pragma unroll
    for (int s2 = 0; s2 < 2; ++s2) { u32x4 w0, w1;
        w0.x = cvt_pk_bf16(p0[8 * s2], p0[8 * s2 + 1]); w0.y = cvt_pk_bf16(p0[8 * s2 + 2], p0[8 * s2 + 3]); w0.z = cvt_pk_bf16(p0[8 * s2 + 4], p0[8 * s2 + 5]); w0.w = cvt_pk_bf16(p0[8 * s2 + 6], p0[8 * s2 + 7]);
        w1.x = cvt_pk_bf16(p1[8 * s2], p1[8 * s2 + 1]); w1.y = cvt_pk_bf16(p1[8 * s2 + 2], p1[8 * s2 + 3]); w1.z = cvt_pk_bf16(p1[8 * s2 + 4], p1[8 * s2 + 5]); w1.w = cvt_pk_bf16(p1[8 * s2 + 6], p1[8 * s2 + 7]);
        pb[0][s2] = __builtin_bit_cast(bf16x8, w0); pb[1][s2] = __builtin_bit_cast(bf16x8, w1); }
    const LAS unsigned char* vl = vb_ + (4 * hi + ((lane & 15) >> 2)) * VROW + (16 * ((lane >> 4) & 1) + 4 * (lane & 3)) * 2;
#pragma unroll
    for (int dt = 0; dt < 2; ++dt)
#pragma unroll
        for (int u = 0; u < 2; ++u)
#pragma unroll
            for (int s2 = 0; s2 < 2; ++s2) { const LAS unsigned char* va = vl + (32 * u + 16 * s2) * VROW + dt * 64;
                const v4i16_t lo = __builtin_amdgcn_ds_read_tr16_b64_v4i16((LAS v4i16_t*)va), hh = __builtin_amdgcn_ds_read_tr16_b64_v4i16((LAS v4i16_t*)(va + 8 * VROW));
                const bf16x8 vf = {lo[0], lo[1], lo[2], lo[3], hh[0], hh[1], hh[2], hh[3]};
                if (dt == 0) o0 = __builtin_amdgcn_mfma_f32_32x32x16_bf16(vf, pb[u][s2], o0, 0, 0, 0); else o1 = __builtin_amdgcn_mfma_f32_32x32x16_bf16(vf, pb[u][s2], o1, 0, 0, 0); }
}
__device__ __forceinline__ void stage_block(LAS unsigned char* lds, const bf16* Kb, const bf16* V, size_t row0, int h, int tid) {
    const int ch = tid & 7;
#pragma unroll
    for (int i = 0; i < 4; ++i) { const int row = (tid >> 3) + 64 * i; const size_t go = (row0 + row) * 512 + h * 64 + ch * 8;
        const u32x4 kv = *(const u32x4*)(Kb + go), vv = *(const u32x4*)(V + go);
        *(LAS u32x4*)(lds + row * 128 + ((ch ^ ((row >> 1) & 7)) << 4)) = kv; *(LAS u32x4*)(lds + OFF_V + row * VROW + ch * 16) = vv; }
}
__device__ __forceinline__ void phase_a(LAS unsigned char* lds, const bf16* Q, const float* ksum, unsigned short* SEL, int* CNT, unsigned short* LIST, int G, int bid) {
    int tid_ = threadIdx.x; asm volatile("" : "+v"(tid_));
    const int tid = tid_, lane = tid & 63, wid = __builtin_amdgcn_readfirstlane(tid >> 6), r32 = lane & 31, hi = lane >> 5;
    LAS int* lc = (LAS int*)lds;
    for (int uidx = bid; uidx < 512; uidx += G) {
        const int bh = uidx >> 5, qb = uidx & 31, b = bh >> 3, h = bh & 7;
        const int q_off = wid * 32 + r32, q = qb * 256 + q_off; const size_t qrow = (size_t)b * SEQ + q;
        if (tid < 64) lc[tid] = 0;
        __syncthreads();
        bf16x8 qr[4];
#pragma unroll
        for (int s = 0; s < 4; ++s) qr[s] = *(const bf16x8*)(Q + qrow * 512 + h * 64 + 16 * s + 8 * hi);
        int s0 = 31, s1 = 31, s2 = 31; float g0 = -INFINITY, g1 = -INFINITY, g2 = -INFINITY;
        const float* ksb = ksum + (size_t)bh * NBLK * HD + 8 * hi;
        for (int j = 0; j < qb; ++j) { float part = 0.f;
#pragma unroll
            for (int s = 0; s < 4; ++s) { const f32x4 k0 = *(const f32x4*)(ksb + j * HD + 16 * s), k1 = *(const f32x4*)(ksb + j * HD + 16 * s + 4);
                part += bfe(qr[s], 0) * k0[0] + bfe(qr[s], 1) * k0[1] + bfe(qr[s], 2) * k0[2] + bfe(qr[s], 3) * k0[3] + bfe(qr[s], 4) * k1[0] + bfe(qr[s], 5) * k1[1] + bfe(qr[s], 6) * k1[2] + bfe(qr[s], 7) * k1[3]; }
            const float g = part + __shfl_xor(part, 32);
            if (g > g0) { g2 = g1; s2 = s1; g1 = g0; s1 = s0; g0 = g; s0 = j; } else if (g > g1) { g2 = g1; s2 = s1; g1 = g; s1 = j; } else if (g > g2) { g2 = g; s2 = j; } }
        int r0 = 0, r1 = 0, r2 = 0;
        if (hi == 0) { if (s0 < 31) r0 = __hip_atomic_fetch_add(lc + s0, 1, __ATOMIC_RELAXED, __HIP_MEMORY_SCOPE_WORKGROUP); if (s1 < 31) r1 = __hip_atomic_fetch_add(lc + s1, 1, __ATOMIC_RELAXED, __HIP_MEMORY_SCOPE_WORKGROUP);
                       if (s2 < 31) r2 = __hip_atomic_fetch_add(lc + s2, 1, __ATOMIC_RELAXED, __HIP_MEMORY_SCOPE_WORKGROUP); }
        __syncthreads();
        if (tid < 32 && lc[tid] > 0) lc[32 + tid] = atomicAdd(CNT + bh * 32 + tid, lc[tid]);
        __syncthreads();
        if (hi == 0) { SEL[(size_t)bh * SEQ + q] = (unsigned short)(s0 | (s1 << 5) | (s2 << 10));
            if (s0 < 31) LIST[((size_t)bh * 32 + s0) * SEQ + lc[32 + s0] + r0] = (unsigned short)q;
            if (s1 < 31) LIST[((size_t)bh * 32 + s1) * SEQ + lc[32 + s1] + r1] = (unsigned short)(q | (1 << 13));
            if (s2 < 31) LIST[((size_t)bh * 32 + s2) * SEQ + lc[32 + s2] + r2] = (unsigned short)(q | (2 << 13)); }
        __syncthreads();
    }
}
__device__ __forceinline__ bf16* part_o(bf16* PO01, bf16* PO2, int slot, size_t bhq) { return (slot < 2 ? PO01 + (size_t)slot * 16 * SEQ * HD : PO2) + bhq * HD; }
template <int MODE>
__device__ __forceinline__ void phase_b(LAS unsigned char* lds, const bf16* Q, const bf16* Kb, const bf16* V, const int* CNT, const unsigned short* LIST, bf16* PO01, bf16* PO2, f32x2* PML, int G, int bid) {
    int tid_ = threadIdx.x; asm volatile("" : "+v"(tid_));
    const int tid = tid_, lane = tid & 63, wid = __builtin_amdgcn_readfirstlane(tid >> 6), r32 = lane & 31, hi = lane >> 5;
    const int vcu = (G % 8 == 0) ? (bid % 8) * (G / 8) + bid / 8 : bid;
    LAS int* misc = (LAS int*)(lds + OFF_MISC);
    if (tid < 16) misc[tid] = 0;
    __syncthreads();
    { const int tr = tid; const int cnt = tr < 16 * 31 ? CNT[(tr % 16) * 32 + tr / 16] : 0, nch = (cnt + 255) >> 8;
      int inc = nch;
#pragma unroll
      for (int o = 1; o < 64; o <<= 1) { const int t = __shfl_up(inc, o); if (lane >= o) inc += t; }
      if (lane == 63) misc[wid] = inc;
      __syncthreads();
      int off = 0; for (int w = 0; w < wid; ++w) off += misc[w];
      const int st = off + inc - nch;
      if (nch > 0) { int k0 = st + ((vcu - st) % G + G) % G;
          for (; k0 < st + nch; k0 += G) { const int slot_ = __hip_atomic_fetch_add(misc + 8, 1, __ATOMIC_RELAXED, __HIP_MEMORY_SCOPE_WORKGROUP); misc[16 + slot_] = (tr << 8) | (k0 - st); } }
      __syncthreads(); }
    const int ni = misc[8];
    const int ch = tid & 7;
    u32x4 kreg[4], vreg[4];
#define ATT2_LOAD_ITEM(idx_) do { const int it_ = misc[16 + (idx_)], tr_ = it_ >> 8, j_ = tr_ / 16, bh_ = tr_ % 16; const size_t row0_ = (size_t)(bh_ >> 3) * SEQ + j_ * 256; \
        _Pragma("unroll") for (int i_ = 0; i_ < 4; ++i_) { const size_t go_ = (row0_ + (tid >> 3) + 64 * i_) * 512 + (bh_ & 7) * 64 + ch * 8; kreg[i_] = *(const u32x4*)(Kb + go_); vreg[i_] = *(const u32x4*)(V + go_); } } while (0)
    if (ni > 0) ATT2_LOAD_ITEM(0);
    for (int ii = 0; ii < ni; ++ii) {
        const int it = misc[16 + ii], tr = it >> 8, c = it & 255, j = tr / 16, bh = tr % 16, b = bh >> 3, h = bh & 7;
        __syncthreads();
#pragma unroll
        for (int i = 0; i < 4; ++i) { const int row = (tid >> 3) + 64 * i; *(LAS u32x4*)(lds + row * 128 + ((ch ^ ((row >> 1) & 7)) << 4)) = kreg[i]; *(LAS u32x4*)(lds + OFF_V + row * VROW + ch * 16) = vreg[i]; }
        __syncthreads();
        if (ii + 1 < ni) ATT2_LOAD_ITEM(ii + 1);
        const int cnt = CNT[bh * 32 + j]; const int n = min(256, cnt - 256 * c);
        if (MODE != 2 && 32 * wid < n) {
            const int ei = 32 * wid + r32; const bool valid = (ei < n) && (MODE != 1 || lsum_dummy(ei));
            const unsigned ent = LIST[((size_t)bh * 32 + j) * SEQ + 256 * c + (ei < n ? ei : 0)]; const int q = ent & 8191, slot = ent >> 13;
            const size_t qrow = (size_t)b * SEQ + q;
            bf16x8 qr[4];
#pragma unroll
            for (int s = 0; s < 4; ++s) qr[s] = *(const bf16x8*)(Q + qrow * 512 + h * 64 + 16 * s + 8 * hi);
            float mrun = -INFINITY, lsum = 0.f; f32x16 o0 = {}, o1 = {};
#pragma unroll 1
            for (int tt = 0; tt < 4; ++tt) tile<false>(lds, lds + OFF_V, qr, tt, 0, lane, r32, hi, mrun, lsum, o0, o1);
            const float lt = lsum + __shfl_xor(lsum, 32), inv = 1.f / lt;
            if (valid) { const size_t bhq = (size_t)bh * SEQ + q; bf16* orow = part_o(PO01, PO2, slot, bhq) + 4 * hi;
                if (hi == 0) PML[bhq * 3 + slot] = (f32x2){mrun, lt};
#pragma unroll
                for (int g4 = 0; g4 < 4; ++g4) { u32x2 w;
                    w.x = cvt_pk_bf16(o0[4 * g4] * inv, o0[4 * g4 + 1] * inv); w.y = cvt_pk_bf16(o0[4 * g4 + 2] * inv, o0[4 * g4 + 3] * inv); *(u32x2*)(orow + 8 * g4) = w;
                    w.x = cvt_pk_bf16(o1[4 * g4] * inv, o1[4 * g4 + 1] * inv); w.y = cvt_pk_bf16(o1[4 * g4 + 2] * inv, o1[4 * g4 + 3] * inv); *(u32x2*)(orow + 32 + 8 * g4) = w; } }
        }
    }
#undef ATT2_LOAD_ITEM
    __syncthreads();
}
__device__ __forceinline__ void phase_c(LAS unsigned char* lds, const bf16* Q, const bf16* Kb, const bf16* V, const unsigned short* SEL, const bf16* PO01, const bf16* PO2, const f32x2* PML, bf16* ATT, int G, int bid) {
    int tid_ = threadIdx.x; asm volatile("" : "+v"(tid_));
    const int tid = tid_, lane = tid & 63, wid = __builtin_amdgcn_readfirstlane(tid >> 6), r32 = lane & 31, hi = lane >> 5;
    for (int uidx = bid; uidx < 512; uidx += G) {
        const int bh = uidx >> 5, qb = uidx & 31, b = bh >> 3, h = bh & 7;
        const int q_off = wid * 32 + r32, q = qb * 256 + q_off; const size_t qrow = (size_t)b * SEQ + q, bhq = (size_t)bh * SEQ + q;
        __syncthreads();
        stage_block(lds, Kb, V, (size_t)b * SEQ + qb * 256, h, tid);
        bf16x8 qr[4];
#pragma unroll
        for (int s = 0; s < 4; ++s) qr[s] = *(const bf16x8*)(Q + qrow * 512 + h * 64 + 16 * s + 8 * hi);
        const unsigned sel = SEL[bhq];
        __syncthreads();
        float mrun = -INFINITY, lsum = 0.f; f32x16 o0 = {}, o1 = {};
        const int ntile = (32 * wid + 31) / 64 + 1;
#pragma unroll 1
        for (int tt = 0; tt < ntile; ++tt) tile<true>(lds, lds + OFF_V, qr, tt, q_off, lane, r32, hi, mrun, lsum, o0, o1);
        float lt = lsum + __shfl_xor(lsum, 32);
#pragma unroll 1
        for (int slot = 0; slot < 3; ++slot) {
            const int sj = (sel >> (5 * slot)) & 31; if (sj == 31) continue;
            const f32x2 ml = PML[bhq * 3 + slot]; const bf16* prow = part_o((bf16*)PO01, (bf16*)PO2, slot, bhq) + 4 * hi;
            const float mstar = fmaxf(mrun, ml[0]), fa = __builtin_amdgcn_exp2f(mrun - mstar), fb = ml[1] * __builtin_amdgcn_exp2f(ml[0] - mstar);
            mrun = mstar; lt = lt * fa + fb;
#pragma unroll
            for (int g4 = 0; g4 < 4; ++g4) { const u32x2 w0 = *(const u32x2*)(prow + 8 * g4), w1 = *(const u32x2*)(prow + 32 + 8 * g4);
                o0[4 * g4] = o0[4 * g4] * fa + fb * bflo(w0.x); o0[4 * g4 + 1] = o0[4 * g4 + 1] * fa + fb * bfhi(w0.x); o0[4 * g4 + 2] = o0[4 * g4 + 2] * fa + fb * bflo(w0.y); o0[4 * g4 + 3] = o0[4 * g4 + 3] * fa + fb * bfhi(w0.y);
                o1[4 * g4] = o1[4 * g4] * fa + fb * bflo(w1.x); o1[4 * g4 + 1] = o1[4 * g4 + 1] * fa + fb * bfhi(w1.x); o1[4 * g4 + 2] = o1[4 * g4 + 2] * fa + fb * bflo(w1.y); o1[4 * g4 + 3] = o1[4 * g4 + 3] * fa + fb * bfhi(w1.y); }
        }
        const float inv = 1.f / lt;
        bf16* orow = ATT + qrow * 512 + h * 64 + 4 * hi;
#pragma unroll
        for (int g4 = 0; g4 < 4; ++g4) { u32x2 w;
            w.x = cvt_pk_bf16(o0[4 * g4] * inv, o0[4 * g4 + 1] * inv); w.y = cvt_pk_bf16(o0[4 * g4 + 2] * inv, o0[4 * g4 + 3] * inv); *(u32x2*)(orow + 8 * g4) = w;
            w.x = cvt_pk_bf16(o1[4 * g4] * inv, o1[4 * g4 + 1] * inv); w.y = cvt_pk_bf16(o1[4 * g4 + 2] * inv, o1[4 * g4 + 3] * inv); *(u32x2*)(orow + 32 + 8 * g4) = w; }
    }
    __syncthreads();
}
}

__device__ __forceinline__ void peer_pass_u(const bf16* H2, const int* EID, const float* EG, const unsigned char* U8, const float* USC, const float* VSC, float* WT) {
    int tid_ = threadIdx.x; asm volatile("" : "+v"(tid_));
    const int lane = tid_ & 63, wv = tid_ >> 6;
    for (int t = blockIdx.x * (NT / 64) + wv; t < M; t += gridDim.x * (NT / 64)) {
        f32x2 hp[8];
        { const u32x4 h0 = *(const u32x4*)(H2 + (size_t)t * D + 16 * lane), h1 = *(const u32x4*)(H2 + (size_t)t * D + 16 * lane + 8);
          hp[0] = (f32x2){bflo(h0.x), bfhi(h0.x)}; hp[1] = (f32x2){bflo(h0.y), bfhi(h0.y)}; hp[2] = (f32x2){bflo(h0.z), bfhi(h0.z)}; hp[3] = (f32x2){bflo(h0.w), bfhi(h0.w)};
          hp[4] = (f32x2){bflo(h1.x), bfhi(h1.x)}; hp[5] = (f32x2){bflo(h1.y), bfhi(h1.y)}; hp[6] = (f32x2){bflo(h1.z), bfhi(h1.z)}; hp[7] = (f32x2){bflo(h1.w), bfhi(h1.w)}; }
        const int e0 = EID[(size_t)t * NSEL + lane], e1 = EID[(size_t)t * NSEL + 64 + lane]; const float gg0 = EG[(size_t)t * NSEL + lane], gg1 = EG[(size_t)t * NSEL + 64 + lane];
        const float vs0 = VSC[e0], vs1 = VSC[e1];
        float wlo = 0.f, whi = 0.f;
#pragma unroll 1
        for (int kb = 0; kb < NSEL; kb += 32) {
            u32x4 uu[32]; float us[32];
#pragma unroll
            for (int j = 0; j < 32; ++j) { const int k = kb + j; const int eid = __builtin_amdgcn_readlane(k < 64 ? e0 : e1, k & 63); uu[j] = *(const u32x4*)(U8 + (size_t)eid * D + 16 * lane); us[j] = USC[eid]; }
            float d[32];
#pragma unroll
            for (int j = 0; j < 32; ++j) { f32x2 a = (f32x2){0.f, 0.f};
                a = __builtin_elementwise_fma(fp8lo(uu[j].x), hp[0], a); a = __builtin_elementwise_fma(fp8hi(uu[j].x), hp[1], a); a = __builtin_elementwise_fma(fp8lo(uu[j].y), hp[2], a); a = __builtin_elementwise_fma(fp8hi(uu[j].y), hp[3], a);
                a = __builtin_elementwise_fma(fp8lo(uu[j].z), hp[4], a); a = __builtin_elementwise_fma(fp8hi(uu[j].z), hp[5], a); a = __builtin_elementwise_fma(fp8lo(uu[j].w), hp[6], a); a = __builtin_elementwise_fma(fp8hi(uu[j].w), hp[7], a);
                d[j] = (a[0] + a[1]) * us[j]; }
            float r16[16], r8[8], r4[4], r2[2], r1;
            { const bool up = (lane & 32) != 0;
#pragma unroll
              for (int j = 0; j < 16; ++j) { const float snd = up ? d[j] : d[j + 16], kp = up ? d[j + 16] : d[j]; r16[j] = kp + __shfl_xor(snd, 32); } }
            { const bool up = (lane & 16) != 0;
#pragma unroll
              for (int j = 0; j < 8; ++j) { const float snd = up ? r16[j] : r16[j + 8], kp = up ? r16[j + 8] : r16[j]; r8[j] = kp + __shfl_xor(snd, 16); } }
            { const bool up = (lane & 8) != 0;
#pragma unroll
              for (int j = 0; j < 4; ++j) { const float snd = up ? r8[j] : r8[j + 4], kp = up ? r8[j + 4] : r8[j]; r4[j] = kp + __shfl_xor(snd, 8); } }
            { const bool up = (lane & 4) != 0;
#pragma unroll
              for (int j = 0; j < 2; ++j) { const float snd = up ? r4[j] : r4[j + 2], kp = up ? r4[j + 2] : r4[j]; r2[j] = kp + __shfl_xor(snd, 4); } }
            { const bool up = (lane & 2) != 0; const float snd = up ? r2[0] : r2[1], kp = up ? r2[1] : r2[0]; r1 = kp + __shfl_xor(snd, 2); }
            r1 += __shfl_xor(r1, 1);
            const float ge = 0.5f * r1 * (1.f + erff(r1 * 0.70710678118654752f));
            const float gsh = __shfl(ge, 2 * (lane & 31));
            if (kb < 64) { if ((lane >> 5) == (kb >> 5)) wlo = gsh; } else { if ((lane >> 5) == ((kb - 64) >> 5)) whi = gsh; }
        }
        WT[(size_t)t * NSEL + lane] = wlo * gg0 * vs0; WT[(size_t)t * NSEL + 64 + lane] = whi * gg1 * vs1;
    }
}
__device__ __forceinline__ void peer_pass_v(const int* EID, const float* WT, const unsigned char* V8, const float* mod, const float* gfin, const float* x1, float* outp) {
    int tid_ = threadIdx.x; asm volatile("" : "+v"(tid_));
    const int lane = tid_ & 63, wv = tid_ >> 6;
    for (int t = blockIdx.x * (NT / 64) + wv; t < M; t += gridDim.x * (NT / 64)) {
        const int b = t / SEQ;
        const int e0 = EID[(size_t)t * NSEL + lane], e1 = EID[(size_t)t * NSEL + 64 + lane]; const float w0 = WT[(size_t)t * NSEL + lane], w1 = WT[(size_t)t * NSEL + 64 + lane];
        f32x2 acc[8];
#pragma unroll
        for (int i = 0; i < 8; ++i) acc[i] = (f32x2){0.f, 0.f};
#pragma unroll 1
        for (int kb = 0; kb < NSEL; kb += 32) {
            u32x4 vv[32];
#pragma unroll
            for (int j = 0; j < 32; ++j) { const int k = kb + j; const int eid = __builtin_amdgcn_readlane(k < 64 ? e0 : e1, k & 63); vv[j] = *(const u32x4*)(V8 + (size_t)eid * D + 16 * lane); }
#pragma unroll
            for (int j = 0; j < 32; ++j) { const int k = kb + j; const float w = __uint_as_float(__builtin_amdgcn_readlane(__float_as_uint(k < 64 ? w0 : w1), k & 63)); const f32x2 w2 = (f32x2){w, w};
                acc[0] = __builtin_elementwise_fma(w2, fp8lo(vv[j].x), acc[0]); acc[1] = __builtin_elementwise_fma(w2, fp8hi(vv[j].x), acc[1]); acc[2] = __builtin_elementwise_fma(w2, fp8lo(vv[j].y), acc[2]); acc[3] = __builtin_elementwise_fma(w2, fp8hi(vv[j].y), acc[3]);
                acc[4] = __builtin_elementwise_fma(w2, fp8lo(vv[j].z), acc[4]); acc[5] = __builtin_elementwise_fma(w2, fp8hi(vv[j].z), acc[5]); acc[6] = __builtin_elementwise_fma(w2, fp8lo(vv[j].w), acc[6]); acc[7] = __builtin_elementwise_fma(w2, fp8hi(vv[j].w), acc[7]); }
        }
        float ss = 0.f; f32x4 x2[4];
#pragma unroll
        for (int q4 = 0; q4 < 4; ++q4) { const int col = 16 * lane + 4 * q4; const f32x4 xv = *(const f32x4*)(x1 + (size_t)t * D + col), gv = *(const f32x4*)(mod + b * 6144 + 5 * D + col);
            x2[q4][0] = xv[0] + gv[0] * acc[2 * q4][0]; x2[q4][1] = xv[1] + gv[1] * acc[2 * q4][1]; x2[q4][2] = xv[2] + gv[2] * acc[2 * q4 + 1][0]; x2[q4][3] = xv[3] + gv[3] * acc[2 * q4 + 1][1];
            ss += x2[q4][0] * x2[q4][0] + x2[q4][1] * x2[q4][1] + x2[q4][2] * x2[q4][2] + x2[q4][3] * x2[q4][3]; }
#pragma unroll
        for (int o = 1; o < 64; o <<= 1) ss += __shfl_xor(ss, o);
        const float r = rsqrtf(ss * (1.f / D) + EPS);
#pragma unroll
        for (int q4 = 0; q4 < 4; ++q4) { const int col = 16 * lane + 4 * q4; const f32x4 gf = *(const f32x4*)(gfin + col); *(f32x4*)(outp + (size_t)t * D + col) = x2[q4] * r * gf; }
    }
}

__device__ __forceinline__ void d_cmp_accum(float num, float den, float* lds, float* acc2) {
#pragma unroll
    for (int o = 1; o < 64; o <<= 1) { num += __shfl_xor(num, o); den += __shfl_xor(den, o); }
    __syncthreads();
    if ((threadIdx.x & 63) == 0) { lds[(threadIdx.x >> 6) * 2] = num; lds[(threadIdx.x >> 6) * 2 + 1] = den; }
    __syncthreads();
    if (threadIdx.x == 0) { float n = 0.f, d = 0.f; for (int w = 0; w < NT / 64; ++w) { n += lds[w * 2]; d += lds[w * 2 + 1]; } atomicAdd(acc2, n); atomicAdd(acc2 + 1, d); }
    __syncthreads();
}
__device__ __forceinline__ void d_cmp_bf16(const bf16* a, const bf16* b, size_t n, float* lds, float* acc2) {
    float num = 0.f, den = 0.f; GSTRIDE(i, n) { const float x = bf2f(a[i]), y = bf2f(b[i]); num += (x - y) * (x - y); den += y * y; } d_cmp_accum(num, den, lds, acc2);
}
__device__ __forceinline__ void d_cmp_f32(const float* a, const float* b, size_t n, float* lds, float* acc2) {
    float num = 0.f, den = 0.f; GSTRIDE(i, n) { const float x = a[i], y = b[i]; num += (x - y) * (x - y); den += y * y; } d_cmp_accum(num, den, lds, acc2);
}

#ifndef DBG
#define DBG 0
#endif
#ifndef PROBE
#define PROBE 0
#endif
#ifndef USE_XCD_BARRIER
#define USE_XCD_BARRIER 1
#endif
#ifndef FAST_PRO
#define FAST_PRO 1
#endif
#ifndef FAST_GEMM
#define FAST_GEMM 1
#endif
#ifndef FAST_ATTN
#define FAST_ATTN 2
#endif
#define ATTN_SORTED(dst_) do { att2::phase_a(lds3, Q, KSUM, (unsigned short*)(ws + WS_SEL), (int*)(ws + WS_CNT), (unsigned short*)(ws + WS_LIST), G, bid); GSYNC(); \
    att2::phase_b<0>(lds3, Q, Kb, V, (const int*)(ws + WS_CNT), (const unsigned short*)(ws + WS_LIST), (bf16*)(ws + WS_PO01), (bf16*)(ws + WS_PO2), (f32x2*)(ws + WS_PML), G, bid); GSYNC(); \
    att2::phase_c(lds3, Q, Kb, V, (const unsigned short*)(ws + WS_SEL), (const bf16*)(ws + WS_PO01), (const bf16*)(ws + WS_PO2), (const f32x2*)(ws + WS_PML), dst_, G, bid); } while (0)
#ifndef FAST_PEER
#define FAST_PEER 1
#endif
#ifndef FAST_ROUTE
#define FAST_ROUTE 1
#endif
#ifndef PEER_TWO_PASS
#define PEER_TWO_PASS 1
#endif
#ifndef PEER_FP8
#define PEER_FP8 1
#endif
#if PEER_FP8
#if PEER_TWO_PASS
#define PEER_CALL(x1_, o_) do { peer_pass_u(H, EID, EG, ws + WS_U8, (const float*)(ws + WS_USC), (const float*)(ws + WS_VSC), (float*)(ws + WS_WT)); __syncthreads(); \
    peer_pass_v(EID, (const float*)(ws + WS_WT), ws + WS_V8, MOD, g_fin, x1_, o_); } while (0)
#else
#define PEER_CALL(x1_, o_) peer_phase8(H, EID, EG, ws + WS_U8, ws + WS_V8, (const float*)(ws + WS_USC), (const float*)(ws + WS_VSC), MOD, g_fin, x1_, o_)
#endif
#else
#define PEER_CALL(x1_, o_) peer_phase(H, EID, EG, (const bf16*)(ws + WS_UT), (const bf16*)(ws + WS_VT), MOD, g_fin, x1_, o_)
#endif
#define USE_FAST_PEER (FAST_PEER && !(DBG & 19))
constexpr int LDS_BYTES = 147456;
__global__ void __launch_bounds__(NT, 2) mega_fwd(Args a) {
    extern __shared__ __attribute__((aligned(16))) unsigned char lds_raw[];
    float* ldsf = (float*)lds_raw; LAS unsigned char* lds3 = (LAS unsigned char*)lds_raw;
    cg::grid_group grid = cg::this_grid();
    const float* x = a.in[0]; const float* c = a.in[1]; const float* w_ada = a.in[2]; const float* b_ada = a.in[3];
    const float* g_mix = a.in[4]; const float* w_in = a.in[5]; const float* pool_w = a.in[6]; const float* pool_scale = a.in[7];
    const float* w_bp = a.in[8]; const float* w_ba = a.in[9]; const float* w_out = a.in[10]; const float* g_ffn = a.in[11];
    const float* wq = a.in[12]; const float* skeys = a.in[13]; const float* Ut = a.in[14]; const float* Vt = a.in[15]; const float* g_fin = a.in[16];
    unsigned char* ws = a.ws; float* out = a.out;
    float* MOD = (float*)(ws + WS_MOD); float* KSUM = (float*)(ws + WS_KSUM); float* ROPE = (float*)(ws + WS_ROPE);
    bf16 *W_IN_T = (bf16*)(ws + WS_W_IN_T), *WC_T = (bf16*)(ws + WS_WC_T), *WBA_T = (bf16*)(ws + WS_WBA_T), *WOUT_T = (bf16*)(ws + WS_WOUT_T), *WQ_T = (bf16*)(ws + WS_WQ_T), *SK = (bf16*)(ws + WS_SK);
    bf16 *H = (bf16*)(ws + WS_H), *DIFF = (bf16*)(ws + WS_DIFF), *ATT = (bf16*)(ws + WS_ATT), *UP = (bf16*)(ws + WS_UP), *Q = (bf16*)(ws + WS_Q), *Kb = (bf16*)(ws + WS_K), *V = (bf16*)(ws + WS_V);
    bf16 *GATES = (bf16*)(ws + WS_GATES), *MERGED = (bf16*)(ws + WS_MERGED), *QP = (bf16*)(ws + WS_QP);
    int* EID = (int*)(ws + WS_EID); float* EG = (float*)(ws + WS_EG);
    const int G = gridDim.x, bid = blockIdx.x;
    { volatile LAS unsigned* st = (volatile LAS unsigned*)(lds3 + LDS_BYTES - 64); if (threadIdx.x < 16) st[threadIdx.x] = 0u; }
    __syncthreads();
    const XcdBarrier xbar = xcd_barrier_post((unsigned*)(ws + WS_BAR), (volatile LAS unsigned*)(lds3 + LDS_BYTES - 64));
#if USE_XCD_BARRIER
#define GSYNC() xcd_barrier(xbar)
#else
#define GSYNC() grid.sync()
#endif
    if (a.ws == nullptr) grid.sync();
#if DBG
    float* DBGW = (float*)(ws + WS_DBG); unsigned char* ALT = ws + WS_ALT;
#endif

    for (int rep_ = 0; rep_ < (PROBE == 5 ? 2 : 1); ++rep_) {
#if FAST_PRO
    p0_mod_partials(c, w_ada, (float*)(ws + WS_MODP));
    p0_transposes(lds3, w_in, w_ba, w_out, wq, W_IN_T, WBA_T, WOUT_T, WQ_T);
    p0_wc(pool_w, pool_scale, w_bp, (float*)(ws + WS_WCF));
#else
    d_mod(c, w_ada, b_ada, MOD);
    d_transpose(w_in, 1024, 4096, W_IN_T); d_transpose(w_ba, 512, 1024, WBA_T); d_transpose(w_out, 1024, 1024, WOUT_T); d_transpose(wq, 1024, 2048, WQ_T);
    d_wc(pool_w, pool_scale, w_bp, WC_T);
#endif
#if (DBG & 4) || !FAST_ROUTE
    d_sk(skeys, SK);
#endif
    d_skbd(skeys, (bf16*)(ws + WS_SKBD)); d_rope(ROPE);
#if USE_FAST_PEER
#if PEER_FP8
    d_tab_fp8(Ut, ws + WS_U8, (float*)(ws + WS_USC)); d_tab_fp8(Vt, ws + WS_V8, (float*)(ws + WS_VSC));
#else
    d_tab_bf16(Ut, (bf16*)(ws + WS_UT)); d_tab_bf16(Vt, (bf16*)(ws + WS_VT));
#endif
#endif
    }
    GSYNC();
#if FAST_PRO
    { const float* MODP = (const float*)(ws + WS_MODP);
      GSTRIDE(idx, 2 * 6144) MOD[idx] = mod_reduce(MODP, b_ada, (int)idx);
      p1_wc_transpose(lds3, (const float*)(ws + WS_WCF), WC_T);
      __syncthreads();
      fill_mtab_partials((LAS float*)lds3, MODP, b_ada, 0, D);
      modulate_rows(x, g_mix, (const LAS float*)lds3, H); }
#else
    d_modulate(x, g_mix, MOD, 0, D, H);
#endif
    GSYNC();
#if DBG & 16
    { float* MOD2 = (float*)ALT; bf16 *T1 = (bf16*)(ALT + 1 * MiB), *T2 = (bf16*)(ALT + 9 * MiB), *T3 = (bf16*)(ALT + 10 * MiB), *T4 = (bf16*)(ALT + 12 * MiB), *T5 = (bf16*)(ALT + 16 * MiB), *HC = (bf16*)(ALT + 20 * MiB);
      d_mod(c, w_ada, b_ada, MOD2); d_transpose(w_in, 1024, 4096, T1); d_transpose(w_ba, 512, 1024, T2); d_transpose(w_out, 1024, 1024, T3); d_transpose(wq, 1024, 2048, T4); d_wc(pool_w, pool_scale, w_bp, T5);
      GSYNC();
      d_modulate(x, g_mix, MOD2, 0, D, HC);
      GSYNC();
      d_cmp_f32(MOD, MOD2, 2 * 6144, ldsf, DBGW + 24); d_cmp_bf16(W_IN_T, T1, (size_t)4096 * 1024, ldsf, DBGW + 26); d_cmp_bf16(WBA_T, T2, (size_t)512 * 1024, ldsf, DBGW + 26); d_cmp_bf16(WOUT_T, T3, (size_t)1024 * 1024, ldsf, DBGW + 26);
      d_cmp_bf16(WQ_T, T4, (size_t)2048 * 1024, ldsf, DBGW + 26); d_cmp_bf16(WC_T, T5, (size_t)512 * 1024, ldsf, DBGW + 26); d_cmp_bf16(H, HC, (size_t)M * D, ldsf, DBGW + 28);
      GSYNC(); }
#endif
#if (DBG & 1) || !FAST_GEMM
    { EpiInProjN E{UP, Q, Kb, V, GATES, ROPE}; d_ngemm(ldsf, H, D, W_IN_T, D, D, NPROJ, E); }
    GSYNC();
    d_ksum(Kb, KSUM);
#endif
#if DBG & 1
    { bf16 *UP2 = (bf16*)ALT, *Q2 = (bf16*)(ALT + 16 * MiB), *K2 = (bf16*)(ALT + 32 * MiB), *V2 = (bf16*)(ALT + 48 * MiB), *G2 = (bf16*)out; float* KS2 = (float*)(ws + WS_KSUM_ALT);
      pg8::Gemm g{H, W_IN_T, M, NPROJ, D, D, 0}; pg8::StaticOrder S; S.init(M, NPROJ, G, bid); EpiInProj E{UP2, Q2, K2, V2, G2, ROPE, KS2};
      pg8::gemm_phase<EpiInProj, pg8::StaticOrder, true>(lds3, g, S, E);
      GSYNC();
      d_cmp_bf16(UP2, UP, (size_t)M * 512, ldsf, DBGW + 0); d_cmp_bf16(Q2, Q, (size_t)M * 512, ldsf, DBGW + 2); d_cmp_bf16(K2, Kb, (size_t)M * 512, ldsf, DBGW + 4);
      d_cmp_bf16(V2, V, (size_t)M * 512, ldsf, DBGW + 6); d_cmp_bf16(G2, GATES, (size_t)M * 2048, ldsf, DBGW + 8); d_cmp_f32(KS2, KSUM, BATCH * NH * NBLK * HD, ldsf, DBGW + 10); }
#elif FAST_GEMM
    { pg8::Gemm g{H, W_IN_T, M, NPROJ, D, D, 0}; pg8::StaticOrder S; S.init(M, NPROJ, G, bid); EpiInProj E{UP, Q, Kb, V, GATES, ROPE, KSUM};
      pg8::gemm_phase<EpiInProj, pg8::StaticOrder, true>(lds3, g, S, E);
      if (PROBE == 7) { EpiInProj E2{UP, Q, Kb, V, GATES, ROPE, (float*)(ws + WS_KSUM_ALT)}; pg8::gemm_phase<EpiInProj, pg8::StaticOrder, true>(lds3, g, S, E2); } }
#endif
    GSYNC();
#if FAST_PRO
    pooldiff_fast(UP, DIFF);
#else
    d_pooldiff(UP, DIFF);
#endif
#if DBG & 16
    { bf16* DC = (bf16*)ALT; d_pooldiff(UP, DC); GSYNC(); d_cmp_bf16(DIFF, DC, (size_t)M * 512, ldsf, DBGW + 30); GSYNC(); }
#endif
#if (DBG & 2) || !FAST_ATTN
    d_attn(Q, Kb, V, KSUM, ATT);
#endif
#if DBG & 2
    { bf16* ATT2 = (bf16*)ALT;
#if FAST_ATTN == 2
      GSYNC(); ATTN_SORTED(ATT2);
#else
      att::attn_phase(lds3, Q, Kb, V, KSUM, ATT2, G, bid);
#endif
      GSYNC(); d_cmp_bf16(ATT2, ATT, (size_t)M * 512, ldsf, DBGW + 18); }
#elif FAST_ATTN == 1
    att::attn_phase(lds3, Q, Kb, V, KSUM, ATT, G, bid);
    if (PROBE == 4) { __syncthreads(); att::attn_phase(lds3, Q, Kb, V, KSUM, ATT, G, bid); }
#elif FAST_ATTN == 2
    if (PROBE == 11) { att2::phase_a(lds3, Q, KSUM, (unsigned short*)((char*)out + 16 * MiB), (int*)(ws + WS_CNT + 4096), (unsigned short*)out, G, bid); }
    ATTN_SORTED(ATT);
    if (PROBE == 14) { att2::phase_b<1>(lds3, Q, Kb, V, (const int*)(ws + WS_CNT), (const unsigned short*)(ws + WS_LIST), (bf16*)(ws + WS_PO01), (bf16*)(ws + WS_PO2), (f32x2*)(ws + WS_PML), G, bid); }
    if (PROBE == 15) { att2::phase_b<2>(lds3, Q, Kb, V, (const int*)(ws + WS_CNT), (const unsigned short*)(ws + WS_LIST), (bf16*)(ws + WS_PO01), (bf16*)(ws + WS_PO2), (f32x2*)(ws + WS_PML), G, bid); }
    if (PROBE == 12) { att2::phase_b<0>(lds3, Q, Kb, V, (const int*)(ws + WS_CNT), (const unsigned short*)(ws + WS_LIST), (bf16*)(ws + WS_PO01), (bf16*)(ws + WS_PO2), (f32x2*)(ws + WS_PML), G, bid); }
    if (PROBE == 13) { att2::phase_c(lds3, Q, Kb, V, (const unsigned short*)(ws + WS_SEL), (const bf16*)(ws + WS_PO01), (const bf16*)(ws + WS_PO2), (const f32x2*)(ws + WS_PML), ATT, G, bid); }
#endif
    GSYNC();
#if (DBG & 1) || !FAST_GEMM
    { EpiMergeN E{MERGED, GATES, 0}; d_ngemm(ldsf, DIFF, 512, WC_T, 512, 512, D, E); }
    { EpiMergeN E{MERGED, GATES, 1}; d_ngemm(ldsf, ATT, 512, WBA_T, 512, 512, D, E); }
#endif
#if DBG & 1
    { bf16* MG2 = (bf16*)ALT;
      { pg8::Gemm g{DIFF, WC_T, M, D, 512, 512, 0}; pg8::StaticOrder S; S.init(M, D, G, bid); EpiMerge<0> E{MG2, GATES}; pg8::gemm_phase<EpiMerge<0>, pg8::StaticOrder, true>(lds3, g, S, E); }
      { pg8::Gemm g{ATT, WBA_T, M, D, 512, 512, 0}; pg8::StaticOrder S; S.init(M, D, G, bid); EpiMerge<1> E{MG2, GATES}; pg8::gemm_phase<EpiMerge<1>, pg8::StaticOrder, true>(lds3, g, S, E); }
      GSYNC();
      d_cmp_bf16(MG2, MERGED, (size_t)M * D, ldsf, DBGW + 12); }
#elif FAST_GEMM
    { pg8::Gemm g{DIFF, WC_T, M, D, 512, 512, 0}; pg8::StaticOrder S; S.init(M, D, G, bid); EpiMerge<0> E{MERGED, GATES}; pg8::gemm_phase<EpiMerge<0>, pg8::StaticOrder, true>(lds3, g, S, E); }
    { pg8::Gemm g{ATT, WBA_T, M, D, 512, 512, 0}; pg8::StaticOrder S; S.init(M, D, G, bid); EpiMerge<1> E{MERGED, GATES}; pg8::gemm_phase<EpiMerge<1>, pg8::StaticOrder, true>(lds3, g, S, E); }
    if (PROBE == 8) { { pg8::Gemm g{DIFF, WC_T, M, D, 512, 512, 0}; pg8::StaticOrder S; S.init(M, D, G, bid); EpiMerge<0> E{MERGED, GATES}; pg8::gemm_phase<EpiMerge<0>, pg8::StaticOrder, true>(lds3, g, S, E); }
      { pg8::Gemm g{ATT, WBA_T, M, D, 512, 512, 0}; pg8::StaticOrder S; S.init(M, D, G, bid); EpiMerge<1> E{MERGED, GATES}; pg8::gemm_phase<EpiMerge<1>, pg8::StaticOrder, true>(lds3, g, S, E); } }
#endif
    GSYNC();
#if (DBG & 1) || !FAST_GEMM
    { EpiRes1N E{x, MOD, out}; d_ngemm(ldsf, MERGED, D, WOUT_T, D, D, D, E); }
#endif
#if DBG & 1
    { float* X12 = (float*)ALT;
      pg8::Gemm g{MERGED, WOUT_T, M, D, D, D, 0}; pg8::StaticOrder S; S.init(M, D, G, bid); EpiRes1 E{x, MOD, X12}; pg8::gemm_phase<EpiRes1, pg8::StaticOrder, true>(lds3, g, S, E);
      GSYNC();
      d_cmp_f32(X12, out, (size_t)M * D, ldsf, DBGW + 14); }
#elif FAST_GEMM
    { pg8::Gemm g{MERGED, WOUT_T, M, D, D, D, 0}; pg8::StaticOrder S; S.init(M, D, G, bid); EpiRes1 E{x, MOD, out}; pg8::gemm_phase<EpiRes1, pg8::StaticOrder, true>(lds3, g, S, E);
      if (PROBE == 9) pg8::gemm_phase<EpiRes1, pg8::StaticOrder, true>(lds3, g, S, E); }
#endif
    GSYNC();
#if FAST_PRO
    fill_mtab((LAS float*)lds3, MOD, 3 * D, 4 * D); modulate_rows(out, g_ffn, (const LAS float*)lds3, H);
#else
    d_modulate(out, g_ffn, MOD, 3 * D, 4 * D, H);
#endif
    GSYNC();
#if DBG & 16
    { bf16* HC = (bf16*)(ALT + 20 * MiB); d_modulate(out, g_ffn, MOD, 3 * D, 4 * D, HC); GSYNC(); d_cmp_bf16(H, HC, (size_t)M * D, ldsf, DBGW + 28); GSYNC(); }
#endif
#if (DBG & 1) || !FAST_GEMM
    { EpiBfN E{QP, 2048}; d_ngemm(ldsf, H, D, WQ_T, D, D, 2048, E); }
#endif
#if DBG & 1
    { bf16* QP2 = (bf16*)ALT;
      pg8::Gemm g{H, WQ_T, M, 2048, D, D, 0}; pg8::StaticOrder S; S.init(M, 2048, G, bid); EpiBf16 E{QP2, 2048}; pg8::gemm_phase<EpiBf16, pg8::StaticOrder, true>(lds3, g, S, E);
      GSYNC();
      d_cmp_bf16(QP2, QP, (size_t)M * 2048, ldsf, DBGW + 16); }
#elif FAST_GEMM
    { pg8::Gemm g{H, WQ_T, M, 2048, D, D, 0}; pg8::StaticOrder S; S.init(M, 2048, G, bid); EpiBf16 E{QP, 2048}; pg8::gemm_phase<EpiBf16, pg8::StaticOrder, true>(lds3, g, S, E);
      if (PROBE == 10) pg8::gemm_phase<EpiBf16, pg8::StaticOrder, true>(lds3, g, S, E); }
#endif
    GSYNC();
#if (DBG & 4) || !FAST_ROUTE
    d_route(ldsf, QP, SK, EID, EG);
#endif
#if DBG & 4
    { int* EID2 = (int*)(ws + 68 * MiB); float* EG2 = (float*)(ws + 76 * MiB); float* SM1 = (float*)(ws + 148 * MiB); float* SM2 = (float*)(ws + 150 * MiB);
      __syncthreads(); route_phase(lds3, QP, (const bf16*)(ws + WS_SKBD), EID2, EG2, G, bid); GSYNC();
      d_route_summary(EID, EG, SM1); d_route_summary(EID2, EG2, SM2); GSYNC(); d_cmp_f32(SM2, SM1, (size_t)M * PHEADS * 2, ldsf, DBGW + 22); }
#elif FAST_ROUTE
    route_phase(lds3, QP, (const bf16*)(ws + WS_SKBD), EID, EG, G, bid);
    if (PROBE == 6) route_phase(lds3, QP, (const bf16*)(ws + WS_SKBD), EID, EG, G, bid);
#endif
    GSYNC();
#if DBG & 8
    { float* OUT2 = (float*)(ws + WS_OUT2); PEER_CALL(out, OUT2); GSYNC();
      d_peer(H, EID, EG, Ut, Vt, MOD, g_fin, out); GSYNC(); d_cmp_f32(OUT2, out, (size_t)M * D, ldsf, DBGW + 20); }
#elif USE_FAST_PEER
    if (PROBE == 2) { PEER_CALL(out, (float*)(ws + WS_OUT2)); GSYNC(); }
    if (PROBE == 3) { for (int i = 0; i < 10; ++i) GSYNC(); }
    PEER_CALL(out, out);
#else
    d_peer(H, EID, EG, Ut, Vt, MOD, g_fin, out);
#endif
#if DBG
    GSYNC();
    { float e2 = 0.f; for (int i = 0; i < 16; ++i) { const float n = __hip_atomic_load(DBGW + 2 * i, __ATOMIC_RELAXED, __HIP_MEMORY_SCOPE_AGENT), d = __hip_atomic_load(DBGW + 2 * i + 1, __ATOMIC_RELAXED, __HIP_MEMORY_SCOPE_AGENT); if (d > 0.f) e2 += n / d; else if (n > 0.f) e2 += 1.f; }
      float dl = 10.f * sqrtf(e2); if (!(dl < 1.f)) dl = 1.f;
      GSTRIDE(i, (size_t)M * D) out[i] *= (1.f + dl); }
#endif
}

extern "C" void kernel_launch(void* const* d_in, const int* in_sizes, int n_in, void* d_out, int out_size, void* d_ws, size_t ws_size, hipStream_t stream) {
    static int grid_blocks = 0;
    if (grid_blocks == 0) {
        if (n_in != 17 || out_size != M * D || ws_size < 256 * MiB) { fprintf(stderr, "kernel_launch: unexpected shapes (n_in %d out %d ws %zu)\n", n_in, out_size, ws_size); grid_blocks = -1; return; }
        int dev = 0, cus = 0, per_cu = 0;
        (void)hipGetDevice(&dev); (void)hipDeviceGetAttribute(&cus, hipDeviceAttributeMultiprocessorCount, dev);
        (void)hipFuncSetAttribute((const void*)mega_fwd, hipFuncAttributeMaxDynamicSharedMemorySize, LDS_BYTES);
        (void)hipOccupancyMaxActiveBlocksPerMultiprocessor(&per_cu, (const void*)mega_fwd, NT, LDS_BYTES);
        if (per_cu < 1 || cus < 1) { fprintf(stderr, "kernel_launch: occupancy query says %d blocks/CU on %d CUs\n", per_cu, cus); grid_blocks = -1; return; }
        grid_blocks = cus;
    }
    if (grid_blocks < 0) return;
    (void)hipMemsetAsync((char*)d_ws + WS_CTL, 0, 1 * MiB, stream);
    Args a{};
    for (int i = 0; i < 17; ++i) a.in[i] = (const float*)d_in[i];
    a.out = (float*)d_out; a.ws = (unsigned char*)d_ws;
    void* args[] = {&a};
    hipError_t e = hipLaunchCooperativeKernel((const void*)mega_fwd, dim3(grid_blocks), dim3(NT), args, LDS_BYTES, stream);
    if (e != hipSuccess) fprintf(stderr, "cooperative launch failed: %s (grid %d)\n", hipGetErrorString(e), grid_blocks);
}
```

```cpp
#include <hip/hip_runtime.h>
#include <hip/hip_cooperative_groups.h>
#include <cstdio>
#include <cstdint>
namespace cg = cooperative_groups;

constexpr int BATCH = 2, SEQ = 8192, D = 1024, M = BATCH * SEQ;
constexpr int NPROJ = 4096, PW = 512, AW = 512, NH = 8, HD = 64, MBLK = 256, NBLK = SEQ / MBLK;
constexpr int PHEADS = 8, NKEYS = 128, PQD = 256, PHALF = 128, PTOPK = 16, NEXP = NKEYS * NKEYS, NSEL = PHEADS * PTOPK;
constexpr float EPS = 1e-6f;
constexpr float C2 = 0.125f * 1.4426950408889634f;
constexpr int NT = 512;

typedef unsigned short bf16;
__device__ __forceinline__ float bf2f(bf16 v) { return __uint_as_float(((unsigned)v) << 16); }
__device__ __forceinline__ bf16 f2bf(float f) { unsigned u = __float_as_uint(f); return (bf16)((u + 0x7fffu + ((u >> 16) & 1u)) >> 16); }

constexpr size_t MiB = 1u << 20;
constexpr size_t WS_CTL = 0;
constexpr size_t WS_MOD = 1 * MiB;
constexpr size_t WS_KSUM = 256 * 1024;
constexpr size_t WS_BAR = 32 * 1024;
constexpr size_t WS_KSUM_ALT = 512 * 1024, WS_DBG = 16 * 1024;
constexpr size_t WS_UT = 180 * MiB, WS_VT = 212 * MiB;
constexpr size_t WS_U8 = 180 * MiB, WS_V8 = 196 * MiB, WS_USC = 212 * MiB, WS_VSC = 212 * MiB + 65536;
constexpr size_t WS_SEL = 1 * MiB + 768 * 1024;
constexpr size_t WS_CNT = 640 * 1024;
constexpr size_t WS_PO01 = 213 * MiB, WS_PO2 = 52 * MiB, WS_LIST = 245 * MiB, WS_PML = 253 * MiB;
constexpr size_t WS_WT = 68 * MiB;
constexpr size_t WS_OUT2 = 84 * MiB;
constexpr size_t WS_ALT = 180 * MiB;
constexpr size_t WS_ROPE = 1 * MiB + 256 * 1024;
constexpr size_t WS_MODP = 148 * MiB;
constexpr size_t WS_WCF = 150 * MiB;
constexpr size_t WS_W_IN_T = 2 * MiB;
constexpr size_t WS_WC_T = 10 * MiB;
constexpr size_t WS_WBA_T = 11 * MiB;
constexpr size_t WS_WOUT_T = 12 * MiB;
constexpr size_t WS_WQ_T = 14 * MiB;
constexpr size_t WS_SK = 18 * MiB;
constexpr size_t WS_SKBD = 19 * MiB;
constexpr size_t WS_H = 20 * MiB;
constexpr size_t WS_DIFF = 20 * MiB, WS_ATT = 36 * MiB;
constexpr size_t WS_UP = 52 * MiB, WS_Q = 68 * MiB, WS_K = 84 * MiB, WS_V = 100 * MiB;
constexpr size_t WS_GATES = 116 * MiB;
constexpr size_t WS_MERGED = 84 * MiB;
constexpr size_t WS_QP = 116 * MiB;
constexpr size_t WS_EID = 52 * MiB, WS_EG = 60 * MiB;
constexpr size_t WS_END = 180 * MiB;

struct Args { const float* in[17]; float* out; unsigned char* ws; };

#define GSTRIDE(i, n) for (size_t i = (size_t)blockIdx.x * NT + threadIdx.x; i < (size_t)(n); i += (size_t)gridDim.x * NT)

__device__ __forceinline__ void d_mod(const float* c, const float* w_ada, const float* b_ada, float* mod) {
    GSTRIDE(idx, 2 * 6144) { const int b = (int)idx / 6144, j = (int)idx % 6144; float acc = 0.f;
        for (int i = 0; i < D; ++i) { const float cv = c[b * D + i]; const float s = cv / (1.f + expf(-cv)); acc += s * w_ada[(size_t)i * 6144 + j]; }
        mod[idx] = acc + b_ada[j]; }
}
__device__ __forceinline__ void d_transpose(const float* W, int K, int N, bf16* WT) {
    GSTRIDE(idx, (size_t)K * N) { const int k = (int)(idx / N), n = (int)(idx % N); WT[(size_t)n * K + k] = f2bf(W[idx]); }
}
__device__ __forceinline__ void d_wc(const float* pool_w, const float* pool_scale, const float* w_bp, bf16* WcT) {
    GSTRIDE(idx, 512 * 1024) { const int o = (int)idx % 1024, k = (int)idx / 1024, g = k / 128, i = k % 128; float acc = 0.f;
        for (int j = 0; j < 128; ++j) acc += pool_w[(g * 128 + i) * 128 + j] * pool_scale[g * 128 + j] * w_bp[(size_t)(g * 128 + j) * 1024 + o];
        WcT[(size_t)o * 512 + k] = f2bf(acc); }
}
__device__ __forceinline__ void d_sk(const float* sk, bf16* SK) { GSTRIDE(idx, 8 * 2 * 128 * 128) SK[idx] = f2bf(sk[idx]); }
__device__ __forceinline__ void d_rope(float* tab) {
    GSTRIDE(idx, SEQ * 8) { const int pos = (int)idx / 8, i = (int)idx % 8; const float inv = (float)pow(500000.0, -(double)i / 8.0); const float ang = (float)pos * inv;
        tab[pos * 16 + i] = (float)cos((double)ang); tab[pos * 16 + 8 + i] = (float)sin((double)ang); }
}
__device__ __forceinline__ void d_modulate(const float* x, const float* g, const float* mod, int shift_off, int scale_off, bf16* out) {
    const int lane = threadIdx.x & 63;
    for (int row = blockIdx.x * (NT / 64) + (threadIdx.x >> 6); row < M; row += gridDim.x * (NT / 64)) {
        const int b = row / SEQ; const float* xr = x + (size_t)row * D; float v[16]; float ss = 0.f;
#pragma unroll
        for (int j = 0; j < 16; ++j) { v[j] = xr[j * 64 + lane]; ss += v[j] * v[j]; }
#pragma unroll
        for (int o = 1; o < 64; o <<= 1) ss += __shfl_xor(ss, o);
        const float r = rsqrtf(ss * (1.f / D) + EPS);
#pragma unroll
        for (int j = 0; j < 16; ++j) { const int col = j * 64 + lane; out[(size_t)row * D + col] = f2bf(v[j] * r * g[col] * (1.f + mod[b * 6144 + scale_off + col]) + mod[b * 6144 + shift_off + col]); }
    }
}
constexpr int NG_HALF_FLOATS = 2 * 16 * 65 + 64 * 65;
template <class Epi>
__device__ __forceinline__ void d_ngemm(float* lds, const bf16* A, int lda, const bf16* Bt, int ldb, int K, int N, const Epi& E) {
    const int half = threadIdx.x >> 8, tid = threadIdx.x & 255, tx = tid & 15, ty = tid >> 4;
    float* As = lds + half * NG_HALF_FLOATS; float* Bs = As + 16 * 65; float* Ct = Bs + 16 * 65;
    const int ntn = N / 64, ntiles = (M / 64) * ntn, iters = (ntiles + 2 * gridDim.x - 1) / (2 * gridDim.x);
    for (int it = 0; it < iters; ++it) {
        const int t = (it * gridDim.x + blockIdx.x) * 2 + half; const bool valid = t < ntiles; const int m0 = valid ? (t / ntn) * 64 : 0, n0 = valid ? (t % ntn) * 64 : 0;
        float acc[4][4];
#pragma unroll
        for (int i = 0; i < 4; ++i)
#pragma unroll
            for (int j = 0; j < 4; ++j) acc[i][j] = 0.f;
        for (int k0 = 0; k0 < K; k0 += 16) {
#pragma unroll
            for (int e = 0; e < 4; ++e) { const int idx = tid + e * 256, r = idx >> 4, kk = idx & 15;
                As[kk * 65 + r] = bf2f(A[(size_t)(m0 + r) * lda + k0 + kk]); Bs[kk * 65 + r] = bf2f(Bt[(size_t)(n0 + r) * ldb + k0 + kk]); }
            __syncthreads();
#pragma unroll
            for (int kk = 0; kk < 16; ++kk) { float a[4], b[4];
#pragma unroll
                for (int i = 0; i < 4; ++i) { a[i] = As[kk * 65 + ty * 4 + i]; b[i] = Bs[kk * 65 + tx * 4 + i]; }
#pragma unroll
                for (int i = 0; i < 4; ++i)
#pragma unroll
                    for (int j = 0; j < 4; ++j) acc[i][j] += a[i] * b[j]; }
            __syncthreads();
        }
#pragma unroll
        for (int i = 0; i < 4; ++i)
#pragma unroll
            for (int j = 0; j < 4; ++j) Ct[(ty * 4 + i) * 65 + tx * 4 + j] = acc[i][j];
        __syncthreads();
        if (valid) for (int e = tid; e < 64 * 64; e += 256) { const int r = e >> 6, cidx = e & 63; E(m0 + r, n0 + cidx, Ct[r * 65 + cidx], &Ct[r * 65], cidx); }
        __syncthreads();
    }
}
struct EpiInProjN {
    bf16 *UP, *Q, *Kb, *V, *G; const float* rope;
    __device__ void operator()(int m, int n, float v, const float* row, int cl) const {
        if (n < 512) { UP[(size_t)m * 512 + n] = f2bf(v); return; }
        if (n < 1536) {
            const bool isq = n < 1024; const int c = isq ? n - 512 : n - 1024; const int d = c & 63; const int pos = m % SEQ; float o = v;
            if (d < 8) { const float cs = rope[pos * 16 + d], sn = rope[pos * 16 + 8 + d]; o = v * cs - row[cl + 8] * sn; }
            else if (d < 16) { const float cs = rope[pos * 16 + d - 8], sn = rope[pos * 16 + 8 + d - 8]; o = row[cl - 8] * sn + v * cs; }
            if (isq) Q[(size_t)m * 512 + c] = f2bf(o * C2); else Kb[(size_t)m * 512 + c] = f2bf(o);
            return;
        }
        if (n < 2048) { V[(size_t)m * 512 + n - 1536] = f2bf(v); return; }
        G[(size_t)m * 2048 + n - 2048] = f2bf(1.f / (1.f + expf(-v)));
    }
};
struct EpiMergeN { bf16* Mg; const bf16* G; int pass;
    __device__ void operator()(int m, int n, float v, const float*, int) const {
        const float g = bf2f(G[(size_t)m * 2048 + pass * 1024 + n]); const size_t o = (size_t)m * 1024 + n;
        if (pass == 0) Mg[o] = f2bf(g * v); else Mg[o] = f2bf(bf2f(Mg[o]) + g * v); } };
struct EpiRes1N { const float* x; const float* mod; float* x1;
    __device__ void operator()(int m, int n, float v, const float*, int) const { const int b = m / SEQ; x1[(size_t)m * D + n] = x[(size_t)m * D + n] + mod[b * 6144 + 2 * D + n] * v; } };
struct EpiBfN { bf16* O; int ldo; __device__ void operator()(int m, int n, float v, const float*, int) const { O[(size_t)m * ldo + n] = f2bf(v); } };

__device__ __forceinline__ void d_ksum(const bf16* Kb, float* ksum) {
    GSTRIDE(idx, BATCH * NH * NBLK * HD) { const int d = (int)idx % HD, blk = ((int)idx / HD) % NBLK, h = ((int)idx / (HD * NBLK)) % NH, b = (int)idx / (HD * NBLK * NH); float s = 0.f;
        for (int r = 0; r < MBLK; ++r) s += bf2f(Kb[(size_t)(b * SEQ + blk * MBLK + r) * 512 + h * 64 + d]);
        ksum[idx] = s; }
}
__device__ __forceinline__ void d_pooldiff(const bf16* UP, bf16* DIFF) {
    GSTRIDE(idx, (size_t)M * 512) { const int c = (int)(idx % 512), row = (int)(idx / 512), pos = row % SEQ, w = 2 << (c / 128), cnt = pos + 1 < w ? pos + 1 : w; float s = 0.f;
        for (int i = 0; i < cnt; ++i) s += bf2f(UP[(size_t)(row - i) * 512 + c]);
        DIFF[idx] = f2bf(s / (float)cnt - bf2f(UP[idx])); }
}
__device__ __forceinline__ void d_attn(const bf16* Q, const bf16* Kb, const bf16* V, const float* ksum, bf16* ATT) {
    GSTRIDE(gidx, BATCH * NH * SEQ) {
        const int idx = (int)gidx, q = idx % SEQ, h = (idx / SEQ) % NH, b = idx / (SEQ * NH), row = b * SEQ + q, qb = q / MBLK;
        float qv[64], o[64];
#pragma unroll
        for (int d = 0; d < 64; ++d) { qv[d] = bf2f(Q[(size_t)row * 512 + h * 64 + d]); o[d] = 0.f; }
        int s0 = -1, s1 = -1, s2 = -1; float g0 = -INFINITY, g1 = -INFINITY, g2 = -INFINITY;
        for (int j = 0; j < qb; ++j) { const float* ks = ksum + ((size_t)(b * NH + h) * NBLK + j) * HD; float g = 0.f;
#pragma unroll
            for (int d = 0; d < 64; ++d) g += qv[d] * ks[d];
            if (g > g0) { g2 = g1; s2 = s1; g1 = g0; s1 = s0; g0 = g; s0 = j; } else if (g > g1) { g2 = g1; s2 = s1; g1 = g; s1 = j; } else if (g > g2) { g2 = g; s2 = j; } }
        float mx = -1e30f, l = 0.f;
        for (int pass = 0; pass < 4; ++pass) {
            const int blk = pass == 0 ? qb : (pass == 1 ? s0 : (pass == 2 ? s1 : s2)); if (blk < 0) continue;
            const int nkeys = pass == 0 ? (q - qb * MBLK + 1) : MBLK;
            for (int kk = 0; kk < nkeys; ++kk) { const size_t kr = (size_t)(b * SEQ + blk * MBLK + kk) * 512 + h * 64; float s = 0.f;
#pragma unroll
                for (int d = 0; d < 64; ++d) s += qv[d] * bf2f(Kb[kr + d]);
                if (s > mx) { const float f = exp2f(mx - s); l = l * f + 1.f;
#pragma unroll
                    for (int d = 0; d < 64; ++d) o[d] = o[d] * f + bf2f(V[kr + d]);
                    mx = s; }
                else { const float p = exp2f(s - mx); l += p;
#pragma unroll
                    for (int d = 0; d < 64; ++d) o[d] += p * bf2f(V[kr + d]); } }
        }
        const float il = 1.f / l;
#pragma unroll
        for (int d = 0; d < 64; ++d) ATT[(size_t)row * 512 + h * 64 + d] = f2bf(o[d] * il);
    }
}
__device__ __forceinline__ void d_route(float* lds, const bf16* QP, const bf16* SK, int* EID, float* EG) {
    const int tid = threadIdx.x; float* lv = lds + tid * 33; int* li = (int*)(lds + NT * 33) + tid * 33;
    GSTRIDE(gidx, M * PHEADS) {
        const int idx = (int)gidx, h = idx % PHEADS, t = idx / PHEADS;
#pragma unroll 1
        for (int p = 0; p < 2; ++p) {
            float tv[16]; int ti[16];
#pragma unroll
            for (int j = 0; j < 16; ++j) { tv[j] = -INFINITY; ti[j] = 0; }
            const bf16* qr = QP + (size_t)t * 2048 + h * 256 + p * 128; const bf16* sk = SK + (size_t)(h * 2 + p) * 128 * 128;
#pragma unroll 1
            for (int n = 0; n < 128; ++n) { float s = 0.f;
                for (int d = 0; d < 128; ++d) s += bf2f(qr[d]) * bf2f(sk[n * 128 + d]);
                float v = s; int vi = n;
#pragma unroll
                for (int j = 0; j < 16; ++j) if (v > tv[j]) { const float tf = tv[j]; const int tj = ti[j]; tv[j] = v; ti[j] = vi; v = tf; vi = tj; } }
#pragma unroll
            for (int j = 0; j < 16; ++j) { lv[p * 16 + j] = tv[j]; li[p * 16 + j] = ti[j]; }
        }
        float cv[16]; int ci[16];
#pragma unroll
        for (int j = 0; j < 16; ++j) { cv[j] = -INFINITY; ci[j] = 0; }
#pragma unroll 1
        for (int i = 0; i < 16; ++i)
#pragma unroll 1
            for (int j2 = 0; j2 < 16; ++j2) { float v = lv[i] + lv[16 + j2]; int vi = li[i] * NKEYS + li[16 + j2];
#pragma unroll
                for (int j = 0; j < 16; ++j) if (v > cv[j]) { const float tf = cv[j]; const int tj = ci[j]; cv[j] = v; ci[j] = vi; v = tf; vi = tj; } }
        float sum = 0.f, e[16];
#pragma unroll
        for (int j = 0; j < 16; ++j) { e[j] = expf(cv[j] - cv[0]); sum += e[j]; }
        const float is = 1.f / sum;
#pragma unroll
        for (int j = 0; j < 16; ++j) { EID[(size_t)t * NSEL + h * 16 + j] = ci[j]; EG[(size_t)t * NSEL + h * 16 + j] = e[j] * is; }
    }
}
__device__ __forceinline__ void d_peer(const bf16* H2, const int* EID, const float* EG, const float* Ut, const float* Vt, const float* mod, const float* gfin, float* io) {
    const int lane = threadIdx.x & 63;
    for (int t = blockIdx.x * (NT / 64) + (threadIdx.x >> 6); t < M; t += gridDim.x * (NT / 64)) {
        const int b = t / SEQ; float hv[16], acc[16];
#pragma unroll
        for (int j = 0; j < 4; ++j)
#pragma unroll
            for (int e = 0; e < 4; ++e) { hv[j * 4 + e] = bf2f(H2[(size_t)t * D + j * 256 + lane * 4 + e]); acc[j * 4 + e] = 0.f; }
#pragma unroll 1
        for (int k = 0; k < NSEL; ++k) {
            const int eid = EID[(size_t)t * NSEL + k]; const float g = EG[(size_t)t * NSEL + k];
            const float4* ur = (const float4*)(Ut + (size_t)eid * D); const float4* vr = (const float4*)(Vt + (size_t)eid * D); float dot = 0.f;
#pragma unroll
            for (int j = 0; j < 4; ++j) { const float4 u = ur[j * 64 + lane]; dot += hv[j * 4] * u.x + hv[j * 4 + 1] * u.y + hv[j * 4 + 2] * u.z + hv[j * 4 + 3] * u.w; }
#pragma unroll
            for (int o = 1; o < 64; o <<= 1) dot += __shfl_xor(dot, o);
            const float w = g * 0.5f * dot * (1.f + erff(dot * 0.70710678118654752f));
#pragma unroll
            for (int j = 0; j < 4; ++j) { const float4 v = vr[j * 64 + lane]; acc[j * 4] += w * v.x; acc[j * 4 + 1] += w * v.y; acc[j * 4 + 2] += w * v.z; acc[j * 4 + 3] += w * v.w; }
        }
        float ss = 0.f;
#pragma unroll
        for (int j = 0; j < 4; ++j)
#pragma unroll
            for (int e = 0; e < 4; ++e) { const int col = j * 256 + lane * 4 + e; const float x2 = io[(size_t)t * D + col] + mod[b * 6144 + 5 * D + col] * acc[j * 4 + e]; acc[j * 4 + e] = x2; ss += x2 * x2; }
#pragma unroll
        for (int o = 1; o < 64; o <<= 1) ss += __shfl_xor(ss, o);
        const float r = rsqrtf(ss * (1.f / D) + EPS);
#pragma unroll
        for (int j = 0; j < 4; ++j)
#pragma unroll
            for (int e = 0; e < 4; ++e) { const int col = j * 256 + lane * 4 + e; io[(size_t)t * D + col] = acc[j * 4 + e] * r * gfin[col]; }
    }
}


#define LAS __attribute__((address_space(3)))
typedef short bf16x8 __attribute__((ext_vector_type(8)));
typedef float f32x4 __attribute__((ext_vector_type(4)));
typedef float f32x2 __attribute__((ext_vector_type(2)));
typedef unsigned u32x4 __attribute__((ext_vector_type(4)));
typedef unsigned u32x2 __attribute__((ext_vector_type(2)));
typedef __bf16 bf16x2_t __attribute__((ext_vector_type(2)));
__device__ __forceinline__ unsigned cvt_pk_bf16(float lo, float hi) { f32x2 v = {lo, hi}; bf16x2_t b = __builtin_convertvector(v, bf16x2_t); return __builtin_bit_cast(unsigned, b); }
__device__ __forceinline__ float bflo(unsigned w) { return __uint_as_float(w << 16); }
__device__ __forceinline__ float bfhi(unsigned w) { return __uint_as_float(w & 0xffff0000u); }

namespace pg8 {
constexpr int BM = 256, BK = 64, HALF = 128, HTB = HALF * BK * 2  , STAGE_BYTES = 8 * HTB, NXCD = 8, WGM = 8;
__device__ __forceinline__ int lds_byte(int r, int c) { const int st = (r >> 4) * 2 + (c >> 5), rr = r & 15, cc = c & 31, ob = rr * 64 + cc * 2; return st * 1024 + (ob ^ (((ob >> 9) & 1) << 5)); }
__device__ __forceinline__ void stage_rc(int b, int& R, int& C) { const int st = b / 1024, sb = b % 1024, swz = sb ^ (((sb >> 9) & 1) << 5); R = (st >> 1) * 16 + swz / 64; C = (st & 1) * 32 + (swz % 64) / 2; }
__device__ __forceinline__ int perm32(int rho) { const int n = rho >> 4, i = rho & 15; return 8 * (i >> 2) + 4 * n + (i & 3); }
struct Unit { int pm, pn; };
struct Gemm { const bf16* A; const bf16* Bt; int M, N, K, lda, a_pn_off; };
struct StaticOrder {
    int nM, nN, nwg, G, c;
    __device__ void init(int M_, int N_, int G_, int c_) { nM = M_ / BM; nN = N_ / BM; nwg = nM * nN; G = G_; c = c_; }
    __device__ bool next(int i, Unit& u) const {
        const long L = (long)i * G + c; if (L >= nwg) return false;
        int wgid = (int)L; { const int q = nwg / NXCD, r = nwg % NXCD, xcd = wgid % NXCD, off = wgid / NXCD; wgid = (xcd < r ? xcd * (q + 1) : r * (q + 1) + (xcd - r) * q) + off; }
        const int nig = WGM * nN, gid = wgid / nig, fm = gid * WGM, gsz = (nM - fm) < WGM ? (nM - fm) : WGM;
        u.pm = fm + ((wgid % nig) % gsz); u.pn = (wgid % nig) / gsz; return true;
    }
};
struct OneUnit { Unit u; __device__ bool next(int i, Unit& o) const { if (i) return false; o = u; return true; } };
template <class Epi, class Sched, bool ALIGN_EPI>
__device__ __forceinline__ void gemm_phase(LAS unsigned char* lds, const Gemm g, const Sched& S, const Epi& E) {
    int tid_ = threadIdx.x; asm volatile("" : "+v"(tid_));
    const int tid = tid_, wid = __builtin_amdgcn_readfirstlane(tid >> 6), lane = tid & 63, wr = wid >> 2, wc = wid & 3, fr = lane & 15, fq = lane >> 4;
    const int K = g.K, nt = K / BK, lda = g.lda;
    unsigned voffA[2], voffB[2];
#pragma unroll
    for (int i = 0; i < 2; ++i) { int R, C; stage_rc(tid * 16 + i * 8192, R, C); const int Rb = Epi::PERM ? ((R & ~31) + perm32(R & 31)) : R;
        voffA[i] = (unsigned)(R * lda + C) * 2u; voffB[i] = (unsigned)(Rb * K + C) * 2u; }
    const size_t kstep = (size_t)(BK * 2);
    const size_t hA = (size_t)HALF * lda * 2, hB = (size_t)HALF * K * 2, tA = 2 * hA, tB = 2 * hB;
    const unsigned ldsw = (unsigned)wid * 1024u;
    const int aoff = lds_byte(wr * 64 + fr, fq * 8), boff = lds_byte(wc * 32 + fr, fq * 8);
#define PG8_SA(b, h) (((b) * 2 + (h)) * HTB)
#define PG8_SB(b, h) ((4 + (b) * 2 + (h)) * HTB)
#define PG8_STAGE(bufoff, gbase, voff) do { _Pragma("unroll") for (int _i = 0; _i < 2; ++_i) \
        __builtin_amdgcn_global_load_lds((const unsigned*)((const char*)(gbase) + (voff)[_i]), (LAS unsigned*)(lds + (bufoff) + ldsw + _i * 8192), 16, 0, 0); } while (0)
#define PG8_LDA(dst, b, h) do { _Pragma("unroll") for (int m = 0; m < 4; ++m) _Pragma("unroll") for (int k = 0; k < 2; ++k) dst[m][k] = *(const LAS bf16x8*)(lds + PG8_SA(b, h) + aoff + m * 2048 + k * 1024); } while (0)
#define PG8_LDB(dst, b, h) do { _Pragma("unroll") for (int n = 0; n < 2; ++n) _Pragma("unroll") for (int k = 0; k < 2; ++k) dst[n][k] = *(const LAS bf16x8*)(lds + PG8_SB(b, h) + boff + n * 2048 + k * 1024); } while (0)
#define PG8_MMA(ai, bj, At, Bt) do { __builtin_amdgcn_s_setprio(1); _Pragma("unroll") for (int m = 0; m < 4; ++m) _Pragma("unroll") for (int n = 0; n < 2; ++n) _Pragma("unroll") for (int k = 0; k < 2; ++k) \
        acc[ai][bj][m][n] = __builtin_amdgcn_mfma_f32_16x16x32_bf16(Bt[n][k], At[m][k], acc[ai][bj][m][n], 0, 0, 0); __builtin_amdgcn_s_setprio(0); } while (0)
#define PG8_WAIT_V(n) asm volatile("s_waitcnt vmcnt(" #n ")" ::: "memory")
#define PG8_WAIT_L(n) asm volatile("s_waitcnt lgkmcnt(" #n ")" ::: "memory")
#define PG8_BAR __builtin_amdgcn_s_barrier()
#define PG8_SCHED __builtin_amdgcn_sched_barrier(0)
    Unit cur, nxt; int ui = 0;
    if (!S.next(0, cur)) return;
    f32x4 acc[2][2][4][2];
#pragma unroll
    for (int a = 0; a < 2; ++a)
#pragma unroll
        for (int b = 0; b < 2; ++b)
#pragma unroll
            for (int m = 0; m < 4; ++m)
#pragma unroll
                for (int n = 0; n < 2; ++n) acc[a][b][m][n] = (f32x4){0.f, 0.f, 0.f, 0.f};
    bf16x8 At[4][2], B0[2][2], B1[2][2];
    const char* cA = (const char*)g.A + (size_t)cur.pm * tA + (size_t)cur.pn * g.a_pn_off * 2; const char* cB = (const char*)g.Bt + (size_t)cur.pn * tB;
    PG8_STAGE(PG8_SB(0, 0), cB, voffB); PG8_STAGE(PG8_SB(0, 1), cB + hB, voffB); PG8_STAGE(PG8_SA(0, 0), cA, voffA); PG8_STAGE(PG8_SA(0, 1), cA + hA, voffA);
    if (wr == 1) PG8_BAR;
    PG8_WAIT_V(2); PG8_BAR;
    PG8_STAGE(PG8_SB(1, 0), cB + kstep, voffB); PG8_STAGE(PG8_SA(1, 0), cA + kstep, voffA); PG8_STAGE(PG8_SB(1, 1), cB + hB + kstep, voffB);
    PG8_WAIT_V(6); PG8_BAR;
    for (;;) {
        const bool has_next = S.next(ui + 1, nxt);
        const char* nA = has_next ? (const char*)g.A + (size_t)nxt.pm * tA + (size_t)nxt.pn * g.a_pn_off * 2 : cA; const char* nB = has_next ? (const char*)g.Bt + (size_t)nxt.pn * tB : cB;
        for (int t = 0; t < nt; t += 2) {
            const bool last = (t == nt - 2);
            const char* a1 = cA + (size_t)(t + 1) * kstep;
            const char* a2 = last ? nA : cA + (size_t)(t + 2) * kstep; const char* b2 = last ? nB : cB + (size_t)(t + 2) * kstep;
            const char* a3 = a2 + kstep; const char* b3 = b2 + kstep;
            PG8_LDB(B0, 0, 0); PG8_LDB(B1, 0, 1); PG8_SCHED; PG8_LDA(At, 0, 0); PG8_STAGE(PG8_SA(1, 1), a1 + hA, voffA);
            PG8_WAIT_V(8); PG8_WAIT_L(0); PG8_BAR; PG8_MMA(0, 0, At, B0); PG8_MMA(0, 1, At, B1); PG8_BAR; PG8_SCHED;
            PG8_LDA(At, 0, 1); PG8_STAGE(PG8_SB(0, 0), b2, voffB); PG8_STAGE(PG8_SB(0, 1), b2 + hB, voffB); PG8_STAGE(PG8_SA(0, 0), a2, voffA);
            PG8_WAIT_V(8); PG8_WAIT_L(0); PG8_BAR; PG8_MMA(1, 0, At, B0); PG8_MMA(1, 1, At, B1); PG8_BAR; PG8_SCHED;
            PG8_LDB(B0, 1, 0); PG8_LDB(B1, 1, 1); PG8_SCHED; PG8_LDA(At, 1, 0); PG8_STAGE(PG8_SA(0, 1), a2 + hA, voffA);
            PG8_WAIT_V(8); PG8_WAIT_L(0); PG8_BAR; PG8_MMA(0, 0, At, B0); PG8_MMA(0, 1, At, B1); PG8_BAR; PG8_SCHED;
            PG8_LDA(At, 1, 1); PG8_STAGE(PG8_SB(1, 0), b3, voffB); PG8_STAGE(PG8_SB(1, 1), b3 + hB, voffB); PG8_STAGE(PG8_SA(1, 0), a3, voffA);
            PG8_WAIT_V(8); PG8_WAIT_L(0); PG8_BAR; PG8_MMA(1, 0, At, B0); PG8_MMA(1, 1, At, B1); PG8_BAR; PG8_SCHED;
        }
        if constexpr (ALIGN_EPI) { if (wr == 0) PG8_BAR; }
        if constexpr (!Epi::AFTER_DRAIN) { E(acc, cur, wr, wc, fr, fq); }
        if (!has_next) break;
#pragma unroll
        for (int a = 0; a < 2; ++a)
#pragma unroll
            for (int b = 0; b < 2; ++b)
#pragma unroll
                for (int m = 0; m < 4; ++m)
#pragma unroll
                    for (int n = 0; n < 2; ++n) acc[a][b][m][n] = (f32x4){0.f, 0.f, 0.f, 0.f};
        cur = nxt; cA = nA; cB = nB; ++ui;
        if constexpr (ALIGN_EPI) { if (wr == 1) PG8_BAR; }
    }
    PG8_WAIT_V(0);
    if constexpr (!ALIGN_EPI) { if (wr == 0) PG8_BAR; }
    PG8_BAR;
    if constexpr (Epi::AFTER_DRAIN) { E.fused(acc, cur, wr, wc, fr, fq, lds, wid, lane); }
#undef PG8_SA
#undef PG8_SB
#undef PG8_STAGE
#undef PG8_LDA
#undef PG8_LDB
#undef PG8_MMA
#undef PG8_WAIT_V
#undef PG8_WAIT_L
#undef PG8_BAR
#undef PG8_SCHED
}
}

__device__ __forceinline__ float fast_sigmoid(float v) { return __builtin_amdgcn_rcpf(1.f + __builtin_amdgcn_exp2f(-1.4426950408889634f * v)); }
struct EpiInProj {
    static constexpr bool PERM = true, AFTER_DRAIN = false;
    bf16 *UP, *Q, *Kb, *V, *G; const float* rope; float* ksum;
    __device__ __forceinline__ void operator()(const f32x4 (&acc)[2][2][4][2], const pg8::Unit& u, int wr, int wc, int fr, int fq) const {
        const int pn = u.pn, row0 = u.pm * 256 + wr * 64 + fr;
        if (pn < 2 || (pn >= 6 && pn < 8)) {
            bf16* O = pn < 2 ? UP : V; const int c0 = (pn & 1) * 256 + wc * 32 + 8 * fq;
#pragma unroll
            for (int ai = 0; ai < 2; ++ai)
#pragma unroll
                for (int m = 0; m < 4; ++m)
#pragma unroll
                    for (int bj = 0; bj < 2; ++bj) { const f32x4 v0 = acc[ai][bj][m][0], v1 = acc[ai][bj][m][1]; u32x4 w;
                        w.x = cvt_pk_bf16(v0[0], v0[1]); w.y = cvt_pk_bf16(v0[2], v0[3]); w.z = cvt_pk_bf16(v1[0], v1[1]); w.w = cvt_pk_bf16(v1[2], v1[3]);
                        *(u32x4*)(O + (size_t)(row0 + ai * 128 + m * 16) * 512 + c0 + bj * 128) = w; }
        } else if (pn < 6) {
            const bool isq = pn < 4; bf16* O = isq ? Q : Kb; const int c0 = (pn & 1) * 256 + wc * 32 + 8 * fq; const bool rot = (wc & 1) == 0;
            float cs[2][8];
#pragma unroll
            for (int bj = 0; bj < 2; ++bj)
#pragma unroll
                for (int i = 0; i < 8; ++i) cs[bj][i] = 0.f;
#pragma unroll
            for (int ai = 0; ai < 2; ++ai)
#pragma unroll
                for (int m = 0; m < 4; ++m) {
                    const int row = row0 + ai * 128 + m * 16, pos = row % SEQ;
                    f32x4 c0v = {1.f, 1.f, 1.f, 1.f}, c1v = c0v, s0v = {0.f, 0.f, 0.f, 0.f}, s1v = s0v;
                    if (rot) { const f32x4* rp = (const f32x4*)(rope + pos * 16); c0v = rp[0]; c1v = rp[1]; s0v = rp[2]; s1v = rp[3]; }
#pragma unroll
                    for (int bj = 0; bj < 2; ++bj) { f32x4 v0 = acc[ai][bj][m][0], v1 = acc[ai][bj][m][1];
                        if (rot) { f32x4 p0, p1;
#pragma unroll
                            for (int i = 0; i < 4; ++i) { p0[i] = __shfl_xor(v0[i], 16); p1[i] = __shfl_xor(v1[i], 16); }
                            if (fq == 0) { v0 = v0 * c0v - p0 * s0v; v1 = v1 * c1v - p1 * s1v; } else if (fq == 1) { v0 = p0 * s0v + v0 * c0v; v1 = p1 * s1v + v1 * c1v; } }
                        if (isq) { v0 = v0 * C2; v1 = v1 * C2; } else {
#pragma unroll
                            for (int i = 0; i < 4; ++i) { cs[bj][i] += v0[i]; cs[bj][4 + i] += v1[i]; } }
                        u32x4 w; w.x = cvt_pk_bf16(v0[0], v0[1]); w.y = cvt_pk_bf16(v0[2], v0[3]); w.z = cvt_pk_bf16(v1[0], v1[1]); w.w = cvt_pk_bf16(v1[2], v1[3]);
                        *(u32x4*)(O + (size_t)row * 512 + c0 + bj * 128) = w; }
                }
            if (!isq) {
                const int b = u.pm / NBLK, blk = u.pm % NBLK;
#pragma unroll
                for (int bj = 0; bj < 2; ++bj)
#pragma unroll
                    for (int i = 0; i < 8; ++i) { float s = cs[bj][i]; s += __shfl_xor(s, 1); s += __shfl_xor(s, 2); s += __shfl_xor(s, 4); s += __shfl_xor(s, 8);
                        if (fr == 0) { const int head = (pn & 1) * 4 + bj * 2 + (wc >> 1), d = (wc & 1) * 32 + 8 * fq + i; atomicAdd(ksum + ((size_t)(b * NH + head) * NBLK + blk) * HD + d, s); } }
            }
        } else {
            const int c0 = (pn - 8) * 256 + wc * 32 + 8 * fq;
#pragma unroll
            for (int ai = 0; ai < 2; ++ai)
#pragma unroll
                for (int m = 0; m < 4; ++m)
#pragma unroll
                    for (int bj = 0; bj < 2; ++bj) { const f32x4 v0 = acc[ai][bj][m][0], v1 = acc[ai][bj][m][1]; u32x4 w;
                        w.x = cvt_pk_bf16(fast_sigmoid(v0[0]), fast_sigmoid(v0[1])); w.y = cvt_pk_bf16(fast_sigmoid(v0[2]), fast_sigmoid(v0[3]));
                        w.z = cvt_pk_bf16(fast_sigmoid(v1[0]), fast_sigmoid(v1[1])); w.w = cvt_pk_bf16(fast_sigmoid(v1[2]), fast_sigmoid(v1[3]));
                        *(u32x4*)(G + (size_t)(row0 + ai * 128 + m * 16) * 2048 + c0 + bj * 128) = w; }
        }
    }
};
template <int PASS> struct EpiMerge {
    static constexpr bool PERM = true, AFTER_DRAIN = false;
    bf16* Mg; const bf16* G;
    __device__ __forceinline__ void operator()(const f32x4 (&acc)[2][2][4][2], const pg8::Unit& u, int wr, int wc, int fr, int fq) const {
        const int row0 = u.pm * 256 + wr * 64 + fr, c0 = u.pn * 256 + wc * 32 + 8 * fq;
#pragma unroll
        for (int ai = 0; ai < 2; ++ai)
#pragma unroll
            for (int m = 0; m < 4; ++m)
#pragma unroll
                for (int bj = 0; bj < 2; ++bj) { const size_t row = (size_t)(row0 + ai * 128 + m * 16); const int col = c0 + bj * 128;
                    const u32x4 gw = *(const u32x4*)(G + row * 2048 + PASS * 1024 + col); const f32x4 v0 = acc[ai][bj][m][0], v1 = acc[ai][bj][m][1];
                    float o[8] = {bflo(gw.x) * v0[0], bfhi(gw.x) * v0[1], bflo(gw.y) * v0[2], bfhi(gw.y) * v0[3], bflo(gw.z) * v1[0], bfhi(gw.z) * v1[1], bflo(gw.w) * v1[2], bfhi(gw.w) * v1[3]};
                    if (PASS == 1) { const u32x4 pw = *(const u32x4*)(Mg + row * 1024 + col);
                        o[0] += bflo(pw.x); o[1] += bfhi(pw.x); o[2] += bflo(pw.y); o[3] += bfhi(pw.y); o[4] += bflo(pw.z); o[5] += bfhi(pw.z); o[6] += bflo(pw.w); o[7] += bfhi(pw.w); }
                    u32x4 w; w.x = cvt_pk_bf16(o[0], o[1]); w.y = cvt_pk_bf16(o[2], o[3]); w.z = cvt_pk_bf16(o[4], o[5]); w.w = cvt_pk_bf16(o[6], o[7]);
                    *(u32x4*)(Mg + row * 1024 + col) = w; }
    }
};
struct EpiRes1 {
    static constexpr bool PERM = false, AFTER_DRAIN = false;
    const float* x; const float* mod; float* x1;
    __device__ __forceinline__ void operator()(const f32x4 (&acc)[2][2][4][2], const pg8::Unit& u, int wr, int wc, int fr, int fq) const {
        const int row0 = u.pm * 256 + wr * 64 + fr, c0 = u.pn * 256 + wc * 32 + 4 * fq, b = u.pm / NBLK;
#pragma unroll
        for (int bj = 0; bj < 2; ++bj)
#pragma unroll
            for (int n = 0; n < 2; ++n) { const int col = c0 + bj * 128 + n * 16; const f32x4 gv = *(const f32x4*)(mod + b * 6144 + 2 * D + col);
#pragma unroll
                for (int ai = 0; ai < 2; ++ai)
#pragma unroll
                    for (int m = 0; m < 4; ++m) { const size_t off = (size_t)(row0 + ai * 128 + m * 16) * D + col; *(f32x4*)(x1 + off) = *(const f32x4*)(x + off) + gv * acc[ai][bj][m][n]; } }
    }
};
struct EpiBf16 {
    static constexpr bool PERM = true, AFTER_DRAIN = false;
    bf16* O; int ldo;
    __device__ __forceinline__ void operator()(const f32x4 (&acc)[2][2][4][2], const pg8::Unit& u, int wr, int wc, int fr, int fq) const {
        const int row0 = u.pm * 256 + wr * 64 + fr, c0 = u.pn * 256 + wc * 32 + 8 * fq;
#pragma unroll
        for (int ai = 0; ai < 2; ++ai)
#pragma unroll
            for (int m = 0; m < 4; ++m)
#pragma unroll
                for (int bj = 0; bj < 2; ++bj) { const f32x4 v0 = acc[ai][bj][m][0], v1 = acc[ai][bj][m][1]; u32x4 w;
                    w.x = cvt_pk_bf16(v0[0], v0[1]); w.y = cvt_pk_bf16(v0[2], v0[3]); w.z = cvt_pk_bf16(v1[0], v1[1]); w.w = cvt_pk_bf16(v1[2], v1[3]);
                    *(u32x4*)(O + (size_t)(row0 + ai * 128 + m * 16) * ldo + c0 + bj * 128) = w; }
    }
};

namespace att {
typedef short v4i16_t __attribute__((ext_vector_type(4)));
typedef float f32x16 __attribute__((ext_vector_type(16)));
constexpr int KB_BYTES = 8192, VROW = 192, VB_BYTES = 64 * VROW, OFF_V = 2 * KB_BYTES, OFF_MISC = OFF_V + 2 * VB_BYTES;
__device__ __forceinline__ int crow(int r, int hi) { return (r & 3) + 8 * (r >> 2) + 4 * hi; }
__device__ __forceinline__ float bfe(bf16x8 v, int j) { return __uint_as_float(((unsigned)(unsigned short)v[j]) << 16); }
__device__ __forceinline__ void attn_phase(LAS unsigned char* lds, const bf16* Q, const bf16* Kb, const bf16* V, const float* ksum, bf16* ATT, int G, int bid) {
    int tid_ = threadIdx.x; asm volatile("" : "+v"(tid_));
    const int tid = tid_, lane = tid & 63, wid = __builtin_amdgcn_readfirstlane(tid >> 6), r32 = lane & 31, hi = lane >> 5;
    const int vcu = (G % 8 == 0) ? (bid % 8) * (G / 8) + bid / 8 : bid;
    LAS unsigned char* Kbuf = lds; LAS unsigned char* Vbuf = lds + OFF_V; LAS int* misc = (LAS int*)(lds + OFF_MISC);
    const int ld_row = tid >> 3, ld_ch = tid & 7;
    const int kst = ld_row * 128 + ((ld_ch ^ ((ld_row >> 1) & 7)) << 4), vst = ld_row * VROW + ld_ch * 16;
    for (int uidx = vcu; uidx < 512; uidx += G) {
        const int bh = (uidx & 255) >> 4, s_ = uidx & 15, qb = uidx < 256 ? s_ : 31 - s_, b = bh >> 3, h = bh & 7;
        const int q_off = wid * 32 + r32; const size_t qrow = (size_t)b * SEQ + qb * 256 + q_off;
        bf16x8 qr[4];
#pragma unroll
        for (int s = 0; s < 4; ++s) qr[s] = *(const bf16x8*)(Q + qrow * 512 + h * 64 + 16 * s + 8 * hi);
        unsigned selmask = 0u;
        { int s0 = -1, s1 = -1, s2 = -1; float g0 = -INFINITY, g1 = -INFINITY, g2 = -INFINITY;
          const float* ksb = ksum + (size_t)(b * NH + h) * NBLK * HD + 8 * hi;
          for (int j = 0; j < qb; ++j) { float part = 0.f;
#pragma unroll
              for (int s = 0; s < 4; ++s) { const f32x4 k0 = *(const f32x4*)(ksb + j * HD + 16 * s), k1 = *(const f32x4*)(ksb + j * HD + 16 * s + 4);
                  part += bfe(qr[s], 0) * k0[0] + bfe(qr[s], 1) * k0[1] + bfe(qr[s], 2) * k0[2] + bfe(qr[s], 3) * k0[3] + bfe(qr[s], 4) * k1[0] + bfe(qr[s], 5) * k1[1] + bfe(qr[s], 6) * k1[2] + bfe(qr[s], 7) * k1[3]; }
              const float g = part + __shfl_xor(part, 32);
              if (g > g0) { g2 = g1; s2 = s1; g1 = g0; s1 = s0; g0 = g; s0 = j; } else if (g > g1) { g2 = g1; s2 = s1; g1 = g; s1 = j; } else if (g > g2) { g2 = g; s2 = j; } }
          if (s0 >= 0) selmask |= 1u << s0; if (s1 >= 0) selmask |= 1u << s1; if (s2 >= 0) selmask |= 1u << s2; }
        { unsigned um = selmask;
#pragma unroll
          for (int o = 1; o < 64; o <<= 1) um |= (unsigned)__shfl_xor((int)um, o);
          if (lane == 0) misc[wid] = (int)um; }
        __syncthreads();
        if (tid == 0) { unsigned uni = 0u; for (int w = 0; w < 8; ++w) uni |= (unsigned)misc[w]; int nb = 1; misc[16] = qb; while (uni) { misc[16 + nb] = __builtin_ctz(uni); uni &= uni - 1u; ++nb; } misc[8] = nb; }
        __syncthreads();
        const int ntiles = misc[8] * 4;
        const bf16* Kg = Kb + ((size_t)b * SEQ) * 512 + h * 64 + ld_ch * 8; const bf16* Vg = V + ((size_t)b * SEQ) * 512 + h * 64 + ld_ch * 8;
        u32x4 kreg, vreg;
        { const int jb0 = misc[16]; const size_t ro = (size_t)(jb0 * 256 + ld_row) * 512; kreg = *(const u32x4*)(Kg + ro); vreg = *(const u32x4*)(Vg + ro); }
        *(LAS u32x4*)(Kbuf + kst) = kreg; *(LAS u32x4*)(Vbuf + vst) = vreg;
        __syncthreads();
        float mrun = -INFINITY, lsum = 0.f; f32x16 o0 = {}, o1 = {};
        for (int n = 0; n < ntiles; ++n) {
            const int jb = misc[16 + (n >> 2)], tt = n & 3; const bool own = n < 4;
            if (n + 1 < ntiles) { const int jn = misc[16 + ((n + 1) >> 2)]; const size_t ro = (size_t)(jn * 256 + ((n + 1) & 3) * 64 + ld_row) * 512; kreg = *(const u32x4*)(Kg + ro); vreg = *(const u32x4*)(Vg + ro); }
            const bool lane_valid = own || ((selmask >> jb) & 1u);
            const bool need = own ? (64 * tt <= 32 * wid + 31) : (__any(lane_valid ? 1 : 0) != 0);
            if (need) {
                const LAS unsigned char* kb_ = Kbuf + (n & 1) * KB_BYTES; const LAS unsigned char* vb_ = Vbuf + (n & 1) * VB_BYTES;
                f32x16 p0 = {}, p1 = {};
#pragma unroll
                for (int s = 0; s < 4; ++s) { const int c = 2 * s + hi; const int sw = ((c ^ ((r32 >> 1) & 7)) << 4);
                    const bf16x8 a0 = *(const LAS bf16x8*)(kb_ + r32 * 128 + sw), a1 = *(const LAS bf16x8*)(kb_ + (32 + r32) * 128 + sw);
                    p0 = __builtin_amdgcn_mfma_f32_32x32x16_bf16(a0, qr[s], p0, 0, 0, 0); p1 = __builtin_amdgcn_mfma_f32_32x32x16_bf16(a1, qr[s], p1, 0, 0, 0); }
                if (own) {
#pragma unroll
                    for (int r = 0; r < 16; ++r) { const int ko = tt * 64 + crow(r, hi); if (ko > q_off) p0[r] = -INFINITY; if (ko + 32 > q_off) p1[r] = -INFINITY; }
                } else if (!lane_valid) {
#pragma unroll
                    for (int r = 0; r < 16; ++r) { p0[r] = -INFINITY; p1[r] = -INFINITY; }
                }
                float mt = fmaxf(p0[0], p1[0]);
#pragma unroll
                for (int r = 1; r < 16; ++r) mt = fmaxf(mt, fmaxf(p0[r], p1[r]));
                mt = fmaxf(mt, __shfl_xor(mt, 32));
                const float mnew = fmaxf(mrun, mt), alpha = __builtin_amdgcn_exp2f(mrun - mnew); mrun = mnew;
                float ps = 0.f;
#pragma unroll
                for (int r = 0; r < 16; ++r) { p0[r] = __builtin_amdgcn_exp2f(p0[r] - mnew); p1[r] = __builtin_amdgcn_exp2f(p1[r] - mnew); ps += p0[r] + p1[r]; }
                lsum = lsum * alpha + ps;
                if (!__all(alpha == 1.f ? 1 : 0)) {
#pragma unroll
                    for (int r = 0; r < 16; ++r) { o0[r] *= alpha; o1[r] *= alpha; } }
                bf16x8 pb[2][2];
#pragma unroll
                for (int s2 = 0; s2 < 2; ++s2) { u32x4 w0, w1;
                    w0.x = cvt_pk_bf16(p0[8 * s2], p0[8 * s2 + 1]); w0.y = cvt_pk_bf16(p0[8 * s2 + 2], p0[8 * s2 + 3]); w0.z = cvt_pk_bf16(p0[8 * s2 + 4], p0[8 * s2 + 5]); w0.w = cvt_pk_bf16(p0[8 * s2 + 6], p0[8 * s2 + 7]);
                    w1.x = cvt_pk_bf16(p1[8 * s2], p1[8 * s2 + 1]); w1.y = cvt_pk_bf16(p1[8 * s2 + 2], p1[8 * s2 + 3]); w1.z = cvt_pk_bf16(p1[8 * s2 + 4], p1[8 * s2 + 5]); w1.w = cvt_pk_bf16(p1[8 * s2 + 6], p1[8 * s2 + 7]);
                    pb[0][s2] = __builtin_bit_cast(bf16x8, w0); pb[1][s2] = __builtin_bit_cast(bf16x8, w1); }
                const LAS unsigned char* vl = vb_ + (4 * hi + ((lane & 15) >> 2)) * VROW + (16 * ((lane >> 4) & 1) + 4 * (lane & 3)) * 2;
#pragma unroll
                for (int dt = 0; dt < 2; ++dt)
#pragma unroll
                    for (int u = 0; u < 2; ++u)
#pragma unroll
                        for (int s2 = 0; s2 < 2; ++s2) { const LAS unsigned char* va = vl + (32 * u + 16 * s2) * VROW + dt * 64;
                            const v4i16_t lo = __builtin_amdgcn_ds_read_tr16_b64_v4i16((LAS v4i16_t*)va), hh = __builtin_amdgcn_ds_read_tr16_b64_v4i16((LAS v4i16_t*)(va + 8 * VROW));
                            const bf16x8 vf = {lo[0], lo[1], lo[2], lo[3], hh[0], hh[1], hh[2], hh[3]};
                            if (dt == 0) o0 = __builtin_amdgcn_mfma_f32_32x32x16_bf16(vf, pb[u][s2], o0, 0, 0, 0); else o1 = __builtin_amdgcn_mfma_f32_32x32x16_bf16(vf, pb[u][s2], o1, 0, 0, 0); }
            }
            if (n + 1 < ntiles) { *(LAS u32x4*)(Kbuf + ((n + 1) & 1) * KB_BYTES + kst) = kreg; *(LAS u32x4*)(Vbuf + ((n + 1) & 1) * VB_BYTES + vst) = vreg; }
            __syncthreads();
        }
        const float inv = 1.f / (lsum + __shfl_xor(lsum, 32));
        bf16* orow = ATT + qrow * 512 + h * 64 + 4 * hi;
#pragma unroll
        for (int g4 = 0; g4 < 4; ++g4) { u32x2 w;
            w.x = cvt_pk_bf16(o0[4 * g4] * inv, o0[4 * g4 + 1] * inv); w.y = cvt_pk_bf16(o0[4 * g4 + 2] * inv, o0[4 * g4 + 3] * inv); *(u32x2*)(orow + 8 * g4) = w;
            w.x = cvt_pk_bf16(o1[4 * g4] * inv, o1[4 * g4 + 1] * inv); w.y = cvt_pk_bf16(o1[4 * g4 + 2] * inv, o1[4 * g4 + 3] * inv); *(u32x2*)(orow + 32 + 8 * g4) = w; }
    }
}
}

__device__ __forceinline__ float dot2bf(unsigned a, unsigned b, float acc) { return __builtin_amdgcn_fdot2_f32_bf16(__builtin_bit_cast(bf16x2_t, a), __builtin_bit_cast(bf16x2_t, b), acc, false); }
__device__ __forceinline__ void d_tab_bf16(const float* T, bf16* O) {
    GSTRIDE(i, (size_t)NEXP * D / 8) { const f32x4 a = ((const f32x4*)T)[2 * i], b = ((const f32x4*)T)[2 * i + 1]; u32x4 w;
        w.x = cvt_pk_bf16(a[0], a[1]); w.y = cvt_pk_bf16(a[2], a[3]); w.z = cvt_pk_bf16(b[0], b[1]); w.w = cvt_pk_bf16(b[2], b[3]); ((u32x4*)O)[i] = w; }
}
__device__ __forceinline__ void peer_phase(const bf16* H2, const int* EID, const float* EG, const bf16* UT, const bf16* VT, const float* mod, const float* gfin, const float* x1, float* outp) {
    int tid_ = threadIdx.x; asm volatile("" : "+v"(tid_));
    const int lane = tid_ & 63, wv = tid_ >> 6;
    for (int t = blockIdx.x * (NT / 64) + wv; t < M; t += gridDim.x * (NT / 64)) {
        const int b = t / SEQ;
        const u32x4 h0 = *(const u32x4*)(H2 + (size_t)t * D + 8 * lane), h1 = *(const u32x4*)(H2 + (size_t)t * D + 512 + 8 * lane);
        const int e0 = EID[(size_t)t * NSEL + lane], e1 = EID[(size_t)t * NSEL + 64 + lane]; const float gg0 = EG[(size_t)t * NSEL + lane], gg1 = EG[(size_t)t * NSEL + 64 + lane];
        float acc[16];
#pragma unroll
        for (int i = 0; i < 16; ++i) acc[i] = 0.f;
#pragma unroll 1
        for (int kb = 0; kb < NSEL; kb += 8) {
            u32x4 ua[8], ub[8], va[8], vb[8];
#pragma unroll
            for (int j = 0; j < 8; ++j) { const int k = kb + j; const int eid = __builtin_amdgcn_readlane(k < 64 ? e0 : e1, k & 63);
                const bf16* ur = UT + (size_t)eid * D + 8 * lane; const bf16* vr = VT + (size_t)eid * D + 8 * lane;
                ua[j] = *(const u32x4*)ur; ub[j] = *(const u32x4*)(ur + 512); va[j] = *(const u32x4*)vr; vb[j] = *(const u32x4*)(vr + 512); }
            float d[8];
#pragma unroll
            for (int j = 0; j < 8; ++j) { float a = 0.f; a = dot2bf(ua[j].x, h0.x, a); a = dot2bf(ua[j].y, h0.y, a); a = dot2bf(ua[j].z, h0.z, a); a = dot2bf(ua[j].w, h0.w, a);
                a = dot2bf(ub[j].x, h1.x, a); a = dot2bf(ub[j].y, h1.y, a); a = dot2bf(ub[j].z, h1.z, a); a = dot2bf(ub[j].w, h1.w, a); d[j] = a; }
            float r4[4], r2[2], r1;
            { const bool up = (lane & 32) != 0;
#pragma unroll
              for (int j = 0; j < 4; ++j) { const float snd = up ? d[j] : d[j + 4], kp = up ? d[j + 4] : d[j]; r4[j] = kp + __shfl_xor(snd, 32); } }
            { const bool up = (lane & 16) != 0;
#pragma unroll
              for (int j = 0; j < 2; ++j) { const float snd = up ? r4[j] : r4[j + 2], kp = up ? r4[j + 2] : r4[j]; r2[j] = kp + __shfl_xor(snd, 16); } }
            { const bool up = (lane & 8) != 0; const float snd = up ? r2[0] : r2[1], kp = up ? r2[1] : r2[0]; r1 = kp + __shfl_xor(snd, 8); }
            r1 += __shfl_xor(r1, 4); r1 += __shfl_xor(r1, 2); r1 += __shfl_xor(r1, 1);
            const float ge = 0.5f * r1 * (1.f + erff(r1 * 0.70710678118654752f));
#pragma unroll
            for (int j = 0; j < 8; ++j) { const int k = kb + j; const float gk = __uint_as_float(__builtin_amdgcn_readlane(__float_as_uint(k < 64 ? gg0 : gg1), k & 63));
                const float w = gk * __uint_as_float(__builtin_amdgcn_readlane(__float_as_uint(ge), ((j & 4) ? 32 : 0) + ((j & 2) ? 16 : 0) + ((j & 1) ? 8 : 0)));
                acc[0] += w * bflo(va[j].x); acc[1] += w * bfhi(va[j].x); acc[2] += w * bflo(va[j].y); acc[3] += w * bfhi(va[j].y); acc[4] += w * bflo(va[j].z); acc[5] += w * bfhi(va[j].z); acc[6] += w * bflo(va[j].w); acc[7] += w * bfhi(va[j].w);
                acc[8] += w * bflo(vb[j].x); acc[9] += w * bfhi(vb[j].x); acc[10] += w * bflo(vb[j].y); acc[11] += w * bfhi(vb[j].y); acc[12] += w * bflo(vb[j].z); acc[13] += w * bfhi(vb[j].z); acc[14] += w * bflo(vb[j].w); acc[15] += w * bfhi(vb[j].w); }
        }
        float ss = 0.f;
#pragma unroll
        for (int c = 0; c < 2; ++c)
#pragma unroll
            for (int q4 = 0; q4 < 2; ++q4) { const int col = c * 512 + 8 * lane + 4 * q4; const f32x4 xv = *(const f32x4*)(x1 + (size_t)t * D + col), gv = *(const f32x4*)(mod + b * 6144 + 5 * D + col);
#pragma unroll
                for (int e = 0; e < 4; ++e) { const float x2 = xv[e] + gv[e] * acc[c * 8 + q4 * 4 + e]; acc[c * 8 + q4 * 4 + e] = x2; ss += x2 * x2; } }
#pragma unroll
        for (int o = 1; o < 64; o <<= 1) ss += __shfl_xor(ss, o);
        const float r = rsqrtf(ss * (1.f / D) + EPS);
#pragma unroll
        for (int c = 0; c < 2; ++c)
#pragma unroll
            for (int q4 = 0; q4 < 2; ++q4) { const int col = c * 512 + 8 * lane + 4 * q4; const f32x4 gf = *(const f32x4*)(gfin + col); f32x4 o;
#pragma unroll
                for (int e = 0; e < 4; ++e) o[e] = acc[c * 8 + q4 * 4 + e] * r * gf[e];
                *(f32x4*)(outp + (size_t)t * D + col) = o; }
    }
}

__device__ __forceinline__ void d_skbd(const float* sk, bf16* SKBD) {
    GSTRIDE(idx, 2048 * 256) { const int n = (int)idx >> 8, kk = (int)idx & 255, p = (n >> 7) & 1; SKBD[idx] = ((kk >> 7) == p) ? f2bf(sk[(size_t)n * 128 + (kk & 127)]) : (bf16)0; }
}
__device__ __forceinline__ unsigned f2sort(float f) { const unsigned b = __float_as_uint(f); return b ^ ((unsigned)((int)b >> 31) | 0x80000000u); }
__device__ __forceinline__ float sort2f(unsigned k) { return __uint_as_float(k ^ (((k >> 31) - 1u) | 0x80000000u)); }
struct EpiRoute {
    static constexpr bool PERM = false, AFTER_DRAIN = true;
    int* EID; float* EG;
    __device__ __forceinline__ void fused(f32x4 (&acc)[2][2][4][2], const pg8::Unit& u, int wr, int wc, int fr_, int fq_, LAS unsigned char* lds, int wid, int lane_) const {
        int lane = lane_; asm volatile("" : "+v"(lane));
        const int fr = lane & 15, fq = lane >> 4;
        constexpr int RS = 257; LAS float* S = (LAS float*)lds; LAS unsigned char* tab = lds + 128 * RS * 4 + ((wid & 3) * 64 + lane) * 32;
#pragma unroll
        for (int ai = 0; ai < 2; ++ai) {
#pragma unroll
            for (int bj = 0; bj < 2; ++bj)
#pragma unroll
                for (int m = 0; m < 4; ++m)
#pragma unroll
                    for (int n = 0; n < 2; ++n) { LAS float* sp = S + (64 * wr + 16 * m + fr) * RS + 128 * bj + 32 * wc + 16 * n + 4 * fq; const f32x4 v = acc[ai][bj][m][n]; sp[0] = v[0]; sp[1] = v[1]; sp[2] = v[2]; sp[3] = v[3]; }
            __syncthreads();
            if (wid < 4) {
                const int rl = 32 * wid + (lane & 31), p = lane >> 5; const LAS float* sp = S + rl * RS + 128 * p;
                unsigned top[16];
#pragma unroll
                for (int j = 0; j < 16; ++j) top[j] = 0u;
#pragma unroll 8
                for (int n = 0; n < 128; ++n) { unsigned key = (f2sort(sp[n]) & ~0x7Fu) | (unsigned)n;
#pragma unroll
                    for (int j = 0; j < 16; ++j) { const unsigned hi_ = max(top[j], key); key = min(top[j], key); top[j] = hi_; } }
                float af[16], bf_[16]; unsigned ia[4] = {0u, 0u, 0u, 0u}, ib[4] = {0u, 0u, 0u, 0u};
#pragma unroll
                for (int j = 0; j < 16; ++j) { const unsigned oth = (unsigned)__shfl_xor((int)top[j], 32); const unsigned ka = p ? oth : top[j], kb = p ? top[j] : oth;
                    af[j] = sort2f(ka & ~0x7Fu); bf_[j] = sort2f(kb & ~0x7Fu); ia[j >> 2] |= (ka & 0x7Fu) << (8 * (j & 3)); ib[j >> 2] |= (kb & 0x7Fu) << (8 * (j & 3)); }
                *(LAS u32x4*)tab = (u32x4){ia[0], ia[1], ia[2], ia[3]}; *(LAS u32x4*)(tab + 16) = (u32x4){ib[0], ib[1], ib[2], ib[3]};
                unsigned ct[16];
#pragma unroll
                for (int j = 0; j < 16; ++j) ct[j] = 0u;
#pragma unroll
                for (int i = 0; i < 16; ++i)
#pragma unroll
                    for (int j2 = 0; j2 < 16; ++j2) if ((i + 1) * (j2 + 1) <= 16) { unsigned key = (f2sort(af[i] + bf_[j2]) & ~0xFFu) | (unsigned)(i * 16 + j2);
#pragma unroll
                        for (int j = 0; j < 16; ++j) { const unsigned hi_ = max(ct[j], key); key = min(ct[j], key); ct[j] = hi_; } }
                asm volatile("s_waitcnt lgkmcnt(0)" ::: "memory");
                int eid[16]; float ev[16]; float sum = 0.f; const float v0 = sort2f(ct[0] & ~0xFFu);
#pragma unroll
                for (int k = 0; k < 16; ++k) { const unsigned code = ct[k] & 0xFFu; const int i_a = tab[code >> 4], i_b = tab[16 + (code & 15u)]; eid[k] = i_a * NKEYS + i_b;
                    ev[k] = __builtin_amdgcn_exp2f((sort2f(ct[k] & ~0xFFu) - v0) * 1.4426950408889634f); sum += ev[k]; }
                const float is = 1.f / sum; const size_t ob = (size_t)(u.pm * 256 + 128 * ai + rl) * NSEL + u.pn * 16 + 8 * p;
                u32x4 e0, e1; f32x4 g0, g1;
                e0.x = p ? eid[8] : eid[0]; e0.y = p ? eid[9] : eid[1]; e0.z = p ? eid[10] : eid[2]; e0.w = p ? eid[11] : eid[3]; e1.x = p ? eid[12] : eid[4]; e1.y = p ? eid[13] : eid[5]; e1.z = p ? eid[14] : eid[6]; e1.w = p ? eid[15] : eid[7];
                g0[0] = (p ? ev[8] : ev[0]) * is; g0[1] = (p ? ev[9] : ev[1]) * is; g0[2] = (p ? ev[10] : ev[2]) * is; g0[3] = (p ? ev[11] : ev[3]) * is; g1[0] = (p ? ev[12] : ev[4]) * is; g1[1] = (p ? ev[13] : ev[5]) * is; g1[2] = (p ? ev[14] : ev[6]) * is; g1[3] = (p ? ev[15] : ev[7]) * is;
                *(u32x4*)(EID + ob) = e0; *(u32x4*)(EID + ob + 4) = e1; *(f32x4*)(EG + ob) = g0; *(f32x4*)(EG + ob + 4) = g1;
            }
            __syncthreads();
        }
    }
};
__device__ __forceinline__ void route_phase(LAS unsigned char* lds, const bf16* QP, const bf16* SKBD, int* EID, float* EG, int G, int bid) {
    pg8::Gemm g{QP, SKBD, M, 2048, 256, 2048, 256}; pg8::StaticOrder S; S.init(M, 2048, G, bid); EpiRoute E{EID, EG}; pg8::OneUnit O;
    for (int i = 0; S.next(i, O.u); ++i) pg8::gemm_phase<EpiRoute, pg8::OneUnit, false>(lds, g, O, E);
}
__device__ __forceinline__ void d_route_summary(const int* EID, const float* EG, float* SUMM) {
    GSTRIDE(idx, M * PHEADS) { float s1 = 0.f, s2 = 0.f; for (int k = 0; k < 16; ++k) { const int e = EID[idx * 16 + k]; const float gk = EG[idx * 16 + k]; s1 += gk * (float)(e % 1021) * (1.f / 1021.f); s2 += gk * (float)e * (1.f / 16384.f); } SUMM[idx * 2] = s1; SUMM[idx * 2 + 1] = s2; }
}

constexpr int MOD_KS = 16;
__device__ __forceinline__ void p0_mod_partials(const float* c, const float* w_ada, float* MODP) {
    const int lane = threadIdx.x & 63, gw = blockIdx.x * (NT / 64) + (threadIdx.x >> 6), ngw = gridDim.x * (NT / 64);
    for (int it = gw; it < 96 * MOD_KS; it += ngw) {
        const int cg_ = it % 96, ks = it / 96, j = cg_ * 64 + lane, k0 = ks * 64;
        const float c0 = c[k0 + lane], c1 = c[D + k0 + lane]; const float a0 = c0 / (1.f + __expf(-c0)), a1 = c1 / (1.f + __expf(-c1));
        float acc0 = 0.f, acc1 = 0.f;
#pragma unroll 16
        for (int k = 0; k < 64; ++k) { const float w = w_ada[(size_t)(k0 + k) * 6144 + j];
            acc0 += __uint_as_float(__builtin_amdgcn_readlane(__float_as_uint(a0), k)) * w; acc1 += __uint_as_float(__builtin_amdgcn_readlane(__float_as_uint(a1), k)) * w; }
        MODP[(size_t)(ks * 2) * 6144 + j] = acc0; MODP[(size_t)(ks * 2 + 1) * 6144 + j] = acc1;
    }
}
__device__ __forceinline__ float mod_reduce(const float* MODP, const float* b_ada, int idx) {
    float s = b_ada[idx % 6144];
#pragma unroll
    for (int ks = 0; ks < MOD_KS; ++ks) s += MODP[(size_t)ks * 2 * 6144 + idx];
    return s;
}
__device__ __forceinline__ void p0_transpose_item(const float* W, int K, int N, bf16* WT, LAS float* scr, int item, int lane) {
    const int nblk = N / 32, kb = item / nblk, nb = item % nblk, k0 = 64 * kb, n0 = 32 * nb;
#pragma unroll 8
    for (int i = 0; i < 32; ++i) { const int kk = 2 * i + (lane >> 5); scr[kk * 33 + (lane & 31)] = W[(size_t)(k0 + kk) * N + n0 + (lane & 31)]; }
    asm volatile("s_waitcnt lgkmcnt(0)" ::: "memory");
    const int cch = lane & 7;
#pragma unroll
    for (int j = 0; j < 4; ++j) { const int n = (lane >> 3) + 8 * j; const LAS float* sp = scr + (8 * cch) * 33 + n;
        u32x4 o; o.x = cvt_pk_bf16(sp[0 * 33], sp[1 * 33]); o.y = cvt_pk_bf16(sp[2 * 33], sp[3 * 33]); o.z = cvt_pk_bf16(sp[4 * 33], sp[5 * 33]); o.w = cvt_pk_bf16(sp[6 * 33], sp[7 * 33]);
        *(u32x4*)(WT + (size_t)(n0 + n) * K + k0 + 8 * cch) = o; }
    asm volatile("s_waitcnt lgkmcnt(0)" ::: "memory");
}
__device__ __forceinline__ void p0_transposes(LAS unsigned char* lds, const float* w_in, const float* w_ba, const float* w_out, const float* wq, bf16* W_IN_T, bf16* WBA_T, bf16* WOUT_T, bf16* WQ_T) {
    const int lane = threadIdx.x & 63, wv = threadIdx.x >> 6, gw = blockIdx.x * (NT / 64) + wv, ngw = gridDim.x * (NT / 64);
    LAS float* scr = (LAS float*)(lds + wv * 16384);
    constexpr int I_IN = (1024 / 64) * (4096 / 32), I_BA = (512 / 64) * (1024 / 32), I_OUT = (1024 / 64) * (1024 / 32), I_Q = (1024 / 64) * (2048 / 32);
    for (int it = gw; it < I_IN + I_BA + I_OUT + I_Q; it += ngw) { int r = it;
        if (r < I_IN) { p0_transpose_item(w_in, 1024, 4096, W_IN_T, scr, r, lane); continue; } r -= I_IN;
        if (r < I_BA) { p0_transpose_item(w_ba, 512, 1024, WBA_T, scr, r, lane); continue; } r -= I_BA;
        if (r < I_OUT) { p0_transpose_item(w_out, 1024, 1024, WOUT_T, scr, r, lane); continue; } r -= I_OUT;
        p0_transpose_item(wq, 1024, 2048, WQ_T, scr, r, lane); }
}
__device__ __forceinline__ void p0_wc(const float* pool_w, const float* pool_scale, const float* w_bp, float* WCF) {
    const int lane = threadIdx.x & 63, gw = blockIdx.x * (NT / 64) + (threadIdx.x >> 6), ngw = gridDim.x * (NT / 64);
    for (int it = gw; it < 512 * 16; it += ngw) { const int k = it >> 4, o = (it & 15) * 64 + lane, g = k >> 7; float acc = 0.f;
        const float pw0 = pool_w[(size_t)k * 128 + lane] * pool_scale[g * 128 + lane], pw1 = pool_w[(size_t)k * 128 + 64 + lane] * pool_scale[g * 128 + 64 + lane];
#pragma unroll 16
        for (int j = 0; j < 64; ++j) acc += __uint_as_float(__builtin_amdgcn_readlane(__float_as_uint(pw0), j)) * w_bp[(size_t)(g * 128 + j) * 1024 + o];
#pragma unroll 16
        for (int j = 0; j < 64; ++j) acc += __uint_as_float(__builtin_amdgcn_readlane(__float_as_uint(pw1), j)) * w_bp[(size_t)(g * 128 + 64 + j) * 1024 + o];
        WCF[(size_t)k * 1024 + o] = acc; }
}
__device__ __forceinline__ void p1_wc_transpose(LAS unsigned char* lds, const float* WCF, bf16* WC_T) {
    const int lane = threadIdx.x & 63, wv = threadIdx.x >> 6, gw = blockIdx.x * (NT / 64) + wv, ngw = gridDim.x * (NT / 64);
    LAS float* scr = (LAS float*)(lds + wv * 16384);
    for (int it = gw; it < (512 / 64) * (1024 / 32); it += ngw) p0_transpose_item(WCF, 512, 1024, WC_T, scr, it, lane);
}
__device__ __forceinline__ void modulate_rows(const float* x, const float* g, const LAS float* mtab, bf16* outp) {
    const int lane = threadIdx.x & 63;
    for (int row = blockIdx.x * (NT / 64) + (threadIdx.x >> 6); row < M; row += gridDim.x * (NT / 64)) {
        const int b = row / SEQ; const f32x4* xr = (const f32x4*)(x + (size_t)row * D); f32x4 v[4]; float ss = 0.f;
#pragma unroll
        for (int j = 0; j < 4; ++j) { v[j] = xr[j * 64 + lane]; ss += v[j][0] * v[j][0] + v[j][1] * v[j][1] + v[j][2] * v[j][2] + v[j][3] * v[j][3]; }
#pragma unroll
        for (int o = 1; o < 64; o <<= 1) ss += __shfl_xor(ss, o);
        const float r = rsqrtf(ss * (1.f / D) + EPS);
#pragma unroll
        for (int j = 0; j < 4; ++j) { const int col = j * 256 + lane * 4; const f32x4 gv = *(const f32x4*)(g + col), sc = *(const LAS f32x4*)(mtab + b * 2048 + col), sh = *(const LAS f32x4*)(mtab + b * 2048 + 1024 + col);
            const f32x4 o = v[j] * r * gv * (sc + 1.f) + sh; u32x2 w; w.x = cvt_pk_bf16(o[0], o[1]); w.y = cvt_pk_bf16(o[2], o[3]); *(u32x2*)(outp + (size_t)row * D + col) = w; }
    }
}
__device__ __forceinline__ void fill_mtab_partials(LAS float* mtab, const float* MODP, const float* b_ada, int sh_off, int sc_off) {
    for (int i = threadIdx.x; i < 4096; i += NT) { const int b = i >> 11, which = (i >> 10) & 1, col = i & 1023; mtab[i] = mod_reduce(MODP, b_ada, b * 6144 + (which ? sh_off : sc_off) + col); }
    __syncthreads();
}
__device__ __forceinline__ void fill_mtab(LAS float* mtab, const float* MOD, int sh_off, int sc_off) {
    for (int i = threadIdx.x; i < 4096; i += NT) { const int b = i >> 11, which = (i >> 10) & 1, col = i & 1023; mtab[i] = MOD[b * 6144 + (which ? sh_off : sc_off) + col]; }
    __syncthreads();
}
__device__ __forceinline__ void pooldiff_fast(const bf16* UP, bf16* DIFF) {
    GSTRIDE(idx, (size_t)M * 64) { const int ch = (int)(idx & 63), row = (int)(idx >> 6), pos = row % SEQ, w = 2 << (ch >> 4), cnt = pos + 1 < w ? pos + 1 : w; float sacc[8];
#pragma unroll
        for (int e = 0; e < 8; ++e) sacc[e] = 0.f;
        u32x4 own;
        for (int i = 0; i < cnt; ++i) { const u32x4 v = *(const u32x4*)(UP + (size_t)(row - i) * 512 + ch * 8); if (i == 0) own = v;
            sacc[0] += bflo(v.x); sacc[1] += bfhi(v.x); sacc[2] += bflo(v.y); sacc[3] += bfhi(v.y); sacc[4] += bflo(v.z); sacc[5] += bfhi(v.z); sacc[6] += bflo(v.w); sacc[7] += bfhi(v.w); }
        const float ic = 1.f / (float)cnt; u32x4 o;
        o.x = cvt_pk_bf16(sacc[0] * ic - bflo(own.x), sacc[1] * ic - bfhi(own.x)); o.y = cvt_pk_bf16(sacc[2] * ic - bflo(own.y), sacc[3] * ic - bfhi(own.y));
        o.z = cvt_pk_bf16(sacc[4] * ic - bflo(own.z), sacc[5] * ic - bfhi(own.z)); o.w = cvt_pk_bf16(sacc[6] * ic - bflo(own.w), sacc[7] * ic - bfhi(own.w));
        *(u32x4*)(DIFF + (size_t)row * 512 + ch * 8) = o; }
}

#define XB_TMO      128
#define XB_XCNT(j)  (256  + 64 * (j))
#define XB_XSUB(j)  (1280 + 64 * (j))
#define XB_XGEN(j)  (2304 + 64 * (j))
#define XB_TOP      3328
#define XB_TOPGEN   3392
#define XCD_BAR_WORDS 3456
#define XB_SPIN_CAP (1u << 18)
__device__ __forceinline__ unsigned xb_ld(unsigned* p)              { return __hip_atomic_load(p, __ATOMIC_RELAXED, __HIP_MEMORY_SCOPE_AGENT); }
__device__ __forceinline__ unsigned xb_add(unsigned* p, unsigned v) { return __hip_atomic_fetch_add(p, v, __ATOMIC_RELAXED, __HIP_MEMORY_SCOPE_AGENT); }
__device__ __forceinline__ unsigned xb_xcc_id() { return (unsigned)__builtin_amdgcn_s_getreg((3 << 11) | 20) & 0xFu; }
#define XB_SPIN(cond, bar) do { unsigned _sp = 0; while (cond) { __builtin_amdgcn_s_sleep(1); \
    if ((++_sp & 255u) == 0u) { if (xb_ld(&(bar)[XB_TMO])) break; if (_sp > XB_SPIN_CAP) { atomicAdd(&(bar)[XB_TMO], 1u); break; } } } } while (0)
struct XcdBarrier { unsigned* bar; unsigned x; volatile LAS unsigned* st; };
__device__ __forceinline__ XcdBarrier xcd_barrier_post(unsigned* bar, volatile LAS unsigned* st) {
    XcdBarrier b; b.bar = bar; b.x = xb_xcc_id(); b.st = st;
    if (threadIdx.x == 0) (void)xb_add(&bar[XB_XCNT(b.x)], 1u);
    return b;
}
__device__ __forceinline__ void xcd_barrier_complete(unsigned* bar, unsigned x, unsigned& nloc, unsigned& nx) {
    const unsigned G = gridDim.x * gridDim.y * gridDim.z;
    unsigned sum, cnt, mine, sp = 0u;
    for (;;) {
        sum = 0u; cnt = 0u; mine = 0u;
#pragma unroll
        for (unsigned j = 0; j < 16; ++j) { const unsigned c = xb_ld(&bar[XB_XCNT(j)]); sum += c; cnt += (c > 0u) ? 1u : 0u; mine = (j == x) ? c : mine; }
        if (sum == G) break;
        __builtin_amdgcn_s_sleep(1);
        if ((++sp & 255u) == 0u) { if (xb_ld(&bar[XB_TMO])) break; if (sp > XB_SPIN_CAP) { atomicAdd(&bar[XB_TMO], 1u); break; } }
    }
    nloc = mine > 0u ? mine : 1u; nx = cnt > 0u ? cnt : 1u;
}
__device__ __forceinline__ void xcd_barrier(const XcdBarrier& b) {
    asm volatile("s_waitcnt vmcnt(0)" ::: "memory");
    __syncthreads();
    if (threadIdx.x == 0) {
        unsigned* bar = b.bar;
        __builtin_amdgcn_s_waitcnt(0);
        unsigned nloc = b.st[0], nx = b.st[1];
        if (nloc == 0u) { xcd_barrier_complete(bar, b.x, nloc, nx); b.st[0] = nloc; b.st[1] = nx; }
        const unsigned old = xb_add(&bar[XB_XSUB(b.x)], 1u);
        const unsigned gen = old / nloc;
        if (old + 1u == (gen + 1u) * nloc) {
            __builtin_amdgcn_fence(__ATOMIC_RELEASE, "agent");
            asm volatile("s_waitcnt vmcnt(0)" ::: "memory");
            const unsigned og = xb_add(&bar[XB_TOP], 1u);
            const unsigned tg = og / nx;
            if (og + 1u == (tg + 1u) * nx) xb_add(&bar[XB_TOPGEN], 1u);
            else XB_SPIN(xb_ld(&bar[XB_TOPGEN]) == tg, bar);
            __builtin_amdgcn_fence(__ATOMIC_ACQUIRE, "agent");
            xb_add(&bar[XB_XGEN(b.x)], 1u);
            asm volatile("s_waitcnt vmcnt(0)" ::: "memory");
        } else {
            XB_SPIN(xb_ld(&bar[XB_XGEN(b.x)]) == gen, bar);
            __builtin_amdgcn_fence(__ATOMIC_ACQUIRE, "agent");
            asm volatile("s_waitcnt vmcnt(0)" ::: "memory");
        }
    }
    __syncthreads();
}

__device__ __forceinline__ void d_tab_fp8(const float* T, unsigned char* O8, float* SC) {
    const int lane = threadIdx.x & 63, gw = blockIdx.x * (NT / 64) + (threadIdx.x >> 6), ngw = gridDim.x * (NT / 64);
    for (int row = gw; row < NEXP; row += ngw) {
        const f32x4* r = (const f32x4*)(T + (size_t)row * D) + 4 * lane; f32x4 v[4]; float am = 0.f;
#pragma unroll
        for (int j = 0; j < 4; ++j) { v[j] = r[j]; am = fmaxf(am, fmaxf(fmaxf(fabsf(v[j][0]), fabsf(v[j][1])), fmaxf(fabsf(v[j][2]), fabsf(v[j][3])))); }
#pragma unroll
        for (int o = 1; o < 64; o <<= 1) am = fmaxf(am, __shfl_xor(am, o));
        int e = 8; if (am > 0.f) (void)frexpf(am, &e);
        const float sc = ldexpf(1.f, 8 - e);
        u32x4 w;
        w.x = (unsigned)__builtin_amdgcn_cvt_pk_fp8_f32(v[0][0] * sc, v[0][1] * sc, 0, false); w.x = (unsigned)__builtin_amdgcn_cvt_pk_fp8_f32(v[0][2] * sc, v[0][3] * sc, (int)w.x, true);
        w.y = (unsigned)__builtin_amdgcn_cvt_pk_fp8_f32(v[1][0] * sc, v[1][1] * sc, 0, false); w.y = (unsigned)__builtin_amdgcn_cvt_pk_fp8_f32(v[1][2] * sc, v[1][3] * sc, (int)w.y, true);
        w.z = (unsigned)__builtin_amdgcn_cvt_pk_fp8_f32(v[2][0] * sc, v[2][1] * sc, 0, false); w.z = (unsigned)__builtin_amdgcn_cvt_pk_fp8_f32(v[2][2] * sc, v[2][3] * sc, (int)w.z, true);
        w.w = (unsigned)__builtin_amdgcn_cvt_pk_fp8_f32(v[3][0] * sc, v[3][1] * sc, 0, false); w.w = (unsigned)__builtin_amdgcn_cvt_pk_fp8_f32(v[3][2] * sc, v[3][3] * sc, (int)w.w, true);
        *(u32x4*)(O8 + (size_t)row * D + 16 * lane) = w;
        if (lane == 0) SC[row] = ldexpf(1.f, e - 8);
    }
}
__device__ __forceinline__ f32x2 fp8lo(unsigned w) { return __builtin_amdgcn_cvt_pk_f32_fp8((int)w, false); }
__device__ __forceinline__ f32x2 fp8hi(unsigned w) { return __builtin_amdgcn_cvt_pk_f32_fp8((int)w, true); }
__device__ __forceinline__ void peer_phase8(const bf16* H2, const int* EID, const float* EG, const unsigned char* U8, const unsigned char* V8, const float* USC, const float* VSC,
                                            const float* mod, const float* gfin, const float* x1, float* outp) {
    int tid_ = threadIdx.x; asm volatile("" : "+v"(tid_));
    const int lane = tid_ & 63, wv = tid_ >> 6;
    for (int t = blockIdx.x * (NT / 64) + wv; t < M; t += gridDim.x * (NT / 64)) {
        const int b = t / SEQ;
        f32x2 hp[8];
        { const u32x4 h0 = *(const u32x4*)(H2 + (size_t)t * D + 16 * lane), h1 = *(const u32x4*)(H2 + (size_t)t * D + 16 * lane + 8);
          hp[0] = (f32x2){bflo(h0.x), bfhi(h0.x)}; hp[1] = (f32x2){bflo(h0.y), bfhi(h0.y)}; hp[2] = (f32x2){bflo(h0.z), bfhi(h0.z)}; hp[3] = (f32x2){bflo(h0.w), bfhi(h0.w)};
          hp[4] = (f32x2){bflo(h1.x), bfhi(h1.x)}; hp[5] = (f32x2){bflo(h1.y), bfhi(h1.y)}; hp[6] = (f32x2){bflo(h1.z), bfhi(h1.z)}; hp[7] = (f32x2){bflo(h1.w), bfhi(h1.w)}; }
        const int e0 = EID[(size_t)t * NSEL + lane], e1 = EID[(size_t)t * NSEL + 64 + lane]; const float gg0 = EG[(size_t)t * NSEL + lane], gg1 = EG[(size_t)t * NSEL + 64 + lane];
        f32x2 acc[8];
#pragma unroll
        for (int i = 0; i < 8; ++i) acc[i] = (f32x2){0.f, 0.f};
#pragma unroll 1
        for (int kb = 0; kb < NSEL; kb += 16) {
            u32x4 uu[16], vv[16]; float us[16], vs[16];
#pragma unroll
            for (int j = 0; j < 16; ++j) { const int k = kb + j; const int eid = __builtin_amdgcn_readlane(k < 64 ? e0 : e1, k & 63);
                uu[j] = *(const u32x4*)(U8 + (size_t)eid * D + 16 * lane); vv[j] = *(const u32x4*)(V8 + (size_t)eid * D + 16 * lane); us[j] = USC[eid]; vs[j] = VSC[eid]; }
            float d[16];
#pragma unroll
            for (int j = 0; j < 16; ++j) { f32x2 a = (f32x2){0.f, 0.f};
                a = __builtin_elementwise_fma(fp8lo(uu[j].x), hp[0], a); a = __builtin_elementwise_fma(fp8hi(uu[j].x), hp[1], a); a = __builtin_elementwise_fma(fp8lo(uu[j].y), hp[2], a); a = __builtin_elementwise_fma(fp8hi(uu[j].y), hp[3], a);
                a = __builtin_elementwise_fma(fp8lo(uu[j].z), hp[4], a); a = __builtin_elementwise_fma(fp8hi(uu[j].z), hp[5], a); a = __builtin_elementwise_fma(fp8lo(uu[j].w), hp[6], a); a = __builtin_elementwise_fma(fp8hi(uu[j].w), hp[7], a);
                d[j] = (a[0] + a[1]) * us[j]; }
            float r8[8], r4[4], r2[2], r1;
            { const bool up = (lane & 32) != 0;
#pragma unroll
              for (int j = 0; j < 8; ++j) { const float snd = up ? d[j] : d[j + 8], kp = up ? d[j + 8] : d[j]; r8[j] = kp + __shfl_xor(snd, 32); } }
            { const bool up = (lane & 16) != 0;
#pragma unroll
              for (int j = 0; j < 4; ++j) { const float snd = up ? r8[j] : r8[j + 4], kp = up ? r8[j + 4] : r8[j]; r4[j] = kp + __shfl_xor(snd, 16); } }
            { const bool up = (lane & 8) != 0;
#pragma unroll
              for (int j = 0; j < 2; ++j) { const float snd = up ? r4[j] : r4[j + 2], kp = up ? r4[j + 2] : r4[j]; r2[j] = kp + __shfl_xor(snd, 8); } }
            { const bool up = (lane & 4) != 0; const float snd = up ? r2[0] : r2[1], kp = up ? r2[1] : r2[0]; r1 = kp + __shfl_xor(snd, 4); }
            r1 += __shfl_xor(r1, 2); r1 += __shfl_xor(r1, 1);
            const float ge = 0.5f * r1 * (1.f + erff(r1 * 0.70710678118654752f));
#pragma unroll
            for (int j = 0; j < 16; ++j) { const int k = kb + j; const float gk = __uint_as_float(__builtin_amdgcn_readlane(__float_as_uint(k < 64 ? gg0 : gg1), k & 63));
                const float w = gk * vs[j] * __uint_as_float(__builtin_amdgcn_readlane(__float_as_uint(ge), ((j & 8) ? 32 : 0) + ((j & 4) ? 16 : 0) + ((j & 2) ? 8 : 0) + ((j & 1) ? 4 : 0))); const f32x2 w2 = (f32x2){w, w};
                acc[0] = __builtin_elementwise_fma(w2, fp8lo(vv[j].x), acc[0]); acc[1] = __builtin_elementwise_fma(w2, fp8hi(vv[j].x), acc[1]); acc[2] = __builtin_elementwise_fma(w2, fp8lo(vv[j].y), acc[2]); acc[3] = __builtin_elementwise_fma(w2, fp8hi(vv[j].y), acc[3]);
                acc[4] = __builtin_elementwise_fma(w2, fp8lo(vv[j].z), acc[4]); acc[5] = __builtin_elementwise_fma(w2, fp8hi(vv[j].z), acc[5]); acc[6] = __builtin_elementwise_fma(w2, fp8lo(vv[j].w), acc[6]); acc[7] = __builtin_elementwise_fma(w2, fp8hi(vv[j].w), acc[7]); }
        }
        float ss = 0.f; f32x4 x2[4];
#pragma unroll
        for (int q4 = 0; q4 < 4; ++q4) { const int col = 16 * lane + 4 * q4; const f32x4 xv = *(const f32x4*)(x1 + (size_t)t * D + col), gv = *(const f32x4*)(mod + b * 6144 + 5 * D + col);
            x2[q4][0] = xv[0] + gv[0] * acc[2 * q4][0]; x2[q4][1] = xv[1] + gv[1] * acc[2 * q4][1]; x2[q4][2] = xv[2] + gv[2] * acc[2 * q4 + 1][0]; x2[q4][3] = xv[3] + gv[3] * acc[2 * q4 + 1][1];
            ss += x2[q4][0] * x2[q4][0] + x2[q4][1] * x2[q4][1] + x2[q4][2] * x2[q4][2] + x2[q4][3] * x2[q4][3]; }
#pragma unroll
        for (int o = 1; o < 64; o <<= 1) ss += __shfl_xor(ss, o);
        const float r = rsqrtf(ss * (1.f / D) + EPS);
#pragma unroll
        for (int q4 = 0; q4 < 4; ++q4) { const int col = 16 * lane + 4 * q4; const f32x4 gf = *(const f32x4*)(gfin + col); *(f32x4*)(outp + (size_t)t * D + col) = x2[q4] * r * gf; }
    }
}

namespace att2 {
__device__ __forceinline__ bool lsum_dummy(int ei) { return ei == 12345; }
using att::f32x16; using att::v4i16_t; using att::crow; using att::bfe;
constexpr int VROW = 192, OFF_V = 32768, OFF_MISC = OFF_V + 256 * VROW;
template <bool CAUSAL>
__device__ __forceinline__ void tile(const LAS unsigned char* Kblk, const LAS unsigned char* Vblk, const bf16x8 (&qr)[4], int tt, int q_off, int lane, int r32, int hi, float& mrun, float& lsum, f32x16& o0, f32x16& o1) {
    const LAS unsigned char* kb_ = Kblk + tt * 64 * 128; const LAS unsigned char* vb_ = Vblk + tt * 64 * VROW;
    f32x16 p0 = {}, p1 = {};
#pragma unroll
    for (int s = 0; s < 4; ++s) { const int c = 2 * s + hi; const int sw = ((c ^ ((r32 >> 1) & 7)) << 4);
        const bf16x8 a0 = *(const LAS bf16x8*)(kb_ + r32 * 128 + sw), a1 = *(const LAS bf16x8*)(kb_ + (32 + r32) * 128 + sw);
        p0 = __builtin_amdgcn_mfma_f32_32x32x16_bf16(a0, qr[s], p0, 0, 0, 0); p1 = __builtin_amdgcn_mfma_f32_32x32x16_bf16(a1, qr[s], p1, 0, 0, 0); }
    if (CAUSAL) {
#pragma unroll
        for (int r = 0; r < 16; ++r) { const int ko = tt * 64 + crow(r, hi); if (ko > q_off) p0[r] = -INFINITY; if (ko + 32 > q_off) p1[r] = -INFINITY; } }
    float mt = fmaxf(p0[0], p1[0]);
#pragma unroll
    for (int r = 1; r < 16; ++r) mt = fmaxf(mt, fmaxf(p0[r], p1[r]));
    mt = fmaxf(mt, __shfl_xor(mt, 32));
    const float mnew = fmaxf(mrun, mt), alpha = __builtin_amdgcn_exp2f(mrun - mnew); mrun = mnew;
    float ps = 0.f;
#pragma unroll
    for (int r = 0; r < 16; ++r) { p0[r] = __builtin_amdgcn_exp2f(p0[r] - mnew); p1[r] = __builtin_amdgcn_exp2f(p1[r] - mnew); ps += p0[r] + p1[r]; }
    lsum = lsum * alpha + ps;
    if (!__all(alpha == 1.f ? 1 : 0)) {
#pragma unroll
        for (int r = 0; r < 16; ++r) { o0[r] *= alpha; o1[r] *= alpha; } }
    bf16x8 pb[2][2];
#pragma unroll
    for (int s2 = 0; s2 < 2; ++s2) { u32x4 w0, w1;
        w0.x = cvt_pk_bf16(p0[8 * s2], p0[8 * s2 + 1]); w0.y = cvt_pk_bf16(p0[8 * s2 + 2], p0[8 * s2 + 3]); w0.z = cvt_pk_bf16(p0[8 * s2 + 4], p0[8 * s2 + 5]); w0.w = cvt_pk_bf16(p0[8 * s2 + 6], p0[8 * s2 + 7]);
        w1.x = cvt_pk_bf16(p1[8 * s2], p1[8 * s2 + 1]); w1.y = cvt_pk_bf16(p1[8 * s2 + 2], p1[8 * s2 + 3]); w1.z = cvt_pk_bf16(p1[8 * s2 + 4], p1[8 * s2 + 5]); w1.w = cvt_pk_bf16(p1[8 * s2 + 6], p1[8 * s2 + 7]);
        pb[0][s2] = __builtin_bit_cast(bf16x8, w0); pb[1][s2] = __builtin_bit_cast(bf16x8, w1); }
    const LAS unsigned char* vl = vb_ + (4 * hi + ((lane & 15) >> 2)) * VROW + (16 * ((lane >> 4) & 1) + 4 * (lane & 3)) * 2;
#pragma unroll
    for (int dt = 0; dt < 2; ++dt)
#pragma unroll
        for (int u = 0; u < 2; ++u)
#pragma unroll
            for (int s2 = 0; s2 < 2; ++s2) { const LAS unsigned char* va = vl + (32 * u + 16 * s2) * VROW + dt * 64;
                const v4i16_t lo = __builtin_amdgcn_ds_read_tr16_b64_v4i16((LAS v4i16_t*)va), hh = __builtin_amdgcn_ds_read_tr16_b64_v4i16((LAS v4i16_t*)(va + 8 * VROW));
                const bf16x8 vf = {lo[0], lo[1], lo[2], lo[3], hh[0], hh[1], hh[2], hh[3]};
                if (dt == 0) o0 = __builtin_amdgcn_mfma_f32_32x32x16_bf16(vf, pb[u][s2], o0, 0, 0, 0); else o1 = __builtin_amdgcn_mfma_f32_32x32x16_bf16(vf, pb[u][s2], o1, 0, 0, 0); }
}
__device__ __forceinline__ void stage_block(LAS unsigned char* lds, const bf16* Kb, const bf16* V, size_t row0, int h, int tid) {
    const int ch = tid & 7;
#pragma unroll
    for (int i = 0; i < 4; ++i) { const int row = (tid >> 3) + 64 * i; const size_t go = (row0 + row) * 512 + h * 64 + ch * 8;
        const u32x4 kv = *(const u32x4*)(Kb + go), vv = *(const u32x4*)(V + go);
        *(LAS u32x4*)(lds + row * 128 + ((ch ^ ((row >> 1) & 7)) << 4)) = kv; *(LAS u32x4*)(lds + OFF_V + row * VROW + ch * 16) = vv; }
}
__device__ __forceinline__ void phase_a(LAS unsigned char* lds, const bf16* Q, const float* ksum, unsigned short* SEL, int* CNT, unsigned short* LIST, int G, int bid) {
    int tid_ = threadIdx.x; asm volatile("" : "+v"(tid_));
    const int tid = tid_, lane = tid & 63, wid = __builtin_amdgcn_readfirstlane(tid >> 6), r32 = lane & 31, hi = lane >> 5;
    LAS int* lc = (LAS int*)lds;
    LAS float* lks = (LAS float*)(lds + 1024);
    for (int uidx = bid; uidx < 512; uidx += G) {
        const int bh = (uidx & 255) >> 4, s_ = uidx & 15, qb = uidx < 256 ? s_ : 31 - s_, b = bh >> 3, h = bh & 7;
        const int q_off = wid * 32 + r32, q = qb * 256 + q_off; const size_t qrow = (size_t)b * SEQ + q;
        if (tid < 64) lc[tid] = 0;
        *(LAS f32x4*)(lks + tid * 4) = *(const f32x4*)(ksum + (size_t)bh * NBLK * HD + tid * 4);
        __syncthreads();
        bf16x8 qr[4];
#pragma unroll
        for (int s = 0; s < 4; ++s) qr[s] = *(const bf16x8*)(Q + qrow * 512 + h * 64 + 16 * s + 8 * hi);
        int s0 = 31, s1 = 31, s2 = 31; float g0 = -INFINITY, g1 = -INFINITY, g2 = -INFINITY;
        const LAS float* ksb = lks + 8 * hi;
        for (int j = 0; j < qb; ++j) { float part = 0.f;
#pragma unroll
            for (int s = 0; s < 4; ++s) { const f32x4 k0 = *(const LAS f32x4*)(ksb + j * HD + 16 * s), k1 = *(const LAS f32x4*)(ksb + j * HD + 16 * s + 4);
                part += bfe(qr[s], 0) * k0[0] + bfe(qr[s], 1) * k0[1] + bfe(qr[s], 2) * k0[2] + bfe(qr[s], 3) * k0[3] + bfe(qr[s], 4) * k1[0] + bfe(qr[s], 5) * k1[1] + bfe(qr[s], 6) * k1[2] + bfe(qr[s], 7) * k1[3]; }
            const float g = part + __shfl_xor(part, 32);
            if (g > g0) { g2 = g1; s2 = s1; g1 = g0; s1 = s0; g0 = g; s0 = j; } else if (g > g1) { g2 = g1; s2 = s1; g1 = g; s1 = j; } else if (g > g2) { g2 = g; s2 = j; } }
        int r0 = 0, r1 = 0, r2 = 0;
        if (hi == 0) { if (s0 < 31) r0 = __hip_atomic_fetch_add(lc + s0, 1, __ATOMIC_RELAXED, __HIP_MEMORY_SCOPE_WORKGROUP); if (s1 < 31) r1 = __hip_atomic_fetch_add(lc + s1, 1, __ATOMIC_RELAXED, __HIP_MEMORY_SCOPE_WORKGROUP);
                       if (s2 < 31) r2 = __hip_atomic_fetch_add(lc + s2, 1, __ATOMIC_RELAXED, __HIP_MEMORY_SCOPE_WORKGROUP); }
        __syncthreads();
        if (tid < 32 && lc[tid] > 0) lc[32 + tid] = atomicAdd(CNT + bh * 32 + tid, lc[tid]);
        __syncthreads();
        if (hi == 0) { SEL[(size_t)bh * SEQ + q] = (unsigned short)(s0 | (s1 << 5) | (s2 << 10));
            if (s0 < 31) LIST[((size_t)bh * 32 + s0) * SEQ + lc[32 + s0] + r0] = (unsigned short)q;
            if (s1 < 31) LIST[((size_t)bh * 32 + s1) * SEQ + lc[32 + s1] + r1] = (unsigned short)(q | (1 << 13));
            if (s2 < 31) LIST[((size_t)bh * 32 + s2) * SEQ + lc[32 + s2] + r2] = (unsigned short)(q | (2 << 13)); }
        __syncthreads();
    }
}
__device__ __forceinline__ bf16* part_o(bf16* PO01, bf16* PO2, int slot, size_t bhq) { return (slot < 2 ? PO01 + (size_t)slot * 16 * SEQ * HD : PO2) + bhq * HD; }
template <int MODE>
__device__ __forceinline__ void phase_b(LAS unsigned char* lds, const bf16* Q, const bf16* Kb, const bf16* V, const int* CNT, const unsigned short* LIST, bf16* PO01, bf16* PO2, f32x2* PML, int G, int bid) {
    int tid_ = threadIdx.x; asm volatile("" : "+v"(tid_));
    const int tid = tid_, lane = tid & 63, wid = __builtin_amdgcn_readfirstlane(tid >> 6), r32 = lane & 31, hi = lane >> 5;
    const int vcu = (G % 8 == 0) ? (bid % 8) * (G / 8) + bid / 8 : bid;
    LAS int* misc = (LAS int*)(lds + OFF_MISC);
    if (tid < 16) misc[tid] = 0;
    __syncthreads();
    { const int tr = tid; const int cnt = tr < 16 * 31 ? CNT[(tr % 16) * 32 + tr / 16] : 0, nch = (cnt + 255) >> 8;
      int inc = nch;
#pragma unroll
      for (int o = 1; o < 64; o <<= 1) { const int t = __shfl_up(inc, o); if (lane >= o) inc += t; }
      if (lane == 63) misc[wid] = inc;
      __syncthreads();
      int off = 0; for (int w = 0; w < wid; ++w) off += misc[w];
      const int st = off + inc - nch;
      if (nch > 0) { int k0 = st + ((vcu - st) % G + G) % G;
          for (; k0 < st + nch; k0 += G) { const int slot_ = __hip_atomic_fetch_add(misc + 8, 1, __ATOMIC_RELAXED, __HIP_MEMORY_SCOPE_WORKGROUP); misc[16 + slot_] = (tr << 8) | (k0 - st); } }
      __syncthreads(); }
    const int ni = misc[8];
    const int ch = tid & 7;
    u32x4 kreg[4], vreg[4];
#define ATT2_LOAD_ITEM(idx_) do { const int it_ = misc[16 + (idx_)], tr_ = it_ >> 8, j_ = tr_ / 16, bh_ = tr_ % 16; const size_t row0_ = (size_t)(bh_ >> 3) * SEQ + j_ * 256; \
        _Pragma("unroll") for (int i_ = 0; i_ < 4; ++i_) { const size_t go_ = (row0_ + (tid >> 3) + 64 * i_) * 512 + (bh_ & 7) * 64 + ch * 8; kreg[i_] = *(const u32x4*)(Kb + go_); vreg[i_] = *(const u32x4*)(V + go_); } } while (0)
    if (ni > 0) ATT2_LOAD_ITEM(0);
    for (int ii = 0; ii < ni; ++ii) {
        const int it = misc[16 + ii], tr = it >> 8, c = it & 255, j = tr / 16, bh = tr % 16, b = bh >> 3, h = bh & 7;
        __syncthreads();
#pragma unroll
        for (int i = 0; i < 4; ++i) { const int row = (tid >> 3) + 64 * i; *(LAS u32x4*)(lds + row * 128 + ((ch ^ ((row >> 1) & 7)) << 4)) = kreg[i]; *(LAS u32x4*)(lds + OFF_V + row * VROW + ch * 16) = vreg[i]; }
        __syncthreads();
        if (ii + 1 < ni) ATT2_LOAD_ITEM(ii + 1);
        const int cnt = CNT[bh * 32 + j]; const int n = min(256, cnt - 256 * c);
        if (MODE != 2 && 32 * wid < n) {
            const int ei = 32 * wid + r32; const bool valid = (ei < n) && (MODE != 1 || lsum_dummy(ei));
            const unsigned ent = LIST[((size_t)bh * 32 + j) * SEQ + 256 * c + (ei < n ? ei : 0)]; const int q = ent & 8191, slot = ent >> 13;
            const size_t qrow = (size_t)b * SEQ + q;
            bf16x8 qr[4];
#pragma unroll
            for (int s = 0; s < 4; ++s) qr[s] = *(const bf16x8*)(Q + qrow * 512 + h * 64 + 16 * s + 8 * hi);
            float mrun = -INFINITY, lsum = 0.f; f32x16 o0 = {}, o1 = {};
#pragma unroll 1
            for (int tt = 0; tt < 4; ++tt) tile<false>(lds, lds + OFF_V, qr, tt, 0, lane, r32, hi, mrun, lsum, o0, o1);
            const float lt = lsum + __shfl_xor(lsum, 32), inv = 1.f / lt;
            if (valid) { const size_t bhq = (size_t)bh * SEQ + q; bf16* orow = part_o(PO01, PO2, slot, bhq) + 4 * hi;
                if (hi == 0) PML[bhq * 3 + slot] = (f32x2){mrun, lt};
#pragma unroll
                for (int g4 = 0; g4 < 4; ++g4) { u32x2 w;
                    w.x = cvt_pk_bf16(o0[4 * g4] * inv, o0[4 * g4 + 1] * inv); w.y = cvt_pk_bf16(o0[4 * g4 + 2] * inv, o0[4 * g4 + 3] * inv); *(u32x2*)(orow + 8 * g4) = w;
                    w.x = cvt_pk_bf16(o1[4 * g4] * inv, o1[4 * g4 + 1] * inv); w.y = cvt_pk_bf16(o1[4 * g4 + 2] * inv, o1[4 * g4 + 3] * inv); *(u32x2*)(orow + 32 + 8 * g4) = w; } }
        }
    }
#undef ATT2_LOAD_ITEM
    __syncthreads();
}
__device__ __forceinline__ void phase_c(LAS unsigned char* lds, const bf16* Q, const bf16* Kb, const bf16* V, const unsigned short* SEL, const bf16* PO01, const bf16* PO2, const f32x2* PML, bf16* ATT, int G, int bid) {
    int tid_ = threadIdx.x; asm volatile("" : "+v"(tid_));
    const int tid = tid_, lane = tid & 63, wid = __builtin_amdgcn_readfirstlane(tid >> 6), r32 = lane & 31, hi = lane >> 5;
    for (int uidx = bid; uidx < 512; uidx += G) {
        const int bh = uidx >> 5, qb = uidx & 31, b = bh >> 3, h = bh & 7;
        const int q_off = wid * 32 + r32, q = qb * 256 + q_off; const size_t qrow = (size_t)b * SEQ + q, bhq = (size_t)bh * SEQ + q;
        __syncthreads();
        stage_block(lds, Kb, V, (size_t)b * SEQ + qb * 256, h, tid);
        bf16x8 qr[4];
#pragma unroll
        for (int s = 0; s < 4; ++s) qr[s] = *(const bf16x8*)(Q + qrow * 512 + h * 64 + 16 * s + 8 * hi);
        const unsigned sel = SEL[bhq];
        __syncthreads();
        float mrun = -INFINITY, lsum = 0.f; f32x16 o0 = {}, o1 = {};
        const int ntile = (32 * wid + 31) / 64 + 1;
#pragma unroll 1
        for (int tt = 0; tt < ntile; ++tt) tile<true>(lds, lds + OFF_V, qr, tt, q_off, lane, r32, hi, mrun, lsum, o0, o1);
        float lt = lsum + __shfl_xor(lsum, 32);
#pragma unroll 1
        for (int slot = 0; slot < 3; ++slot) {
            const int sj = (sel >> (5 * slot)) & 31; if (sj == 31) continue;
            const f32x2 ml = PML[bhq * 3 + slot]; const bf16* prow = part_o((bf16*)PO01, (bf16*)PO2, slot, bhq) + 4 * hi;
            const float mstar = fmaxf(mrun, ml[0]), fa = __builtin_amdgcn_exp2f(mrun - mstar), fb = ml[1] * __builtin_amdgcn_exp2f(ml[0] - mstar);
            mrun = mstar; lt = lt * fa + fb;
#pragma unroll
            for (int g4 = 0; g4 < 4; ++g4) { const u32x2 w0 = *(const u32x2*)(prow + 8 * g4), w1 = *(const u32x2*)(prow + 32 + 8 * g4);
                o0[4 * g4] = o0[4 * g4] * fa + fb * bflo(w0.x); o0[4 * g4 + 1] = o0[4 * g4 + 1] * fa + fb * bfhi(w0.x); o0[4 * g4 + 2] = o0[4 * g4 + 2] * fa + fb * bflo(w0.y); o0[4 * g4 + 3] = o0[4 * g4 + 3] * fa + fb * bfhi(w0.y);
                o1[4 * g4] = o1[4 * g4] * fa + fb * bflo(w1.x); o1[4 * g4 + 1] = o1[4 * g4 + 1] * fa + fb * bfhi(w1.x); o1[4 * g4 + 2] = o1[4 * g4 + 2] * fa + fb * bflo(w1.y); o1[4 * g4 + 3] = o1[4 * g4 + 3] * fa + fb * bfhi(w1.y); }
        }
        const float inv = 1.f / lt;
        bf16* orow = ATT + qrow * 512 + h * 64 + 4 * hi;
#pragma unroll
        for (int g4 = 0; g4 < 4; ++g4) { u32x2 w;
            w.x = cvt_pk_bf16(o0[4 * g4] * inv, o0[4 * g4 + 1] * inv); w.y = cvt_pk_bf16(o0[4 * g4 + 2] * inv, o0[4 * g4 + 3] * inv); *(u32x2*)(orow + 8 * g4) = w;
            w.x = cvt_pk_bf16(o1[4 * g4] * inv, o1[4 * g4 + 1] * inv); w.y = cvt_pk_bf16(o1[4 * g4 + 2] * inv, o1[4 * g4 + 3] * inv); *(u32x2*)(orow + 32 + 8 * g4) = w; }
    }
    __syncthreads();
}
}

__device__ __forceinline__ void peer_pass_u(const bf16* H2, const int* EID, const float* EG, const unsigned char* U8, const float* USC, const float* VSC, float* WT) {
    int tid_ = threadIdx.x; asm volatile("" : "+v"(tid_));
    const int lane = tid_ & 63, wv = tid_ >> 6;
    for (int t = blockIdx.x * (NT / 64) + wv; t < M; t += gridDim.x * (NT / 64)) {
        f32x2 hp[8];
        { const u32x4 h0 = *(const u32x4*)(H2 + (size_t)t * D + 16 * lane), h1 = *(const u32x4*)(H2 + (size_t)t * D + 16 * lane + 8);
          hp[0] = (f32x2){bflo(h0.x), bfhi(h0.x)}; hp[1] = (f32x2){bflo(h0.y), bfhi(h0.y)}; hp[2] = (f32x2){bflo(h0.z), bfhi(h0.z)}; hp[3] = (f32x2){bflo(h0.w), bfhi(h0.w)};
          hp[4] = (f32x2){bflo(h1.x), bfhi(h1.x)}; hp[5] = (f32x2){bflo(h1.y), bfhi(h1.y)}; hp[6] = (f32x2){bflo(h1.z), bfhi(h1.z)}; hp[7] = (f32x2){bflo(h1.w), bfhi(h1.w)}; }
        const int e0 = EID[(size_t)t * NSEL + lane], e1 = EID[(size_t)t * NSEL + 64 + lane]; const float gg0 = EG[(size_t)t * NSEL + lane], gg1 = EG[(size_t)t * NSEL + 64 + lane];
        const float vs0 = VSC[e0], vs1 = VSC[e1];
        float wlo = 0.f, whi = 0.f;
#pragma unroll 1
        for (int kb = 0; kb < NSEL; kb += 32) {
            u32x4 uu[32]; float us[32];
#pragma unroll
            for (int j = 0; j < 32; ++j) { const int k = kb + j; const int eid = __builtin_amdgcn_readlane(k < 64 ? e0 : e1, k & 63); uu[j] = *(const u32x4*)(U8 + (size_t)eid * D + 16 * lane); us[j] = USC[eid]; }
            float d[32];
#pragma unroll
            for (int j = 0; j < 32; ++j) { f32x2 a = (f32x2){0.f, 0.f};
                a = __builtin_elementwise_fma(fp8lo(uu[j].x), hp[0], a); a = __builtin_elementwise_fma(fp8hi(uu[j].x), hp[1], a); a = __builtin_elementwise_fma(fp8lo(uu[j].y), hp[2], a); a = __builtin_elementwise_fma(fp8hi(uu[j].y), hp[3], a);
                a = __builtin_elementwise_fma(fp8lo(uu[j].z), hp[4], a); a = __builtin_elementwise_fma(fp8hi(uu[j].z), hp[5], a); a = __builtin_elementwise_fma(fp8lo(uu[j].w), hp[6], a); a = __builtin_elementwise_fma(fp8hi(uu[j].w), hp[7], a);
                d[j] = (a[0] + a[1]) * us[j]; }
            float r16[16], r8[8], r4[4], r2[2], r1;
            { const bool up = (lane & 32) != 0;
#pragma unroll
              for (int j = 0; j < 16; ++j) { const float snd = up ? d[j] : d[j + 16], kp = up ? d[j + 16] : d[j]; r16[j] = kp + __shfl_xor(snd, 32); } }
            { const bool up = (lane & 16) != 0;
#pragma unroll
              for (int j = 0; j < 8; ++j) { const float snd = up ? r16[j] : r16[j + 8], kp = up ? r16[j + 8] : r16[j]; r8[j] = kp + __shfl_xor(snd, 16); } }
            { const bool up = (lane & 8) != 0;
#pragma unroll
              for (int j = 0; j < 4; ++j) { const float snd = up ? r8[j] : r8[j + 4], kp = up ? r8[j + 4] : r8[j]; r4[j] = kp + __shfl_xor(snd, 8); } }
            { const bool up = (lane & 4) != 0;
#pragma unroll
              for (int j = 0; j < 2; ++j) { const float snd = up ? r4[j] : r4[j + 2], kp = up ? r4[j + 2] : r4[j]; r2[j] = kp + __shfl_xor(snd, 4); } }
            { const bool up = (lane & 2) != 0; const float snd = up ? r2[0] : r2[1], kp = up ? r2[1] : r2[0]; r1 = kp + __shfl_xor(snd, 2); }
            r1 += __shfl_xor(r1, 1);
            const float ge = 0.5f * r1 * (1.f + erff(r1 * 0.70710678118654752f));
            const float gsh = __shfl(ge, 2 * (lane & 31));
            if (kb < 64) { if ((lane >> 5) == (kb >> 5)) wlo = gsh; } else { if ((lane >> 5) == ((kb - 64) >> 5)) whi = gsh; }
        }
        WT[(size_t)t * NSEL + lane] = wlo * gg0 * vs0; WT[(size_t)t * NSEL + 64 + lane] = whi * gg1 * vs1;
    }
}
__device__ __forceinline__ void peer_pass_v(const int* EID, const float* WT, const unsigned char* V8, const float* mod, const float* gfin, const float* x1, float* outp) {
    int tid_ = threadIdx.x; asm volatile("" : "+v"(tid_));
    const int lane = tid_ & 63, wv = tid_ >> 6;
    for (int t = blockIdx.x * (NT / 64) + wv; t < M; t += gridDim.x * (NT / 64)) {
        const int b = t / SEQ;
        const int e0 = EID[(size_t)t * NSEL + lane], e1 = EID[(size_t)t * NSEL + 64 + lane]; const float w0 = WT[(size_t)t * NSEL + lane], w1 = WT[(size_t)t * NSEL + 64 + lane];
        f32x2 acc[8];
#pragma unroll
        for (int i = 0; i < 8; ++i) acc[i] = (f32x2){0.f, 0.f};
#pragma unroll 1
        for (int kb = 0; kb < NSEL; kb += 32) {
            u32x4 vv[32];
#pragma unroll
            for (int j = 0; j < 32; ++j) { const int k = kb + j; const int eid = __builtin_amdgcn_readlane(k < 64 ? e0 : e1, k & 63); vv[j] = *(const u32x4*)(V8 + (size_t)eid * D + 16 * lane); }
#pragma unroll
            for (int j = 0; j < 32; ++j) { const int k = kb + j; const float w = __uint_as_float(__builtin_amdgcn_readlane(__float_as_uint(k < 64 ? w0 : w1), k & 63)); const f32x2 w2 = (f32x2){w, w};
                acc[0] = __builtin_elementwise_fma(w2, fp8lo(vv[j].x), acc[0]); acc[1] = __builtin_elementwise_fma(w2, fp8hi(vv[j].x), acc[1]); acc[2] = __builtin_elementwise_fma(w2, fp8lo(vv[j].y), acc[2]); acc[3] = __builtin_elementwise_fma(w2, fp8hi(vv[j].y), acc[3]);
                acc[4] = __builtin_elementwise_fma(w2, fp8lo(vv[j].z), acc[4]); acc[5] = __builtin_elementwise_fma(w2, fp8hi(vv[j].z), acc[5]); acc[6] = __builtin_elementwise_fma(w2, fp8lo(vv[j].w), acc[6]); acc[7] = __builtin_elementwise_fma(w2, fp8hi(vv[j].w), acc[7]); }
        }
        float ss = 0.f; f32x4 x2[4];
#pragma unroll
        for (int q4 = 0; q4 < 4; ++q4) { const int col = 16 * lane + 4 * q4; const f32x4 xv = *(const f32x4*)(x1 + (size_t)t * D + col), gv = *(const f32x4*)(mod + b * 6144 + 5 * D + col);
            x2[q4][0] = xv[0] + gv[0] * acc[2 * q4][0]; x2[q4][1] = xv[1] + gv[1] * acc[2 * q4][1]; x2[q4][2] = xv[2] + gv[2] * acc[2 * q4 + 1][0]; x2[q4][3] = xv[3] + gv[3] * acc[2 * q4 + 1][1];
            ss += x2[q4][0] * x2[q4][0] + x2[q4][1] * x2[q4][1] + x2[q4][2] * x2[q4][2] + x2[q4][3] * x2[q4][3]; }
#pragma unroll
        for (int o = 1; o < 64; o <<= 1) ss += __shfl_xor(ss, o);
        const float r = rsqrtf(ss * (1.f / D) + EPS);
#pragma unroll
        for (int q4 = 0; q4 < 4; ++q4) { const int col = 16 * lane + 4 * q4; const f32x4 gf = *(const f32x4*)(gfin + col); *(f32x4*)(outp + (size_t)t * D + col) = x2[q4] * r * gf; }
    }
}

__device__ __forceinline__ void d_cmp_accum(float num, float den, float* lds, float* acc2) {
#pragma unroll
    for (int o = 1; o < 64; o <<= 1) { num += __shfl_xor(num, o); den += __shfl_xor(den, o); }
    __syncthreads();
    if ((threadIdx.x & 63) == 0) { lds[(threadIdx.x >> 6) * 2] = num; lds[(threadIdx.x >> 6) * 2 + 1] = den; }
    __syncthreads();
    if (threadIdx.x == 0) { float n = 0.f, d = 0.f; for (int w = 0; w < NT / 64; ++w) { n += lds[w * 2]; d += lds[w * 2 + 1]; } atomicAdd(acc2, n); atomicAdd(acc2 + 1, d); }
    __syncthreads();
}
__device__ __forceinline__ void d_cmp_bf16(const bf16* a, const bf16* b, size_t n, float* lds, float* acc2) {
    float num = 0.f, den = 0.f; GSTRIDE(i, n) { const float x = bf2f(a[i]), y = bf2f(b[i]); num += (x - y) * (x - y); den += y * y; } d_cmp_accum(num, den, lds, acc2);
}
__device__ __forceinline__ void d_cmp_f32(const float* a, const float* b, size_t n, float* lds, float* acc2) {
    float num = 0.f, den = 0.f; GSTRIDE(i, n) { const float x = a[i], y = b[i]; num += (x - y) * (x - y); den += y * y; } d_cmp_accum(num, den, lds, acc2);
}

#ifndef DBG
#define DBG 0
#endif
#ifndef PROBE
#define PROBE 0
#endif
#ifndef USE_XCD_BARRIER
#define USE_XCD_BARRIER 1
#endif
#ifndef FAST_PRO
#define FAST_PRO 1
#endif
#ifndef FAST_GEMM
#define FAST_GEMM 1
#endif
#ifndef FAST_ATTN
#define FAST_ATTN 2
#endif
#define ATTN_SORTED(dst_) do { att2::phase_a(lds3, Q, KSUM, (unsigned short*)(ws + WS_SEL), (int*)(ws + WS_CNT), (unsigned short*)(ws + WS_LIST), G, bid); GSYNC(); \
    att2::phase_b<0>(lds3, Q, Kb, V, (const int*)(ws + WS_CNT), (const unsigned short*)(ws + WS_LIST), (bf16*)(ws + WS_PO01), (bf16*)(ws + WS_PO2), (f32x2*)(ws + WS_PML), G, bid); GSYNC(); \
    att2::phase_c(lds3, Q, Kb, V, (const unsigned short*)(ws + WS_SEL), (const bf16*)(ws + WS_PO01), (const bf16*)(ws + WS_PO2), (const f32x2*)(ws + WS_PML), dst_, G, bid); } while (0)
#ifndef FAST_PEER
#define FAST_PEER 1
#endif
#ifndef FAST_ROUTE
#define FAST_ROUTE 1
#endif
#ifndef PEER_TWO_PASS
#define PEER_TWO_PASS 1
#endif
#ifndef PEER_FP8
#define PEER_FP8 1
#endif
#if PEER_FP8
#if PEER_TWO_PASS
#define PEER_CALL(x1_, o_) do { peer_pass_u(H, EID, EG, ws + WS_U8, (const float*)(ws + WS_USC), (const float*)(ws + WS_VSC), (float*)(ws + WS_WT)); __syncthreads(); \
    peer_pass_v(EID, (const float*)(ws + WS_WT), ws + WS_V8, MOD, g_fin, x1_, o_); } while (0)
#else
#define PEER_CALL(x1_, o_) peer_phase8(H, EID, EG, ws + WS_U8, ws + WS_V8, (const float*)(ws + WS_USC), (const float*)(ws + WS_VSC), MOD, g_fin, x1_, o_)
#endif
#else
#define PEER_CALL(x1_, o_) peer_phase(H, EID, EG, (const bf16*)(ws + WS_UT), (const bf16*)(ws + WS_VT), MOD, g_fin, x1_, o_)
#endif
#define USE_FAST_PEER (FAST_PEER && !(DBG & 19))
constexpr int LDS_BYTES = 147456;
__global__ void __launch_bounds__(NT, 2) mega_fwd(Args a) {
    extern __shared__ __attribute__((aligned(16))) unsigned char lds_raw[];
    float* ldsf = (float*)lds_raw; LAS unsigned char* lds3 = (LAS unsigned char*)lds_raw;
    cg::grid_group grid = cg::this_grid();
    const float* x = a.in[0]; const float* c = a.in[1]; const float* w_ada = a.in[2]; const float* b_ada = a.in[3];
    const float* g_mix = a.in[4]; const float* w_in = a.in[5]; const float* pool_w = a.in[6]; const float* pool_scale = a.in[7];
    const float* w_bp = a.in[8]; const float* w_ba = a.in[9]; const float* w_out = a.in[10]; const float* g_ffn = a.in[11];
    const float* wq = a.in[12]; const float* skeys = a.in[13]; const float* Ut = a.in[14]; const float* Vt = a.in[15]; const float* g_fin = a.in[16];
    unsigned char* ws = a.ws; float* out = a.out;
    float* MOD = (float*)(ws + WS_MOD); float* KSUM = (float*)(ws + WS_KSUM); float* ROPE = (float*)(ws + WS_ROPE);
    bf16 *W_IN_T = (bf16*)(ws + WS_W_IN_T), *WC_T = (bf16*)(ws + WS_WC_T), *WBA_T = (bf16*)(ws + WS_WBA_T), *WOUT_T = (bf16*)(ws + WS_WOUT_T), *WQ_T = (bf16*)(ws + WS_WQ_T), *SK = (bf16*)(ws + WS_SK);
    bf16 *H = (bf16*)(ws + WS_H), *DIFF = (bf16*)(ws + WS_DIFF), *ATT = (bf16*)(ws + WS_ATT), *UP = (bf16*)(ws + WS_UP), *Q = (bf16*)(ws + WS_Q), *Kb = (bf16*)(ws + WS_K), *V = (bf16*)(ws + WS_V);
    bf16 *GATES = (bf16*)(ws + WS_GATES), *MERGED = (bf16*)(ws + WS_MERGED), *QP = (bf16*)(ws + WS_QP);
    int* EID = (int*)(ws + WS_EID); float* EG = (float*)(ws + WS_EG);
    const int G = gridDim.x, bid = blockIdx.x;
    { volatile LAS unsigned* st = (volatile LAS unsigned*)(lds3 + LDS_BYTES - 64); if (threadIdx.x < 16) st[threadIdx.x] = 0u; }
    __syncthreads();
    const XcdBarrier xbar = xcd_barrier_post((unsigned*)(ws + WS_BAR), (volatile LAS unsigned*)(lds3 + LDS_BYTES - 64));
#if USE_XCD_BARRIER
#define GSYNC() do { xcd_barrier(xbar); if (PROBE == 19) xcd_barrier(xbar); } while (0)
#else
#define GSYNC() grid.sync()
#endif
    if (a.ws == nullptr) grid.sync();
#if DBG
    float* DBGW = (float*)(ws + WS_DBG); unsigned char* ALT = ws + WS_ALT;
#endif

    for (int rep_ = 0; rep_ < (PROBE == 5 ? 2 : 1); ++rep_) {
#if FAST_PRO
    p0_mod_partials(c, w_ada, (float*)(ws + WS_MODP));
    p0_transposes(lds3, w_in, w_ba, w_out, wq, W_IN_T, WBA_T, WOUT_T, WQ_T);
    p0_wc(pool_w, pool_scale, w_bp, (float*)(ws + WS_WCF));
#else
    d_mod(c, w_ada, b_ada, MOD);
    d_transpose(w_in, 1024, 4096, W_IN_T); d_transpose(w_ba, 512, 1024, WBA_T); d_transpose(w_out, 1024, 1024, WOUT_T); d_transpose(wq, 1024, 2048, WQ_T);
    d_wc(pool_w, pool_scale, w_bp, WC_T);
#endif
#if (DBG & 4) || !FAST_ROUTE
    d_sk(skeys, SK);
#endif
    d_skbd(skeys, (bf16*)(ws + WS_SKBD)); d_rope(ROPE);
#if USE_FAST_PEER
#if PEER_FP8
    d_tab_fp8(Ut, ws + WS_U8, (float*)(ws + WS_USC)); d_tab_fp8(Vt, ws + WS_V8, (float*)(ws + WS_VSC));
#else
    d_tab_bf16(Ut, (bf16*)(ws + WS_UT)); d_tab_bf16(Vt, (bf16*)(ws + WS_VT));
#endif
#endif
    }
    GSYNC();
#if FAST_PRO
    { const float* MODP = (const float*)(ws + WS_MODP);
      GSTRIDE(idx, 2 * 6144) MOD[idx] = mod_reduce(MODP, b_ada, (int)idx);
      p1_wc_transpose(lds3, (const float*)(ws + WS_WCF), WC_T);
      __syncthreads();
      fill_mtab_partials((LAS float*)lds3, MODP, b_ada, 0, D);
      modulate_rows(x, g_mix, (const LAS float*)lds3, H);
      if (PROBE == 16) modulate_rows(x, g_mix, (const LAS float*)lds3, H); }
#else
    d_modulate(x, g_mix, MOD, 0, D, H);
#endif
    GSYNC();
#if DBG & 16
    { float* MOD2 = (float*)ALT; bf16 *T1 = (bf16*)(ALT + 1 * MiB), *T2 = (bf16*)(ALT + 9 * MiB), *T3 = (bf16*)(ALT + 10 * MiB), *T4 = (bf16*)(ALT + 12 * MiB), *T5 = (bf16*)(ALT + 16 * MiB), *HC = (bf16*)(ALT + 20 * MiB);
      d_mod(c, w_ada, b_ada, MOD2); d_transpose(w_in, 1024, 4096, T1); d_transpose(w_ba, 512, 1024, T2); d_transpose(w_out, 1024, 1024, T3); d_transpose(wq, 1024, 2048, T4); d_wc(pool_w, pool_scale, w_bp, T5);
      GSYNC();
      d_modulate(x, g_mix, MOD2, 0, D, HC);
      GSYNC();
      d_cmp_f32(MOD, MOD2, 2 * 6144, ldsf, DBGW + 24); d_cmp_bf16(W_IN_T, T1, (size_t)4096 * 1024, ldsf, DBGW + 26); d_cmp_bf16(WBA_T, T2, (size_t)512 * 1024, ldsf, DBGW + 26); d_cmp_bf16(WOUT_T, T3, (size_t)1024 * 1024, ldsf, DBGW + 26);
      d_cmp_bf16(WQ_T, T4, (size_t)2048 * 1024, ldsf, DBGW + 26); d_cmp_bf16(WC_T, T5, (size_t)512 * 1024, ldsf, DBGW + 26); d_cmp_bf16(H, HC, (size_t)M * D, ldsf, DBGW + 28);
      GSYNC(); }
#endif
#if (DBG & 1) || !FAST_GEMM
    { EpiInProjN E{UP, Q, Kb, V, GATES, ROPE}; d_ngemm(ldsf, H, D, W_IN_T, D, D, NPROJ, E); }
    GSYNC();
    d_ksum(Kb, KSUM);
#endif
#if DBG & 1
    { bf16 *UP2 = (bf16*)ALT, *Q2 = (bf16*)(ALT + 16 * MiB), *K2 = (bf16*)(ALT + 32 * MiB), *V2 = (bf16*)(ALT + 48 * MiB), *G2 = (bf16*)out; float* KS2 = (float*)(ws + WS_KSUM_ALT);
      pg8::Gemm g{H, W_IN_T, M, NPROJ, D, D, 0}; pg8::StaticOrder S; S.init(M, NPROJ, G, bid); EpiInProj E{UP2, Q2, K2, V2, G2, ROPE, KS2};
      pg8::gemm_phase<EpiInProj, pg8::StaticOrder, true>(lds3, g, S, E);
      GSYNC();
      d_cmp_bf16(UP2, UP, (size_t)M * 512, ldsf, DBGW + 0); d_cmp_bf16(Q2, Q, (size_t)M * 512, ldsf, DBGW + 2); d_cmp_bf16(K2, Kb, (size_t)M * 512, ldsf, DBGW + 4);
      d_cmp_bf16(V2, V, (size_t)M * 512, ldsf, DBGW + 6); d_cmp_bf16(G2, GATES, (size_t)M * 2048, ldsf, DBGW + 8); d_cmp_f32(KS2, KSUM, BATCH * NH * NBLK * HD, ldsf, DBGW + 10); }
#elif FAST_GEMM
    { pg8::Gemm g{H, W_IN_T, M, NPROJ, D, D, 0}; pg8::StaticOrder S; S.init(M, NPROJ, G, bid); EpiInProj E{UP, Q, Kb, V, GATES, ROPE, KSUM};
      pg8::gemm_phase<EpiInProj, pg8::StaticOrder, true>(lds3, g, S, E);
      if (PROBE == 7) { EpiInProj E2{UP, Q, Kb, V, GATES, ROPE, (float*)(ws + WS_KSUM_ALT)}; pg8::gemm_phase<EpiInProj, pg8::StaticOrder, true>(lds3, g, S, E2); } }
#endif
    GSYNC();
#if FAST_PRO
    pooldiff_fast(UP, DIFF);
    if (PROBE == 18) pooldiff_fast(UP, DIFF);
#else
    d_pooldiff(UP, DIFF);
#endif
#if DBG & 16
    { bf16* DC = (bf16*)ALT; d_pooldiff(UP, DC); GSYNC(); d_cmp_bf16(DIFF, DC, (size_t)M * 512, ldsf, DBGW + 30); GSYNC(); }
#endif
#if (DBG & 2) || !FAST_ATTN
    d_attn(Q, Kb, V, KSUM, ATT);
#endif
#if DBG & 2
    { bf16* ATT2 = (bf16*)ALT;
#if FAST_ATTN == 2
      GSYNC(); ATTN_SORTED(ATT2);
#else
      att::attn_phase(lds3, Q, Kb, V, KSUM, ATT2, G, bid);
#endif
      GSYNC(); d_cmp_bf16(ATT2, ATT, (size_t)M * 512, ldsf, DBGW + 18); }
#elif FAST_ATTN == 1
    att::attn_phase(lds3, Q, Kb, V, KSUM, ATT, G, bid);
    if (PROBE == 4) { __syncthreads(); att::attn_phase(lds3, Q, Kb, V, KSUM, ATT, G, bid); }
#elif FAST_ATTN == 2
    if (PROBE == 11) { att2::phase_a(lds3, Q, KSUM, (unsigned short*)((char*)out + 16 * MiB), (int*)(ws + WS_CNT + 4096), (unsigned short*)out, G, bid); }
    ATTN_SORTED(ATT);
    if (PROBE == 14) { att2::phase_b<1>(lds3, Q, Kb, V, (const int*)(ws + WS_CNT), (const unsigned short*)(ws + WS_LIST), (bf16*)(ws + WS_PO01), (bf16*)(ws + WS_PO2), (f32x2*)(ws + WS_PML), G, bid); }
    if (PROBE == 15) { att2::phase_b<2>(lds3, Q, Kb, V, (const int*)(ws + WS_CNT), (const unsigned short*)(ws + WS_LIST), (bf16*)(ws + WS_PO01), (bf16*)(ws + WS_PO2), (f32x2*)(ws + WS_PML), G, bid); }
    if (PROBE == 12) { att2::phase_b<0>(lds3, Q, Kb, V, (const int*)(ws + WS_CNT), (const unsigned short*)(ws + WS_LIST), (bf16*)(ws + WS_PO01), (bf16*)(ws + WS_PO2), (f32x2*)(ws + WS_PML), G, bid); }
    if (PROBE == 13) { att2::phase_c(lds3, Q, Kb, V, (const unsigned short*)(ws + WS_SEL), (const bf16*)(ws + WS_PO01), (const bf16*)(ws + WS_PO2), (const f32x2*)(ws + WS_PML), ATT, G, bid); }
#endif
    GSYNC();
#if (DBG & 1) || !FAST_GEMM
    { EpiMergeN E{MERGED, GATES, 0}; d_ngemm(ldsf, DIFF, 512, WC_T, 512, 512, D, E); }
    { EpiMergeN E{MERGED, GATES, 1}; d_ngemm(ldsf, ATT, 512, WBA_T, 512, 512, D, E); }
#endif
#if DBG & 1
    { bf16* MG2 = (bf16*)ALT;
      { pg8::Gemm g{DIFF, WC_T, M, D, 512, 512, 0}; pg8::StaticOrder S; S.init(M, D, G, bid); EpiMerge<0> E{MG2, GATES}; pg8::gemm_phase<EpiMerge<0>, pg8::StaticOrder, true>(lds3, g, S, E); }
      { pg8::Gemm g{ATT, WBA_T, M, D, 512, 512, 0}; pg8::StaticOrder S; S.init(M, D, G, bid); EpiMerge<1> E{MG2, GATES}; pg8::gemm_phase<EpiMerge<1>, pg8::StaticOrder, true>(lds3, g, S, E); }
      GSYNC();
      d_cmp_bf16(MG2, MERGED, (size_t)M * D, ldsf, DBGW + 12); }
#elif FAST_GEMM
    { pg8::Gemm g{DIFF, WC_T, M, D, 512, 512, 0}; pg8::StaticOrder S; S.init(M, D, G, bid); EpiMerge<0> E{MERGED, GATES}; pg8::gemm_phase<EpiMerge<0>, pg8::StaticOrder, true>(lds3, g, S, E); }
    { pg8::Gemm g{ATT, WBA_T, M, D, 512, 512, 0}; pg8::StaticOrder S; S.init(M, D, G, bid); EpiMerge<1> E{MERGED, GATES}; pg8::gemm_phase<EpiMerge<1>, pg8::StaticOrder, true>(lds3, g, S, E); }
    if (PROBE == 8) { { pg8::Gemm g{DIFF, WC_T, M, D, 512, 512, 0}; pg8::StaticOrder S; S.init(M, D, G, bid); EpiMerge<0> E{MERGED, GATES}; pg8::gemm_phase<EpiMerge<0>, pg8::StaticOrder, true>(lds3, g, S, E); }
      { pg8::Gemm g{ATT, WBA_T, M, D, 512, 512, 0}; pg8::StaticOrder S; S.init(M, D, G, bid); EpiMerge<1> E{MERGED, GATES}; pg8::gemm_phase<EpiMerge<1>, pg8::StaticOrder, true>(lds3, g, S, E); } }
#endif
    GSYNC();
#if (DBG & 1) || !FAST_GEMM
    { EpiRes1N E{x, MOD, out}; d_ngemm(ldsf, MERGED, D, WOUT_T, D, D, D, E); }
#endif
#if DBG & 1
    { float* X12 = (float*)ALT;
      pg8::Gemm g{MERGED, WOUT_T, M, D, D, D, 0}; pg8::StaticOrder S; S.init(M, D, G, bid); EpiRes1 E{x, MOD, X12}; pg8::gemm_phase<EpiRes1, pg8::StaticOrder, true>(lds3, g, S, E);
      GSYNC();
      d_cmp_f32(X12, out, (size_t)M * D, ldsf, DBGW + 14); }
#elif FAST_GEMM
    { pg8::Gemm g{MERGED, WOUT_T, M, D, D, D, 0}; pg8::StaticOrder S; S.init(M, D, G, bid); EpiRes1 E{x, MOD, out}; pg8::gemm_phase<EpiRes1, pg8::StaticOrder, true>(lds3, g, S, E);
      if (PROBE == 9) pg8::gemm_phase<EpiRes1, pg8::StaticOrder, true>(lds3, g, S, E); }
#endif
    GSYNC();
#if FAST_PRO
    fill_mtab((LAS float*)lds3, MOD, 3 * D, 4 * D); modulate_rows(out, g_ffn, (const LAS float*)lds3, H);
    if (PROBE == 17) modulate_rows(out, g_ffn, (const LAS float*)lds3, H);
#else
    d_modulate(out, g_ffn, MOD, 3 * D, 4 * D, H);
#endif
    GSYNC();
#if DBG & 16
    { bf16* HC = (bf16*)(ALT + 20 * MiB); d_modulate(out, g_ffn, MOD, 3 * D, 4 * D, HC); GSYNC(); d_cmp_bf16(H, HC, (size_t)M * D, ldsf, DBGW + 28); GSYNC(); }
#endif
#if (DBG & 1) || !FAST_GEMM
    { EpiBfN E{QP, 2048}; d_ngemm(ldsf, H, D, WQ_T, D, D, 2048, E); }
#endif
#if DBG & 1
    { bf16* QP2 = (bf16*)ALT;
      pg8::Gemm g{H, WQ_T, M, 2048, D, D, 0}; pg8::StaticOrder S; S.init(M, 2048, G, bid); EpiBf16 E{QP2, 2048}; pg8::gemm_phase<EpiBf16, pg8::StaticOrder, true>(lds3, g, S, E);
      GSYNC();
      d_cmp_bf16(QP2, QP, (size_t)M * 2048, ldsf, DBGW + 16); }
#elif FAST_GEMM
    { pg8::Gemm g{H, WQ_T, M, 2048, D, D, 0}; pg8::StaticOrder S; S.init(M, 2048, G, bid); EpiBf16 E{QP, 2048}; pg8::gemm_phase<EpiBf16, pg8::StaticOrder, true>(lds3, g, S, E);
      if (PROBE == 10) pg8::gemm_phase<EpiBf16, pg8::StaticOrder, true>(lds3, g, S, E); }
#endif
#if FAST_GEMM && FAST_ROUTE && !DBG
    asm volatile("s_waitcnt vmcnt(0)" ::: "memory"); __syncthreads();
#else
    GSYNC();
#endif
#if (DBG & 4) || !FAST_ROUTE
    d_route(ldsf, QP, SK, EID, EG);
#endif
#if DBG & 4
    { int* EID2 = (int*)(ws + 68 * MiB); float* EG2 = (float*)(ws + 76 * MiB); float* SM1 = (float*)(ws + 148 * MiB); float* SM2 = (float*)(ws + 150 * MiB);
      __syncthreads(); route_phase(lds3, QP, (const bf16*)(ws + WS_SKBD), EID2, EG2, G, bid); GSYNC();
      d_route_summary(EID, EG, SM1); d_route_summary(EID2, EG2, SM2); GSYNC(); d_cmp_f32(SM2, SM1, (size_t)M * PHEADS * 2, ldsf, DBGW + 22); }
#elif FAST_ROUTE
    route_phase(lds3, QP, (const bf16*)(ws + WS_SKBD), EID, EG, G, bid);
    if (PROBE == 6) route_phase(lds3, QP, (const bf16*)(ws + WS_SKBD), EID, EG, G, bid);
#endif
    GSYNC();
#if DBG & 8
    { float* OUT2 = (float*)(ws + WS_OUT2); PEER_CALL(out, OUT2); GSYNC();
      d_peer(H, EID, EG, Ut, Vt, MOD, g_fin, out); GSYNC(); d_cmp_f32(OUT2, out, (size_t)M * D, ldsf, DBGW + 20); }
#elif USE_FAST_PEER
    if (PROBE == 2) { PEER_CALL(out, (float*)(ws + WS_OUT2)); GSYNC(); }
    if (PROBE == 3) { for (int i = 0; i < 10; ++i) GSYNC(); }
    PEER_CALL(out, out);
#else
    d_peer(H, EID, EG, Ut, Vt, MOD, g_fin, out);
#endif
#if DBG
    GSYNC();
    { float e2 = 0.f; for (int i = 0; i < 16; ++i) { const float n = __hip_atomic_load(DBGW + 2 * i, __ATOMIC_RELAXED, __HIP_MEMORY_SCOPE_AGENT), d = __hip_atomic_load(DBGW + 2 * i + 1, __ATOMIC_RELAXED, __HIP_MEMORY_SCOPE_AGENT); if (d > 0.f) e2 += n / d; else if (n > 0.f) e2 += 1.f; }
      float dl = 10.f * sqrtf(e2); if (!(dl < 1.f)) dl = 1.f;
      GSTRIDE(i, (size_t)M * D) out[i] *= (1.f + dl); }
#endif
}

extern "C" void kernel_launch(void* const* d_in, const int* in_sizes, int n_in, void* d_out, int out_size, void* d_ws, size_t ws_size, hipStream_t stream) {
    static int grid_blocks = 0;
    if (grid_blocks == 0) {
        if (n_in != 17 || out_size != M * D || ws_size < 256 * MiB) { fprintf(stderr, "kernel_launch: unexpected shapes (n_in %d out %d ws %zu)\n", n_in, out_size, ws_size); grid_blocks = -1; return; }
        int dev = 0, cus = 0, per_cu = 0;
        (void)hipGetDevice(&dev); (void)hipDeviceGetAttribute(&cus, hipDeviceAttributeMultiprocessorCount, dev);
        (void)hipFuncSetAttribute((const void*)mega_fwd, hipFuncAttributeMaxDynamicSharedMemorySize, LDS_BYTES);
        (void)hipOccupancyMaxActiveBlocksPerMultiprocessor(&per_cu, (const void*)mega_fwd, NT, LDS_BYTES);
        if (per_cu < 1 || cus < 1) { fprintf(stderr, "kernel_launch: occupancy query says %d blocks/CU on %d CUs\n", per_cu, cus); grid_blocks = -1; return; }
        grid_blocks = cus;
    }
    if (grid_blocks < 0) return;
    (void)hipMemsetAsync((char*)d_ws + WS_CTL, 0, 1 * MiB, stream);
    Args a{};
    for (int i = 0; i < 17; ++i) a.in[i] = (const float*)d_in[i];
    a.out = (float*)d_out; a.ws = (unsigned char*)d_ws;
    void* args[] = {&a};
    hipError_t e = hipLaunchCooperativeKernel((const void*)mega_fwd, dim3(grid_blocks), dim3(NT), args, LDS_BYTES, stream);
    if (e != hipSuccess) fprintf(stderr, "cooperative launch failed: %s (grid %d)\n", hipGetErrorString(e), grid_blocks);
}
```

```cpp
#include <hip/hip_runtime.h>
#include <hip/hip_cooperative_groups.h>
#include <cstdio>
#include <cstdint>
namespace cg = cooperative_groups;

constexpr int BATCH = 2, SEQ = 8192, D = 1024, M = BATCH * SEQ;
constexpr int NPROJ = 4096, PW = 512, AW = 512, NH = 8, HD = 64, MBLK = 256, NBLK = SEQ / MBLK;
constexpr int PHEADS = 8, NKEYS = 128, PQD = 256, PHALF = 128, PTOPK = 16, NEXP = NKEYS * NKEYS, NSEL = PHEADS * PTOPK;
constexpr float EPS = 1e-6f;
constexpr float C2 = 0.125f * 1.4426950408889634f;
constexpr int NT = 512;

typedef unsigned short bf16;
__device__ __forceinline__ float bf2f(bf16 v) { return __uint_as_float(((unsigned)v) << 16); }
__device__ __forceinline__ bf16 f2bf(float f) { unsigned u = __float_as_uint(f); return (bf16)((u + 0x7fffu + ((u >> 16) & 1u)) >> 16); }

template <class T> __device__ __forceinline__ T shx_(T v, int m, int lane) { asm volatile("" : "+v"(lane)); return __builtin_bit_cast(T, __builtin_amdgcn_ds_bpermute((lane ^ m) << 2, __builtin_bit_cast(int, v))); }
template <class T> __device__ __forceinline__ T shl_(T v, int src) { return __builtin_bit_cast(T, __builtin_amdgcn_ds_bpermute(src << 2, __builtin_bit_cast(int, v))); }
#define SHX(v, m) shx_((v), (m), lane)
#define SHL(v, src) shl_((v), (src))
#define SHUP(v, o) shl_((v), lane >= (o) ? lane - (o) : lane)

constexpr size_t MiB = 1u << 20;
constexpr size_t WS_CTL = 0;
constexpr size_t WS_MOD = 1 * MiB;
constexpr size_t WS_KSUM = 256 * 1024;
constexpr size_t WS_BAR = 32 * 1024;
constexpr size_t WS_KSUM_ALT = 512 * 1024, WS_DBG = 16 * 1024;
constexpr size_t WS_UT = 180 * MiB, WS_VT = 212 * MiB;
constexpr size_t WS_U8 = 180 * MiB, WS_V8 = 196 * MiB, WS_USC = 212 * MiB, WS_VSC = 212 * MiB + 65536;
constexpr size_t WS_SEL = 1 * MiB + 768 * 1024;
constexpr size_t WS_CNT = 640 * 1024;
constexpr size_t WS_PO01 = 213 * MiB, WS_PO2 = 52 * MiB, WS_LIST = 245 * MiB, WS_PML = 253 * MiB;
constexpr size_t WS_WT = 68 * MiB;
constexpr size_t WS_OUT2 = 84 * MiB;
constexpr size_t WS_ALT = 180 * MiB;
constexpr size_t WS_ROPE = 1 * MiB + 256 * 1024;
constexpr size_t WS_MODP = 148 * MiB;
constexpr size_t WS_WCF = 150 * MiB;
constexpr size_t WS_W_IN_T = 2 * MiB;
constexpr size_t WS_WC_T = 10 * MiB;
constexpr size_t WS_WBA_T = 11 * MiB;
constexpr size_t WS_WOUT_T = 12 * MiB;
constexpr size_t WS_WQ_T = 14 * MiB;
constexpr size_t WS_SK = 18 * MiB;
constexpr size_t WS_SKBD = 19 * MiB;
constexpr size_t WS_H = 20 * MiB;
constexpr size_t WS_DIFF = 20 * MiB, WS_ATT = 36 * MiB;
constexpr size_t WS_UP = 52 * MiB, WS_Q = 68 * MiB, WS_K = 84 * MiB, WS_V = 100 * MiB;
constexpr size_t WS_GATES = 116 * MiB;
constexpr size_t WS_MERGED = 84 * MiB;
constexpr size_t WS_QP = 116 * MiB;
constexpr size_t WS_EID = 52 * MiB, WS_EG = 60 * MiB;
constexpr size_t WS_END = 180 * MiB;

struct Args { const float* in[17]; float* out; unsigned char* ws; };

__device__ __forceinline__ size_t gstart_() { unsigned t = blockIdx.x * NT + threadIdx.x; asm volatile("" : "+v"(t)); return t; }
#define GSTRIDE(i, n) for (size_t i = gstart_(); i < (size_t)(n); i += (size_t)gridDim.x * NT)

__device__ __forceinline__ void d_mod(const float* c, const float* w_ada, const float* b_ada, float* mod) {
    GSTRIDE(idx, 2 * 6144) { const int b = (int)idx / 6144, j = (int)idx % 6144; float acc = 0.f;
        for (int i = 0; i < D; ++i) { const float cv = c[b * D + i]; const float s = cv / (1.f + expf(-cv)); acc += s * w_ada[(size_t)i * 6144 + j]; }
        mod[idx] = acc + b_ada[j]; }
}
__device__ __forceinline__ void d_transpose(const float* W, int K, int N, bf16* WT) {
    GSTRIDE(idx, (size_t)K * N) { const int k = (int)(idx / N), n = (int)(idx % N); WT[(size_t)n * K + k] = f2bf(W[idx]); }
}
__device__ __forceinline__ void d_wc(const float* pool_w, const float* pool_scale, const float* w_bp, bf16* WcT) {
    GSTRIDE(idx, 512 * 1024) { const int o = (int)idx % 1024, k = (int)idx / 1024, g = k / 128, i = k % 128; float acc = 0.f;
        for (int j = 0; j < 128; ++j) acc += pool_w[(g * 128 + i) * 128 + j] * pool_scale[g * 128 + j] * w_bp[(size_t)(g * 128 + j) * 1024 + o];
        WcT[(size_t)o * 512 + k] = f2bf(acc); }
}
__device__ __forceinline__ void d_sk(const float* sk, bf16* SK) { GSTRIDE(idx, 8 * 2 * 128 * 128) SK[idx] = f2bf(sk[idx]); }
__device__ __forceinline__ void d_rope(float* tab) {
    GSTRIDE(idx, SEQ * 8) { const int pos = (int)idx / 8, i = (int)idx % 8; const float inv = (float)pow(500000.0, -(double)i / 8.0); const float ang = (float)pos * inv;
        tab[pos * 16 + i] = (float)cos((double)ang); tab[pos * 16 + 8 + i] = (float)sin((double)ang); }
}
__device__ __forceinline__ void d_modulate(const float* x, const float* g, const float* mod, int shift_off, int scale_off, bf16* out) {
    const int lane = threadIdx.x & 63;
    for (int row = blockIdx.x * (NT / 64) + (threadIdx.x >> 6); row < M; row += gridDim.x * (NT / 64)) {
        const int b = row / SEQ; const float* xr = x + (size_t)row * D; float v[16]; float ss = 0.f;
#pragma unroll
        for (int j = 0; j < 16; ++j) { v[j] = xr[j * 64 + lane]; ss += v[j] * v[j]; }
#pragma unroll
        for (int o = 1; o < 64; o <<= 1) ss += SHX(ss, o);
        const float r = rsqrtf(ss * (1.f / D) + EPS);
#pragma unroll
        for (int j = 0; j < 16; ++j) { const int col = j * 64 + lane; out[(size_t)row * D + col] = f2bf(v[j] * r * g[col] * (1.f + mod[b * 6144 + scale_off + col]) + mod[b * 6144 + shift_off + col]); }
    }
}
constexpr int NG_HALF_FLOATS = 2 * 16 * 65 + 64 * 65;
template <class Epi>
__device__ __forceinline__ void d_ngemm(float* lds, const bf16* A, int lda, const bf16* Bt, int ldb, int K, int N, const Epi& E) {
    const int half = threadIdx.x >> 8, tid = threadIdx.x & 255, tx = tid & 15, ty = tid >> 4;
    float* As = lds + half * NG_HALF_FLOATS; float* Bs = As + 16 * 65; float* Ct = Bs + 16 * 65;
    const int ntn = N / 64, ntiles = (M / 64) * ntn, iters = (ntiles + 2 * gridDim.x - 1) / (2 * gridDim.x);
    for (int it = 0; it < iters; ++it) {
        const int t = (it * gridDim.x + blockIdx.x) * 2 + half; const bool valid = t < ntiles; const int m0 = valid ? (t / ntn) * 64 : 0, n0 = valid ? (t % ntn) * 64 : 0;
        float acc[4][4];
#pragma unroll
        for (int i = 0; i < 4; ++i)
#pragma unroll
            for (int j = 0; j < 4; ++j) acc[i][j] = 0.f;
        for (int k0 = 0; k0 < K; k0 += 16) {
#pragma unroll
            for (int e = 0; e < 4; ++e) { const int idx = tid + e * 256, r = idx >> 4, kk = idx & 15;
                As[kk * 65 + r] = bf2f(A[(size_t)(m0 + r) * lda + k0 + kk]); Bs[kk * 65 + r] = bf2f(Bt[(size_t)(n0 + r) * ldb + k0 + kk]); }
            __syncthreads();
#pragma unroll
            for (int kk = 0; kk < 16; ++kk) { float a[4], b[4];
#pragma unroll
                for (int i = 0; i < 4; ++i) { a[i] = As[kk * 65 + ty * 4 + i]; b[i] = Bs[kk * 65 + tx * 4 + i]; }
#pragma unroll
                for (int i = 0; i < 4; ++i)
#pragma unroll
                    for (int j = 0; j < 4; ++j) acc[i][j] += a[i] * b[j]; }
            __syncthreads();
        }
#pragma unroll
        for (int i = 0; i < 4; ++i)
#pragma unroll
            for (int j = 0; j < 4; ++j) Ct[(ty * 4 + i) * 65 + tx * 4 + j] = acc[i][j];
        __syncthreads();
        if (valid) for (int e = tid; e < 64 * 64; e += 256) { const int r = e >> 6, cidx = e & 63; E(m0 + r, n0 + cidx, Ct[r * 65 + cidx], &Ct[r * 65], cidx); }
        __syncthreads();
    }
}
struct EpiInProjN {
    bf16 *UP, *Q, *Kb, *V, *G; const float* rope;
    __device__ void operator()(int m, int n, float v, const float* row, int cl) const {
        if (n < 512) { UP[(size_t)m * 512 + n] = f2bf(v); return; }
        if (n < 1536) {
            const bool isq = n < 1024; const int c = isq ? n - 512 : n - 1024; const int d = c & 63; const int pos = m % SEQ; float o = v;
            if (d < 8) { const float cs = rope[pos * 16 + d], sn = rope[pos * 16 + 8 + d]; o = v * cs - row[cl + 8] * sn; }
            else if (d < 16) { const float cs = rope[pos * 16 + d - 8], sn = rope[pos * 16 + 8 + d - 8]; o = row[cl - 8] * sn + v * cs; }
            if (isq) Q[(size_t)m * 512 + c] = f2bf(o * C2); else Kb[(size_t)m * 512 + c] = f2bf(o);
            return;
        }
        if (n < 2048) { V[(size_t)m * 512 + n - 1536] = f2bf(v); return; }
        G[(size_t)m * 2048 + n - 2048] = f2bf(1.f / (1.f + expf(-v)));
    }
};
struct EpiMergeN { bf16* Mg; const bf16* G; int pass;
    __device__ void operator()(int m, int n, float v, const float*, int) const {
        const float g = bf2f(G[(size_t)m * 2048 + pass * 1024 + n]); const size_t o = (size_t)m * 1024 + n;
        if (pass == 0) Mg[o] = f2bf(g * v); else Mg[o] = f2bf(bf2f(Mg[o]) + g * v); } };
struct EpiRes1N { const float* x; const float* mod; float* x1;
    __device__ void operator()(int m, int n, float v, const float*, int) const { const int b = m / SEQ; x1[(size_t)m * D + n] = x[(size_t)m * D + n] + mod[b * 6144 + 2 * D + n] * v; } };
struct EpiBfN { bf16* O; int ldo; __device__ void operator()(int m, int n, float v, const float*, int) const { O[(size_t)m * ldo + n] = f2bf(v); } };

__device__ __forceinline__ void d_ksum(const bf16* Kb, float* ksum) {
    GSTRIDE(idx, BATCH * NH * NBLK * HD) { const int d = (int)idx % HD, blk = ((int)idx / HD) % NBLK, h = ((int)idx / (HD * NBLK)) % NH, b = (int)idx / (HD * NBLK * NH); float s = 0.f;
        for (int r = 0; r < MBLK; ++r) s += bf2f(Kb[(size_t)(b * SEQ + blk * MBLK + r) * 512 + h * 64 + d]);
        ksum[idx] = s; }
}
__device__ __forceinline__ void d_pooldiff(const bf16* UP, bf16* DIFF) {
    GSTRIDE(idx, (size_t)M * 512) { const int c = (int)(idx % 512), row = (int)(idx / 512), pos = row % SEQ, w = 2 << (c / 128), cnt = pos + 1 < w ? pos + 1 : w; float s = 0.f;
        for (int i = 0; i < cnt; ++i) s += bf2f(UP[(size_t)(row - i) * 512 + c]);
        DIFF[idx] = f2bf(s / (float)cnt - bf2f(UP[idx])); }
}
__device__ __forceinline__ void d_attn(const bf16* Q, const bf16* Kb, const bf16* V, const float* ksum, bf16* ATT) {
    GSTRIDE(gidx, BATCH * NH * SEQ) {
        const int idx = (int)gidx, q = idx % SEQ, h = (idx / SEQ) % NH, b = idx / (SEQ * NH), row = b * SEQ + q, qb = q / MBLK;
        float qv[64], o[64];
#pragma unroll
        for (int d = 0; d < 64; ++d) { qv[d] = bf2f(Q[(size_t)row * 512 + h * 64 + d]); o[d] = 0.f; }
        int s0 = -1, s1 = -1, s2 = -1; float g0 = -INFINITY, g1 = -INFINITY, g2 = -INFINITY;
        for (int j = 0; j < qb; ++j) { const float* ks = ksum + ((size_t)(b * NH + h) * NBLK + j) * HD; float g = 0.f;
#pragma unroll
            for (int d = 0; d < 64; ++d) g += qv[d] * ks[d];
            if (g > g0) { g2 = g1; s2 = s1; g1 = g0; s1 = s0; g0 = g; s0 = j; } else if (g > g1) { g2 = g1; s2 = s1; g1 = g; s1 = j; } else if (g > g2) { g2 = g; s2 = j; } }
        float mx = -1e30f, l = 0.f;
        for (int pass = 0; pass < 4; ++pass) {
            const int blk = pass == 0 ? qb : (pass == 1 ? s0 : (pass == 2 ? s1 : s2)); if (blk < 0) continue;
            const int nkeys = pass == 0 ? (q - qb * MBLK + 1) : MBLK;
            for (int kk = 0; kk < nkeys; ++kk) { const size_t kr = (size_t)(b * SEQ + blk * MBLK + kk) * 512 + h * 64; float s = 0.f;
#pragma unroll
                for (int d = 0; d < 64; ++d) s += qv[d] * bf2f(Kb[kr + d]);
                if (s > mx) { const float f = exp2f(mx - s); l = l * f + 1.f;
#pragma unroll
                    for (int d = 0; d < 64; ++d) o[d] = o[d] * f + bf2f(V[kr + d]);
                    mx = s; }
                else { const float p = exp2f(s - mx); l += p;
#pragma unroll
                    for (int d = 0; d < 64; ++d) o[d] += p * bf2f(V[kr + d]); } }
        }
        const float il = 1.f / l;
#pragma unroll
        for (int d = 0; d < 64; ++d) ATT[(size_t)row * 512 + h * 64 + d] = f2bf(o[d] * il);
    }
}
__device__ __forceinline__ void d_route(float* lds, const bf16* QP, const bf16* SK, int* EID, float* EG) {
    const int tid = threadIdx.x; float* lv = lds + tid * 33; int* li = (int*)(lds + NT * 33) + tid * 33;
    GSTRIDE(gidx, M * PHEADS) {
        const int idx = (int)gidx, h = idx % PHEADS, t = idx / PHEADS;
#pragma unroll 1
        for (int p = 0; p < 2; ++p) {
            float tv[16]; int ti[16];
#pragma unroll
            for (int j = 0; j < 16; ++j) { tv[j] = -INFINITY; ti[j] = 0; }
            const bf16* qr = QP + (size_t)t * 2048 + h * 256 + p * 128; const bf16* sk = SK + (size_t)(h * 2 + p) * 128 * 128;
#pragma unroll 1
            for (int n = 0; n < 128; ++n) { float s = 0.f;
                for (int d = 0; d < 128; ++d) s += bf2f(qr[d]) * bf2f(sk[n * 128 + d]);
                float v = s; int vi = n;
#pragma unroll
                for (int j = 0; j < 16; ++j) if (v > tv[j]) { const float tf = tv[j]; const int tj = ti[j]; tv[j] = v; ti[j] = vi; v = tf; vi = tj; } }
#pragma unroll
            for (int j = 0; j < 16; ++j) { lv[p * 16 + j] = tv[j]; li[p * 16 + j] = ti[j]; }
        }
        float cv[16]; int ci[16];
#pragma unroll
        for (int j = 0; j < 16; ++j) { cv[j] = -INFINITY; ci[j] = 0; }
#pragma unroll 1
        for (int i = 0; i < 16; ++i)
#pragma unroll 1
            for (int j2 = 0; j2 < 16; ++j2) { float v = lv[i] + lv[16 + j2]; int vi = li[i] * NKEYS + li[16 + j2];
#pragma unroll
                for (int j = 0; j < 16; ++j) if (v > cv[j]) { const float tf = cv[j]; const int tj = ci[j]; cv[j] = v; ci[j] = vi; v = tf; vi = tj; } }
        float sum = 0.f, e[16];
#pragma unroll
        for (int j = 0; j < 16; ++j) { e[j] = expf(cv[j] - cv[0]); sum += e[j]; }
        const float is = 1.f / sum;
#pragma unroll
        for (int j = 0; j < 16; ++j) { EID[(size_t)t * NSEL + h * 16 + j] = ci[j]; EG[(size_t)t * NSEL + h * 16 + j] = e[j] * is; }
    }
}
__device__ __forceinline__ void d_peer(const bf16* H2, const int* EID, const float* EG, const float* Ut, const float* Vt, const float* mod, const float* gfin, float* io) {
    const int lane = threadIdx.x & 63;
    for (int t = blockIdx.x * (NT / 64) + (threadIdx.x >> 6); t < M; t += gridDim.x * (NT / 64)) {
        const int b = t / SEQ; float hv[16], acc[16];
#pragma unroll
        for (int j = 0; j < 4; ++j)
#pragma unroll
            for (int e = 0; e < 4; ++e) { hv[j * 4 + e] = bf2f(H2[(size_t)t * D + j * 256 + lane * 4 + e]); acc[j * 4 + e] = 0.f; }
#pragma unroll 1
        for (int k = 0; k < NSEL; ++k) {
            const int eid = EID[(size_t)t * NSEL + k]; const float g = EG[(size_t)t * NSEL + k];
            const float4* ur = (const float4*)(Ut + (size_t)eid * D); const float4* vr = (const float4*)(Vt + (size_t)eid * D); float dot = 0.f;
#pragma unroll
            for (int j = 0; j < 4; ++j) { const float4 u = ur[j * 64 + lane]; dot += hv[j * 4] * u.x + hv[j * 4 + 1] * u.y + hv[j * 4 + 2] * u.z + hv[j * 4 + 3] * u.w; }
#pragma unroll
            for (int o = 1; o < 64; o <<= 1) dot += SHX(dot, o);
            const float w = g * 0.5f * dot * (1.f + erff(dot * 0.70710678118654752f));
#pragma unroll
            for (int j = 0; j < 4; ++j) { const float4 v = vr[j * 64 + lane]; acc[j * 4] += w * v.x; acc[j * 4 + 1] += w * v.y; acc[j * 4 + 2] += w * v.z; acc[j * 4 + 3] += w * v.w; }
        }
        float ss = 0.f;
#pragma unroll
        for (int j = 0; j < 4; ++j)
#pragma unroll
            for (int e = 0; e < 4; ++e) { const int col = j * 256 + lane * 4 + e; const float x2 = io[(size_t)t * D + col] + mod[b * 6144 + 5 * D + col] * acc[j * 4 + e]; acc[j * 4 + e] = x2; ss += x2 * x2; }
#pragma unroll
        for (int o = 1; o < 64; o <<= 1) ss += SHX(ss, o);
        const float r = rsqrtf(ss * (1.f / D) + EPS);
#pragma unroll
        for (int j = 0; j < 4; ++j)
#pragma unroll
            for (int e = 0; e < 4; ++e) { const int col = j * 256 + lane * 4 + e; io[(size_t)t * D + col] = acc[j * 4 + e] * r * gfin[col]; }
    }
}


#define LAS __attribute__((address_space(3)))
typedef short bf16x8 __attribute__((ext_vector_type(8)));
typedef float f32x4 __attribute__((ext_vector_type(4)));
typedef float f32x2 __attribute__((ext_vector_type(2)));
typedef unsigned u32x4 __attribute__((ext_vector_type(4)));
typedef unsigned u32x2 __attribute__((ext_vector_type(2)));
typedef __bf16 bf16x2_t __attribute__((ext_vector_type(2)));
__device__ __forceinline__ unsigned cvt_pk_bf16(float lo, float hi) { f32x2 v = {lo, hi}; bf16x2_t b = __builtin_convertvector(v, bf16x2_t); return __builtin_bit_cast(unsigned, b); }
__device__ __forceinline__ float bflo(unsigned w) { return __uint_as_float(w << 16); }
__device__ __forceinline__ float bfhi(unsigned w) { return __uint_as_float(w & 0xffff0000u); }

namespace pg8 {
constexpr int BM = 256, BK = 64, HALF = 128, HTB = HALF * BK * 2  , STAGE_BYTES = 8 * HTB, NXCD = 8, WGM = 8;
__device__ __forceinline__ int lds_byte(int r, int c) { const int st = (r >> 4) * 2 + (c >> 5), rr = r & 15, cc = c & 31, ob = rr * 64 + cc * 2; return st * 1024 + (ob ^ (((ob >> 9) & 1) << 5)); }
__device__ __forceinline__ void stage_rc(int b, int& R, int& C) { const int st = b / 1024, sb = b % 1024, swz = sb ^ (((sb >> 9) & 1) << 5); R = (st >> 1) * 16 + swz / 64; C = (st & 1) * 32 + (swz % 64) / 2; }
__device__ __forceinline__ int perm32(int rho) { const int n = rho >> 4, i = rho & 15; return 8 * (i >> 2) + 4 * n + (i & 3); }
struct Unit { int pm, pn; };
struct Gemm { const bf16* A; const bf16* Bt; int M, N, K, lda, a_pn_off; };
struct StaticOrder {
    int nM, nN, nwg, G, c;
    __device__ void init(int M_, int N_, int G_, int c_) { nM = M_ / BM; nN = N_ / BM; nwg = nM * nN; G = G_; c = c_; }
    __device__ bool next(int i, Unit& u) const {
        const long L = (long)i * G + c; if (L >= nwg) return false;
        int wgid = (int)L; { const int q = nwg / NXCD, r = nwg % NXCD, xcd = wgid % NXCD, off = wgid / NXCD; wgid = (xcd < r ? xcd * (q + 1) : r * (q + 1) + (xcd - r) * q) + off; }
        const int nig = WGM * nN, gid = wgid / nig, fm = gid * WGM, gsz = (nM - fm) < WGM ? (nM - fm) : WGM;
        u.pm = fm + ((wgid % nig) % gsz); u.pn = (wgid % nig) / gsz; return true;
    }
};
struct OneUnit { Unit u; __device__ bool next(int i, Unit& o) const { if (i) return false; o = u; return true; } };
template <class Epi, class Sched, bool ALIGN_EPI>
__device__ __forceinline__ void gemm_phase(LAS unsigned char* lds, const Gemm g, const Sched& S, const Epi& E) {
    int tid_ = threadIdx.x; asm volatile("" : "+v"(tid_));
    const int tid = tid_, wid = __builtin_amdgcn_readfirstlane(tid >> 6), lane = tid & 63, wr = wid >> 2, wc = wid & 3, fr = lane & 15, fq = lane >> 4;
    const int K = g.K, nt = K / BK, lda = g.lda;
    unsigned voffA[2], voffB[2];
#pragma unroll
    for (int i = 0; i < 2; ++i) { int R, C; stage_rc(tid * 16 + i * 8192, R, C); const int Rb = Epi::PERM ? ((R & ~31) + perm32(R & 31)) : R;
        voffA[i] = (unsigned)(R * lda + C) * 2u; voffB[i] = (unsigned)(Rb * K + C) * 2u; }
    const size_t kstep = (size_t)(BK * 2);
    const size_t hA = (size_t)HALF * lda * 2, hB = (size_t)HALF * K * 2, tA = 2 * hA, tB = 2 * hB;
    const unsigned ldsw = (unsigned)wid * 1024u;
    const int aoff = lds_byte(wr * 64 + fr, fq * 8), boff = lds_byte(wc * 32 + fr, fq * 8);
#define PG8_SA(b, h) (((b) * 2 + (h)) * HTB)
#define PG8_SB(b, h) ((4 + (b) * 2 + (h)) * HTB)
#define PG8_STAGE(bufoff, gbase, voff) do { _Pragma("unroll") for (int _i = 0; _i < 2; ++_i) \
        __builtin_amdgcn_global_load_lds((const unsigned*)((const char*)(gbase) + (voff)[_i]), (LAS unsigned*)(lds + (bufoff) + ldsw + _i * 8192), 16, 0, 0); } while (0)
#define PG8_LDA(dst, b, h) do { _Pragma("unroll") for (int m = 0; m < 4; ++m) _Pragma("unroll") for (int k = 0; k < 2; ++k) dst[m][k] = *(const LAS bf16x8*)(lds + PG8_SA(b, h) + aoff + m * 2048 + k * 1024); } while (0)
#define PG8_LDB(dst, b, h) do { _Pragma("unroll") for (int n = 0; n < 2; ++n) _Pragma("unroll") for (int k = 0; k < 2; ++k) dst[n][k] = *(const LAS bf16x8*)(lds + PG8_SB(b, h) + boff + n * 2048 + k * 1024); } while (0)
#define PG8_MMA(ai, bj, At, Bt) do { __builtin_amdgcn_s_setprio(1); _Pragma("unroll") for (int m = 0; m < 4; ++m) _Pragma("unroll") for (int n = 0; n < 2; ++n) _Pragma("unroll") for (int k = 0; k < 2; ++k) \
        acc[ai][bj][m][n] = __builtin_amdgcn_mfma_f32_16x16x32_bf16(Bt[n][k], At[m][k], acc[ai][bj][m][n], 0, 0, 0); __builtin_amdgcn_s_setprio(0); } while (0)
#define PG8_WAIT_V(n) asm volatile("s_waitcnt vmcnt(" #n ")" ::: "memory")
#define PG8_WAIT_L(n) asm volatile("s_waitcnt lgkmcnt(" #n ")" ::: "memory")
#define PG8_BAR __builtin_amdgcn_s_barrier()
#define PG8_SCHED __builtin_amdgcn_sched_barrier(0)
    Unit cur, nxt; int ui = 0;
    if (!S.next(0, cur)) return;
    f32x4 acc[2][2][4][2];
#pragma unroll
    for (int a = 0; a < 2; ++a)
#pragma unroll
        for (int b = 0; b < 2; ++b)
#pragma unroll
            for (int m = 0; m < 4; ++m)
#pragma unroll
                for (int n = 0; n < 2; ++n) acc[a][b][m][n] = (f32x4){0.f, 0.f, 0.f, 0.f};
    bf16x8 At[4][2], B0[2][2], B1[2][2];
    const char* cA = (const char*)g.A + (size_t)cur.pm * tA + (size_t)cur.pn * g.a_pn_off * 2; const char* cB = (const char*)g.Bt + (size_t)cur.pn * tB;
    PG8_STAGE(PG8_SB(0, 0), cB, voffB); PG8_STAGE(PG8_SB(0, 1), cB + hB, voffB); PG8_STAGE(PG8_SA(0, 0), cA, voffA); PG8_STAGE(PG8_SA(0, 1), cA + hA, voffA);
    if (wr == 1) PG8_BAR;
    PG8_WAIT_V(2); PG8_BAR;
    PG8_STAGE(PG8_SB(1, 0), cB + kstep, voffB); PG8_STAGE(PG8_SA(1, 0), cA + kstep, voffA); PG8_STAGE(PG8_SB(1, 1), cB + hB + kstep, voffB);
    PG8_WAIT_V(6); PG8_BAR;
    for (;;) {
        const bool has_next = S.next(ui + 1, nxt);
        const char* nA = has_next ? (const char*)g.A + (size_t)nxt.pm * tA + (size_t)nxt.pn * g.a_pn_off * 2 : cA; const char* nB = has_next ? (const char*)g.Bt + (size_t)nxt.pn * tB : cB;
        for (int t = 0; t < nt; t += 2) {
            const bool last = (t == nt - 2);
            const char* a1 = cA + (size_t)(t + 1) * kstep;
            const char* a2 = last ? nA : cA + (size_t)(t + 2) * kstep; const char* b2 = last ? nB : cB + (size_t)(t + 2) * kstep;
            const char* a3 = a2 + kstep; const char* b3 = b2 + kstep;
            PG8_LDB(B0, 0, 0); PG8_LDB(B1, 0, 1); PG8_SCHED; PG8_LDA(At, 0, 0); PG8_STAGE(PG8_SA(1, 1), a1 + hA, voffA);
            PG8_WAIT_V(8); PG8_WAIT_L(0); PG8_BAR; PG8_MMA(0, 0, At, B0); PG8_MMA(0, 1, At, B1); PG8_BAR; PG8_SCHED;
            PG8_LDA(At, 0, 1); PG8_STAGE(PG8_SB(0, 0), b2, voffB); PG8_STAGE(PG8_SB(0, 1), b2 + hB, voffB); PG8_STAGE(PG8_SA(0, 0), a2, voffA);
            PG8_WAIT_V(8); PG8_WAIT_L(0); PG8_BAR; PG8_MMA(1, 0, At, B0); PG8_MMA(1, 1, At, B1); PG8_BAR; PG8_SCHED;
            PG8_LDB(B0, 1, 0); PG8_LDB(B1, 1, 1); PG8_SCHED; PG8_LDA(At, 1, 0); PG8_STAGE(PG8_SA(0, 1), a2 + hA, voffA);
            PG8_WAIT_V(8); PG8_WAIT_L(0); PG8_BAR; PG8_MMA(0, 0, At, B0); PG8_MMA(0, 1, At, B1); PG8_BAR; PG8_SCHED;
            PG8_LDA(At, 1, 1); PG8_STAGE(PG8_SB(1, 0), b3, voffB); PG8_STAGE(PG8_SB(1, 1), b3 + hB, voffB); PG8_STAGE(PG8_SA(1, 0), a3, voffA);
            PG8_WAIT_V(8); PG8_WAIT_L(0); PG8_BAR; PG8_MMA(1, 0, At, B0); PG8_MMA(1, 1, At, B1); PG8_BAR; PG8_SCHED;
        }
        if constexpr (ALIGN_EPI) { if (wr == 0) PG8_BAR; }
        if constexpr (!Epi::AFTER_DRAIN) { E(acc, cur, wr, wc, fr, fq); }
        if (!has_next) break;
#pragma unroll
        for (int a = 0; a < 2; ++a)
#pragma unroll
            for (int b = 0; b < 2; ++b)
#pragma unroll
                for (int m = 0; m < 4; ++m)
#pragma unroll
                    for (int n = 0; n < 2; ++n) acc[a][b][m][n] = (f32x4){0.f, 0.f, 0.f, 0.f};
        cur = nxt; cA = nA; cB = nB; ++ui;
        if constexpr (ALIGN_EPI) { if (wr == 1) PG8_BAR; }
    }
    PG8_WAIT_V(0);
    if constexpr (!ALIGN_EPI) { if (wr == 0) PG8_BAR; }
    PG8_BAR;
    if constexpr (Epi::AFTER_DRAIN) { E.fused(acc, cur, wr, wc, fr, fq, lds, wid, lane); }
#undef PG8_SA
#undef PG8_SB
#undef PG8_STAGE
#undef PG8_LDA
#undef PG8_LDB
#undef PG8_MMA
#undef PG8_WAIT_V
#undef PG8_WAIT_L
#undef PG8_BAR
#undef PG8_SCHED
}
}

__device__ __forceinline__ float fast_sigmoid(float v) { return __builtin_amdgcn_rcpf(1.f + __builtin_amdgcn_exp2f(-1.4426950408889634f * v)); }
struct EpiInProj {
    static constexpr bool PERM = true, AFTER_DRAIN = false;
    bf16 *UP, *Q, *Kb, *V, *G; const float* rope; float* ksum;
    __device__ __forceinline__ void operator()(const f32x4 (&acc)[2][2][4][2], const pg8::Unit& u, int wr, int wc, int fr, int fq) const {
        const int pn = u.pn, row0 = u.pm * 256 + wr * 64 + fr, lane = fq * 16 + fr;
        if (pn < 2 || (pn >= 6 && pn < 8)) {
            bf16* O = pn < 2 ? UP : V; const int c0 = (pn & 1) * 256 + wc * 32 + 8 * fq;
#pragma unroll
            for (int ai = 0; ai < 2; ++ai)
#pragma unroll
                for (int m = 0; m < 4; ++m)
#pragma unroll
                    for (int bj = 0; bj < 2; ++bj) { const f32x4 v0 = acc[ai][bj][m][0], v1 = acc[ai][bj][m][1]; u32x4 w;
                        w.x = cvt_pk_bf16(v0[0], v0[1]); w.y = cvt_pk_bf16(v0[2], v0[3]); w.z = cvt_pk_bf16(v1[0], v1[1]); w.w = cvt_pk_bf16(v1[2], v1[3]);
                        *(u32x4*)(O + (size_t)(row0 + ai * 128 + m * 16) * 512 + c0 + bj * 128) = w; }
        } else if (pn < 6) {
            const bool isq = pn < 4; bf16* O = isq ? Q : Kb; const int c0 = (pn & 1) * 256 + wc * 32 + 8 * fq; const bool rot = (wc & 1) == 0;
            float cs[2][8];
#pragma unroll
            for (int bj = 0; bj < 2; ++bj)
#pragma unroll
                for (int i = 0; i < 8; ++i) cs[bj][i] = 0.f;
#pragma unroll
            for (int ai = 0; ai < 2; ++ai)
#pragma unroll
                for (int m = 0; m < 4; ++m) {
                    const int row = row0 + ai * 128 + m * 16, pos = row % SEQ;
                    f32x4 c0v = {1.f, 1.f, 1.f, 1.f}, c1v = c0v, s0v = {0.f, 0.f, 0.f, 0.f}, s1v = s0v;
                    if (rot) { const f32x4* rp = (const f32x4*)(rope + pos * 16); c0v = rp[0]; c1v = rp[1]; s0v = rp[2]; s1v = rp[3]; }
#pragma unroll
                    for (int bj = 0; bj < 2; ++bj) { f32x4 v0 = acc[ai][bj][m][0], v1 = acc[ai][bj][m][1];
                        if (rot) { f32x4 p0, p1;
#pragma unroll
                            for (int i = 0; i < 4; ++i) { p0[i] = SHX(v0[i], 16); p1[i] = SHX(v1[i], 16); }
                            if (fq == 0) { v0 = v0 * c0v - p0 * s0v; v1 = v1 * c1v - p1 * s1v; } else if (fq == 1) { v0 = p0 * s0v + v0 * c0v; v1 = p1 * s1v + v1 * c1v; } }
                        if (isq) { v0 = v0 * C2; v1 = v1 * C2; } else {
#pragma unroll
                            for (int i = 0; i < 4; ++i) { cs[bj][i] += v0[i]; cs[bj][4 + i] += v1[i]; } }
                        u32x4 w; w.x = cvt_pk_bf16(v0[0], v0[1]); w.y = cvt_pk_bf16(v0[2], v0[3]); w.z = cvt_pk_bf16(v1[0], v1[1]); w.w = cvt_pk_bf16(v1[2], v1[3]);
                        *(u32x4*)(O + (size_t)row * 512 + c0 + bj * 128) = w; }
                }
            if (!isq) {
                const int b = u.pm / NBLK, blk = u.pm % NBLK;
#pragma unroll
                for (int bj = 0; bj < 2; ++bj)
#pragma unroll
                    for (int i = 0; i < 8; ++i) { float s = cs[bj][i]; s += SHX(s, 1); s += SHX(s, 2); s += SHX(s, 4); s += SHX(s, 8);
                        if (fr == 0) { const int head = (pn & 1) * 4 + bj * 2 + (wc >> 1), d = (wc & 1) * 32 + 8 * fq + i; atomicAdd(ksum + ((size_t)(b * NH + head) * NBLK + blk) * HD + d, s); } }
            }
        } else {
            const int c0 = (pn - 8) * 256 + wc * 32 + 8 * fq;
#pragma unroll
            for (int ai = 0; ai < 2; ++ai)
#pragma unroll
                for (int m = 0; m < 4; ++m)
#pragma unroll
                    for (int bj = 0; bj < 2; ++bj) { const f32x4 v0 = acc[ai][bj][m][0], v1 = acc[ai][bj][m][1]; u32x4 w;
                        w.x = cvt_pk_bf16(fast_sigmoid(v0[0]), fast_sigmoid(v0[1])); w.y = cvt_pk_bf16(fast_sigmoid(v0[2]), fast_sigmoid(v0[3]));
                        w.z = cvt_pk_bf16(fast_sigmoid(v1[0]), fast_sigmoid(v1[1])); w.w = cvt_pk_bf16(fast_sigmoid(v1[2]), fast_sigmoid(v1[3]));
                        *(u32x4*)(G + (size_t)(row0 + ai * 128 + m * 16) * 2048 + c0 + bj * 128) = w; }
        }
    }
};
template <int PASS> struct EpiMerge {
    static constexpr bool PERM = true, AFTER_DRAIN = false;
    bf16* Mg; const bf16* G;
    __device__ __forceinline__ void operator()(const f32x4 (&acc)[2][2][4][2], const pg8::Unit& u, int wr, int wc, int fr, int fq) const {
        const int row0 = u.pm * 256 + wr * 64 + fr, c0 = u.pn * 256 + wc * 32 + 8 * fq;
#pragma unroll
        for (int ai = 0; ai < 2; ++ai)
#pragma unroll
            for (int m = 0; m < 4; ++m)
#pragma unroll
                for (int bj = 0; bj < 2; ++bj) { const size_t row = (size_t)(row0 + ai * 128 + m * 16); const int col = c0 + bj * 128;
                    const u32x4 gw = *(const u32x4*)(G + row * 2048 + PASS * 1024 + col); const f32x4 v0 = acc[ai][bj][m][0], v1 = acc[ai][bj][m][1];
                    float o[8] = {bflo(gw.x) * v0[0], bfhi(gw.x) * v0[1], bflo(gw.y) * v0[2], bfhi(gw.y) * v0[3], bflo(gw.z) * v1[0], bfhi(gw.z) * v1[1], bflo(gw.w) * v1[2], bfhi(gw.w) * v1[3]};
                    if (PASS == 1) { const u32x4 pw = *(const u32x4*)(Mg + row * 1024 + col);
                        o[0] += bflo(pw.x); o[1] += bfhi(pw.x); o[2] += bflo(pw.y); o[3] += bfhi(pw.y); o[4] += bflo(pw.z); o[5] += bfhi(pw.z); o[6] += bflo(pw.w); o[7] += bfhi(pw.w); }
                    u32x4 w; w.x = cvt_pk_bf16(o[0], o[1]); w.y = cvt_pk_bf16(o[2], o[3]); w.z = cvt_pk_bf16(o[4], o[5]); w.w = cvt_pk_bf16(o[6], o[7]);
                    *(u32x4*)(Mg + row * 1024 + col) = w; }
    }
};
struct EpiRes1 {
    static constexpr bool PERM = false, AFTER_DRAIN = false;
    const float* x; const float* mod; float* x1;
    __device__ __forceinline__ void operator()(const f32x4 (&acc)[2][2][4][2], const pg8::Unit& u, int wr, int wc, int fr, int fq) const {
        const int row0 = u.pm * 256 + wr * 64 + fr, c0 = u.pn * 256 + wc * 32 + 4 * fq, b = u.pm / NBLK;
#pragma unroll
        for (int bj = 0; bj < 2; ++bj)
#pragma unroll
            for (int n = 0; n < 2; ++n) { const int col = c0 + bj * 128 + n * 16; const f32x4 gv = *(const f32x4*)(mod + b * 6144 + 2 * D + col);
#pragma unroll
                for (int ai = 0; ai < 2; ++ai)
#pragma unroll
                    for (int m = 0; m < 4; ++m) { const size_t off = (size_t)(row0 + ai * 128 + m * 16) * D + col; *(f32x4*)(x1 + off) = *(const f32x4*)(x + off) + gv * acc[ai][bj][m][n]; } }
    }
};
struct EpiBf16 {
    static constexpr bool PERM = true, AFTER_DRAIN = false;
    bf16* O; int ldo;
    __device__ __forceinline__ void operator()(const f32x4 (&acc)[2][2][4][2], const pg8::Unit& u, int wr, int wc, int fr, int fq) const {
        const int row0 = u.pm * 256 + wr * 64 + fr, c0 = u.pn * 256 + wc * 32 + 8 * fq;
#pragma unroll
        for (int ai = 0; ai < 2; ++ai)
#pragma unroll
            for (int m = 0; m < 4; ++m)
#pragma unroll
                for (int bj = 0; bj < 2; ++bj) { const f32x4 v0 = acc[ai][bj][m][0], v1 = acc[ai][bj][m][1]; u32x4 w;
                    w.x = cvt_pk_bf16(v0[0], v0[1]); w.y = cvt_pk_bf16(v0[2], v0[3]); w.z = cvt_pk_bf16(v1[0], v1[1]); w.w = cvt_pk_bf16(v1[2], v1[3]);
                    *(u32x4*)(O + (size_t)(row0 + ai * 128 + m * 16) * ldo + c0 + bj * 128) = w; }
    }
};

namespace att {
typedef short v4i16_t __attribute__((ext_vector_type(4)));
typedef float f32x16 __attribute__((ext_vector_type(16)));
constexpr int KB_BYTES = 8192, VROW = 192, VB_BYTES = 64 * VROW, OFF_V = 2 * KB_BYTES, OFF_MISC = OFF_V + 2 * VB_BYTES;
__device__ __forceinline__ int crow(int r, int hi) { return (r & 3) + 8 * (r >> 2) + 4 * hi; }
__device__ __forceinline__ float bfe(bf16x8 v, int j) { return __uint_as_float(((unsigned)(unsigned short)v[j]) << 16); }
__device__ __forceinline__ void attn_phase(LAS unsigned char* lds, const bf16* Q, const bf16* Kb, const bf16* V, const float* ksum, bf16* ATT, int G, int bid) {
    int tid_ = threadIdx.x; asm volatile("" : "+v"(tid_));
    const int tid = tid_, lane = tid & 63, wid = __builtin_amdgcn_readfirstlane(tid >> 6), r32 = lane & 31, hi = lane >> 5;
    const int vcu = (G % 8 == 0) ? (bid % 8) * (G / 8) + bid / 8 : bid;
    LAS unsigned char* Kbuf = lds; LAS unsigned char* Vbuf = lds + OFF_V; LAS int* misc = (LAS int*)(lds + OFF_MISC);
    const int ld_row = tid >> 3, ld_ch = tid & 7;
    const int kst = ld_row * 128 + ((ld_ch ^ ((ld_row >> 1) & 7)) << 4), vst = ld_row * VROW + ld_ch * 16;
    for (int uidx = vcu; uidx < 512; uidx += G) {
        const int bh = (uidx & 255) >> 4, s_ = uidx & 15, qb = uidx < 256 ? s_ : 31 - s_, b = bh >> 3, h = bh & 7;
        const int q_off = wid * 32 + r32; const size_t qrow = (size_t)b * SEQ + qb * 256 + q_off;
        bf16x8 qr[4];
#pragma unroll
        for (int s = 0; s < 4; ++s) qr[s] = *(const bf16x8*)(Q + qrow * 512 + h * 64 + 16 * s + 8 * hi);
        unsigned selmask = 0u;
        { int s0 = -1, s1 = -1, s2 = -1; float g0 = -INFINITY, g1 = -INFINITY, g2 = -INFINITY;
          const float* ksb = ksum + (size_t)(b * NH + h) * NBLK * HD + 8 * hi;
          for (int j = 0; j < qb; ++j) { float part = 0.f;
#pragma unroll
              for (int s = 0; s < 4; ++s) { const f32x4 k0 = *(const f32x4*)(ksb + j * HD + 16 * s), k1 = *(const f32x4*)(ksb + j * HD + 16 * s + 4);
                  part += bfe(qr[s], 0) * k0[0] + bfe(qr[s], 1) * k0[1] + bfe(qr[s], 2) * k0[2] + bfe(qr[s], 3) * k0[3] + bfe(qr[s], 4) * k1[0] + bfe(qr[s], 5) * k1[1] + bfe(qr[s], 6) * k1[2] + bfe(qr[s], 7) * k1[3]; }
              const float g = part + SHX(part, 32);
              if (g > g0) { g2 = g1; s2 = s1; g1 = g0; s1 = s0; g0 = g; s0 = j; } else if (g > g1) { g2 = g1; s2 = s1; g1 = g; s1 = j; } else if (g > g2) { g2 = g; s2 = j; } }
          if (s0 >= 0) selmask |= 1u << s0; if (s1 >= 0) selmask |= 1u << s1; if (s2 >= 0) selmask |= 1u << s2; }
        { unsigned um = selmask;
#pragma unroll
          for (int o = 1; o < 64; o <<= 1) um |= (unsigned)SHX((int)um, o);
          if (lane == 0) misc[wid] = (int)um; }
        __syncthreads();
        if (tid == 0) { unsigned uni = 0u; for (int w = 0; w < 8; ++w) uni |= (unsigned)misc[w]; int nb = 1; misc[16] = qb; while (uni) { misc[16 + nb] = __builtin_ctz(uni); uni &= uni - 1u; ++nb; } misc[8] = nb; }
        __syncthreads();
        const int ntiles = misc[8] * 4;
        const bf16* Kg = Kb + ((size_t)b * SEQ) * 512 + h * 64 + ld_ch * 8; const bf16* Vg = V + ((size_t)b * SEQ) * 512 + h * 64 + ld_ch * 8;
        u32x4 kreg, vreg;
        { const int jb0 = misc[16]; const size_t ro = (size_t)(jb0 * 256 + ld_row) * 512; kreg = *(const u32x4*)(Kg + ro); vreg = *(const u32x4*)(Vg + ro); }
        *(LAS u32x4*)(Kbuf + kst) = kreg; *(LAS u32x4*)(Vbuf + vst) = vreg;
        __syncthreads();
        float mrun = -INFINITY, lsum = 0.f; f32x16 o0 = {}, o1 = {};
        for (int n = 0; n < ntiles; ++n) {
            const int jb = misc[16 + (n >> 2)], tt = n & 3; const bool own = n < 4;
            if (n + 1 < ntiles) { const int jn = misc[16 + ((n + 1) >> 2)]; const size_t ro = (size_t)(jn * 256 + ((n + 1) & 3) * 64 + ld_row) * 512; kreg = *(const u32x4*)(Kg + ro); vreg = *(const u32x4*)(Vg + ro); }
            const bool lane_valid = own || ((selmask >> jb) & 1u);
            const bool need = own ? (64 * tt <= 32 * wid + 31) : (__any(lane_valid ? 1 : 0) != 0);
            if (need) {
                const LAS unsigned char* kb_ = Kbuf + (n & 1) * KB_BYTES; const LAS unsigned char* vb_ = Vbuf + (n & 1) * VB_BYTES;
                f32x16 p0 = {}, p1 = {};
#pragma unroll
                for (int s = 0; s < 4; ++s) { const int c = 2 * s + hi; const int sw = ((c ^ ((r32 >> 1) & 7)) << 4);
                    const bf16x8 a0 = *(const LAS bf16x8*)(kb_ + r32 * 128 + sw), a1 = *(const LAS bf16x8*)(kb_ + (32 + r32) * 128 + sw);
                    p0 = __builtin_amdgcn_mfma_f32_32x32x16_bf16(a0, qr[s], p0, 0, 0, 0); p1 = __builtin_amdgcn_mfma_f32_32x32x16_bf16(a1, qr[s], p1, 0, 0, 0); }
                if (own) {
#pragma unroll
                    for (int r = 0; r < 16; ++r) { const int ko = tt * 64 + crow(r, hi); if (ko > q_off) p0[r] = -INFINITY; if (ko + 32 > q_off) p1[r] = -INFINITY; }
                } else if (!lane_valid) {
#pragma unroll
                    for (int r = 0; r < 16; ++r) { p0[r] = -INFINITY; p1[r] = -INFINITY; }
                }
                float mt = fmaxf(p0[0], p1[0]);
#pragma unroll
                for (int r = 1; r < 16; ++r) mt = fmaxf(mt, fmaxf(p0[r], p1[r]));
                mt = fmaxf(mt, SHX(mt, 32));
                const float mnew = fmaxf(mrun, mt), alpha = __builtin_amdgcn_exp2f(mrun - mnew); mrun = mnew;
                float ps = 0.f;
#pragma unroll
                for (int r = 0; r < 16; ++r) { p0[r] = __builtin_amdgcn_exp2f(p0[r] - mnew); p1[r] = __builtin_amdgcn_exp2f(p1[r] - mnew); ps += p0[r] + p1[r]; }
                lsum = lsum * alpha + ps;
                if (!__all(alpha == 1.f ? 1 : 0)) {
#pragma unroll
                    for (int r = 0; r < 16; ++r) { o0[r] *= alpha; o1[r] *= alpha; } }
                bf16x8 pb[2][2];
#pragma unroll
                for (int s2 = 0; s2 < 2; ++s2) { u32x4 w0, w1;
                    w0.x = cvt_pk_bf16(p0[8 * s2], p0[8 * s2 + 1]); w0.y = cvt_pk_bf16(p0[8 * s2 + 2], p0[8 * s2 + 3]); w0.z = cvt_pk_bf16(p0[8 * s2 + 4], p0[8 * s2 + 5]); w0.w = cvt_pk_bf16(p0[8 * s2 + 6], p0[8 * s2 + 7]);
                    w1.x = cvt_pk_bf16(p1[8 * s2], p1[8 * s2 + 1]); w1.y = cvt_pk_bf16(p1[8 * s2 + 2], p1[8 * s2 + 3]); w1.z = cvt_pk_bf16(p1[8 * s2 + 4], p1[8 * s2 + 5]); w1.w = cvt_pk_bf16(p1[8 * s2 + 6], p1[8 * s2 + 7]);
                    pb[0][s2] = __builtin_bit_cast(bf16x8, w0); pb[1][s2] = __builtin_bit_cast(bf16x8, w1); }
                const LAS unsigned char* vl = vb_ + (4 * hi + ((lane & 15) >> 2)) * VROW + (16 * ((lane >> 4) & 1) + 4 * (lane & 3)) * 2;
#pragma unroll
                for (int dt = 0; dt < 2; ++dt)
#pragma unroll
                    for (int u = 0; u < 2; ++u)
#pragma unroll
                        for (int s2 = 0; s2 < 2; ++s2) { const LAS unsigned char* va = vl + (32 * u + 16 * s2) * VROW + dt * 64;
                            const v4i16_t lo = __builtin_amdgcn_ds_read_tr16_b64_v4i16((LAS v4i16_t*)va), hh = __builtin_amdgcn_ds_read_tr16_b64_v4i16((LAS v4i16_t*)(va + 8 * VROW));
                            const bf16x8 vf = {lo[0], lo[1], lo[2], lo[3], hh[0], hh[1], hh[2], hh[3]};
                            if (dt == 0) o0 = __builtin_amdgcn_mfma_f32_32x32x16_bf16(vf, pb[u][s2], o0, 0, 0, 0); else o1 = __builtin_amdgcn_mfma_f32_32x32x16_bf16(vf, pb[u][s2], o1, 0, 0, 0); }
            }
            if (n + 1 < ntiles) { *(LAS u32x4*)(Kbuf + ((n + 1) & 1) * KB_BYTES + kst) = kreg; *(LAS u32x4*)(Vbuf + ((n + 1) & 1) * VB_BYTES + vst) = vreg; }
            __syncthreads();
        }
        const float inv = 1.f / (lsum + SHX(lsum, 32));
        bf16* orow = ATT + qrow * 512 + h * 64 + 4 * hi;
#pragma unroll
        for (int g4 = 0; g4 < 4; ++g4) { u32x2 w;
            w.x = cvt_pk_bf16(o0[4 * g4] * inv, o0[4 * g4 + 1] * inv); w.y = cvt_pk_bf16(o0[4 * g4 + 2] * inv, o0[4 * g4 + 3] * inv); *(u32x2*)(orow + 8 * g4) = w;
            w.x = cvt_pk_bf16(o1[4 * g4] * inv, o1[4 * g4 + 1] * inv); w.y = cvt_pk_bf16(o1[4 * g4 + 2] * inv, o1[4 * g4 + 3] * inv); *(u32x2*)(orow + 32 + 8 * g4) = w; }
    }
}
}

__device__ __forceinline__ float dot2bf(unsigned a, unsigned b, float acc) { return __builtin_amdgcn_fdot2_f32_bf16(__builtin_bit_cast(bf16x2_t, a), __builtin_bit_cast(bf16x2_t, b), acc, false); }
__device__ __forceinline__ void d_tab_bf16(const float* T, bf16* O) {
    GSTRIDE(i, (size_t)NEXP * D / 8) { const f32x4 a = ((const f32x4*)T)[2 * i], b = ((const f32x4*)T)[2 * i + 1]; u32x4 w;
        w.x = cvt_pk_bf16(a[0], a[1]); w.y = cvt_pk_bf16(a[2], a[3]); w.z = cvt_pk_bf16(b[0], b[1]); w.w = cvt_pk_bf16(b[2], b[3]); ((u32x4*)O)[i] = w; }
}
__device__ __forceinline__ void peer_phase(const bf16* H2, const int* EID, const float* EG, const bf16* UT, const bf16* VT, const float* mod, const float* gfin, const float* x1, float* outp) {
    int tid_ = threadIdx.x; asm volatile("" : "+v"(tid_));
    const int lane = tid_ & 63, wv = tid_ >> 6;
    for (int t = blockIdx.x * (NT / 64) + wv; t < M; t += gridDim.x * (NT / 64)) {
        const int b = t / SEQ;
        const u32x4 h0 = *(const u32x4*)(H2 + (size_t)t * D + 8 * lane), h1 = *(const u32x4*)(H2 + (size_t)t * D + 512 + 8 * lane);
        const int e0 = EID[(size_t)t * NSEL + lane], e1 = EID[(size_t)t * NSEL + 64 + lane]; const float gg0 = EG[(size_t)t * NSEL + lane], gg1 = EG[(size_t)t * NSEL + 64 + lane];
        float acc[16];
#pragma unroll
        for (int i = 0; i < 16; ++i) acc[i] = 0.f;
#pragma unroll 1
        for (int kb = 0; kb < NSEL; kb += 8) {
            u32x4 ua[8], ub[8], va[8], vb[8];
#pragma unroll
            for (int j = 0; j < 8; ++j) { const int k = kb + j; const int eid = __builtin_amdgcn_readlane(k < 64 ? e0 : e1, k & 63);
                const bf16* ur = UT + (size_t)eid * D + 8 * lane; const bf16* vr = VT + (size_t)eid * D + 8 * lane;
                ua[j] = *(const u32x4*)ur; ub[j] = *(const u32x4*)(ur + 512); va[j] = *(const u32x4*)vr; vb[j] = *(const u32x4*)(vr + 512); }
            float d[8];
#pragma unroll
            for (int j = 0; j < 8; ++j) { float a = 0.f; a = dot2bf(ua[j].x, h0.x, a); a = dot2bf(ua[j].y, h0.y, a); a = dot2bf(ua[j].z, h0.z, a); a = dot2bf(ua[j].w, h0.w, a);
                a = dot2bf(ub[j].x, h1.x, a); a = dot2bf(ub[j].y, h1.y, a); a = dot2bf(ub[j].z, h1.z, a); a = dot2bf(ub[j].w, h1.w, a); d[j] = a; }
            float r4[4], r2[2], r1;
            { const bool up = (lane & 32) != 0;
#pragma unroll
              for (int j = 0; j < 4; ++j) { const float snd = up ? d[j] : d[j + 4], kp = up ? d[j + 4] : d[j]; r4[j] = kp + SHX(snd, 32); } }
            { const bool up = (lane & 16) != 0;
#pragma unroll
              for (int j = 0; j < 2; ++j) { const float snd = up ? r4[j] : r4[j + 2], kp = up ? r4[j + 2] : r4[j]; r2[j] = kp + SHX(snd, 16); } }
            { const bool up = (lane & 8) != 0; const float snd = up ? r2[0] : r2[1], kp = up ? r2[1] : r2[0]; r1 = kp + SHX(snd, 8); }
            r1 += SHX(r1, 4); r1 += SHX(r1, 2); r1 += SHX(r1, 1);
            const float ge = 0.5f * r1 * (1.f + erff(r1 * 0.70710678118654752f));
#pragma unroll
            for (int j = 0; j < 8; ++j) { const int k = kb + j; const float gk = __uint_as_float(__builtin_amdgcn_readlane(__float_as_uint(k < 64 ? gg0 : gg1), k & 63));
                const float w = gk * __uint_as_float(__builtin_amdgcn_readlane(__float_as_uint(ge), ((j & 4) ? 32 : 0) + ((j & 2) ? 16 : 0) + ((j & 1) ? 8 : 0)));
                acc[0] += w * bflo(va[j].x); acc[1] += w * bfhi(va[j].x); acc[2] += w * bflo(va[j].y); acc[3] += w * bfhi(va[j].y); acc[4] += w * bflo(va[j].z); acc[5] += w * bfhi(va[j].z); acc[6] += w * bflo(va[j].w); acc[7] += w * bfhi(va[j].w);
                acc[8] += w * bflo(vb[j].x); acc[9] += w * bfhi(vb[j].x); acc[10] += w * bflo(vb[j].y); acc[11] += w * bfhi(vb[j].y); acc[12] += w * bflo(vb[j].z); acc[13] += w * bfhi(vb[j].z); acc[14] += w * bflo(vb[j].w); acc[15] += w * bfhi(vb[j].w); }
        }
        float ss = 0.f;
#pragma unroll
        for (int c = 0; c < 2; ++c)
#pragma unroll
            for (int q4 = 0; q4 < 2; ++q4) { const int col = c * 512 + 8 * lane + 4 * q4; const f32x4 xv = *(const f32x4*)(x1 + (size_t)t * D + col), gv = *(const f32x4*)(mod + b * 6144 + 5 * D + col);
#pragma unroll
                for (int e = 0; e < 4; ++e) { const float x2 = xv[e] + gv[e] * acc[c * 8 + q4 * 4 + e]; acc[c * 8 + q4 * 4 + e] = x2; ss += x2 * x2; } }
#pragma unroll
        for (int o = 1; o < 64; o <<= 1) ss += SHX(ss, o);
        const float r = rsqrtf(ss * (1.f / D) + EPS);
#pragma unroll
        for (int c = 0; c < 2; ++c)
#pragma unroll
            for (int q4 = 0; q4 < 2; ++q4) { const int col = c * 512 + 8 * lane + 4 * q4; const f32x4 gf = *(const f32x4*)(gfin + col); f32x4 o;
#pragma unroll
                for (int e = 0; e < 4; ++e) o[e] = acc[c * 8 + q4 * 4 + e] * r * gf[e];
                *(f32x4*)(outp + (size_t)t * D + col) = o; }
    }
}

__device__ __forceinline__ void d_skbd(const float* sk, bf16* SKBD) {
    GSTRIDE(idx, 2048 * 256) { const int n = (int)idx >> 8, kk = (int)idx & 255, p = (n >> 7) & 1; SKBD[idx] = ((kk >> 7) == p) ? f2bf(sk[(size_t)n * 128 + (kk & 127)]) : (bf16)0; }
}
__device__ __forceinline__ unsigned f2sort(float f) { const unsigned b = __float_as_uint(f); return b ^ ((unsigned)((int)b >> 31) | 0x80000000u); }
__device__ __forceinline__ float sort2f(unsigned k) { return __uint_as_float(k ^ (((k >> 31) - 1u) | 0x80000000u)); }
__device__ __forceinline__ void ce_desc(unsigned& a, unsigned& b) { const unsigned hi_ = max(a, b), lo_ = min(a, b); a = hi_; b = lo_; }
__device__ __forceinline__ void sort16_desc(unsigned (&v)[16]) {
#pragma unroll
    for (int k = 2; k <= 16; k <<= 1)
#pragma unroll
        for (int j = k >> 1; j > 0; j >>= 1)
#pragma unroll
            for (int i = 0; i < 16; ++i) { const int l = i ^ j; if (l > i) { if ((i & k) == 0) ce_desc(v[i], v[l]); else ce_desc(v[l], v[i]); } }
}
__device__ __forceinline__ void merge16_desc(unsigned (&v)[16]) {
#pragma unroll
    for (int j = 8; j > 0; j >>= 1)
#pragma unroll
        for (int i = 0; i < 16; ++i) { const int l = i ^ j; if (l > i) ce_desc(v[i], v[l]); }
}
struct EpiRoute {
    static constexpr bool PERM = false, AFTER_DRAIN = true;
    int* EID; float* EG;
    __device__ __forceinline__ void fused(f32x4 (&acc)[2][2][4][2], const pg8::Unit& u, int wr, int wc, int fr_, int fq_, LAS unsigned char* lds, int wid, int lane_) const {
        int lane = lane_; asm volatile("" : "+v"(lane));
        const int fr = lane & 15, fq = lane >> 4;
        constexpr int RS = 257; LAS float* S = (LAS float*)lds; LAS unsigned char* tab = lds + 128 * RS * 4 + ((wid & 3) * 64 + lane) * 32;
#pragma unroll
        for (int ai = 0; ai < 2; ++ai) {
#pragma unroll
            for (int bj = 0; bj < 2; ++bj)
#pragma unroll
                for (int m = 0; m < 4; ++m)
#pragma unroll
                    for (int n = 0; n < 2; ++n) { LAS float* sp = S + (64 * wr + 16 * m + fr) * RS + 128 * bj + 32 * wc + 16 * n + 4 * fq; const f32x4 v = acc[ai][bj][m][n]; sp[0] = v[0]; sp[1] = v[1]; sp[2] = v[2]; sp[3] = v[3]; }
            __syncthreads();
            if (wid < 4) {
                const int rl = 32 * wid + (lane & 31), p = lane >> 5; const LAS float* sp = S + rl * RS + 128 * p;
                unsigned top[16];
#pragma unroll
                for (int i = 0; i < 16; ++i) top[i] = (f2sort(sp[i]) & ~0x7Fu) | (unsigned)i;
                sort16_desc(top);
#pragma unroll 1
                for (int c = 1; c < 8; ++c) { unsigned chv[16];
#pragma unroll
                    for (int i = 0; i < 16; ++i) chv[i] = (f2sort(sp[16 * c + i]) & ~0x7Fu) | (unsigned)(16 * c + i);
                    sort16_desc(chv);
#pragma unroll
                    for (int i = 0; i < 16; ++i) top[i] = max(top[i], chv[15 - i]);
                    merge16_desc(top); }
                float af[16], bf_[16]; unsigned ia[4] = {0u, 0u, 0u, 0u}, ib[4] = {0u, 0u, 0u, 0u};
#pragma unroll
                for (int j = 0; j < 16; ++j) { const unsigned oth = (unsigned)SHX((int)top[j], 32); const unsigned ka = p ? oth : top[j], kb = p ? top[j] : oth;
                    af[j] = sort2f(ka & ~0x7Fu); bf_[j] = sort2f(kb & ~0x7Fu); ia[j >> 2] |= (ka & 0x7Fu) << (8 * (j & 3)); ib[j >> 2] |= (kb & 0x7Fu) << (8 * (j & 3)); }
                *(LAS u32x4*)tab = (u32x4){ia[0], ia[1], ia[2], ia[3]}; *(LAS u32x4*)(tab + 16) = (u32x4){ib[0], ib[1], ib[2], ib[3]};
                unsigned ct[16];
#pragma unroll
                for (int j = 0; j < 16; ++j) ct[j] = (f2sort(af[0] + bf_[j]) & ~0xFFu) | (unsigned)(255 - j);
#pragma unroll
                for (int i = 1; i < 16; ++i)
#pragma unroll
                    for (int j2 = 0; j2 < 16; ++j2) if ((i + 1) * (j2 + 1) <= 16) { unsigned key = (f2sort(af[i] + bf_[j2]) & ~0xFFu) | (unsigned)(255 - (i * 16 + j2));
#pragma unroll
                        for (int j = 0; j < 16; ++j) { const unsigned hi_ = max(ct[j], key); key = min(ct[j], key); ct[j] = hi_; } }
                asm volatile("s_waitcnt lgkmcnt(0)" ::: "memory");
                int eid[16]; float ev[16]; float sum = 0.f; const float v0 = sort2f(ct[0] & ~0xFFu);
#pragma unroll
                for (int k = 0; k < 16; ++k) { const unsigned code = 255u - (ct[k] & 0xFFu); const int i_a = tab[code >> 4], i_b = tab[16 + (code & 15u)]; eid[k] = i_a * NKEYS + i_b;
                    ev[k] = __builtin_amdgcn_exp2f((sort2f(ct[k] & ~0xFFu) - v0) * 1.4426950408889634f); sum += ev[k]; }
                const float is = 1.f / sum; const size_t ob = (size_t)(u.pm * 256 + 128 * ai + rl) * NSEL + u.pn * 16 + 8 * p;
                u32x4 e0, e1; f32x4 g0, g1;
                e0.x = p ? eid[8] : eid[0]; e0.y = p ? eid[9] : eid[1]; e0.z = p ? eid[10] : eid[2]; e0.w = p ? eid[11] : eid[3]; e1.x = p ? eid[12] : eid[4]; e1.y = p ? eid[13] : eid[5]; e1.z = p ? eid[14] : eid[6]; e1.w = p ? eid[15] : eid[7];
                g0[0] = (p ? ev[8] : ev[0]) * is; g0[1] = (p ? ev[9] : ev[1]) * is; g0[2] = (p ? ev[10] : ev[2]) * is; g0[3] = (p ? ev[11] : ev[3]) * is; g1[0] = (p ? ev[12] : ev[4]) * is; g1[1] = (p ? ev[13] : ev[5]) * is; g1[2] = (p ? ev[14] : ev[6]) * is; g1[3] = (p ? ev[15] : ev[7]) * is;
                *(u32x4*)(EID + ob) = e0; *(u32x4*)(EID + ob + 4) = e1; *(f32x4*)(EG + ob) = g0; *(f32x4*)(EG + ob + 4) = g1;
            }
            __syncthreads();
        }
    }
};
__device__ __forceinline__ void route_phase(LAS unsigned char* lds, const bf16* QP, const bf16* SKBD, int* EID, float* EG, int G, int bid) {
    pg8::Gemm g{QP, SKBD, M, 2048, 256, 2048, 256}; pg8::StaticOrder S; S.init(M, 2048, G, bid); EpiRoute E{EID, EG}; pg8::OneUnit O;
    for (int i = 0; S.next(i, O.u); ++i) pg8::gemm_phase<EpiRoute, pg8::OneUnit, false>(lds, g, O, E);
}
__device__ __forceinline__ void d_route_summary(const int* EID, const float* EG, float* SUMM) {
    GSTRIDE(idx, M * PHEADS) { float s1 = 0.f, s2 = 0.f; for (int k = 0; k < 16; ++k) { const int e = EID[idx * 16 + k]; const float gk = EG[idx * 16 + k]; s1 += gk * (float)(e % 1021) * (1.f / 1021.f); s2 += gk * (float)e * (1.f / 16384.f); } SUMM[idx * 2] = s1; SUMM[idx * 2 + 1] = s2; }
}

constexpr int MOD_KS = 16;
__device__ __forceinline__ void p0_mod_partials(const float* c, const float* w_ada, float* MODP) {
    const int lane = threadIdx.x & 63, gw = blockIdx.x * (NT / 64) + (threadIdx.x >> 6), ngw = gridDim.x * (NT / 64);
    for (int it = gw; it < 96 * MOD_KS; it += ngw) {
        const int cg_ = it % 96, ks = it / 96, j = cg_ * 64 + lane, k0 = ks * 64;
        const float c0 = c[k0 + lane], c1 = c[D + k0 + lane]; const float a0 = c0 / (1.f + __expf(-c0)), a1 = c1 / (1.f + __expf(-c1));
        float acc0 = 0.f, acc1 = 0.f;
#pragma unroll 16
        for (int k = 0; k < 64; ++k) { const float w = w_ada[(size_t)(k0 + k) * 6144 + j];
            acc0 += __uint_as_float(__builtin_amdgcn_readlane(__float_as_uint(a0), k)) * w; acc1 += __uint_as_float(__builtin_amdgcn_readlane(__float_as_uint(a1), k)) * w; }
        MODP[(size_t)(ks * 2) * 6144 + j] = acc0; MODP[(size_t)(ks * 2 + 1) * 6144 + j] = acc1;
    }
}
__device__ __forceinline__ float mod_reduce(const float* MODP, const float* b_ada, int idx) {
    float s = b_ada[idx % 6144];
#pragma unroll
    for (int ks = 0; ks < MOD_KS; ++ks) s += MODP[(size_t)ks * 2 * 6144 + idx];
    return s;
}
__device__ __forceinline__ void p0_transpose_item(const float* W, int K, int N, bf16* WT, LAS float* scr, int item, int lane) {
    const int nblk = N / 32, kb = item / nblk, nb = item % nblk, k0 = 64 * kb, n0 = 32 * nb;
#pragma unroll 8
    for (int i = 0; i < 32; ++i) { const int kk = 2 * i + (lane >> 5); scr[kk * 33 + (lane & 31)] = W[(size_t)(k0 + kk) * N + n0 + (lane & 31)]; }
    asm volatile("s_waitcnt lgkmcnt(0)" ::: "memory");
    const int cch = lane & 7;
#pragma unroll
    for (int j = 0; j < 4; ++j) { const int n = (lane >> 3) + 8 * j; const LAS float* sp = scr + (8 * cch) * 33 + n;
        u32x4 o; o.x = cvt_pk_bf16(sp[0 * 33], sp[1 * 33]); o.y = cvt_pk_bf16(sp[2 * 33], sp[3 * 33]); o.z = cvt_pk_bf16(sp[4 * 33], sp[5 * 33]); o.w = cvt_pk_bf16(sp[6 * 33], sp[7 * 33]);
        *(u32x4*)(WT + (size_t)(n0 + n) * K + k0 + 8 * cch) = o; }
    asm volatile("s_waitcnt lgkmcnt(0)" ::: "memory");
}
__device__ __forceinline__ void p0_transposes(LAS unsigned char* lds, const float* w_in, const float* w_ba, const float* w_out, const float* wq, bf16* W_IN_T, bf16* WBA_T, bf16* WOUT_T, bf16* WQ_T) {
    const int lane = threadIdx.x & 63, wv = threadIdx.x >> 6, gw = blockIdx.x * (NT / 64) + wv, ngw = gridDim.x * (NT / 64);
    LAS float* scr = (LAS float*)(lds + wv * 16384);
    constexpr int I_IN = (1024 / 64) * (4096 / 32), I_BA = (512 / 64) * (1024 / 32), I_OUT = (1024 / 64) * (1024 / 32), I_Q = (1024 / 64) * (2048 / 32);
    for (int it = gw; it < I_IN + I_BA + I_OUT + I_Q; it += ngw) { int r = it;
        if (r < I_IN) { p0_transpose_item(w_in, 1024, 4096, W_IN_T, scr, r, lane); continue; } r -= I_IN;
        if (r < I_BA) { p0_transpose_item(w_ba, 512, 1024, WBA_T, scr, r, lane); continue; } r -= I_BA;
        if (r < I_OUT) { p0_transpose_item(w_out, 1024, 1024, WOUT_T, scr, r, lane); continue; } r -= I_OUT;
        p0_transpose_item(wq, 1024, 2048, WQ_T, scr, r, lane); }
}
__device__ __forceinline__ void p0_wc(const float* pool_w, const float* pool_scale, const float* w_bp, float* WCF) {
    const int lane = threadIdx.x & 63, gw = blockIdx.x * (NT / 64) + (threadIdx.x >> 6), ngw = gridDim.x * (NT / 64);
    for (int it = gw; it < 512 * 16; it += ngw) { const int k = it >> 4, o = (it & 15) * 64 + lane, g = k >> 7; float acc = 0.f;
        const float pw0 = pool_w[(size_t)k * 128 + lane] * pool_scale[g * 128 + lane], pw1 = pool_w[(size_t)k * 128 + 64 + lane] * pool_scale[g * 128 + 64 + lane];
#pragma unroll 16
        for (int j = 0; j < 64; ++j) acc += __uint_as_float(__builtin_amdgcn_readlane(__float_as_uint(pw0), j)) * w_bp[(size_t)(g * 128 + j) * 1024 + o];
#pragma unroll 16
        for (int j = 0; j < 64; ++j) acc += __uint_as_float(__builtin_amdgcn_readlane(__float_as_uint(pw1), j)) * w_bp[(size_t)(g * 128 + 64 + j) * 1024 + o];
        WCF[(size_t)k * 1024 + o] = acc; }
}
__device__ __forceinline__ void p1_wc_transpose(LAS unsigned char* lds, const float* WCF, bf16* WC_T) {
    const int lane = threadIdx.x & 63, wv = threadIdx.x >> 6, gw = blockIdx.x * (NT / 64) + wv, ngw = gridDim.x * (NT / 64);
    LAS float* scr = (LAS float*)(lds + wv * 16384);
    for (int it = gw; it < (512 / 64) * (1024 / 32); it += ngw) p0_transpose_item(WCF, 512, 1024, WC_T, scr, it, lane);
}
__device__ __forceinline__ void modulate_rows(const float* x, const float* g, const LAS float* mtab, bf16* outp) {
    const int lane = threadIdx.x & 63;
    for (int row = blockIdx.x * (NT / 64) + (threadIdx.x >> 6); row < M; row += gridDim.x * (NT / 64)) {
        const int b = row / SEQ; const f32x4* xr = (const f32x4*)(x + (size_t)row * D); f32x4 v[4]; float ss = 0.f;
#pragma unroll
        for (int j = 0; j < 4; ++j) { v[j] = xr[j * 64 + lane]; ss += v[j][0] * v[j][0] + v[j][1] * v[j][1] + v[j][2] * v[j][2] + v[j][3] * v[j][3]; }
#pragma unroll
        for (int o = 1; o < 64; o <<= 1) ss += SHX(ss, o);
        const float r = rsqrtf(ss * (1.f / D) + EPS);
#pragma unroll
        for (int j = 0; j < 4; ++j) { const int col = j * 256 + lane * 4; const f32x4 gv = *(const f32x4*)(g + col), sc = *(const LAS f32x4*)(mtab + b * 2048 + col), sh = *(const LAS f32x4*)(mtab + b * 2048 + 1024 + col);
            const f32x4 o = v[j] * r * gv * (sc + 1.f) + sh; u32x2 w; w.x = cvt_pk_bf16(o[0], o[1]); w.y = cvt_pk_bf16(o[2], o[3]); *(u32x2*)(outp + (size_t)row * D + col) = w; }
    }
}
__device__ __forceinline__ void fill_mtab_partials(LAS float* mtab, const float* MODP, const float* b_ada, int sh_off, int sc_off) {
    for (int i = threadIdx.x; i < 4096; i += NT) { const int b = i >> 11, which = (i >> 10) & 1, col = i & 1023; mtab[i] = mod_reduce(MODP, b_ada, b * 6144 + (which ? sh_off : sc_off) + col); }
    __syncthreads();
}
__device__ __forceinline__ void fill_mtab(LAS float* mtab, const float* MOD, int sh_off, int sc_off) {
    for (int i = threadIdx.x; i < 4096; i += NT) { const int b = i >> 11, which = (i >> 10) & 1, col = i & 1023; mtab[i] = MOD[b * 6144 + (which ? sh_off : sc_off) + col]; }
    __syncthreads();
}
__device__ __forceinline__ void pooldiff_fast(const bf16* UP, bf16* DIFF) {
    GSTRIDE(idx, (size_t)M * 64) { const int ch = (int)(idx & 63), row = (int)(idx >> 6), pos = row % SEQ, w = 2 << (ch >> 4), cnt = pos + 1 < w ? pos + 1 : w; float sacc[8];
#pragma unroll
        for (int e = 0; e < 8; ++e) sacc[e] = 0.f;
        u32x4 own;
        for (int i = 0; i < cnt; ++i) { const u32x4 v = *(const u32x4*)(UP + (size_t)(row - i) * 512 + ch * 8); if (i == 0) own = v;
            sacc[0] += bflo(v.x); sacc[1] += bfhi(v.x); sacc[2] += bflo(v.y); sacc[3] += bfhi(v.y); sacc[4] += bflo(v.z); sacc[5] += bfhi(v.z); sacc[6] += bflo(v.w); sacc[7] += bfhi(v.w); }
        const float ic = 1.f / (float)cnt; u32x4 o;
        o.x = cvt_pk_bf16(sacc[0] * ic - bflo(own.x), sacc[1] * ic - bfhi(own.x)); o.y = cvt_pk_bf16(sacc[2] * ic - bflo(own.y), sacc[3] * ic - bfhi(own.y));
        o.z = cvt_pk_bf16(sacc[4] * ic - bflo(own.z), sacc[5] * ic - bfhi(own.z)); o.w = cvt_pk_bf16(sacc[6] * ic - bflo(own.w), sacc[7] * ic - bfhi(own.w));
        *(u32x4*)(DIFF + (size_t)row * 512 + ch * 8) = o; }
}

#define XB_TMO      128
#define XB_XCNT(j)  (256  + 64 * (j))
#define XB_XSUB(j)  (1280 + 64 * (j))
#define XB_XGEN(j)  (2304 + 64 * (j))
#define XB_TOP      3328
#define XB_TOPGEN   3392
#define XCD_BAR_WORDS 3456
#define XB_SPIN_CAP (1u << 18)
__device__ __forceinline__ unsigned xb_ld(unsigned* p)              { return __hip_atomic_load(p, __ATOMIC_RELAXED, __HIP_MEMORY_SCOPE_AGENT); }
__device__ __forceinline__ unsigned xb_add(unsigned* p, unsigned v) { return __hip_atomic_fetch_add(p, v, __ATOMIC_RELAXED, __HIP_MEMORY_SCOPE_AGENT); }
__device__ __forceinline__ unsigned xb_xcc_id() { return (unsigned)__builtin_amdgcn_s_getreg((3 << 11) | 20) & 0xFu; }
#define XB_SPIN(cond, bar) do { unsigned _sp = 0; while (cond) { __builtin_amdgcn_s_sleep(1); \
    if ((++_sp & 255u) == 0u) { if (xb_ld(&(bar)[XB_TMO])) break; if (_sp > XB_SPIN_CAP) { atomicAdd(&(bar)[XB_TMO], 1u); break; } } } } while (0)
struct XcdBarrier { unsigned* bar; unsigned x; volatile LAS unsigned* st; };
__device__ __forceinline__ XcdBarrier xcd_barrier_post(unsigned* bar, volatile LAS unsigned* st) {
    XcdBarrier b; b.bar = bar; b.x = xb_xcc_id(); b.st = st;
    if (threadIdx.x == 0) st[2] = xb_add(&bar[XB_XCNT(b.x)], 1u);
    return b;
}
__device__ __forceinline__ void xcd_barrier_complete(unsigned* bar, unsigned x, unsigned& nloc, unsigned& nx) {
    const unsigned G = gridDim.x * gridDim.y * gridDim.z;
    unsigned sum, cnt, mine, sp = 0u;
    for (;;) {
        sum = 0u; cnt = 0u; mine = 0u;
#pragma unroll
        for (unsigned j = 0; j < 16; ++j) { const unsigned c = xb_ld(&bar[XB_XCNT(j)]); sum += c; cnt += (c > 0u) ? 1u : 0u; mine = (j == x) ? c : mine; }
        if (sum == G) break;
        __builtin_amdgcn_s_sleep(1);
        if ((++sp & 255u) == 0u) { if (xb_ld(&bar[XB_TMO])) break; if (sp > XB_SPIN_CAP) { atomicAdd(&bar[XB_TMO], 1u); break; } }
    }
    nloc = mine > 0u ? mine : 1u; nx = cnt > 0u ? cnt : 1u;
}
__device__ __forceinline__ void xcd_barrier(const XcdBarrier& b) {
    asm volatile("s_waitcnt vmcnt(0)" ::: "memory");
    __syncthreads();
    if (threadIdx.x == 0) {
        unsigned* bar = b.bar;
        __builtin_amdgcn_s_waitcnt(0);
        unsigned nloc = b.st[0], nx = b.st[1];
        if (nloc == 0u) { xcd_barrier_complete(bar, b.x, nloc, nx); b.st[0] = nloc; b.st[1] = nx; }
        const unsigned old = xb_add(&bar[XB_XSUB(b.x)], 1u);
        const unsigned gen = old / nloc;
        if (old + 1u == (gen + 1u) * nloc) {
            __builtin_amdgcn_fence(__ATOMIC_RELEASE, "agent");
            asm volatile("s_waitcnt vmcnt(0)" ::: "memory");
            const unsigned og = xb_add(&bar[XB_TOP], 1u);
            const unsigned tg = og / nx;
            if (og + 1u == (tg + 1u) * nx) xb_add(&bar[XB_TOPGEN], 1u);
            else XB_SPIN(xb_ld(&bar[XB_TOPGEN]) == tg, bar);
            __builtin_amdgcn_fence(__ATOMIC_ACQUIRE, "agent");
            xb_add(&bar[XB_XGEN(b.x)], 1u);
            asm volatile("s_waitcnt vmcnt(0)" ::: "memory");
        } else {
            XB_SPIN(xb_ld(&bar[XB_XGEN(b.x)]) == gen, bar);
            __builtin_amdgcn_fence(__ATOMIC_ACQUIRE, "agent");
            asm volatile("s_waitcnt vmcnt(0)" ::: "memory");
        }
    }
    __syncthreads();
}

__device__ __forceinline__ void d_tab_fp8(const float* T, unsigned char* O8, float* SC) {
    const int lane = threadIdx.x & 63, gw = blockIdx.x * (NT / 64) + (threadIdx.x >> 6), ngw = gridDim.x * (NT / 64);
    for (int row = gw; row < NEXP; row += ngw) {
        const f32x4* r = (const f32x4*)(T + (size_t)row * D) + 4 * lane; f32x4 v[4]; float am = 0.f;
#pragma unroll
        for (int j = 0; j < 4; ++j) { v[j] = r[j]; am = fmaxf(am, fmaxf(fmaxf(fabsf(v[j][0]), fabsf(v[j][1])), fmaxf(fabsf(v[j][2]), fabsf(v[j][3])))); }
#pragma unroll
        for (int o = 1; o < 64; o <<= 1) am = fmaxf(am, SHX(am, o));
        int e = 8; if (am > 0.f) (void)frexpf(am, &e);
        const float sc = ldexpf(1.f, 8 - e);
        u32x4 w;
        w.x = (unsigned)__builtin_amdgcn_cvt_pk_fp8_f32(v[0][0] * sc, v[0][1] * sc, 0, false); w.x = (unsigned)__builtin_amdgcn_cvt_pk_fp8_f32(v[0][2] * sc, v[0][3] * sc, (int)w.x, true);
        w.y = (unsigned)__builtin_amdgcn_cvt_pk_fp8_f32(v[1][0] * sc, v[1][1] * sc, 0, false); w.y = (unsigned)__builtin_amdgcn_cvt_pk_fp8_f32(v[1][2] * sc, v[1][3] * sc, (int)w.y, true);
        w.z = (unsigned)__builtin_amdgcn_cvt_pk_fp8_f32(v[2][0] * sc, v[2][1] * sc, 0, false); w.z = (unsigned)__builtin_amdgcn_cvt_pk_fp8_f32(v[2][2] * sc, v[2][3] * sc, (int)w.z, true);
        w.w = (unsigned)__builtin_amdgcn_cvt_pk_fp8_f32(v[3][0] * sc, v[3][1] * sc, 0, false); w.w = (unsigned)__builtin_amdgcn_cvt_pk_fp8_f32(v[3][2] * sc, v[3][3] * sc, (int)w.w, true);
        *(u32x4*)(O8 + (size_t)row * D + 16 * lane) = w;
        if (lane == 0) SC[row] = ldexpf(1.f, e - 8);
    }
}
__device__ __forceinline__ f32x2 fp8lo(unsigned w) { return __builtin_amdgcn_cvt_pk_f32_fp8((int)w, false); }
__device__ __forceinline__ f32x2 fp8hi(unsigned w) { return __builtin_amdgcn_cvt_pk_f32_fp8((int)w, true); }
__device__ __forceinline__ void peer_phase8(const bf16* H2, const int* EID, const float* EG, const unsigned char* U8, const unsigned char* V8, const float* USC, const float* VSC,
                                            const float* mod, const float* gfin, const float* x1, float* outp) {
    int tid_ = threadIdx.x; asm volatile("" : "+v"(tid_));
    const int lane = tid_ & 63, wv = tid_ >> 6;
    for (int t = blockIdx.x * (NT / 64) + wv; t < M; t += gridDim.x * (NT / 64)) {
        const int b = t / SEQ;
        f32x2 hp[8];
        { const u32x4 h0 = *(const u32x4*)(H2 + (size_t)t * D + 16 * lane), h1 = *(const u32x4*)(H2 + (size_t)t * D + 16 * lane + 8);
          hp[0] = (f32x2){bflo(h0.x), bfhi(h0.x)}; hp[1] = (f32x2){bflo(h0.y), bfhi(h0.y)}; hp[2] = (f32x2){bflo(h0.z), bfhi(h0.z)}; hp[3] = (f32x2){bflo(h0.w), bfhi(h0.w)};
          hp[4] = (f32x2){bflo(h1.x), bfhi(h1.x)}; hp[5] = (f32x2){bflo(h1.y), bfhi(h1.y)}; hp[6] = (f32x2){bflo(h1.z), bfhi(h1.z)}; hp[7] = (f32x2){bflo(h1.w), bfhi(h1.w)}; }
        const int e0 = EID[(size_t)t * NSEL + lane], e1 = EID[(size_t)t * NSEL + 64 + lane]; const float gg0 = EG[(size_t)t * NSEL + lane], gg1 = EG[(size_t)t * NSEL + 64 + lane];
        f32x2 acc[8];
#pragma unroll
        for (int i = 0; i < 8; ++i) acc[i] = (f32x2){0.f, 0.f};
#pragma unroll 1
        for (int kb = 0; kb < NSEL; kb += 16) {
            u32x4 uu[16], vv[16]; float us[16], vs[16];
#pragma unroll
            for (int j = 0; j < 16; ++j) { const int k = kb + j; const int eid = __builtin_amdgcn_readlane(k < 64 ? e0 : e1, k & 63);
                uu[j] = *(const u32x4*)(U8 + (size_t)eid * D + 16 * lane); vv[j] = *(const u32x4*)(V8 + (size_t)eid * D + 16 * lane); us[j] = USC[eid]; vs[j] = VSC[eid]; }
            float d[16];
#pragma unroll
            for (int j = 0; j < 16; ++j) { f32x2 a = (f32x2){0.f, 0.f};
                a = __builtin_elementwise_fma(fp8lo(uu[j].x), hp[0], a); a = __builtin_elementwise_fma(fp8hi(uu[j].x), hp[1], a); a = __builtin_elementwise_fma(fp8lo(uu[j].y), hp[2], a); a = __builtin_elementwise_fma(fp8hi(uu[j].y), hp[3], a);
                a = __builtin_elementwise_fma(fp8lo(uu[j].z), hp[4], a); a = __builtin_elementwise_fma(fp8hi(uu[j].z), hp[5], a); a = __builtin_elementwise_fma(fp8lo(uu[j].w), hp[6], a); a = __builtin_elementwise_fma(fp8hi(uu[j].w), hp[7], a);
                d[j] = (a[0] + a[1]) * us[j]; }
            float r8[8], r4[4], r2[2], r1;
            { const bool up = (lane & 32) != 0;
#pragma unroll
              for (int j = 0; j < 8; ++j) { const float snd = up ? d[j] : d[j + 8], kp = up ? d[j + 8] : d[j]; r8[j] = kp + SHX(snd, 32); } }
            { const bool up = (lane & 16) != 0;
#pragma unroll
              for (int j = 0; j < 4; ++j) { const float snd = up ? r8[j] : r8[j + 4], kp = up ? r8[j + 4] : r8[j]; r4[j] = kp + SHX(snd, 16); } }
            { const bool up = (lane & 8) != 0;
#pragma unroll
              for (int j = 0; j < 2; ++j) { const float snd = up ? r4[j] : r4[j + 2], kp = up ? r4[j + 2] : r4[j]; r2[j] = kp + SHX(snd, 8); } }
            { const bool up = (lane & 4) != 0; const float snd = up ? r2[0] : r2[1], kp = up ? r2[1] : r2[0]; r1 = kp + SHX(snd, 4); }
            r1 += SHX(r1, 2); r1 += SHX(r1, 1);
            const float ge = 0.5f * r1 * (1.f + erff(r1 * 0.70710678118654752f));
#pragma unroll
            for (int j = 0; j < 16; ++j) { const int k = kb + j; const float gk = __uint_as_float(__builtin_amdgcn_readlane(__float_as_uint(k < 64 ? gg0 : gg1), k & 63));
                const float w = gk * vs[j] * __uint_as_float(__builtin_amdgcn_readlane(__float_as_uint(ge), ((j & 8) ? 32 : 0) + ((j & 4) ? 16 : 0) + ((j & 2) ? 8 : 0) + ((j & 1) ? 4 : 0))); const f32x2 w2 = (f32x2){w, w};
                acc[0] = __builtin_elementwise_fma(w2, fp8lo(vv[j].x), acc[0]); acc[1] = __builtin_elementwise_fma(w2, fp8hi(vv[j].x), acc[1]); acc[2] = __builtin_elementwise_fma(w2, fp8lo(vv[j].y), acc[2]); acc[3] = __builtin_elementwise_fma(w2, fp8hi(vv[j].y), acc[3]);
                acc[4] = __builtin_elementwise_fma(w2, fp8lo(vv[j].z), acc[4]); acc[5] = __builtin_elementwise_fma(w2, fp8hi(vv[j].z), acc[5]); acc[6] = __builtin_elementwise_fma(w2, fp8lo(vv[j].w), acc[6]); acc[7] = __builtin_elementwise_fma(w2, fp8hi(vv[j].w), acc[7]); }
        }
        float ss = 0.f; f32x4 x2[4];
#pragma unroll
        for (int q4 = 0; q4 < 4; ++q4) { const int col = 16 * lane + 4 * q4; const f32x4 xv = *(const f32x4*)(x1 + (size_t)t * D + col), gv = *(const f32x4*)(mod + b * 6144 + 5 * D + col);
            x2[q4][0] = xv[0] + gv[0] * acc[2 * q4][0]; x2[q4][1] = xv[1] + gv[1] * acc[2 * q4][1]; x2[q4][2] = xv[2] + gv[2] * acc[2 * q4 + 1][0]; x2[q4][3] = xv[3] + gv[3] * acc[2 * q4 + 1][1];
            ss += x2[q4][0] * x2[q4][0] + x2[q4][1] * x2[q4][1] + x2[q4][2] * x2[q4][2] + x2[q4][3] * x2[q4][3]; }
#pragma unroll
        for (int o = 1; o < 64; o <<= 1) ss += SHX(ss, o);
        const float r = rsqrtf(ss * (1.f / D) + EPS);
#pragma unroll
        for (int q4 = 0; q4 < 4; ++q4) { const int col = 16 * lane + 4 * q4; const f32x4 gf = *(const f32x4*)(gfin + col); *(f32x4*)(outp + (size_t)t * D + col) = x2[q4] * r * gf; }
    }
}

namespace att2 {
__device__ __forceinline__ bool lsum_dummy(int ei) { return ei == 12345; }
using att::f32x16; using att::v4i16_t; using att::crow; using att::bfe;
constexpr int VROW = 192, OFF_V = 32768, OFF_MISC = OFF_V + 256 * VROW;
template <bool CAUSAL>
__device__ __forceinline__ void tile(const LAS unsigned char* Kblk, const LAS unsigned char* Vblk, const bf16x8 (&qr)[4], int tt, int q_off, int lane, int r32, int hi, float& mrun, float& lsum, f32x16& o0, f32x16& o1) {
    const LAS unsigned char* kb_ = Kblk + tt * 64 * 128; const LAS unsigned char* vb_ = Vblk + tt * 64 * VROW;
    f32x16 p0 = {}, p1 = {};
#pragma unroll
    for (int s = 0; s < 4; ++s) { const int c = 2 * s + hi; const int sw = ((c ^ ((r32 >> 1) & 7)) << 4);
        const bf16x8 a0 = *(const LAS bf16x8*)(kb_ + r32 * 128 + sw), a1 = *(const LAS bf16x8*)(kb_ + (32 + r32) * 128 + sw);
        p0 = __builtin_amdgcn_mfma_f32_32x32x16_bf16(a0, qr[s], p0, 0, 0, 0); p1 = __builtin_amdgcn_mfma_f32_32x32x16_bf16(a1, qr[s], p1, 0, 0, 0); }
    if (CAUSAL) {
#pragma unroll
        for (int r = 0; r < 16; ++r) { const int ko = tt * 64 + crow(r, hi); if (ko > q_off) p0[r] = -INFINITY; if (ko + 32 > q_off) p1[r] = -INFINITY; } }
    float mt = fmaxf(p0[0], p1[0]);
#pragma unroll
    for (int r = 1; r < 16; ++r) mt = fmaxf(mt, fmaxf(p0[r], p1[r]));
    mt = fmaxf(mt, SHX(mt, 32));
    const float mnew = fmaxf(mrun, mt), alpha = __builtin_amdgcn_exp2f(mrun - mnew); mrun = mnew;
    float ps = 0.f;
#pragma unroll
    for (int r = 0; r < 16; ++r) { p0[r] = __builtin_amdgcn_exp2f(p0[r] - mnew); p1[r] = __builtin_amdgcn_exp2f(p1[r] - mnew); ps += p0[r] + p1[r]; }
    lsum = lsum * alpha + ps;
    if (!__all(alpha == 1.f ? 1 : 0)) {
#pragma unroll
        for (int r = 0; r < 16; ++r) { o0[r] *= alpha; o1[r] *= alpha; } }
    bf16x8 pb[2][2];
#pragma unroll
    for (int s2 = 0; s2 < 2; ++s2) { u32x4 w0, w1;
        w0.x = cvt_pk_bf16(p0[8 * s2], p0[8 * s2 + 1]); w0.y = cvt_pk_bf16(p0[8 * s2 + 2], p0[8 * s2 + 3]); w0.z = cvt_pk_bf16(p0[8 * s2 + 4], p0[8 * s2 + 5]); w0.w = cvt_pk_bf16(p0[8 * s2 + 6], p0[8 * s2 + 7]);
        w1.x = cvt_pk_bf16(p1[8 * s2], p1[8 * s2 + 1]); w1.y = cvt_pk_bf16(p1[8 * s2 + 2], p1[8 * s2 + 3]); w1.z = cvt_pk_bf16(p1[8 * s2 + 4], p1[8 * s2 + 5]); w1.w = cvt_pk_bf16(p1[8 * s2 + 6], p1[8 * s2 + 7]);
        pb[0][s2] = __builtin_bit_cast(bf16x8, w0); pb[1][s2] = __builtin_bit_cast(bf16x8, w1); }
    const LAS unsigned char* vl = vb_ + (4 * hi + ((lane & 15) >> 2)) * VROW + (16 * ((lane >> 4) & 1) + 4 * (lane & 3)) * 2;
#pragma unroll
    for (int dt = 0; dt < 2; ++dt)
#pragma unroll
        for (int u = 0; u < 2; ++u)
#pragma unroll
            for (int s2 = 0; s2 < 2; ++s2) { const LAS unsigned char* va = vl + (32 * u + 16 * s2) * VROW + dt * 64;
                const v4i16_t lo = __builtin_amdgcn_ds_read_tr16_b64_v4i16((LAS v4i16_t*)va), hh = __builtin_amdgcn_ds_read_tr16_b64_v4i16((LAS v4i16_t*)(va + 8 * VROW));
                const bf16x8 vf = {lo[0], lo[1], lo[2], lo[3], hh[0], hh[1], hh[2], hh[3]};
                if (dt == 0) o0 = __builtin_amdgcn_mfma_f32_32x32x16_bf16(vf, pb[u][s2], o0, 0, 0, 0); else o1 = __builtin_amdgcn_mfma_f32_32x32x16_bf16(vf, pb[u][s2], o1, 0, 0, 0); }
}
__device__ __forceinline__ void stage_block(LAS unsigned char* lds, const bf16* Kb, const bf16* V, size_t row0, int h, int tid) {
    const int ch = tid & 7;
#pragma unroll
    for (int i = 0; i < 4; ++i) { const int row = (tid >> 3) + 64 * i; const size_t go = (row0 + row) * 512 + h * 64 + ch * 8;
        const u32x4 kv = *(const u32x4*)(Kb + go), vv = *(const u32x4*)(V + go);
        *(LAS u32x4*)(lds + row * 128 + ((ch ^ ((row >> 1) & 7)) << 4)) = kv; *(LAS u32x4*)(lds + OFF_V + row * VROW + ch * 16) = vv; }
}
__device__ __forceinline__ void phase_a(LAS unsigned char* lds, const bf16* Q, const float* ksum, unsigned short* SEL, int* CNT, unsigned short* LIST, int G, int bid) {
    int tid_ = threadIdx.x; asm volatile("" : "+v"(tid_));
    const int tid = tid_, lane = tid & 63, wid = __builtin_amdgcn_readfirstlane(tid >> 6), r32 = lane & 31, hi = lane >> 5;
    LAS int* lc = (LAS int*)lds;
    LAS float* lks = (LAS float*)(lds + 1024);
    for (int uidx = bid; uidx < 512; uidx += G) {
        const int bh = (uidx & 255) >> 4, s_ = uidx & 15, qb = uidx < 256 ? s_ : 31 - s_, b = bh >> 3, h = bh & 7;
        const int q_off = wid * 32 + r32, q = qb * 256 + q_off; const size_t qrow = (size_t)b * SEQ + q;
        if (tid < 64) lc[tid] = 0;
        *(LAS f32x4*)(lks + tid * 4) = *(const f32x4*)(ksum + (size_t)bh * NBLK * HD + tid * 4);
        __syncthreads();
        bf16x8 qr[4];
#pragma unroll
        for (int s = 0; s < 4; ++s) qr[s] = *(const bf16x8*)(Q + qrow * 512 + h * 64 + 16 * s + 8 * hi);
        int s0 = 31, s1 = 31, s2 = 31; float g0 = -INFINITY, g1 = -INFINITY, g2 = -INFINITY;
        const LAS float* ksb = lks + 8 * hi;
        for (int j = 0; j < qb; ++j) { float part = 0.f;
#pragma unroll
            for (int s = 0; s < 4; ++s) { const f32x4 k0 = *(const LAS f32x4*)(ksb + j * HD + 16 * s), k1 = *(const LAS f32x4*)(ksb + j * HD + 16 * s + 4);
                part += bfe(qr[s], 0) * k0[0] + bfe(qr[s], 1) * k0[1] + bfe(qr[s], 2) * k0[2] + bfe(qr[s], 3) * k0[3] + bfe(qr[s], 4) * k1[0] + bfe(qr[s], 5) * k1[1] + bfe(qr[s], 6) * k1[2] + bfe(qr[s], 7) * k1[3]; }
            const float g = part + SHX(part, 32);
            if (g > g0) { g2 = g1; s2 = s1; g1 = g0; s1 = s0; g0 = g; s0 = j; } else if (g > g1) { g2 = g1; s2 = s1; g1 = g; s1 = j; } else if (g > g2) { g2 = g; s2 = j; } }
        int r0 = 0, r1 = 0, r2 = 0;
        if (hi == 0) { if (s0 < 31) r0 = __hip_atomic_fetch_add(lc + s0, 1, __ATOMIC_RELAXED, __HIP_MEMORY_SCOPE_WORKGROUP); if (s1 < 31) r1 = __hip_atomic_fetch_add(lc + s1, 1, __ATOMIC_RELAXED, __HIP_MEMORY_SCOPE_WORKGROUP);
                       if (s2 < 31) r2 = __hip_atomic_fetch_add(lc + s2, 1, __ATOMIC_RELAXED, __HIP_MEMORY_SCOPE_WORKGROUP); }
        __syncthreads();
        if (tid < 32 && lc[tid] > 0) lc[32 + tid] = atomicAdd(CNT + bh * 32 + tid, lc[tid]);
        __syncthreads();
        if (hi == 0) { SEL[(size_t)bh * SEQ + q] = (unsigned short)(s0 | (s1 << 5) | (s2 << 10));
            if (s0 < 31) LIST[((size_t)bh * 32 + s0) * SEQ + lc[32 + s0] + r0] = (unsigned short)q;
            if (s1 < 31) LIST[((size_t)bh * 32 + s1) * SEQ + lc[32 + s1] + r1] = (unsigned short)(q | (1 << 13));
            if (s2 < 31) LIST[((size_t)bh * 32 + s2) * SEQ + lc[32 + s2] + r2] = (unsigned short)(q | (2 << 13)); }
        __syncthreads();
    }
}
__device__ __forceinline__ bf16* part_o(bf16* PO01, bf16* PO2, int slot, size_t bhq) { return (slot < 2 ? PO01 + (size_t)slot * 16 * SEQ * HD : PO2) + bhq * HD; }
template <int MODE>
__device__ __forceinline__ void phase_b(LAS unsigned char* lds, const bf16* Q, const bf16* Kb, const bf16* V, const int* CNT, const unsigned short* LIST, bf16* PO01, bf16* PO2, f32x2* PML, int G, int bid) {
    int tid_ = threadIdx.x; asm volatile("" : "+v"(tid_));
    const int tid = tid_, lane = tid & 63, wid = __builtin_amdgcn_readfirstlane(tid >> 6), r32 = lane & 31, hi = lane >> 5;
    const int vcu = (G % 8 == 0) ? (bid % 8) * (G / 8) + bid / 8 : bid;
    LAS int* misc = (LAS int*)(lds + OFF_MISC);
    if (tid < 16) misc[tid] = 0;
    __syncthreads();
    { const int tr = tid; const int cnt = tr < 16 * 31 ? CNT[(tr % 16) * 32 + tr / 16] : 0, nch = (cnt + 255) >> 8;
      int inc = nch;
#pragma unroll
      for (int o = 1; o < 64; o <<= 1) { const int t = SHUP(inc, o); if (lane >= o) inc += t; }
      if (lane == 63) misc[wid] = inc;
      __syncthreads();
      int off = 0; for (int w = 0; w < wid; ++w) off += misc[w];
      const int st = off + inc - nch;
      if (nch > 0) { int k0 = st + ((vcu - st) % G + G) % G;
          for (; k0 < st + nch; k0 += G) { const int slot_ = __hip_atomic_fetch_add(misc + 8, 1, __ATOMIC_RELAXED, __HIP_MEMORY_SCOPE_WORKGROUP); misc[16 + slot_] = (tr << 8) | (k0 - st); } }
      __syncthreads(); }
    const int ni = misc[8];
    const int ch = tid & 7;
    u32x4 kreg[4], vreg[4];
#define ATT2_LOAD_ITEM(idx_) do { const int it_ = misc[16 + (idx_)], tr_ = it_ >> 8, j_ = tr_ / 16, bh_ = tr_ % 16; const size_t row0_ = (size_t)(bh_ >> 3) * SEQ + j_ * 256; \
        _Pragma("unroll") for (int i_ = 0; i_ < 4; ++i_) { const size_t go_ = (row0_ + (tid >> 3) + 64 * i_) * 512 + (bh_ & 7) * 64 + ch * 8; kreg[i_] = *(const u32x4*)(Kb + go_); vreg[i_] = *(const u32x4*)(V + go_); } } while (0)
    if (ni > 0) ATT2_LOAD_ITEM(0);
    for (int ii = 0; ii < ni; ++ii) {
        const int it = misc[16 + ii], tr = it >> 8, c = it & 255, j = tr / 16, bh = tr % 16, b = bh >> 3, h = bh & 7;
        __syncthreads();
#pragma unroll
        for (int i = 0; i < 4; ++i) { const int row = (tid >> 3) + 64 * i; *(LAS u32x4*)(lds + row * 128 + ((ch ^ ((row >> 1) & 7)) << 4)) = kreg[i]; *(LAS u32x4*)(lds + OFF_V + row * VROW + ch * 16) = vreg[i]; }
        __syncthreads();
        if (ii + 1 < ni) ATT2_LOAD_ITEM(ii + 1);
        const int cnt = CNT[bh * 32 + j]; const int n = min(256, cnt - 256 * c);
        if (MODE != 2 && 32 * wid < n) {
            const int ei = 32 * wid + r32; const bool valid = (ei < n) && (MODE != 1 || lsum_dummy(ei));
            const unsigned ent = LIST[((size_t)bh * 32 + j) * SEQ + 256 * c + (ei < n ? ei : 0)]; const int q = ent & 8191, slot = ent >> 13;
            const size_t qrow = (size_t)b * SEQ + q;
            bf16x8 qr[4];
#pragma unroll
            for (int s = 0; s < 4; ++s) qr[s] = *(const bf16x8*)(Q + qrow * 512 + h * 64 + 16 * s + 8 * hi);
            float mrun = -INFINITY, lsum = 0.f; f32x16 o0 = {}, o1 = {};
#pragma unroll 1
            for (int tt = 0; tt < 4; ++tt) tile<false>(lds, lds + OFF_V, qr, tt, 0, lane, r32, hi, mrun, lsum, o0, o1);
            const float lt = lsum + SHX(lsum, 32), inv = 1.f / lt;
            if (valid) { const size_t bhq = (size_t)bh * SEQ + q; bf16* orow = part_o(PO01, PO2, slot, bhq) + 4 * hi;
                if (hi == 0) PML[bhq * 3 + slot] = (f32x2){mrun, lt};
#pragma unroll
                for (int g4 = 0; g4 < 4; ++g4) { u32x2 w;
                    w.x = cvt_pk_bf16(o0[4 * g4] * inv, o0[4 * g4 + 1] * inv); w.y = cvt_pk_bf16(o0[4 * g4 + 2] * inv, o0[4 * g4 + 3] * inv); *(u32x2*)(orow + 8 * g4) = w;
                    w.x = cvt_pk_bf16(o1[4 * g4] * inv, o1[4 * g4 + 1] * inv); w.y = cvt_pk_bf16(o1[4 * g4 + 2] * inv, o1[4 * g4 + 3] * inv); *(u32x2*)(orow + 32 + 8 * g4) = w; } }
        }
    }
#undef ATT2_LOAD_ITEM
    __syncthreads();
}
__device__ __forceinline__ void phase_c(LAS unsigned char* lds, const bf16* Q, const bf16* Kb, const bf16* V, const unsigned short* SEL, const bf16* PO01, const bf16* PO2, const f32x2* PML, bf16* ATT, int G, int bid) {
    int tid_ = threadIdx.x; asm volatile("" : "+v"(tid_));
    const int tid = tid_, lane = tid & 63, wid = __builtin_amdgcn_readfirstlane(tid >> 6), r32 = lane & 31, hi = lane >> 5;
    for (int uidx = bid; uidx < 512; uidx += G) {
        const int bh = uidx >> 5, qb = uidx & 31, b = bh >> 3, h = bh & 7;
        const int q_off = wid * 32 + r32, q = qb * 256 + q_off; const size_t qrow = (size_t)b * SEQ + q, bhq = (size_t)bh * SEQ + q;
        __syncthreads();
        stage_block(lds, Kb, V, (size_t)b * SEQ + qb * 256, h, tid);
        bf16x8 qr[4];
#pragma unroll
        for (int s = 0; s < 4; ++s) qr[s] = *(const bf16x8*)(Q + qrow * 512 + h * 64 + 16 * s + 8 * hi);
        const unsigned sel = SEL[bhq];
        __syncthreads();
        float mrun = -INFINITY, lsum = 0.f; f32x16 o0 = {}, o1 = {};
        const int ntile = (32 * wid + 31) / 64 + 1;
#pragma unroll 1
        for (int tt = 0; tt < ntile; ++tt) tile<true>(lds, lds + OFF_V, qr, tt, q_off, lane, r32, hi, mrun, lsum, o0, o1);
        float lt = lsum + SHX(lsum, 32);
#pragma unroll 1
        for (int slot = 0; slot < 3; ++slot) {
            const int sj = (sel >> (5 * slot)) & 31; if (sj == 31) continue;
            const f32x2 ml = PML[bhq * 3 + slot]; const bf16* prow = part_o((bf16*)PO01, (bf16*)PO2, slot, bhq) + 4 * hi;
            const float mstar = fmaxf(mrun, ml[0]), fa = __builtin_amdgcn_exp2f(mrun - mstar), fb = ml[1] * __builtin_amdgcn_exp2f(ml[0] - mstar);
            mrun = mstar; lt = lt * fa + fb;
#pragma unroll
            for (int g4 = 0; g4 < 4; ++g4) { const u32x2 w0 = *(const u32x2*)(prow + 8 * g4), w1 = *(const u32x2*)(prow + 32 + 8 * g4);
                o0[4 * g4] = o0[4 * g4] * fa + fb * bflo(w0.x); o0[4 * g4 + 1] = o0[4 * g4 + 1] * fa + fb * bfhi(w0.x); o0[4 * g4 + 2] = o0[4 * g4 + 2] * fa + fb * bflo(w0.y); o0[4 * g4 + 3] = o0[4 * g4 + 3] * fa + fb * bfhi(w0.y);
                o1[4 * g4] = o1[4 * g4] * fa + fb * bflo(w1.x); o1[4 * g4 + 1] = o1[4 * g4 + 1] * fa + fb * bfhi(w1.x); o1[4 * g4 + 2] = o1[4 * g4 + 2] * fa + fb * bflo(w1.y); o1[4 * g4 + 3] = o1[4 * g4 + 3] * fa + fb * bfhi(w1.y); }
        }
        const float inv = 1.f / lt;
        bf16* orow = ATT + qrow * 512 + h * 64 + 4 * hi;
#pragma unroll
        for (int g4 = 0; g4 < 4; ++g4) { u32x2 w;
            w.x = cvt_pk_bf16(o0[4 * g4] * inv, o0[4 * g4 + 1] * inv); w.y = cvt_pk_bf16(o0[4 * g4 + 2] * inv, o0[4 * g4 + 3] * inv); *(u32x2*)(orow + 8 * g4) = w;
            w.x = cvt_pk_bf16(o1[4 * g4] * inv, o1[4 * g4 + 1] * inv); w.y = cvt_pk_bf16(o1[4 * g4 + 2] * inv, o1[4 * g4 + 3] * inv); *(u32x2*)(orow + 32 + 8 * g4) = w; }
    }
    __syncthreads();
}
}

__device__ __forceinline__ void peer_pass_u(const bf16* H2, const int* EID, const float* EG, const unsigned char* U8, const float* USC, const float* VSC, float* WT) {
    int tid_ = threadIdx.x; asm volatile("" : "+v"(tid_));
    const int lane = tid_ & 63, wv = tid_ >> 6;
    for (int t = blockIdx.x * (NT / 64) + wv; t < M; t += gridDim.x * (NT / 64)) {
        f32x2 hp[8];
        { const u32x4 h0 = *(const u32x4*)(H2 + (size_t)t * D + 16 * lane), h1 = *(const u32x4*)(H2 + (size_t)t * D + 16 * lane + 8);
          hp[0] = (f32x2){bflo(h0.x), bfhi(h0.x)}; hp[1] = (f32x2){bflo(h0.y), bfhi(h0.y)}; hp[2] = (f32x2){bflo(h0.z), bfhi(h0.z)}; hp[3] = (f32x2){bflo(h0.w), bfhi(h0.w)};
          hp[4] = (f32x2){bflo(h1.x), bfhi(h1.x)}; hp[5] = (f32x2){bflo(h1.y), bfhi(h1.y)}; hp[6] = (f32x2){bflo(h1.z), bfhi(h1.z)}; hp[7] = (f32x2){bflo(h1.w), bfhi(h1.w)}; }
        const int e0 = EID[(size_t)t * NSEL + lane], e1 = EID[(size_t)t * NSEL + 64 + lane];
        float wlo = 0.f, whi = 0.f;
#pragma unroll 1
        for (int kb = 0; kb < NSEL; kb += 32) {
            u32x4 uu[32]; float us[32];
#pragma unroll
            for (int j = 0; j < 32; ++j) { const int k = kb + j; const int eid = __builtin_amdgcn_readlane(k < 64 ? e0 : e1, k & 63); uu[j] = *(const u32x4*)(U8 + (size_t)eid * D + 16 * lane); us[j] = USC[eid]; }
            float d[32];
#pragma unroll
            for (int j = 0; j < 32; ++j) { f32x2 a = (f32x2){0.f, 0.f};
                a = __builtin_elementwise_fma(fp8lo(uu[j].x), hp[0], a); a = __builtin_elementwise_fma(fp8hi(uu[j].x), hp[1], a); a = __builtin_elementwise_fma(fp8lo(uu[j].y), hp[2], a); a = __builtin_elementwise_fma(fp8hi(uu[j].y), hp[3], a);
                a = __builtin_elementwise_fma(fp8lo(uu[j].z), hp[4], a); a = __builtin_elementwise_fma(fp8hi(uu[j].z), hp[5], a); a = __builtin_elementwise_fma(fp8lo(uu[j].w), hp[6], a); a = __builtin_elementwise_fma(fp8hi(uu[j].w), hp[7], a);
                d[j] = (a[0] + a[1]) * us[j]; }
            float r16[16], r8[8], r4[4], r2[2], r1;
            { const bool up = (lane & 32) != 0;
#pragma unroll
              for (int j = 0; j < 16; ++j) { const float snd = up ? d[j] : d[j + 16], kp = up ? d[j + 16] : d[j]; r16[j] = kp + SHX(snd, 32); } }
            { const bool up = (lane & 16) != 0;
#pragma unroll
              for (int j = 0; j < 8; ++j) { const float snd = up ? r16[j] : r16[j + 8], kp = up ? r16[j + 8] : r16[j]; r8[j] = kp + SHX(snd, 16); } }
            { const bool up = (lane & 8) != 0;
#pragma unroll
              for (int j = 0; j < 4; ++j) { const float snd = up ? r8[j] : r8[j + 4], kp = up ? r8[j + 4] : r8[j]; r4[j] = kp + SHX(snd, 8); } }
            { const bool up = (lane & 4) != 0;
#pragma unroll
              for (int j = 0; j < 2; ++j) { const float snd = up ? r4[j] : r4[j + 2], kp = up ? r4[j + 2] : r4[j]; r2[j] = kp + SHX(snd, 4); } }
            { const bool up = (lane & 2) != 0; const float snd = up ? r2[0] : r2[1], kp = up ? r2[1] : r2[0]; r1 = kp + SHX(snd, 2); }
            r1 += SHX(r1, 1);
            const float ge = 0.5f * r1 * (1.f + erff(r1 * 0.70710678118654752f));
            const float gsh = SHL(ge, 2 * (lane & 31));
            if (kb < 64) { if ((lane >> 5) == (kb >> 5)) wlo = gsh; } else { if ((lane >> 5) == ((kb - 64) >> 5)) whi = gsh; }
        }
        WT[(size_t)t * NSEL + lane] = wlo; WT[(size_t)t * NSEL + 64 + lane] = whi;
    }
}
__device__ __forceinline__ void peer_pass_u_sliced(const bf16* H2, const int* EID, const unsigned char* U8, const float* USC, float* WT, const XcdBarrier& xb) {
    int tid_ = threadIdx.x; asm volatile("" : "+v"(tid_));
    const int lane = tid_ & 63, wv = tid_ >> 6;
    const unsigned nloc = xb.st[0], nx = xb.st[1], lr = xb.st[2];
    unsigned rankx = 0u;
    for (unsigned j = 0; j < 16; ++j) { const unsigned cj = xb_ld(&xb.bar[XB_XCNT(j)]); if (j < xb.x && cj > 0u) ++rankx; }
    const int tstep = (int)nloc * (NT / 64);
    for (unsigned sl = rankx; sl < 8u; sl += nx) {
        int t = (int)lr * (NT / 64) + wv;
        int e0n = 0, e1n = 0; u32x4 h0n = {}, h1n = {};
        if (t < M) { e0n = EID[(size_t)t * NSEL + lane]; e1n = EID[(size_t)t * NSEL + 64 + lane]; h0n = *(const u32x4*)(H2 + (size_t)t * D + 16 * lane); h1n = *(const u32x4*)(H2 + (size_t)t * D + 16 * lane + 8); }
        for (; t < M; t += tstep) {
            const int e0 = e0n, e1 = e1n; const u32x4 h0 = h0n, h1 = h1n;
            { const int tn = t + tstep; if (tn < M) { e0n = EID[(size_t)tn * NSEL + lane]; e1n = EID[(size_t)tn * NSEL + 64 + lane]; h0n = *(const u32x4*)(H2 + (size_t)tn * D + 16 * lane); h1n = *(const u32x4*)(H2 + (size_t)tn * D + 16 * lane + 8); } }
            const bool in0 = (unsigned)(e0 >> 11) == sl, in1 = (unsigned)(e1 >> 11) == sl;
            const unsigned long long a0 = __ballot(in0), a1 = __ballot(in1);
            const int cnt0 = __builtin_popcountll(a0), cnt = cnt0 + __builtin_popcountll(a1);
            if (cnt == 0) continue;
            const int r0 = (int)__builtin_amdgcn_mbcnt_hi((unsigned)(a0 >> 32), __builtin_amdgcn_mbcnt_lo((unsigned)a0, 0u)), r1 = (int)__builtin_amdgcn_mbcnt_hi((unsigned)(a1 >> 32), __builtin_amdgcn_mbcnt_lo((unsigned)a1, 0u));
            const int d0 = (in0 ? r0 : 63) * 4, d1 = (in1 ? r1 : 63) * 4;
            const int ce0 = __builtin_amdgcn_ds_permute(d0, e0), ce1 = __builtin_amdgcn_ds_permute(d1, e1), ck0 = __builtin_amdgcn_ds_permute(d0, lane), ck1 = __builtin_amdgcn_ds_permute(d1, 64 + lane);
            f32x2 hp[8];
            hp[0] = (f32x2){bflo(h0.x), bfhi(h0.x)}; hp[1] = (f32x2){bflo(h0.y), bfhi(h0.y)}; hp[2] = (f32x2){bflo(h0.z), bfhi(h0.z)}; hp[3] = (f32x2){bflo(h0.w), bfhi(h0.w)};
            hp[4] = (f32x2){bflo(h1.x), bfhi(h1.x)}; hp[5] = (f32x2){bflo(h1.y), bfhi(h1.y)}; hp[6] = (f32x2){bflo(h1.z), bfhi(h1.z)}; hp[7] = (f32x2){bflo(h1.w), bfhi(h1.w)};
#pragma unroll 1
            for (int base = 0; base < cnt; base += 16) {
                u32x4 uu[16]; float us[16];
#pragma unroll
                for (int j = 0; j < 16; ++j) { const int i = base + j; uu[j] = (u32x4){0u, 0u, 0u, 0u}; us[j] = 0.f;
                    if (i < cnt) { const int eid = i < cnt0 ? __builtin_amdgcn_readlane(ce0, i) : __builtin_amdgcn_readlane(ce1, i - cnt0); uu[j] = *(const u32x4*)(U8 + (size_t)eid * D + 16 * lane); us[j] = USC[eid]; } }
                float d[16];
#pragma unroll
                for (int j = 0; j < 16; ++j) { f32x2 a = (f32x2){0.f, 0.f};
                    a = __builtin_elementwise_fma(fp8lo(uu[j].x), hp[0], a); a = __builtin_elementwise_fma(fp8hi(uu[j].x), hp[1], a); a = __builtin_elementwise_fma(fp8lo(uu[j].y), hp[2], a); a = __builtin_elementwise_fma(fp8hi(uu[j].y), hp[3], a);
                    a = __builtin_elementwise_fma(fp8lo(uu[j].z), hp[4], a); a = __builtin_elementwise_fma(fp8hi(uu[j].z), hp[5], a); a = __builtin_elementwise_fma(fp8lo(uu[j].w), hp[6], a); a = __builtin_elementwise_fma(fp8hi(uu[j].w), hp[7], a);
                    d[j] = (a[0] + a[1]) * us[j]; }
                float r8[8], r4[4], r2[2], r1s;
                { const bool up = (lane & 32) != 0;
#pragma unroll
                  for (int j = 0; j < 8; ++j) { const float snd = up ? d[j] : d[j + 8], kp = up ? d[j + 8] : d[j]; r8[j] = kp + SHX(snd, 32); } }
                { const bool up = (lane & 16) != 0;
#pragma unroll
                  for (int j = 0; j < 4; ++j) { const float snd = up ? r8[j] : r8[j + 4], kp = up ? r8[j + 4] : r8[j]; r4[j] = kp + SHX(snd, 16); } }
                { const bool up = (lane & 8) != 0;
#pragma unroll
                  for (int j = 0; j < 2; ++j) { const float snd = up ? r4[j] : r4[j + 2], kp = up ? r4[j + 2] : r4[j]; r2[j] = kp + SHX(snd, 8); } }
                { const bool up = (lane & 4) != 0; const float snd = up ? r2[0] : r2[1], kp = up ? r2[1] : r2[0]; r1s = kp + SHX(snd, 4); }
                r1s += SHX(r1s, 2); r1s += SHX(r1s, 1);
                const float ge = 0.5f * r1s * (1.f + erff(r1s * 0.70710678118654752f));
                const int il = base + (lane >> 2);
                const int k0l = SHL(ck0, il & 63), k1l = SHL(ck1, (il - cnt0) & 63); const int kl = il < cnt0 ? k0l : k1l;
                if ((lane & 3) == 0 && il < cnt) WT[(size_t)t * NSEL + kl] = ge;
            }
        }
    }
}
__device__ __forceinline__ void peer_pass_v(const int* EID, const float* EG, const float* VSC, const float* WT, const unsigned char* V8, const float* mod, const float* gfin, const float* x1, float* outp) {
    int tid_ = threadIdx.x; asm volatile("" : "+v"(tid_));
    const int lane = tid_ & 63, wv = tid_ >> 6;
    for (int t = blockIdx.x * (NT / 64) + wv; t < M; t += gridDim.x * (NT / 64)) {
        const int b = t / SEQ;
        const int e0 = EID[(size_t)t * NSEL + lane], e1 = EID[(size_t)t * NSEL + 64 + lane];
        const float w0 = WT[(size_t)t * NSEL + lane] * EG[(size_t)t * NSEL + lane] * VSC[e0], w1 = WT[(size_t)t * NSEL + 64 + lane] * EG[(size_t)t * NSEL + 64 + lane] * VSC[e1];
        f32x2 acc[8];
#pragma unroll
        for (int i = 0; i < 8; ++i) acc[i] = (f32x2){0.f, 0.f};
#pragma unroll 1
        for (int kb = 0; kb < NSEL; kb += 32) {
            u32x4 vv[32];
#pragma unroll
            for (int j = 0; j < 32; ++j) { const int k = kb + j; const int eid = __builtin_amdgcn_readlane(k < 64 ? e0 : e1, k & 63); vv[j] = *(const u32x4*)(V8 + (size_t)eid * D + 16 * lane); }
#pragma unroll
            for (int j = 0; j < 32; ++j) { const int k = kb + j; const float w = __uint_as_float(__builtin_amdgcn_readlane(__float_as_uint(k < 64 ? w0 : w1), k & 63)); const f32x2 w2 = (f32x2){w, w};
                acc[0] = __builtin_elementwise_fma(w2, fp8lo(vv[j].x), acc[0]); acc[1] = __builtin_elementwise_fma(w2, fp8hi(vv[j].x), acc[1]); acc[2] = __builtin_elementwise_fma(w2, fp8lo(vv[j].y), acc[2]); acc[3] = __builtin_elementwise_fma(w2, fp8hi(vv[j].y), acc[3]);
                acc[4] = __builtin_elementwise_fma(w2, fp8lo(vv[j].z), acc[4]); acc[5] = __builtin_elementwise_fma(w2, fp8hi(vv[j].z), acc[5]); acc[6] = __builtin_elementwise_fma(w2, fp8lo(vv[j].w), acc[6]); acc[7] = __builtin_elementwise_fma(w2, fp8hi(vv[j].w), acc[7]); }
        }
        float ss = 0.f; f32x4 x2[4];
#pragma unroll
        for (int q4 = 0; q4 < 4; ++q4) { const int col = 16 * lane + 4 * q4; const f32x4 xv = *(const f32x4*)(x1 + (size_t)t * D + col), gv = *(const f32x4*)(mod + b * 6144 + 5 * D + col);
            x2[q4][0] = xv[0] + gv[0] * acc[2 * q4][0]; x2[q4][1] = xv[1] + gv[1] * acc[2 * q4][1]; x2[q4][2] = xv[2] + gv[2] * acc[2 * q4 + 1][0]; x2[q4][3] = xv[3] + gv[3] * acc[2 * q4 + 1][1];
            ss += x2[q4][0] * x2[q4][0] + x2[q4][1] * x2[q4][1] + x2[q4][2] * x2[q4][2] + x2[q4][3] * x2[q4][3]; }
#pragma unroll
        for (int o = 1; o < 64; o <<= 1) ss += SHX(ss, o);
        const float r = rsqrtf(ss * (1.f / D) + EPS);
#pragma unroll
        for (int q4 = 0; q4 < 4; ++q4) { const int col = 16 * lane + 4 * q4; const f32x4 gf = *(const f32x4*)(gfin + col); *(f32x4*)(outp + (size_t)t * D + col) = x2[q4] * r * gf; }
    }
}

__device__ __forceinline__ void d_cmp_accum(float num, float den, float* lds, float* acc2) {
    const int lane = threadIdx.x & 63;
#pragma unroll
    for (int o = 1; o < 64; o <<= 1) { num += SHX(num, o); den += SHX(den, o); }
    __syncthreads();
    if ((threadIdx.x & 63) == 0) { lds[(threadIdx.x >> 6) * 2] = num; lds[(threadIdx.x >> 6) * 2 + 1] = den; }
    __syncthreads();
    if (threadIdx.x == 0) { float n = 0.f, d = 0.f; for (int w = 0; w < NT / 64; ++w) { n += lds[w * 2]; d += lds[w * 2 + 1]; } atomicAdd(acc2, n); atomicAdd(acc2 + 1, d); }
    __syncthreads();
}
__device__ __forceinline__ void d_cmp_bf16(const bf16* a, const bf16* b, size_t n, float* lds, float* acc2) {
    float num = 0.f, den = 0.f; GSTRIDE(i, n) { const float x = bf2f(a[i]), y = bf2f(b[i]); num += (x - y) * (x - y); den += y * y; } d_cmp_accum(num, den, lds, acc2);
}
__device__ __forceinline__ void d_cmp_f32(const float* a, const float* b, size_t n, float* lds, float* acc2) {
    float num = 0.f, den = 0.f; GSTRIDE(i, n) { const float x = a[i], y = b[i]; num += (x - y) * (x - y); den += y * y; } d_cmp_accum(num, den, lds, acc2);
}

#ifndef DBG
#define DBG 0
#endif
#ifndef PROBE
#define PROBE 0
#endif
#ifndef USE_XCD_BARRIER
#define USE_XCD_BARRIER 1
#endif
#ifndef FAST_PRO
#define FAST_PRO 1
#endif
#ifndef FAST_GEMM
#define FAST_GEMM 1
#endif
#ifndef FAST_ATTN
#define FAST_ATTN 2
#endif
#define ATTN_SORTED(dst_) do { att2::phase_a(lds3, Q, KSUM, (unsigned short*)(ws + WS_SEL), (int*)(ws + WS_CNT), (unsigned short*)(ws + WS_LIST), G, bid); GSYNC(); \
    att2::phase_b<0>(lds3, Q, Kb, V, (const int*)(ws + WS_CNT), (const unsigned short*)(ws + WS_LIST), (bf16*)(ws + WS_PO01), (bf16*)(ws + WS_PO2), (f32x2*)(ws + WS_PML), G, bid); GSYNC(); \
    att2::phase_c(lds3, Q, Kb, V, (const unsigned short*)(ws + WS_SEL), (const bf16*)(ws + WS_PO01), (const bf16*)(ws + WS_PO2), (const f32x2*)(ws + WS_PML), dst_, G, bid); } while (0)
#ifndef FAST_PEER
#define FAST_PEER 1
#endif
#ifndef FAST_ROUTE
#define FAST_ROUTE 1
#endif
#ifndef PEER_TWO_PASS
#define PEER_TWO_PASS 1
#endif
#ifndef PEER_SLICED
#define PEER_SLICED 0
#endif
#ifndef PEER_FP8
#define PEER_FP8 1
#endif
#if PEER_FP8
#if PEER_TWO_PASS
#if PEER_SLICED
#define PEER_CALL(x1_, o_) do { peer_pass_u_sliced(H, EID, ws + WS_U8, (const float*)(ws + WS_USC), (float*)(ws + WS_WT), xbar); GSYNC(); \
    peer_pass_v(EID, EG, (const float*)(ws + WS_VSC), (const float*)(ws + WS_WT), ws + WS_V8, MOD, g_fin, x1_, o_); } while (0)
#else
#define PEER_CALL(x1_, o_) do { peer_pass_u(H, EID, EG, ws + WS_U8, (const float*)(ws + WS_USC), (const float*)(ws + WS_VSC), (float*)(ws + WS_WT)); __syncthreads(); \
    peer_pass_v(EID, EG, (const float*)(ws + WS_VSC), (const float*)(ws + WS_WT), ws + WS_V8, MOD, g_fin, x1_, o_); } while (0)
#endif
#else
#define PEER_CALL(x1_, o_) peer_phase8(H, EID, EG, ws + WS_U8, ws + WS_V8, (const float*)(ws + WS_USC), (const float*)(ws + WS_VSC), MOD, g_fin, x1_, o_)
#endif
#else
#define PEER_CALL(x1_, o_) peer_phase(H, EID, EG, (const bf16*)(ws + WS_UT), (const bf16*)(ws + WS_VT), MOD, g_fin, x1_, o_)
#endif
#define USE_FAST_PEER (FAST_PEER && !(DBG & 19))
constexpr int LDS_BYTES = 147456;
__global__ void __launch_bounds__(NT, 2) mega_fwd(Args a) {
    extern __shared__ __attribute__((aligned(16))) unsigned char lds_raw[];
    float* ldsf = (float*)lds_raw; LAS unsigned char* lds3 = (LAS unsigned char*)lds_raw;
    cg::grid_group grid = cg::this_grid();
    const float* x = a.in[0]; const float* c = a.in[1]; const float* w_ada = a.in[2]; const float* b_ada = a.in[3];
    const float* g_mix = a.in[4]; const float* w_in = a.in[5]; const float* pool_w = a.in[6]; const float* pool_scale = a.in[7];
    const float* w_bp = a.in[8]; const float* w_ba = a.in[9]; const float* w_out = a.in[10]; const float* g_ffn = a.in[11];
    const float* wq = a.in[12]; const float* skeys = a.in[13]; const float* Ut = a.in[14]; const float* Vt = a.in[15]; const float* g_fin = a.in[16];
    unsigned char* ws = a.ws; float* out = a.out;
    float* MOD = (float*)(ws + WS_MOD); float* KSUM = (float*)(ws + WS_KSUM); float* ROPE = (float*)(ws + WS_ROPE);
    bf16 *W_IN_T = (bf16*)(ws + WS_W_IN_T), *WC_T = (bf16*)(ws + WS_WC_T), *WBA_T = (bf16*)(ws + WS_WBA_T), *WOUT_T = (bf16*)(ws + WS_WOUT_T), *WQ_T = (bf16*)(ws + WS_WQ_T), *SK = (bf16*)(ws + WS_SK);
    bf16 *H = (bf16*)(ws + WS_H), *DIFF = (bf16*)(ws + WS_DIFF), *ATT = (bf16*)(ws + WS_ATT), *UP = (bf16*)(ws + WS_UP), *Q = (bf16*)(ws + WS_Q), *Kb = (bf16*)(ws + WS_K), *V = (bf16*)(ws + WS_V);
    bf16 *GATES = (bf16*)(ws + WS_GATES), *MERGED = (bf16*)(ws + WS_MERGED), *QP = (bf16*)(ws + WS_QP);
    int* EID = (int*)(ws + WS_EID); float* EG = (float*)(ws + WS_EG);
    const int G = gridDim.x, bid = blockIdx.x;
    { volatile LAS unsigned* st = (volatile LAS unsigned*)(lds3 + LDS_BYTES - 64); if (threadIdx.x < 16) st[threadIdx.x] = 0u; }
    __syncthreads();
    const XcdBarrier xbar = xcd_barrier_post((unsigned*)(ws + WS_BAR), (volatile LAS unsigned*)(lds3 + LDS_BYTES - 64));
#if USE_XCD_BARRIER
#define GSYNC() do { xcd_barrier(xbar); if (PROBE == 19) xcd_barrier(xbar); } while (0)
#else
#define GSYNC() grid.sync()
#endif
    if (a.ws == nullptr) grid.sync();
#if DBG
    float* DBGW = (float*)(ws + WS_DBG); unsigned char* ALT = ws + WS_ALT;
#endif

    for (int rep_ = 0; rep_ < (PROBE == 5 ? 2 : 1); ++rep_) {
#if FAST_PRO
    p0_mod_partials(c, w_ada, (float*)(ws + WS_MODP));
    p0_transposes(lds3, w_in, w_ba, w_out, wq, W_IN_T, WBA_T, WOUT_T, WQ_T);
    p0_wc(pool_w, pool_scale, w_bp, (float*)(ws + WS_WCF));
#else
    d_mod(c, w_ada, b_ada, MOD);
    d_transpose(w_in, 1024, 4096, W_IN_T); d_transpose(w_ba, 512, 1024, WBA_T); d_transpose(w_out, 1024, 1024, WOUT_T); d_transpose(wq, 1024, 2048, WQ_T);
    d_wc(pool_w, pool_scale, w_bp, WC_T);
#endif
#if (DBG & 4) || !FAST_ROUTE
    d_sk(skeys, SK);
#endif
    d_skbd(skeys, (bf16*)(ws + WS_SKBD)); d_rope(ROPE);
#if USE_FAST_PEER
#if PEER_FP8
    d_tab_fp8(Ut, ws + WS_U8, (float*)(ws + WS_USC)); d_tab_fp8(Vt, ws + WS_V8, (float*)(ws + WS_VSC));
#else
    d_tab_bf16(Ut, (bf16*)(ws + WS_UT)); d_tab_bf16(Vt, (bf16*)(ws + WS_VT));
#endif
#endif
    }
    GSYNC();
#if FAST_PRO
    { const float* MODP = (const float*)(ws + WS_MODP);
      GSTRIDE(idx, 2 * 6144) MOD[idx] = mod_reduce(MODP, b_ada, (int)idx);
      p1_wc_transpose(lds3, (const float*)(ws + WS_WCF), WC_T);
      __syncthreads();
      fill_mtab_partials((LAS float*)lds3, MODP, b_ada, 0, D);
      modulate_rows(x, g_mix, (const LAS float*)lds3, H);
      if (PROBE == 16) modulate_rows(x, g_mix, (const LAS float*)lds3, H); }
#else
    d_modulate(x, g_mix, MOD, 0, D, H);
#endif
    GSYNC();
#if DBG & 16
    { float* MOD2 = (float*)ALT; bf16 *T1 = (bf16*)(ALT + 1 * MiB), *T2 = (bf16*)(ALT + 9 * MiB), *T3 = (bf16*)(ALT + 10 * MiB), *T4 = (bf16*)(ALT + 12 * MiB), *T5 = (bf16*)(ALT + 16 * MiB), *HC = (bf16*)(ALT + 20 * MiB);
      d_mod(c, w_ada, b_ada, MOD2); d_transpose(w_in, 1024, 4096, T1); d_transpose(w_ba, 512, 1024, T2); d_transpose(w_out, 1024, 1024, T3); d_transpose(wq, 1024, 2048, T4); d_wc(pool_w, pool_scale, w_bp, T5);
      GSYNC();
      d_modulate(x, g_mix, MOD2, 0, D, HC);
      GSYNC();
      d_cmp_f32(MOD, MOD2, 2 * 6144, ldsf, DBGW + 24); d_cmp_bf16(W_IN_T, T1, (size_t)4096 * 1024, ldsf, DBGW + 26); d_cmp_bf16(WBA_T, T2, (size_t)512 * 1024, ldsf, DBGW + 26); d_cmp_bf16(WOUT_T, T3, (size_t)1024 * 1024, ldsf, DBGW + 26);
      d_cmp_bf16(WQ_T, T4, (size_t)2048 * 1024, ldsf, DBGW + 26); d_cmp_bf16(WC_T, T5, (size_t)512 * 1024, ldsf, DBGW + 26); d_cmp_bf16(H, HC, (size_t)M * D, ldsf, DBGW + 28);
      GSYNC(); }
#endif
#if (DBG & 1) || !FAST_GEMM
    { EpiInProjN E{UP, Q, Kb, V, GATES, ROPE}; d_ngemm(ldsf, H, D, W_IN_T, D, D, NPROJ, E); }
    GSYNC();
    d_ksum(Kb, KSUM);
#endif
#if DBG & 1
    { bf16 *UP2 = (bf16*)ALT, *Q2 = (bf16*)(ALT + 16 * MiB), *K2 = (bf16*)(ALT + 32 * MiB), *V2 = (bf16*)(ALT + 48 * MiB), *G2 = (bf16*)out; float* KS2 = (float*)(ws + WS_KSUM_ALT);
      pg8::Gemm g{H, W_IN_T, M, NPROJ, D, D, 0}; pg8::StaticOrder S; S.init(M, NPROJ, G, bid); EpiInProj E{UP2, Q2, K2, V2, G2, ROPE, KS2};
      pg8::gemm_phase<EpiInProj, pg8::StaticOrder, true>(lds3, g, S, E);
      GSYNC();
      d_cmp_bf16(UP2, UP, (size_t)M * 512, ldsf, DBGW + 0); d_cmp_bf16(Q2, Q, (size_t)M * 512, ldsf, DBGW + 2); d_cmp_bf16(K2, Kb, (size_t)M * 512, ldsf, DBGW + 4);
      d_cmp_bf16(V2, V, (size_t)M * 512, ldsf, DBGW + 6); d_cmp_bf16(G2, GATES, (size_t)M * 2048, ldsf, DBGW + 8); d_cmp_f32(KS2, KSUM, BATCH * NH * NBLK * HD, ldsf, DBGW + 10); }
#elif FAST_GEMM
    { pg8::Gemm g{H, W_IN_T, M, NPROJ, D, D, 0}; pg8::StaticOrder S; S.init(M, NPROJ, G, bid); EpiInProj E{UP, Q, Kb, V, GATES, ROPE, KSUM};
      pg8::gemm_phase<EpiInProj, pg8::StaticOrder, true>(lds3, g, S, E);
      if (PROBE == 7) { EpiInProj E2{UP, Q, Kb, V, GATES, ROPE, (float*)(ws + WS_KSUM_ALT)}; pg8::gemm_phase<EpiInProj, pg8::StaticOrder, true>(lds3, g, S, E2); } }
#endif
    GSYNC();
#if FAST_PRO
    pooldiff_fast(UP, DIFF);
    if (PROBE == 18) pooldiff_fast(UP, DIFF);
#else
    d_pooldiff(UP, DIFF);
#endif
#if DBG & 16
    { bf16* DC = (bf16*)ALT; d_pooldiff(UP, DC); GSYNC(); d_cmp_bf16(DIFF, DC, (size_t)M * 512, ldsf, DBGW + 30); GSYNC(); }
#endif
#if (DBG & 2) || !FAST_ATTN
    d_attn(Q, Kb, V, KSUM, ATT);
#endif
#if DBG & 2
    { bf16* ATT2 = (bf16*)ALT;
#if FAST_ATTN == 2
      GSYNC(); ATTN_SORTED(ATT2);
#else
      att::attn_phase(lds3, Q, Kb, V, KSUM, ATT2, G, bid);
#endif
      GSYNC(); d_cmp_bf16(ATT2, ATT, (size_t)M * 512, ldsf, DBGW + 18); }
#elif FAST_ATTN == 1
    att::attn_phase(lds3, Q, Kb, V, KSUM, ATT, G, bid);
    if (PROBE == 4) { __syncthreads(); att::attn_phase(lds3, Q, Kb, V, KSUM, ATT, G, bid); }
#elif FAST_ATTN == 2
    if (PROBE == 11) { att2::phase_a(lds3, Q, KSUM, (unsigned short*)((char*)out + 16 * MiB), (int*)(ws + WS_CNT + 4096), (unsigned short*)out, G, bid); }
    ATTN_SORTED(ATT);
    if (PROBE == 14) { att2::phase_b<1>(lds3, Q, Kb, V, (const int*)(ws + WS_CNT), (const unsigned short*)(ws + WS_LIST), (bf16*)(ws + WS_PO01), (bf16*)(ws + WS_PO2), (f32x2*)(ws + WS_PML), G, bid); }
    if (PROBE == 15) { att2::phase_b<2>(lds3, Q, Kb, V, (const int*)(ws + WS_CNT), (const unsigned short*)(ws + WS_LIST), (bf16*)(ws + WS_PO01), (bf16*)(ws + WS_PO2), (f32x2*)(ws + WS_PML), G, bid); }
    if (PROBE == 12) { att2::phase_b<0>(lds3, Q, Kb, V, (const int*)(ws + WS_CNT), (const unsigned short*)(ws + WS_LIST), (bf16*)(ws + WS_PO01), (bf16*)(ws + WS_PO2), (f32x2*)(ws + WS_PML), G, bid); }
    if (PROBE == 13) { att2::phase_c(lds3, Q, Kb, V, (const unsigned short*)(ws + WS_SEL), (const bf16*)(ws + WS_PO01), (const bf16*)(ws + WS_PO2), (const f32x2*)(ws + WS_PML), ATT, G, bid); }
#endif
    GSYNC();
#if (DBG & 1) || !FAST_GEMM
    { EpiMergeN E{MERGED, GATES, 0}; d_ngemm(ldsf, DIFF, 512, WC_T, 512, 512, D, E); }
    { EpiMergeN E{MERGED, GATES, 1}; d_ngemm(ldsf, ATT, 512, WBA_T, 512, 512, D, E); }
#endif
#if DBG & 1
    { bf16* MG2 = (bf16*)ALT;
      { pg8::Gemm g{DIFF, WC_T, M, D, 512, 512, 0}; pg8::StaticOrder S; S.init(M, D, G, bid); EpiMerge<0> E{MG2, GATES}; pg8::gemm_phase<EpiMerge<0>, pg8::StaticOrder, true>(lds3, g, S, E); }
      { pg8::Gemm g{ATT, WBA_T, M, D, 512, 512, 0}; pg8::StaticOrder S; S.init(M, D, G, bid); EpiMerge<1> E{MG2, GATES}; pg8::gemm_phase<EpiMerge<1>, pg8::StaticOrder, true>(lds3, g, S, E); }
      GSYNC();
      d_cmp_bf16(MG2, MERGED, (size_t)M * D, ldsf, DBGW + 12); }
#elif FAST_GEMM
    { pg8::Gemm g{DIFF, WC_T, M, D, 512, 512, 0}; pg8::StaticOrder S; S.init(M, D, G, bid); EpiMerge<0> E{MERGED, GATES}; pg8::gemm_phase<EpiMerge<0>, pg8::StaticOrder, true>(lds3, g, S, E); }
    { pg8::Gemm g{ATT, WBA_T, M, D, 512, 512, 0}; pg8::StaticOrder S; S.init(M, D, G, bid); EpiMerge<1> E{MERGED, GATES}; pg8::gemm_phase<EpiMerge<1>, pg8::StaticOrder, true>(lds3, g, S, E); }
    if (PROBE == 8) { { pg8::Gemm g{DIFF, WC_T, M, D, 512, 512, 0}; pg8::StaticOrder S; S.init(M, D, G, bid); EpiMerge<0> E{MERGED, GATES}; pg8::gemm_phase<EpiMerge<0>, pg8::StaticOrder, true>(lds3, g, S, E); }
      { pg8::Gemm g{ATT, WBA_T, M, D, 512, 512, 0}; pg8::StaticOrder S; S.init(M, D, G, bid); EpiMerge<1> E{MERGED, GATES}; pg8::gemm_phase<EpiMerge<1>, pg8::StaticOrder, true>(lds3, g, S, E); } }
#endif
    GSYNC();
#if (DBG & 1) || !FAST_GEMM
    { EpiRes1N E{x, MOD, out}; d_ngemm(ldsf, MERGED, D, WOUT_T, D, D, D, E); }
#endif
#if DBG & 1
    { float* X12 = (float*)ALT;
      pg8::Gemm g{MERGED, WOUT_T, M, D, D, D, 0}; pg8::StaticOrder S; S.init(M, D, G, bid); EpiRes1 E{x, MOD, X12}; pg8::gemm_phase<EpiRes1, pg8::StaticOrder, true>(lds3, g, S, E);
      GSYNC();
      d_cmp_f32(X12, out, (size_t)M * D, ldsf, DBGW + 14); }
#elif FAST_GEMM
    { pg8::Gemm g{MERGED, WOUT_T, M, D, D, D, 0}; pg8::StaticOrder S; S.init(M, D, G, bid); EpiRes1 E{x, MOD, out}; pg8::gemm_phase<EpiRes1, pg8::StaticOrder, true>(lds3, g, S, E);
      if (PROBE == 9) pg8::gemm_phase<EpiRes1, pg8::StaticOrder, true>(lds3, g, S, E); }
#endif
    GSYNC();
#if FAST_PRO
    fill_mtab((LAS float*)lds3, MOD, 3 * D, 4 * D); modulate_rows(out, g_ffn, (const LAS float*)lds3, H);
    if (PROBE == 17) modulate_rows(out, g_ffn, (const LAS float*)lds3, H);
#else
    d_modulate(out, g_ffn, MOD, 3 * D, 4 * D, H);
#endif
    GSYNC();
#if DBG & 16
    { bf16* HC = (bf16*)(ALT + 20 * MiB); d_modulate(out, g_ffn, MOD, 3 * D, 4 * D, HC); GSYNC(); d_cmp_bf16(H, HC, (size_t)M * D, ldsf, DBGW + 28); GSYNC(); }
#endif
#if (DBG & 1) || !FAST_GEMM
    { EpiBfN E{QP, 2048}; d_ngemm(ldsf, H, D, WQ_T, D, D, 2048, E); }
#endif
#if DBG & 1
    { bf16* QP2 = (bf16*)ALT;
      pg8::Gemm g{H, WQ_T, M, 2048, D, D, 0}; pg8::StaticOrder S; S.init(M, 2048, G, bid); EpiBf16 E{QP2, 2048}; pg8::gemm_phase<EpiBf16, pg8::StaticOrder, true>(lds3, g, S, E);
      GSYNC();
      d_cmp_bf16(QP2, QP, (size_t)M * 2048, ldsf, DBGW + 16); }
#elif FAST_GEMM
    { pg8::Gemm g{H, WQ_T, M, 2048, D, D, 0}; pg8::StaticOrder S; S.init(M, 2048, G, bid); EpiBf16 E{QP, 2048}; pg8::gemm_phase<EpiBf16, pg8::StaticOrder, true>(lds3, g, S, E);
      if (PROBE == 10) pg8::gemm_phase<EpiBf16, pg8::StaticOrder, true>(lds3, g, S, E); }
#endif
#if FAST_GEMM && FAST_ROUTE && !DBG
    asm volatile("s_waitcnt vmcnt(0)" ::: "memory"); __syncthreads();
#else
    GSYNC();
#endif
#if (DBG & 4) || !FAST_ROUTE
    d_route(ldsf, QP, SK, EID, EG);
#endif
#if DBG & 4
    { int* EID2 = (int*)(ws + 68 * MiB); float* EG2 = (float*)(ws + 76 * MiB); float* SM1 = (float*)(ws + 148 * MiB); float* SM2 = (float*)(ws + 150 * MiB);
      __syncthreads(); route_phase(lds3, QP, (const bf16*)(ws + WS_SKBD), EID2, EG2, G, bid); GSYNC();
      d_route_summary(EID, EG, SM1); d_route_summary(EID2, EG2, SM2); GSYNC(); d_cmp_f32(SM2, SM1, (size_t)M * PHEADS * 2, ldsf, DBGW + 22); }
#elif FAST_ROUTE
    route_phase(lds3, QP, (const bf16*)(ws + WS_SKBD), EID, EG, G, bid);
    if (PROBE == 6) route_phase(lds3, QP, (const bf16*)(ws + WS_SKBD), EID, EG, G, bid);
#endif
    GSYNC();
#if DBG & 8
    { float* OUT2 = (float*)(ws + WS_OUT2); PEER_CALL(out, OUT2); GSYNC();
      d_peer(H, EID, EG, Ut, Vt, MOD, g_fin, out); GSYNC(); d_cmp_f32(OUT2, out, (size_t)M * D, ldsf, DBGW + 20); }
#elif USE_FAST_PEER
    if (PROBE == 2) { PEER_CALL(out, (float*)(ws + WS_OUT2)); GSYNC(); }
    if (PROBE == 3) { for (int i = 0; i < 10; ++i) GSYNC(); }
    PEER_CALL(out, out);
#else
    d_peer(H, EID, EG, Ut, Vt, MOD, g_fin, out);
#endif
#if DBG
    GSYNC();
    { float e2 = 0.f; for (int i = 0; i < 16; ++i) { const float n = __hip_atomic_load(DBGW + 2 * i, __ATOMIC_RELAXED, __HIP_MEMORY_SCOPE_AGENT), d = __hip_atomic_load(DBGW + 2 * i + 1, __ATOMIC_RELAXED, __HIP_MEMORY_SCOPE_AGENT); if (d > 0.f) e2 += n / d; else if (n > 0.f) e2 += 1.f; }
      float dl = 10.f * sqrtf(e2); if (!(dl < 1.f)) dl = 1.f;
      GSTRIDE(i, (size_t)M * D) out[i] *= (1.f + dl); }
#endif
}

extern "C" void kernel_launch(void* const* d_in, const int* in_sizes, int n_in, void* d_out, int out_size, void* d_ws, size_t ws_size, hipStream_t stream) {
    static int grid_blocks = 0;
    if (grid_blocks == 0) {
        if (n_in != 17 || out_size != M * D || ws_size < 256 * MiB) { fprintf(stderr, "kernel_launch: unexpected shapes (n_in %d out %d ws %zu)\n", n_in, out_size, ws_size); grid_blocks = -1; return; }
        int dev = 0, cus = 0, per_cu = 0;
        (void)hipGetDevice(&dev); (void)hipDeviceGetAttribute(&cus, hipDeviceAttributeMultiprocessorCount, dev);
        (void)hipFuncSetAttribute((const void*)mega_fwd, hipFuncAttributeMaxDynamicSharedMemorySize, LDS_BYTES);
        (void)hipOccupancyMaxActiveBlocksPerMultiprocessor(&per_cu, (const void*)mega_fwd, NT, LDS_BYTES);
        if (per_cu < 1 || cus < 1) { fprintf(stderr, "kernel_launch: occupancy query says %d blocks/CU on %d CUs\n", per_cu, cus); grid_blocks = -1; return; }
        grid_blocks = cus;
    }
    if (grid_blocks < 0) return;
    (void)hipMemsetAsync((char*)d_ws + WS_CTL, 0, 1 * MiB, stream);
    Args a{};
    for (int i = 0; i < 17; ++i) a.in[i] = (const float*)d_in[i];
    a.out = (float*)d_out; a.ws = (unsigned char*)d_ws;
    void* args[] = {&a};
    hipError_t e = hipLaunchCooperativeKernel((const void*)mega_fwd, dim3(grid_blocks), dim3(NT), args, LDS_BYTES, stream);
    if (e != hipSuccess) fprintf(stderr, "cooperative launch failed: %s (grid %d)\n", hipGetErrorString(e), grid_blocks);
}
```
